# Optimizing an MI355X kernel written in HIP

```python
import jax
import jax.numpy as jnp
from jax import lax
import numpy as np

D_MODEL = 2048
BATCH = 4
SEQ = 2048
DEPTH = 1
DEC_BATCH = 128
DEC_SEQ = 1
PAST_LEN = 16384
PAGE_SIZE = 128

MIX_WIDTH = D_MODEL
POOL_WIDTH = MIX_WIDTH // 2
RWKV_WIDTH = MIX_WIDTH - POOL_WIDTH
POOL_WINDOWS = (2, 4, 8, 16)
N_POOL_GROUPS = len(POOL_WINDOWS)
POOL_GROUP = POOL_WIDTH // N_POOL_GROUPS
POOL_HIST = max(POOL_WINDOWS) - 1
HEAD_DIM = 64
N_HEADS = RWKV_WIDTH // HEAD_DIM
DECAY_RANK = 64
AAA_RANK = 64
GATE_RANK = 160
SHIFT_WIDTH = 3 * RWKV_WIDTH + DECAY_RANK + AAA_RANK + GATE_RANK
PROJ_WIDTH = POOL_WIDTH + SHIFT_WIDTH
D_FF = ((8 * D_MODEL + 3 * 256 - 1) // (3 * 256)) * 256
RMS_EPS = 1e-6
GN_EPS = 64e-5
NORM_EPS_SQ = 1e-24

kernel_name = "hymba_pool_rwkv7_step"


def rmsnorm(x, g):
    x32 = x.astype(jnp.float32)
    y = x32 * lax.rsqrt(jnp.mean(x32 * x32, axis=-1, keepdims=True) + RMS_EPS)
    return (y * g.astype(jnp.float32)).astype(x.dtype)


def pool_mixer(u, prev, start, w_pool, pool_scale):
    B, T, _ = u.shape
    full = jnp.concatenate([prev.astype(u.dtype), u], axis=1)
    cs = jnp.pad(jnp.cumsum(full.astype(jnp.float32), axis=1), ((0, 0), (1, 0), (0, 0)))
    pos = (start + jnp.arange(T)).astype(jnp.float32)
    end = POOL_HIST + 1
    means = []
    for g, w in enumerate(POOL_WINDOWS):
        c = slice(g * POOL_GROUP, (g + 1) * POOL_GROUP)
        s = cs[:, end:end + T, c] - cs[:, end - w:end - w + T, c]
        cnt = jnp.minimum(pos + 1.0, float(w))
        means.append(s / cnt[None, :, None])
    pooled = jnp.concatenate(means, axis=-1) - u.astype(jnp.float32)
    pooled = pooled.reshape(B, T, N_POOL_GROUPS, POOL_GROUP)
    out = jnp.einsum('btgc,gcd->btgd', pooled, w_pool.astype(jnp.float32))
    out = out.reshape(B, T, POOL_WIDTH) * pool_scale.astype(jnp.float32)
    return out, full[:, -POOL_HIST:]


def wkv_scan(state0, r, decay, k, v, aa, bb):
    def step(S, inp):
        r_t, w_t, k_t, v_t, a_t, b_t = inp
        Sa = jnp.einsum('bhvk,bhk->bhv', S, a_t)
        S = S * w_t[:, :, None, :] + Sa[..., None] * b_t[:, :, None, :] + v_t[..., None] * k_t[:, :, None, :]
        y = jnp.einsum('bhvk,bhk->bhv', S, r_t)
        return S, y
    xs = (jnp.moveaxis(r, 1, 0), jnp.moveaxis(decay, 1, 0), jnp.moveaxis(k, 1, 0),
          jnp.moveaxis(v, 1, 0), jnp.moveaxis(aa, 1, 0), jnp.moveaxis(bb, 1, 0))
    S, ys = lax.scan(step, state0, xs)
    return jnp.moveaxis(ys, 0, 1), S


def rwkv7_mixer(p, shift_prev, wkv_prev, mu_shift, w0, w2, a0, a2, g2, k_k, k_a, r_k, gn_w, gn_b):
    B, T, _ = p.shape
    C = RWKV_WIDTH
    f32 = jnp.float32
    p32 = p.astype(f32)
    p_prev = jnp.concatenate([shift_prev.astype(f32)[:, None, :], p32[:, :-1]], axis=1)
    pm = p32 + (p_prev - p32) * mu_shift.astype(f32)
    r = pm[..., :C]
    k = pm[..., C:2 * C]
    v = pm[..., 2 * C:3 * C]
    o = 3 * C
    wd = pm[..., o:o + DECAY_RANK]
    o = o + DECAY_RANK
    ad = pm[..., o:o + AAA_RANK]
    o = o + AAA_RANK
    gd = pm[..., o:o + GATE_RANK]
    w = -jax.nn.softplus(-(w0.astype(f32) + jnp.tanh(wd) @ w2.astype(f32))) - 0.5
    decay = jnp.exp(-jnp.exp(w))
    a = jax.nn.sigmoid(a0.astype(f32) + ad @ a2.astype(f32))
    gate = jax.nn.sigmoid(gd) @ g2.astype(f32)
    kk = (k * k_k.astype(f32)).reshape(B, T, N_HEADS, HEAD_DIM)
    kk = kk * lax.rsqrt(jnp.maximum(jnp.sum(kk * kk, axis=-1, keepdims=True), NORM_EPS_SQ))
    k = k * (1.0 + (a - 1.0) * k_a.astype(f32))
    rh = r.reshape(B, T, N_HEADS, HEAD_DIM)
    kh = k.reshape(B, T, N_HEADS, HEAD_DIM)
    vh = v.reshape(B, T, N_HEADS, HEAD_DIM)
    ah = a.reshape(B, T, N_HEADS, HEAD_DIM)
    dh = decay.reshape(B, T, N_HEADS, HEAD_DIM)
    y, wkv_new = wkv_scan(wkv_prev.astype(f32), rh, dh, kh, vh, -kk, kk * ah)
    mu = jnp.mean(y, axis=-1, keepdims=True)
    var = jnp.mean(jnp.square(y - mu), axis=-1, keepdims=True)
    yn = ((y - mu) * lax.rsqrt(var + GN_EPS)).reshape(B, T, C) * gn_w.astype(f32) + gn_b.astype(f32)
    bonus = jnp.sum(rh * kh * r_k.astype(f32), axis=-1, keepdims=True) * vh
    out = (yn + bonus.reshape(B, T, C)) * gate
    return out, p[:, -1], wkv_new


def mixer_block(x, pool_prev, shift_prev, wkv_prev, start, norm_mix, w_in, w_pool, pool_scale,
                mu_shift, w0, w2, a0, a2, g2, k_k, k_a, r_k, gn_w, gn_b, w_out):
    h = rmsnorm(x, norm_mix)
    proj = jnp.einsum('btd,de->bte', h, w_in)
    pool_out, pool_new = pool_mixer(proj[..., :POOL_WIDTH], pool_prev, start, w_pool, pool_scale)
    rwkv_out, shift_new, wkv_new = rwkv7_mixer(proj[..., POOL_WIDTH:], shift_prev, wkv_prev, mu_shift,
                                               w0, w2, a0, a2, g2, k_k, k_a, r_k, gn_w, gn_b)
    mix = jnp.concatenate([pool_out, rwkv_out], axis=-1).astype(x.dtype)
    x = x + jnp.einsum('btc,cd->btd', mix, w_out)
    return x, pool_new, shift_new, wkv_new.astype(wkv_prev.dtype)


def swiglu_ffn(x, norm_ffn, w_gate, w_up, w_down):
    h = rmsnorm(x, norm_ffn)
    u = jax.nn.silu(h @ w_gate) * (h @ w_up)
    return x + u @ w_down


def setup_inputs(seed: int = 0) -> dict:
    key = jax.random.key(seed)
    ks = list(jax.random.split(key, 32))

    def nrm(i, shape, scale):
        return scale * jax.random.normal(ks[i], shape, jnp.float32)

    C = RWKV_WIDTH
    n = jnp.arange(C, dtype=jnp.float32) / (C - 1)
    w0_base = -6.0 + 5.0 * n ** 0.85 + 0.5
    return {
        "x_prompt": nrm(0, (BATCH, SEQ, D_MODEL), 1.0),
        "x_sample": nrm(1, (DEC_BATCH, DEC_SEQ, D_MODEL), 1.0),
        "state_pool": nrm(2, (DEPTH, DEC_BATCH, POOL_HIST, POOL_WIDTH), 1.0),
        "state_shift": nrm(3, (DEPTH, DEC_BATCH, SHIFT_WIDTH), 1.0),
        "state_wkv": nrm(4, (DEPTH, DEC_BATCH, N_HEADS, HEAD_DIM, HEAD_DIM), 0.5),
        "norm_mix": 1.0 + nrm(5, (DEPTH, D_MODEL), 0.02),
        "w_in": nrm(6, (DEPTH, D_MODEL, PROJ_WIDTH), D_MODEL ** -0.5),
        "w_pool": nrm(7, (DEPTH, N_POOL_GROUPS, POOL_GROUP, POOL_GROUP), POOL_GROUP ** -0.5),
        "pool_scale": 1.0 + nrm(8, (DEPTH, POOL_WIDTH), 0.1),
        "mu_shift": jax.random.uniform(ks[9], (DEPTH, SHIFT_WIDTH), jnp.float32),
        "w0": w0_base[None, :] + nrm(10, (DEPTH, C), 0.1),
        "w2": nrm(11, (DEPTH, DECAY_RANK, C), 0.5 * DECAY_RANK ** -0.5),
        "a0": nrm(12, (DEPTH, C), 0.1),
        "a2": nrm(13, (DEPTH, AAA_RANK, C), AAA_RANK ** -0.5),
        "g2": nrm(14, (DEPTH, GATE_RANK, C), GATE_RANK ** -0.5),
        "k_k": 0.85 + nrm(15, (DEPTH, C), 0.02),
        "k_a": 1.0 + nrm(16, (DEPTH, C), 0.02),
        "r_k": nrm(17, (DEPTH, N_HEADS, HEAD_DIM), 0.1),
        "gn_w": 1.0 + nrm(18, (DEPTH, C), 0.02),
        "gn_b": nrm(19, (DEPTH, C), 0.02),
        "w_out": nrm(20, (DEPTH, MIX_WIDTH, D_MODEL), MIX_WIDTH ** -0.5),
        "norm_ffn": 1.0 + nrm(21, (DEPTH, D_MODEL), 0.02),
        "w_gate": nrm(22, (DEPTH, D_MODEL, D_FF), D_MODEL ** -0.5),
        "w_up": nrm(23, (DEPTH, D_MODEL, D_FF), D_MODEL ** -0.5),
        "w_down": nrm(24, (DEPTH, D_FF, D_MODEL), D_FF ** -0.5),
        "norm_final": 1.0 + nrm(25, (D_MODEL,), 0.02),
    }


def reference(x_prompt, x_sample, state_pool, state_shift, state_wkv, norm_mix, w_in, w_pool,
              pool_scale, mu_shift, w0, w2, a0, a2, g2, k_k, k_a, r_k, gn_w, gn_b, w_out,
              norm_ffn, w_gate, w_up, w_down, norm_final):
    def run_group(x, pool_st, shift_st, wkv_st, start):
        pools, shifts, wkvs = [], [], []
        for l in range(DEPTH):
            x, p_new, s_new, w_new = mixer_block(
                x, pool_st[l], shift_st[l], wkv_st[l], start, norm_mix[l], w_in[l], w_pool[l],
                pool_scale[l], mu_shift[l], w0[l], w2[l], a0[l], a2[l], g2[l], k_k[l], k_a[l],
                r_k[l], gn_w[l], gn_b[l], w_out[l])
            x = swiglu_ffn(x, norm_ffn[l], w_gate[l], w_up[l], w_down[l])
            pools.append(p_new)
            shifts.append(s_new)
            wkvs.append(w_new)
        return rmsnorm(x, norm_final), jnp.stack(pools), jnp.stack(shifts), jnp.stack(wkvs)

    B = x_prompt.shape[0]
    pool0 = jnp.zeros((DEPTH, B, POOL_HIST, POOL_WIDTH), x_prompt.dtype)
    shift0 = jnp.zeros((DEPTH, B, SHIFT_WIDTH), x_prompt.dtype)
    wkv0 = jnp.zeros((DEPTH, B, N_HEADS, HEAD_DIM, HEAD_DIM), state_wkv.dtype)
    y_prompt, new_pool_prompt, new_shift_prompt, new_wkv_prompt = run_group(x_prompt, pool0, shift0, wkv0, 0)
    y_sample, new_pool_sample, new_shift_sample, new_wkv_sample = run_group(
        x_sample, state_pool, state_shift, state_wkv, PAST_LEN)
    return (y_prompt, y_sample, new_pool_prompt, new_shift_prompt, new_wkv_prompt,
            new_pool_sample, new_shift_sample, new_wkv_sample)
```

```cpp
#include <hip/hip_runtime.h>
#include <hip/hip_cooperative_groups.h>
#include <cstdio>
namespace cg = cooperative_groups;

#define LAS __attribute__((address_space(3)))
typedef unsigned short bf16_t;
typedef short bf16x8 __attribute__((ext_vector_type(8)));
typedef float f32x4 __attribute__((ext_vector_type(4)));
typedef float f32x2 __attribute__((ext_vector_type(2)));
typedef unsigned u32x4 __attribute__((ext_vector_type(4)));
typedef unsigned u32x2 __attribute__((ext_vector_type(2)));

constexpr int D = 2048, TT = 2048, MPR = 8192, MSA = 128, MV = 8320, MPAD = 8448;
constexpr int PW = 1024, SW = 3360, PJ = 4384, PJP = 4608, DFF = 5632, CW = 1024, NH = 16;
constexpr int NTHR = 512, LDS_BYTES = 131072;
constexpr float RMS_EPS = 1e-6f, GN_EPS = 64e-5f;

constexpr size_t WS_WIN = 0;
constexpr size_t WS_WOUT = WS_WIN + (size_t)PJP * D * 2;
constexpr size_t WS_WGU = WS_WOUT + (size_t)D * D * 2;
constexpr size_t WS_WDN = WS_WGU + (size_t)2 * DFF * D * 2;
constexpr size_t WS_WPOOL = WS_WDN + (size_t)D * DFF * 2;
constexpr size_t WS_WLORA = WS_WPOOL + (size_t)4 * 256 * 256 * 2;
constexpr size_t WS_R1 = WS_WLORA + (size_t)3 * 1024 * 256 * 2;
constexpr size_t WS_PROJ = WS_R1 + (size_t)MPAD * D * 2;
constexpr size_t WS_A = WS_PROJ + (size_t)MPAD * PJP * 2;
constexpr size_t WS_GATE = WS_A + (size_t)MPAD * CW * 2;
constexpr size_t WS_MIX = WS_GATE + (size_t)MPAD * CW * 2;
constexpr size_t WS_ROWSQ = WS_MIX + (size_t)MPAD * D * 2;
constexpr size_t WS_BONUS = WS_ROWSQ + (size_t)2 * MPAD * 4;
constexpr size_t WS_BAR = WS_BONUS + (size_t)MV * NH * 4;
constexpr size_t WS_END = WS_BAR + 4096;
static_assert((size_t)MPAD * DFF * 2 <= (WS_MIX - WS_PROJ), "U must fit in proj+a+gate");
constexpr size_t R1_POOLED = 0, R1_L = (size_t)MPAD * PW * 2;

constexpr size_t OUT_Y = 0;
constexpr size_t OUT_POOLP = (size_t)MV * D;
constexpr size_t OUT_SHIFTP = OUT_POOLP + (size_t)4 * 15 * PW;
constexpr size_t OUT_WKVP = OUT_SHIFTP + (size_t)4 * SW;
constexpr size_t OUT_POOLS = OUT_WKVP + (size_t)4 * NH * 64 * 64;
constexpr size_t OUT_SHIFTS = OUT_POOLS + (size_t)MSA * 15 * PW;
constexpr size_t OUT_WKVS = OUT_SHIFTS + (size_t)MSA * SW;
constexpr size_t SCR_Y = 0;
constexpr size_t SCR_DEC = (size_t)MPR * CW;
static_assert(SCR_DEC + (size_t)MV * CW <= OUT_POOLP, "scratch must fit in the y region");

struct Params { const float* in[26]; float* out; unsigned char* ws; int multi; int phase; };

__device__ __forceinline__ float bf2f(unsigned b) { return __uint_as_float(b << 16); }
__device__ __forceinline__ unsigned f2bf(float f) { unsigned u = __float_as_uint(f); u += 0x7FFFu + ((u >> 16) & 1u); return u >> 16; }
__device__ __forceinline__ unsigned pk_bf16(float lo, float hi) { unsigned r; asm volatile("v_cvt_pk_bf16_f32 %0, %1, %2" : "=v"(r) : "v"(lo), "v"(hi)); return r; }
template <int CTRL> __device__ __forceinline__ float dpp(float x) { return __int_as_float(__builtin_amdgcn_update_dpp(0, __float_as_int(x), CTRL, 0xF, 0xF, true)); }
__device__ __forceinline__ float red16(float x) {
    x += dpp<0x128>(x); x += dpp<0x124>(x); x += dpp<0x4E>(x); x += dpp<0xB1>(x); return x;
}
__device__ __forceinline__ float wsum(float x) { x = red16(x); x += __shfl_xor(x, 16); x += __shfl_xor(x, 32); return x; }
__device__ __forceinline__ float sigmoidf_(float x) { return 1.0f / (1.0f + __expf(-x)); }

__device__ __forceinline__ void grid_bar(unsigned* ctr, unsigned target) {
    asm volatile("s_waitcnt vmcnt(0) lgkmcnt(0)" ::: "memory");
    __syncthreads();
    if (threadIdx.x == 0) {
        __builtin_amdgcn_fence(__ATOMIC_RELEASE, "agent");
        asm volatile("s_waitcnt vmcnt(0)" ::: "memory");
        __hip_atomic_fetch_add(ctr, 1u, __ATOMIC_RELAXED, __HIP_MEMORY_SCOPE_AGENT);
        while (__hip_atomic_load(ctr, __ATOMIC_RELAXED, __HIP_MEMORY_SCOPE_AGENT) < target) __builtin_amdgcn_s_sleep(4);
        __builtin_amdgcn_fence(__ATOMIC_ACQUIRE, "agent");
        asm volatile("s_waitcnt vmcnt(0)" ::: "memory");
    }
    __syncthreads();
}

namespace pg8 {
constexpr int BM = 256, BK = 64, HALF = 128, HTB = HALF * BK * 2, NXCD = 8, WGM = 8;
__device__ __forceinline__ int lds_byte(int r, int c) { const int st = (r >> 4) * 2 + (c >> 5), rr = r & 15, cc = c & 31, ob = rr * 64 + cc * 2; return st * 1024 + (ob ^ (((ob >> 9) & 1) << 5)); }
__device__ __forceinline__ void stage_rc(int b, int& R, int& C) { const int st = b / 1024, sb = b % 1024, swz = sb ^ (((sb >> 9) & 1) << 5); R = (st >> 1) * 16 + swz / 64; C = (st & 1) * 32 + (swz % 64) / 2; }
__device__ __forceinline__ int perm32(int rho) { const int n = rho >> 4, i = rho & 15; return 8 * (i >> 2) + 4 * n + (i & 3); }
struct Unit { int pm, pn; };
struct Gemm { const bf16_t* A; const bf16_t* Bt; int lda, ldb, K; };
struct StaticOrder {
    int nM, nN, nwg, G, c;
    __device__ void init(int M, int N, int G_, int c_) { nM = M / BM; nN = N / BM; nwg = nM * nN; G = G_; c = c_; }
    __device__ bool next(int i, Unit& u) const {
        const long L = (long)i * G + c; if (L >= nwg) return false;
        int wgid = (int)L; { const int q = nwg / NXCD, r = nwg % NXCD, xcd = wgid % NXCD, off = wgid / NXCD; wgid = (xcd < r ? xcd * (q + 1) : r * (q + 1) + (xcd - r) * q) + off; }
        const int nig = WGM * nN, gid = wgid / nig, fm = gid * WGM, gsz = (nM - fm) < WGM ? (nM - fm) : WGM;
        u.pm = fm + ((wgid % nig) % gsz); u.pn = (wgid % nig) / gsz; return true;
    }
};

template <class Epi>
__device__ __forceinline__ void gemm_phase(LAS unsigned char* lds, const Gemm g, const StaticOrder& S, const Epi& E) {
    const int tid = threadIdx.x, wid = __builtin_amdgcn_readfirstlane(tid >> 6), lane = tid & 63, wr = wid >> 2, wc = wid & 3, fr = lane & 15, fq = lane >> 4;
    const int K = g.K, nt = K / BK;
    unsigned voffA[2], voffB[2];
#pragma unroll
    for (int i = 0; i < 2; ++i) { int R, C; stage_rc(tid * 16 + i * 8192, R, C); const int Rb = Epi::PERM ? ((R & ~31) + perm32(R & 31)) : R;
        voffA[i] = (unsigned)(R * g.lda + C) * 2u; voffB[i] = (unsigned)(Rb * g.ldb + C) * 2u; }
    const size_t kstep = (size_t)(BK * 2);
    const size_t hstepA = (size_t)HALF * g.lda * 2, hstepB = (size_t)HALF * g.ldb * 2;
    const size_t tstepA = 2 * hstepA, tstepB = 2 * hstepB;
    const unsigned ldsw = (unsigned)wid * 1024u;
    const int aoff = lds_byte(wr * 64 + fr, fq * 8), boff = lds_byte(wc * 32 + fr, fq * 8);
#define PG8_SA(b, h) (((b) * 2 + (h)) * HTB)
#define PG8_SB(b, h) ((4 + (b) * 2 + (h)) * HTB)
#define PG8_STAGE(bufoff, gbase, voff) do { _Pragma("unroll") for (int _i = 0; _i < 2; ++_i) \
        __builtin_amdgcn_global_load_lds((const unsigned*)((const char*)(gbase) + (voff)[_i]), (LAS unsigned*)(lds + (bufoff) + ldsw + _i * 8192), 16, 0, 0); } while (0)
#define PG8_LDA(dst, b, h) do { _Pragma("unroll") for (int m = 0; m < 4; ++m) _Pragma("unroll") for (int k = 0; k < 2; ++k) dst[m][k] = *(const LAS bf16x8*)(lds + PG8_SA(b, h) + aoff + m * 2048 + k * 1024); } while (0)
#define PG8_LDB(dst, b, h) do { _Pragma("unroll") for (int n = 0; n < 2; ++n) _Pragma("unroll") for (int k = 0; k < 2; ++k) dst[n][k] = *(const LAS bf16x8*)(lds + PG8_SB(b, h) + boff + n * 2048 + k * 1024); } while (0)
#define PG8_MMA(ai, bj, At, Bt) do { __builtin_amdgcn_s_setprio(1); _Pragma("unroll") for (int m = 0; m < 4; ++m) _Pragma("unroll") for (int n = 0; n < 2; ++n) _Pragma("unroll") for (int k = 0; k < 2; ++k) \
        acc[ai][bj][m][n] = __builtin_amdgcn_mfma_f32_16x16x32_bf16(Bt[n][k], At[m][k], acc[ai][bj][m][n], 0, 0, 0); __builtin_amdgcn_s_setprio(0); } while (0)
#define PG8_WAIT_V(n) asm volatile("s_waitcnt vmcnt(" #n ")" ::: "memory")
#define PG8_WAIT_L(n) asm volatile("s_waitcnt lgkmcnt(" #n ")" ::: "memory")
#define PG8_BAR __builtin_amdgcn_s_barrier()
#define PG8_SCHED __builtin_amdgcn_sched_barrier(0)
    Unit cur, nxt; int ui = 0;
    if (!S.next(0, cur)) return;
    f32x4 acc[2][2][4][2];
#pragma unroll
    for (int a = 0; a < 2; ++a)
#pragma unroll
        for (int b = 0; b < 2; ++b)
#pragma unroll
            for (int m = 0; m < 4; ++m)
#pragma unroll
                for (int n = 0; n < 2; ++n) acc[a][b][m][n] = (f32x4){0.f, 0.f, 0.f, 0.f};
    bf16x8 At[4][2], B0[2][2], B1[2][2];
    const char* cA = (const char*)g.A + (size_t)cur.pm * tstepA; const char* cB = (const char*)g.Bt + (size_t)cur.pn * tstepB;
    PG8_STAGE(PG8_SB(0, 0), cB, voffB); PG8_STAGE(PG8_SA(0, 0), cA, voffA); PG8_STAGE(PG8_SB(0, 1), cB + hstepB, voffB); PG8_STAGE(PG8_SA(0, 1), cA + hstepA, voffA);
    if (wr == 1) PG8_BAR;
    PG8_WAIT_V(4); PG8_BAR;
    PG8_STAGE(PG8_SB(1, 0), cB + kstep, voffB); PG8_STAGE(PG8_SA(1, 0), cA + kstep, voffA); PG8_STAGE(PG8_SB(1, 1), cB + hstepB + kstep, voffB);
    PG8_WAIT_V(6); PG8_BAR;
    for (;;) {
        const bool has_next = S.next(ui + 1, nxt);
        const char* nA = has_next ? (const char*)g.A + (size_t)nxt.pm * tstepA : cA; const char* nB = has_next ? (const char*)g.Bt + (size_t)nxt.pn * tstepB : cB;
#pragma clang loop unroll(disable)
        for (int t = 0; t < nt; t += 2) {
            const bool last = (t == nt - 2);
            const char* a1 = cA + (size_t)(t + 1) * kstep;
            const char* a2 = last ? nA : cA + (size_t)(t + 2) * kstep; const char* b2 = last ? nB : cB + (size_t)(t + 2) * kstep;
            const char* a3 = a2 + kstep; const char* b3 = b2 + kstep;
            PG8_LDB(B0, 0, 0); PG8_SCHED; PG8_LDA(At, 0, 0); PG8_STAGE(PG8_SA(1, 1), a1 + hstepA, voffA);
            PG8_WAIT_L(8); PG8_BAR; PG8_WAIT_L(0); PG8_MMA(0, 0, At, B0); PG8_BAR; PG8_SCHED;
            PG8_LDB(B1, 0, 1); PG8_STAGE(PG8_SB(0, 0), b2, voffB);
            PG8_BAR; PG8_WAIT_L(0); PG8_MMA(0, 1, At, B1); PG8_BAR;
            PG8_LDA(At, 0, 1); PG8_STAGE(PG8_SA(0, 0), a2, voffA);
            PG8_BAR; PG8_WAIT_L(0); PG8_MMA(1, 0, At, B0); PG8_BAR; PG8_SCHED;
            PG8_STAGE(PG8_SB(0, 1), b2 + hstepB, voffB);
            PG8_WAIT_V(6); PG8_BAR; PG8_MMA(1, 1, At, B1); PG8_BAR;
            PG8_LDB(B0, 1, 0); PG8_SCHED; PG8_LDA(At, 1, 0); PG8_STAGE(PG8_SA(0, 1), a2 + hstepA, voffA);
            PG8_WAIT_L(8); PG8_BAR; PG8_WAIT_L(0); PG8_MMA(0, 0, At, B0); PG8_BAR; PG8_SCHED;
            PG8_LDB(B1, 1, 1); PG8_STAGE(PG8_SB(1, 0), b3, voffB);
            PG8_BAR; PG8_WAIT_L(0); PG8_MMA(0, 1, At, B1); PG8_BAR;
            PG8_LDA(At, 1, 1); PG8_STAGE(PG8_SA(1, 0), a3, voffA);
            PG8_BAR; PG8_WAIT_L(0); PG8_MMA(1, 0, At, B0); PG8_BAR; PG8_SCHED;
            PG8_STAGE(PG8_SB(1, 1), b3 + hstepB, voffB);
            PG8_WAIT_V(6); PG8_BAR; PG8_MMA(1, 1, At, B1); PG8_BAR;
        }
        E(acc, cur, wr, wc, fr, fq);
        if (!has_next) break;
#pragma unroll
        for (int a = 0; a < 2; ++a)
#pragma unroll
            for (int b = 0; b < 2; ++b)
#pragma unroll
                for (int m = 0; m < 4; ++m)
#pragma unroll
                    for (int n = 0; n < 2; ++n) acc[a][b][m][n] = (f32x4){0.f, 0.f, 0.f, 0.f};
        cur = nxt; cA = nA; cB = nB; ++ui;
    }
    PG8_WAIT_V(0);
    if (wr == 0) PG8_BAR;
    PG8_BAR;
#undef PG8_SA
#undef PG8_SB
#undef PG8_STAGE
#undef PG8_LDA
#undef PG8_LDB
#undef PG8_MMA
#undef PG8_WAIT_V
#undef PG8_WAIT_L
#undef PG8_BAR
#undef PG8_SCHED
}
}
using pg8::Unit;

template <int MODE> struct EpiBf16 {
    static constexpr bool PERM = true;
    bf16_t* O; int ldc; int coff; const float* vec;
    __device__ __forceinline__ void operator()(const f32x4 (&acc)[2][2][4][2], const Unit& u, int wr, int wc, int fr, int fq) const {
        const int row0 = u.pm * 256 + wr * 64 + fr, col0 = coff + u.pn * 256 + wc * 32 + 8 * fq;
#pragma unroll
        for (int bj = 0; bj < 2; ++bj) {
            const int c = col0 + bj * 128;
            f32x4 s0, s1;
            if (MODE == 0) { s0 = vec ? *(const f32x4*)(vec + c) : (f32x4){1.f, 1.f, 1.f, 1.f}; s1 = vec ? *(const f32x4*)(vec + c + 4) : (f32x4){1.f, 1.f, 1.f, 1.f}; }
            else { s0 = *(const f32x4*)(vec + c); s1 = *(const f32x4*)(vec + c + 4); }
#pragma unroll
            for (int ai = 0; ai < 2; ++ai)
#pragma unroll
                for (int m = 0; m < 4; ++m) {
                    f32x4 v0 = acc[ai][bj][m][0], v1 = acc[ai][bj][m][1];
                    if (MODE == 0) { v0 = v0 * s0; v1 = v1 * s1; }
                    else {
#pragma unroll
                        for (int j = 0; j < 4; ++j) { v0[j] = sigmoidf_(v0[j] + s0[j]); v1[j] = sigmoidf_(v1[j] + s1[j]); } }
                    u32x4 w; w.x = pk_bf16(v0[0], v0[1]); w.y = pk_bf16(v0[2], v0[3]); w.z = pk_bf16(v1[0], v1[1]); w.w = pk_bf16(v1[2], v1[3]);
                    *(u32x4*)(O + (size_t)(row0 + ai * 128 + m * 16) * ldc + c) = w;
                }
        }
    }
};
struct EpiDecay {
    static constexpr bool PERM = false;
    float* O; const float* w0;
    __device__ __forceinline__ void operator()(const f32x4 (&acc)[2][2][4][2], const Unit& u, int wr, int wc, int fr, int fq) const {
        const int row0 = u.pm * 256 + wr * 64 + fr, col0 = u.pn * 256 + wc * 32 + 4 * fq;
#pragma unroll
        for (int bj = 0; bj < 2; ++bj)
#pragma unroll
            for (int n = 0; n < 2; ++n) {
                const int c = col0 + bj * 128 + n * 16; const f32x4 b = *(const f32x4*)(w0 + c);
#pragma unroll
                for (int ai = 0; ai < 2; ++ai)
#pragma unroll
                    for (int m = 0; m < 4; ++m) {
                        const int row = row0 + ai * 128 + m * 16; f32x4 v = acc[ai][bj][m][n] + b, o;
#pragma unroll
                        for (int j = 0; j < 4; ++j) { const float z = -v[j]; const float sp = fmaxf(z, 0.f) + __logf(1.0f + __expf(-fabsf(z))); o[j] = __expf(-__expf(-sp - 0.5f)); }
                        if (row < MV) *(f32x4*)(O + (size_t)row * CW + c) = o;
                    }
            }
    }
};
struct EpiOut {
    static constexpr bool PERM = false;
    const float* xp; const float* xs; float* out; bf16_t* h2; const float* g; float* rowsq;
    __device__ __forceinline__ void operator()(const f32x4 (&acc)[2][2][4][2], const Unit& u, int wr, int wc, int fr, int fq) const {
        const int row0 = u.pm * 256 + wr * 64 + fr, col0 = u.pn * 256 + wc * 32 + 4 * fq;
#pragma unroll
        for (int ai = 0; ai < 2; ++ai)
#pragma unroll
            for (int m = 0; m < 4; ++m) {
                const int row = row0 + ai * 128 + m * 16; const bool ok = row < MV;
                const float* xr = row < MPR ? xp + (size_t)row * D : xs + (size_t)(ok ? row - MPR : 0) * D;
                float s = 0.f;
#pragma unroll
                for (int bj = 0; bj < 2; ++bj)
#pragma unroll
                    for (int n = 0; n < 2; ++n) {
                        const int c = col0 + bj * 128 + n * 16;
                        f32x4 x1 = acc[ai][bj][m][n];
                        if (ok) { x1 = x1 + *(const f32x4*)(xr + c); *(f32x4*)(out + (size_t)row * D + c) = x1; }
                        s += (x1[0] * x1[0] + x1[1] * x1[1]) + (x1[2] * x1[2] + x1[3] * x1[3]);
                        const f32x4 gg = *(const f32x4*)(g + c); const f32x4 hv = x1 * gg;
                        u32x2 w; w.x = pk_bf16(hv[0], hv[1]); w.y = pk_bf16(hv[2], hv[3]);
                        *(u32x2*)(h2 + (size_t)row * D + c) = w;
                    }
                s += __shfl_xor(s, 16); s += __shfl_xor(s, 32);
                if (ok && fq == 0) unsafeAtomicAdd(rowsq + row, s);
            }
    }
};
struct EpiGU {
    static constexpr bool PERM = true;
    bf16_t* U; const float* rowsq;
    __device__ __forceinline__ void operator()(const f32x4 (&acc)[2][2][4][2], const Unit& u, int wr, int wc, int fr, int fq) const {
        const int row0 = u.pm * 256 + wr * 64 + fr, col0 = u.pn * 128 + wc * 32 + 8 * fq;
#pragma unroll
        for (int ai = 0; ai < 2; ++ai)
#pragma unroll
            for (int m = 0; m < 4; ++m) {
                const int row = row0 + ai * 128 + m * 16;
                const float rstd = rsqrtf(rowsq[row] * (1.0f / D) + RMS_EPS);
                f32x4 o[2];
#pragma unroll
                for (int n = 0; n < 2; ++n)
#pragma unroll
                    for (int j = 0; j < 4; ++j) { const float gt = acc[ai][0][m][n][j] * rstd, up = acc[ai][1][m][n][j] * rstd; o[n][j] = gt * sigmoidf_(gt) * up; }
                u32x4 w; w.x = pk_bf16(o[0][0], o[0][1]); w.y = pk_bf16(o[0][2], o[0][3]); w.z = pk_bf16(o[1][0], o[1][1]); w.w = pk_bf16(o[1][2], o[1][3]);
                *(u32x4*)(U + (size_t)row * DFF + col0) = w;
            }
    }
};
struct EpiDown {
    static constexpr bool PERM = false;
    float* out; float* rowsq;
    __device__ __forceinline__ void operator()(const f32x4 (&acc)[2][2][4][2], const Unit& u, int wr, int wc, int fr, int fq) const {
        const int row0 = u.pm * 256 + wr * 64 + fr, col0 = u.pn * 256 + wc * 32 + 4 * fq;
#pragma unroll
        for (int ai = 0; ai < 2; ++ai)
#pragma unroll
            for (int m = 0; m < 4; ++m) {
                const int row = row0 + ai * 128 + m * 16; const bool ok = row < MV;
                float s = 0.f;
                if (ok) {
#pragma unroll
                    for (int bj = 0; bj < 2; ++bj)
#pragma unroll
                        for (int n = 0; n < 2; ++n) {
                            const int c = col0 + bj * 128 + n * 16; float* p = out + (size_t)row * D + c;
                            const f32x4 x2 = acc[ai][bj][m][n] + *(const f32x4*)p; *(f32x4*)p = x2;
                            s += (x2[0] * x2[0] + x2[1] * x2[1]) + (x2[2] * x2[2] + x2[3] * x2[3]);
                        }
                }
                s += __shfl_xor(s, 16); s += __shfl_xor(s, 32);
                if (ok && fq == 0) unsafeAtomicAdd(rowsq + row, s);
            }
    }
};

template <int RM> __device__ __forceinline__ int rowmap(int n) { return RM == 0 ? n : (RM == 1 ? ((n >> 7) * 256 + (n & 127)) : ((n >> 7) * 256 + 128 + (n & 127))); }
template <int RM>
__device__ void transpose_bf16(LAS float* tile, const float* src, int Ksrc, int Nsrc, int ld, bf16_t* dst, int Kdst, int Ndst, int rot) {
    const int tid = threadIdx.x, G = gridDim.x;
    const int nk = Kdst / 64, nn = Ndst / 64, ntile = nk * nn;
    for (int t = (blockIdx.x + rot) % G; t < ntile; t += G) {
        const int k0 = (t % nk) * 64, n0 = (t / nk) * 64;
        {
            const int kk = tid >> 4, n4 = (tid & 15) * 4;
#pragma unroll
            for (int i = 0; i < 2; ++i) {
                const int k = kk + 32 * i, gk = k0 + k, gn = n0 + n4;
                f32x4 v = (f32x4){0.f, 0.f, 0.f, 0.f};
                if (gk < Ksrc && gn < Nsrc) v = *(const f32x4*)(src + (size_t)gk * ld + gn);
                tile[k * 65 + n4 + 0] = v[0]; tile[k * 65 + n4 + 1] = v[1]; tile[k * 65 + n4 + 2] = v[2]; tile[k * 65 + n4 + 3] = v[3];
            }
        }
        __syncthreads();
        {
            const int n = tid >> 3, k8 = (tid & 7) * 8;
            float v[8];
#pragma unroll
            for (int j = 0; j < 8; ++j) v[j] = tile[(k8 + j) * 65 + n];
            u32x4 w; w.x = pk_bf16(v[0], v[1]); w.y = pk_bf16(v[2], v[3]); w.z = pk_bf16(v[4], v[5]); w.w = pk_bf16(v[6], v[7]);
            *(u32x4*)(dst + (size_t)rowmap<RM>(n0 + n) * Kdst + k0 + k8) = w;
        }
        __syncthreads();
    }
}

template <int W>
__device__ __forceinline__ void pool_block_prompt(const bf16_t* proj, bf16_t* pooled, int b, int t0, int c) {
    float ux[15 + W], uy[15 + W];
#pragma unroll
    for (int j = 0; j < 15 + W; ++j) {
        const int t = t0 - (W - 1) + j;
        if (t >= 0) { const unsigned v = *(const unsigned*)(proj + (size_t)(b * TT + t) * PJP + c); ux[j] = bf2f(v & 0xffffu); uy[j] = bf2f(v >> 16); }
        else { ux[j] = 0.f; uy[j] = 0.f; }
    }
#pragma unroll
    for (int i = 0; i < 16; ++i) {
        const int t = t0 + i; float sx = 0.f, sy = 0.f;
#pragma unroll
        for (int j = 0; j < W; ++j) { sx += ux[i + j]; sy += uy[i + j]; }
        const float inv = 1.0f / (float)(t + 1 < W ? t + 1 : W);
        const float px = sx * inv - ux[i + W - 1], py = sy * inv - uy[i + W - 1];
        *(unsigned*)(pooled + (size_t)(b * TT + t) * PW + c) = pk_bf16(px, py);
    }
}

__global__ void __launch_bounds__(NTHR) hymba_fwd(Params P) {
    extern __shared__ __attribute__((aligned(16))) unsigned char lds_raw[];
    LAS unsigned char* lds = (LAS unsigned char*)lds_raw;
    const int tid = threadIdx.x, lane = tid & 63, wave = tid >> 6, G = gridDim.x, bid = blockIdx.x;
    const int gtid = bid * NTHR + tid, gthreads = G * NTHR, gwave = bid * 8 + wave, gwaves = G * 8;
    unsigned char* ws = P.ws; float* out = P.out;
    const float* x_prompt = P.in[0]; const float* x_sample = P.in[1]; const float* state_pool = P.in[2]; const float* state_shift = P.in[3]; const float* state_wkv = P.in[4];
    const float* norm_mix = P.in[5]; const float* w_in = P.in[6]; const float* w_pool = P.in[7]; const float* pool_scale = P.in[8]; const float* mu_shift = P.in[9];
    const float* w0 = P.in[10]; const float* w2 = P.in[11]; const float* a0 = P.in[12]; const float* a2 = P.in[13]; const float* g2 = P.in[14];
    const float* k_k = P.in[15]; const float* k_a = P.in[16]; const float* r_k = P.in[17]; const float* gn_w = P.in[18]; const float* gn_b = P.in[19];
    const float* w_out = P.in[20]; const float* norm_ffn = P.in[21]; const float* w_gate = P.in[22]; const float* w_up = P.in[23]; const float* w_down = P.in[24]; const float* norm_final = P.in[25];
    bf16_t* WinT = (bf16_t*)(ws + WS_WIN); bf16_t* WoutT = (bf16_t*)(ws + WS_WOUT); bf16_t* WguT = (bf16_t*)(ws + WS_WGU); bf16_t* WdnT = (bf16_t*)(ws + WS_WDN);
    bf16_t* WpoolT = (bf16_t*)(ws + WS_WPOOL); bf16_t* WloraT = (bf16_t*)(ws + WS_WLORA);
    bf16_t* Hb = (bf16_t*)(ws + WS_R1); bf16_t* Pooled = (bf16_t*)(ws + WS_R1 + R1_POOLED); bf16_t* Lb = (bf16_t*)(ws + WS_R1 + R1_L); bf16_t* H2 = (bf16_t*)(ws + WS_R1);
    bf16_t* Proj = (bf16_t*)(ws + WS_PROJ); bf16_t* Ub = (bf16_t*)(ws + WS_PROJ); bf16_t* Ab = (bf16_t*)(ws + WS_A); bf16_t* Gb = (bf16_t*)(ws + WS_GATE);
    bf16_t* Mix = (bf16_t*)(ws + WS_MIX); float* rowsq1 = (float*)(ws + WS_ROWSQ); float* rowsq2 = rowsq1 + MPAD; float* Bonus = (float*)(ws + WS_BONUS);
    unsigned* barctr = (unsigned*)(ws + WS_BAR);
    float* Yb = out + SCR_Y; float* Dec = out + SCR_DEC;
    unsigned nbar = 0;
#ifndef P3SEL
#define P3SEL 15
#endif
#ifndef PHASE_MASK
#define PHASE_MASK 0x3ff
#endif
#define IN(k) (((PHASE_MASK >> (k)) & 1) && (!P.multi || P.phase == (k)))
#define SEAM() do { if (!P.multi) { ++nbar; grid_bar(barctr, nbar * (unsigned)G); } } while (0)

    if (IN(0)) {
        LAS float* tile = (LAS float*)lds;
        transpose_bf16<0>(tile, w_in, D, PJ, PJ, WinT, D, PJP, 0);
        transpose_bf16<0>(tile, w_out, D, D, D, WoutT, D, D, 64);
        transpose_bf16<1>(tile, w_gate, D, DFF, DFF, WguT, D, DFF, 0);
        transpose_bf16<2>(tile, w_up, D, DFF, DFF, WguT, D, DFF, 0);
        transpose_bf16<0>(tile, w_down, DFF, D, D, WdnT, DFF, D, 0);
        for (int g = 0; g < 4; ++g) transpose_bf16<0>(tile, w_pool + (size_t)g * 65536, 256, 256, 256, WpoolT + (size_t)g * 65536, 256, 256, 64 + g * 16);
        transpose_bf16<0>(tile, w2, 64, CW, CW, WloraT, 256, CW, 128);
        transpose_bf16<0>(tile, a2, 64, CW, CW, WloraT + (size_t)CW * 256, 256, CW, 192);
        transpose_bf16<0>(tile, g2, 160, CW, CW, WloraT + (size_t)2 * CW * 256, 256, CW, 0);
        for (int i = gtid; i < 2 * MPAD; i += gthreads) rowsq1[i] = 0.f;
        for (int m = gwave; m < MPAD; m += gwaves) {
            bf16_t* hr = Hb + (size_t)m * D;
            if (m < MV) {
                const float* xr = m < MPR ? x_prompt + (size_t)m * D : x_sample + (size_t)(m - MPR) * D;
                f32x4 v[8]; float s = 0.f;
#pragma unroll
                for (int i = 0; i < 8; ++i) { v[i] = *(const f32x4*)(xr + (i * 64 + lane) * 4); s += (v[i][0] * v[i][0] + v[i][1] * v[i][1]) + (v[i][2] * v[i][2] + v[i][3] * v[i][3]); }
                s = wsum(s); const float rstd = rsqrtf(s * (1.0f / D) + RMS_EPS);
#pragma unroll
                for (int i = 0; i < 8; ++i) { const int c = (i * 64 + lane) * 4; const f32x4 gg = *(const f32x4*)(norm_mix + c); const f32x4 o = v[i] * rstd * gg;
                    u32x2 w; w.x = pk_bf16(o[0], o[1]); w.y = pk_bf16(o[2], o[3]); *(u32x2*)(hr + c) = w; }
            } else {
#pragma unroll
                for (int i = 0; i < 8; ++i) *(u32x2*)(hr + (i * 64 + lane) * 4) = (u32x2){0u, 0u};
            }
        }
    }
    if (!P.multi) { cg::this_grid().sync(); }

    if (IN(1)) {
        pg8::Gemm g{Hb, WinT, D, D, D}; pg8::StaticOrder S; S.init(MPAD, PJP, G, bid);
        EpiBf16<0> E{Proj, PJP, 0, nullptr};
        pg8::gemm_phase(lds, g, S, E);
    }
    SEAM();

    if (IN(2)) {
        for (int rb = bid; rb < MPR / 16; rb += G) {
            const int b = rb >> 7, t0 = (rb & 127) * 16, c = tid * 2, gq = tid >> 7;
            if (gq == 0) pool_block_prompt<2>(Proj, Pooled, b, t0, c);
            else if (gq == 1) pool_block_prompt<4>(Proj, Pooled, b, t0, c);
            else if (gq == 2) pool_block_prompt<8>(Proj, Pooled, b, t0, c);
            else pool_block_prompt<16>(Proj, Pooled, b, t0, c);
        }
        for (int b = bid; b < MSA; b += G) {
            const int c = tid * 2, W = 2 << (tid >> 7);
            const unsigned v = *(const unsigned*)(Proj + (size_t)(MPR + b) * PJP + c); const float ux = bf2f(v & 0xffffu), uy = bf2f(v >> 16);
            float sx = ux, sy = uy;
            for (int j = 1; j < W; ++j) { const f32x2 p = *(const f32x2*)(state_pool + ((size_t)b * 15 + 15 - j) * PW + c); sx += p[0]; sy += p[1]; }
            const float inv = 1.0f / (float)W;
            *(unsigned*)(Pooled + (size_t)(MPR + b) * PW + c) = pk_bf16(sx * inv - ux, sy * inv - uy);
            float* np = out + OUT_POOLS + (size_t)b * 15 * PW;
            for (int j = 0; j < 14; ++j) *(f32x2*)(np + (size_t)j * PW + c) = *(const f32x2*)(state_pool + ((size_t)b * 15 + j + 1) * PW + c);
            *(f32x2*)(np + (size_t)14 * PW + c) = (f32x2){ux, uy};
        }
        for (int idx = gtid; idx < MPAD * 384; idx += gthreads) {
            const int m = idx / 384, cp = (idx - m * 384) * 2, seg = cp >> 8, j = cp & 255, lim = seg == 2 ? 160 : 64;
            unsigned o = 0u;
            if (m < MV && j < lim) {
                const int pc = (seg == 0 ? 3072 : (seg == 1 ? 3136 : 3200)) + j;
                const unsigned cv = *(const unsigned*)(Proj + (size_t)m * PJP + PW + pc); const float cx = bf2f(cv & 0xffffu), cy = bf2f(cv >> 16);
                float px = 0.f, py = 0.f;
                if (m >= MPR) { const f32x2 p = *(const f32x2*)(state_shift + (size_t)(m - MPR) * SW + pc); px = p[0]; py = p[1]; }
                else if ((m & (TT - 1)) != 0) { const unsigned pv = *(const unsigned*)(Proj + (size_t)(m - 1) * PJP + PW + pc); px = bf2f(pv & 0xffffu); py = bf2f(pv >> 16); }
                const f32x2 mu = *(const f32x2*)(mu_shift + pc);
                float vx = cx + (px - cx) * mu[0], vy = cy + (py - cy) * mu[1];
                if (seg == 0) { vx = tanhf(vx); vy = tanhf(vy); } else if (seg == 2) { vx = sigmoidf_(vx); vy = sigmoidf_(vy); }
                o = pk_bf16(vx, vy);
            }
            *(unsigned*)(Lb + (size_t)m * 768 + cp) = o;
        }
        for (int i = gtid; i < 4 * SW; i += gthreads) { const int b = i / SW, j = i - b * SW; out[OUT_SHIFTP + i] = bf2f(Proj[(size_t)(b * TT + TT - 1) * PJP + PW + j]); }
        for (int i = gtid; i < MSA * SW; i += gthreads) { const int b = i / SW, j = i - b * SW; out[OUT_SHIFTS + i] = bf2f(Proj[(size_t)(MPR + b) * PJP + PW + j]); }
        for (int i = gtid; i < 4 * 15 * PW; i += gthreads) { const int b = i / (15 * PW), r = i - b * 15 * PW, j = r / PW, c = r - j * PW; out[OUT_POOLP + i] = bf2f(Proj[(size_t)(b * TT + TT - 15 + j) * PJP + c]); }
    }
    SEAM();

    if (IN(3)) {
#if P3SEL & 1
        for (int g4 = 0; g4 < 4; ++g4) {
            pg8::Gemm g{Pooled + g4 * 256, WpoolT + (size_t)g4 * 65536, PW, 256, 256}; pg8::StaticOrder S; S.init(MPAD, 256, G, (bid + G - (g4 * 33) % G) % G);
            EpiBf16<0> E{Mix, D, g4 * 256, pool_scale};
            pg8::gemm_phase(lds, g, S, E);
        }
#endif
#if P3SEL & 2
        { pg8::Gemm g{Lb, WloraT, 768, 256, 256}; pg8::StaticOrder S; S.init(MPAD, CW, G, (bid + G - 132 % G) % G);
          EpiDecay E{Dec, w0}; pg8::gemm_phase(lds, g, S, E); }
#endif
#if P3SEL & 4
        { pg8::Gemm g{Lb + 256, WloraT + (size_t)CW * 256, 768, 256, 256}; pg8::StaticOrder S; S.init(MPAD, CW, G, (bid + G - 8 % G) % G);
          EpiBf16<1> E{Ab, CW, 0, a0}; pg8::gemm_phase(lds, g, S, E); }
#endif
#if P3SEL & 8
        { pg8::Gemm g{Lb + 512, WloraT + (size_t)2 * CW * 256, 768, 256, 256}; pg8::StaticOrder S; S.init(MPAD, CW, G, (bid + G - 140 % G) % G);
          EpiBf16<0> E{Gb, CW, 0, nullptr}; pg8::gemm_phase(lds, g, S, E); }
#endif
    }
    SEAM();

    if (IN(4)) {
        LAS float* ldf = (LAS float*)lds;
        constexpr int REC = 392, TB = 32;
        for (int unit = bid; unit < 256; unit += G) {
            const int s = unit >> 2, b = s >> 4, h = s & 15, q = unit & 3;
            const bool consumer = wave < 4;
            const int crow = (tid & 255) >> 4, kq = tid & 15;
            float S0 = 0.f, S1 = 0.f, S2 = 0.f, S3 = 0.f;
            const int pw = wave - 4, ch = h * 64 + lane;
            float c_kk = 0.f, c_ka = 0.f, c_rk = 0.f, mu_r = 0.f, mu_k = 0.f, mu_v = 0.f;
            if (!consumer) { c_kk = k_k[ch]; c_ka = k_a[ch]; c_rk = r_k[ch]; mu_r = mu_shift[ch]; mu_k = mu_shift[CW + ch]; mu_v = mu_shift[2 * CW + ch]; }
            float rr[9], kr_[9], vr[9], dd[8], aa[8];
#define SCAN_LOAD(blk) do { const int t0_ = (blk) * TB + pw * 8; \
            _Pragma("unroll") for (int i_ = 0; i_ < 9; ++i_) { const int t_ = t0_ - 1 + i_; \
                if (t_ >= 0) { const bf16_t* pp_ = Proj + (size_t)(b * TT + t_) * PJP + PW + ch; rr[i_] = bf2f(pp_[0]); kr_[i_] = bf2f(pp_[CW]); vr[i_] = bf2f(pp_[2 * CW]); } \
                else { rr[i_] = 0.f; kr_[i_] = 0.f; vr[i_] = 0.f; } } \
            _Pragma("unroll") for (int i_ = 0; i_ < 8; ++i_) { const size_t mi_ = (size_t)(b * TT + t0_ + i_) * CW + ch; dd[i_] = Dec[mi_]; aa[i_] = bf2f(Ab[mi_]); } } while (0)
#define SCAN_PRODUCE(blk) do { LAS float* bufp_ = ldf + ((blk) & 1) * (TB * REC); const int t0_ = (blk) * TB + pw * 8; \
            _Pragma("unroll") for (int i_ = 0; i_ < 8; ++i_) { \
                const float r_ = rr[i_ + 1] + (rr[i_] - rr[i_ + 1]) * mu_r, k_ = kr_[i_ + 1] + (kr_[i_] - kr_[i_ + 1]) * mu_k, v_ = vr[i_ + 1] + (vr[i_] - vr[i_ + 1]) * mu_v; \
                const float a_ = aa[i_], d_ = dd[i_]; \
                const float kkr_ = k_ * c_kk; const float n2_ = wsum(kkr_ * kkr_); const float kk_ = kkr_ * rsqrtf(fmaxf(n2_, 1e-24f)); \
                const float kt_ = k_ * (1.0f + (a_ - 1.0f) * c_ka); const float bv_ = kk_ * a_; \
                const float br_ = wsum(bv_ * r_), krs_ = wsum(kt_ * r_), bon_ = wsum(r_ * kt_ * c_rk); \
                LAS float* rec_ = bufp_ + (pw * 8 + i_) * REC; \
                rec_[lane] = -kk_; rec_[64 + lane] = bv_; rec_[128 + lane] = d_; rec_[192 + lane] = kt_; rec_[256 + lane] = d_ * r_; rec_[320 + lane] = v_; \
                if (lane == 0) { rec_[384] = br_; rec_[385] = krs_; if (q == 0) Bonus[(size_t)(b * TT + t0_ + i_) * NH + h] = bon_; } } } while (0)
            if (!consumer) { SCAN_LOAD(0); SCAN_PRODUCE(0); SCAN_LOAD(1); }
            __syncthreads();
            for (int blk = 0; blk < TT / TB; ++blk) {
                if (consumer) {
                    const LAS float* bufc = ldf + (blk & 1) * (TB * REC);
                    float* yp = Yb + (size_t)(b * TT + blk * TB) * CW + h * 64 + q * 16 + crow;
#pragma unroll 4
                    for (int st = 0; st < TB; ++st) {
                        const LAS float* rec = bufc + st * REC;
                        const f32x4 av = *(const LAS f32x4*)(rec + kq * 4), bv = *(const LAS f32x4*)(rec + 64 + kq * 4), dw = *(const LAS f32x4*)(rec + 128 + kq * 4);
                        const f32x4 kt = *(const LAS f32x4*)(rec + 192 + kq * 4), wrv = *(const LAS f32x4*)(rec + 256 + kq * 4);
                        const float vv = rec[320 + q * 16 + crow]; const f32x2 sc = *(const LAS f32x2*)(rec + 384);
                        float da = (S0 * av[0] + S1 * av[1]) + (S2 * av[2] + S3 * av[3]);
                        float dy = (S0 * wrv[0] + S1 * wrv[1]) + (S2 * wrv[2] + S3 * wrv[3]);
                        da = red16(da); dy = red16(dy);
                        const float y = dy + da * sc[0] + vv * sc[1];
                        S0 = S0 * dw[0] + da * bv[0] + vv * kt[0]; S1 = S1 * dw[1] + da * bv[1] + vv * kt[1];
                        S2 = S2 * dw[2] + da * bv[2] + vv * kt[2]; S3 = S3 * dw[3] + da * bv[3] + vv * kt[3];
                        if (kq == 0) yp[(size_t)st * CW] = y;
                    }
                } else {
                    if (blk + 1 < TT / TB) { SCAN_PRODUCE(blk + 1); if (blk + 2 < TT / TB) SCAN_LOAD(blk + 2); }
                }
                __syncthreads();
            }
            if (consumer) *(f32x4*)(out + OUT_WKVP + ((size_t)(b * NH + h) * 64 + q * 16 + crow) * 64 + kq * 4) = (f32x4){S0, S1, S2, S3};
#undef SCAN_LOAD
#undef SCAN_PRODUCE
        }
        __syncthreads();
        LAS float* wl = ldf + wave * 512;
        for (int p = gwave; p < MSA * NH; p += gwaves) {
            const int b = p >> 4, h = p & 15, m = MPR + b, ch = h * 64 + lane;
            const bf16_t* pp = Proj + (size_t)m * PJP + PW + ch; const float* sp = state_shift + (size_t)b * SW + ch;
            const float rc = bf2f(pp[0]), kc = bf2f(pp[CW]), vc = bf2f(pp[2 * CW]);
            const float r = rc + (sp[0] - rc) * mu_shift[ch], k = kc + (sp[CW] - kc) * mu_shift[CW + ch], v = vc + (sp[2 * CW] - vc) * mu_shift[2 * CW + ch];
            const float d = Dec[(size_t)m * CW + ch], a = bf2f(Ab[(size_t)m * CW + ch]);
            const float kkr = k * k_k[ch]; const float n2 = wsum(kkr * kkr); const float kk = kkr * rsqrtf(fmaxf(n2, 1e-24f));
            const float kt = k * (1.0f + (a - 1.0f) * k_a[ch]);
            const float bon = wsum(r * kt * r_k[ch]);
            wl[lane] = -kk; wl[64 + lane] = kk * a; wl[128 + lane] = d; wl[192 + lane] = kt; wl[256 + lane] = r; wl[320 + lane] = v;
            asm volatile("s_waitcnt lgkmcnt(0)" ::: "memory");
            const int kq = lane & 15, r4 = lane >> 4;
            const f32x4 av = *(const LAS f32x4*)(wl + kq * 4), bv = *(const LAS f32x4*)(wl + 64 + kq * 4), dw = *(const LAS f32x4*)(wl + 128 + kq * 4);
            const f32x4 ktv = *(const LAS f32x4*)(wl + 192 + kq * 4), rv = *(const LAS f32x4*)(wl + 256 + kq * 4);
            const float* sin_ = state_wkv + (size_t)(b * NH + h) * 4096; float* sout = out + OUT_WKVS + (size_t)(b * NH + h) * 4096;
#pragma unroll 4
            for (int j = 0; j < 16; ++j) {
                const int row = r4 + 4 * j; f32x4 Sv = *(const f32x4*)(sin_ + row * 64 + kq * 4);
                float da = (Sv[0] * av[0] + Sv[1] * av[1]) + (Sv[2] * av[2] + Sv[3] * av[3]); da = red16(da);
                const float vv = wl[320 + row];
                Sv = Sv * dw + da * bv + vv * ktv;
                *(f32x4*)(sout + row * 64 + kq * 4) = Sv;
                float dy = (Sv[0] * rv[0] + Sv[1] * rv[1]) + (Sv[2] * rv[2] + Sv[3] * rv[3]); dy = red16(dy);
                if (kq == 0) wl[384 + row] = dy;
            }
            asm volatile("s_waitcnt lgkmcnt(0)" ::: "memory");
            const float y = wl[384 + lane];
            const float mean = wsum(y) * (1.0f / 64.0f); const float dl = y - mean; const float var = wsum(dl * dl) * (1.0f / 64.0f);
            const float yn = dl * rsqrtf(var + GN_EPS) * gn_w[ch] + gn_b[ch];
            const float o = (yn + bon * v) * bf2f(Gb[(size_t)m * CW + ch]);
            Mix[(size_t)m * D + PW + ch] = (bf16_t)f2bf(o);
            asm volatile("s_waitcnt lgkmcnt(0)" ::: "memory");
        }
    }
    SEAM();

    if (IN(5)) {
        for (int p = gwave; p < MPR * NH; p += gwaves) {
            const int m = p >> 4, h = p & 15, ch = h * 64 + lane;
            const float y = Yb[(size_t)m * CW + ch];
            const float mean = wsum(y) * (1.0f / 64.0f); const float dl = y - mean; const float var = wsum(dl * dl) * (1.0f / 64.0f);
            const float yn = dl * rsqrtf(var + GN_EPS) * gn_w[ch] + gn_b[ch];
            const float vc = bf2f(Proj[(size_t)m * PJP + PW + 2 * CW + ch]);
            const float vp = (m & (TT - 1)) ? bf2f(Proj[(size_t)(m - 1) * PJP + PW + 2 * CW + ch]) : 0.f;
            const float v = vc + (vp - vc) * mu_shift[2 * CW + ch];
            const float o = (yn + Bonus[(size_t)m * NH + h] * v) * bf2f(Gb[(size_t)m * CW + ch]);
            Mix[(size_t)m * D + PW + ch] = (bf16_t)f2bf(o);
        }
    }
    SEAM();

    if (IN(6)) {
        pg8::Gemm g{Mix, WoutT, D, D, D}; pg8::StaticOrder S; S.init(MPAD, D, G, bid);
        EpiOut E{x_prompt, x_sample, out, H2, norm_ffn, rowsq1};
        pg8::gemm_phase(lds, g, S, E);
    }
    SEAM();

    if (IN(7)) {
        pg8::Gemm g{H2, WguT, D, D, D}; pg8::StaticOrder S; S.init(MPAD, 2 * DFF, G, bid);
        EpiGU E{Ub, rowsq1};
        pg8::gemm_phase(lds, g, S, E);
    }
    SEAM();

    if (IN(8)) {
        pg8::Gemm g{Ub, WdnT, DFF, DFF, DFF}; pg8::StaticOrder S; S.init(MPAD, D, G, bid);
        EpiDown E{out, rowsq2};
        pg8::gemm_phase(lds, g, S, E);
    }
    SEAM();

    if (IN(9)) {
        for (int i = gtid; i < MV * (D / 4); i += gthreads) {
            const int row = i >> 9, c = (i & 511) * 4;
            const float rstd = rsqrtf(rowsq2[row] * (1.0f / D) + RMS_EPS);
            float* p = out + (size_t)row * D + c; const f32x4 gg = *(const f32x4*)(norm_final + c);
            *(f32x4*)p = *(const f32x4*)p * rstd * gg;
        }
    }
#undef IN
#undef SEAM
}

#ifndef HY_MULTI
#define HY_MULTI 0
#endif
extern "C" void kernel_launch(void* const* d_in, const int* in_sizes, int n_in, void* d_out, int out_size, void* d_ws, size_t ws_size, hipStream_t stream) {
    static int grid = 0;
    if (grid == 0) {
        if (n_in != 26 || ws_size < WS_END) { fprintf(stderr, "kernel_launch: need 26 inputs and >= %zu bytes of workspace (got %d, %zu)\n", (size_t)WS_END, n_in, ws_size); grid = -1; return; }
        int dev = 0, cus = 0, per_cu = 0;
        hipGetDevice(&dev); hipDeviceGetAttribute(&cus, hipDeviceAttributeMultiprocessorCount, dev);
        if (hipFuncSetAttribute((const void*)hymba_fwd, hipFuncAttributeMaxDynamicSharedMemorySize, LDS_BYTES) != hipSuccess) { fprintf(stderr, "kernel_launch: hipFuncSetAttribute failed\n"); grid = -1; return; }
        if (hipOccupancyMaxActiveBlocksPerMultiprocessor(&per_cu, (const void*)hymba_fwd, NTHR, LDS_BYTES) != hipSuccess || per_cu < 1) { fprintf(stderr, "kernel_launch: occupancy query says %d\n", per_cu); per_cu = 1; }
        (void)hipGetLastError();
        grid = cus;
        if (grid > 256) grid = 256;
    }
    if (grid < 0) return;
    Params p{};
    for (int i = 0; i < 26; ++i) p.in[i] = (const float*)d_in[i];
    p.out = (float*)d_out; p.ws = (unsigned char*)d_ws;
#if HY_MULTI
    p.multi = 1;
    for (int ph = 0; ph < 10; ++ph) { p.phase = ph; hipLaunchKernelGGL(hymba_fwd, dim3(grid), dim3(NTHR), LDS_BYTES, stream, p); }
#else
    p.multi = 0; p.phase = 0;
    hipMemsetAsync((char*)d_ws + WS_BAR, 0, 4096, stream);
    void* args[] = {&p};
    hipError_t e = hipLaunchCooperativeKernel((const void*)hymba_fwd, dim3(grid), dim3(NTHR), args, LDS_BYTES, stream);
    if (e != hipSuccess) fprintf(stderr, "cooperative launch failed: %s (grid %d)\n", hipGetErrorString(e), grid);
#endif
}
```

```cpp
#include <hip/hip_runtime.h>
#include <hip/hip_cooperative_groups.h>
#include <cstdio>
namespace cg = cooperative_groups;

#define LAS __attribute__((address_space(3)))
typedef unsigned short bf16_t;
typedef short bf16x8 __attribute__((ext_vector_type(8)));
typedef float f32x4 __attribute__((ext_vector_type(4)));
typedef float f32x2 __attribute__((ext_vector_type(2)));
typedef unsigned u32x4 __attribute__((ext_vector_type(4)));
typedef unsigned u32x2 __attribute__((ext_vector_type(2)));

constexpr int D = 2048, TT = 2048, MPR = 8192, MSA = 128, MV = 8320, MPAD = 8448;
constexpr int PW = 1024, SW = 3360, PJ = 4384, PJP = 4608, DFF = 5632, CW = 1024, NH = 16;
constexpr int NTHR = 512, LDS_BYTES = 131072;
constexpr float RMS_EPS = 1e-6f, GN_EPS = 64e-5f;

constexpr size_t WS_WIN = 0;
constexpr size_t WS_WOUT = WS_WIN + (size_t)PJP * D * 2;
constexpr size_t WS_WGU = WS_WOUT + (size_t)D * D * 2;
constexpr size_t WS_WDN = WS_WGU + (size_t)2 * DFF * D * 2;
constexpr size_t WS_WPOOL = WS_WDN + (size_t)D * DFF * 2;
constexpr size_t WS_WLORA = WS_WPOOL + (size_t)4 * 256 * 256 * 2;
constexpr size_t WS_R1 = WS_WLORA + (size_t)3 * 1024 * 256 * 2;
constexpr size_t WS_PROJ = WS_R1 + (size_t)MPAD * D * 2;
constexpr size_t WS_A = WS_PROJ + (size_t)MPAD * PJP * 2;
constexpr size_t WS_GATE = WS_A + (size_t)MPAD * CW * 2;
constexpr size_t WS_MIX = WS_GATE + (size_t)MPAD * CW * 2;
constexpr size_t WS_ROWSQ = WS_MIX + (size_t)MPAD * D * 2;
constexpr size_t WS_BONUS = WS_ROWSQ + (size_t)2 * MPAD * 4;
constexpr size_t WS_BAR = WS_BONUS + (size_t)MV * NH * 4;
constexpr size_t WS_END = WS_BAR + 4096;
static_assert((size_t)MPAD * DFF * 2 <= (WS_MIX - WS_PROJ), "U must fit in proj+a+gate");
constexpr size_t R1_POOLED = 0, R1_L = (size_t)MPAD * PW * 2;
constexpr int KS6 = 8, KS8 = 11;
static_assert((size_t)KS6 * MSA * D * 4 <= (size_t)MPAD * CW * 2 && (size_t)KS8 * MSA * D * 4 <= (size_t)MPAD * D * 2, "partial buffers alias WS_A / WS_R1");

constexpr size_t OUT_Y = 0;
constexpr size_t OUT_POOLP = (size_t)MV * D;
constexpr size_t OUT_SHIFTP = OUT_POOLP + (size_t)4 * 15 * PW;
constexpr size_t OUT_WKVP = OUT_SHIFTP + (size_t)4 * SW;
constexpr size_t OUT_POOLS = OUT_WKVP + (size_t)4 * NH * 64 * 64;
constexpr size_t OUT_SHIFTS = OUT_POOLS + (size_t)MSA * 15 * PW;
constexpr size_t OUT_WKVS = OUT_SHIFTS + (size_t)MSA * SW;
constexpr size_t SCR_Y = 0;
constexpr size_t SCR_DEC = (size_t)MPR * CW;
static_assert(SCR_DEC + (size_t)MV * CW <= OUT_POOLP, "scratch must fit in the y region");

struct Params { const float* in[26]; float* out; unsigned char* ws; int multi; int phase; };

__device__ __forceinline__ float bf2f(unsigned b) { return __uint_as_float(b << 16); }
__device__ __forceinline__ unsigned f2bf(float f) { unsigned u = __float_as_uint(f); u += 0x7FFFu + ((u >> 16) & 1u); return u >> 16; }
__device__ __forceinline__ unsigned pk_bf16(float lo, float hi) { unsigned r; asm volatile("v_cvt_pk_bf16_f32 %0, %1, %2" : "=v"(r) : "v"(lo), "v"(hi)); return r; }
template <int CTRL> __device__ __forceinline__ float dpp(float x) { return __int_as_float(__builtin_amdgcn_update_dpp(0, __float_as_int(x), CTRL, 0xF, 0xF, true)); }
__device__ __forceinline__ float red16(float x) {
    x += dpp<0x128>(x); x += dpp<0x124>(x); x += dpp<0x4E>(x); x += dpp<0xB1>(x); return x;
}
__device__ __forceinline__ float wsum(float x) { x = red16(x); x += __shfl_xor(x, 16); x += __shfl_xor(x, 32); return x; }
__device__ __forceinline__ float sigmoidf_(float x) { return 1.0f / (1.0f + __expf(-x)); }

__device__ __forceinline__ void grid_bar(unsigned* ctr, unsigned target) {
    asm volatile("s_waitcnt vmcnt(0) lgkmcnt(0)" ::: "memory");
    __syncthreads();
    if (threadIdx.x == 0) {
        __builtin_amdgcn_fence(__ATOMIC_RELEASE, "agent");
        asm volatile("s_waitcnt vmcnt(0)" ::: "memory");
        __hip_atomic_fetch_add(ctr, 1u, __ATOMIC_RELAXED, __HIP_MEMORY_SCOPE_AGENT);
        while (__hip_atomic_load(ctr, __ATOMIC_RELAXED, __HIP_MEMORY_SCOPE_AGENT) < target) __builtin_amdgcn_s_sleep(4);
        __builtin_amdgcn_fence(__ATOMIC_ACQUIRE, "agent");
        asm volatile("s_waitcnt vmcnt(0)" ::: "memory");
    }
    __syncthreads();
}

namespace pg8 {
constexpr int BM = 256, BK = 64, HALF = 128, HTB = HALF * BK * 2, NXCD = 8, WGM = 8;
__device__ __forceinline__ int lds_byte(int r, int c) { const int st = (r >> 4) * 2 + (c >> 5), rr = r & 15, cc = c & 31, ob = rr * 64 + cc * 2; return st * 1024 + (ob ^ (((ob >> 9) & 1) << 5)); }
__device__ __forceinline__ void stage_rc(int b, int& R, int& C) { const int st = b / 1024, sb = b % 1024, swz = sb ^ (((sb >> 9) & 1) << 5); R = (st >> 1) * 16 + swz / 64; C = (st & 1) * 32 + (swz % 64) / 2; }
__device__ __forceinline__ int perm32(int rho) { const int n = rho >> 4, i = rho & 15; return 8 * (i >> 2) + 4 * n + (i & 3); }
struct Unit { int pm, pn, ks, koff; };
struct Gemm { const bf16_t* A; const bf16_t* Bt; int lda, ldb, K; };
struct StaticOrder {
    int nM, nN, nwg, G, c;
    __device__ void init(int M, int N, int G_, int c_) { nM = M / BM; nN = N / BM; nwg = nM * nN; G = G_; c = c_; }
    __device__ bool next(int i, Unit& u) const {
        const long L = (long)i * G + c; if (L >= nwg) return false;
        int wgid = (int)L; { const int q = nwg / NXCD, r = nwg % NXCD, xcd = wgid % NXCD, off = wgid / NXCD; wgid = (xcd < r ? xcd * (q + 1) : r * (q + 1) + (xcd - r) * q) + off; }
        const int nig = WGM * nN, gid = wgid / nig, fm = gid * WGM, gsz = (nM - fm) < WGM ? (nM - fm) : WGM;
        u.pm = fm + ((wgid % nig) % gsz); u.pn = (wgid % nig) / gsz; u.ks = 0; u.koff = 0; return true;
    }
};
struct SplitKOrder {
    int nN, nks, pm, kchunk, G, c;
    __device__ bool next(int i, Unit& u) const { const long L = (long)i * G + c; if (L >= (long)nN * nks) return false;
        u.pm = pm; u.pn = (int)(L % nN); u.ks = (int)(L / nN); u.koff = u.ks * kchunk; return true; }
};

template <class Epi, class Sched>
__device__ __forceinline__ void gemm_phase(LAS unsigned char* lds, const Gemm g, const Sched& S, const Epi& E) {
    const int tid = threadIdx.x, wid = __builtin_amdgcn_readfirstlane(tid >> 6), lane = tid & 63, wr = wid >> 2, wc = wid & 3, fr = lane & 15, fq = lane >> 4;
    const int K = g.K, nt = K / BK;
    unsigned voffA[2], voffB[2];
#pragma unroll
    for (int i = 0; i < 2; ++i) { int R, C; stage_rc(tid * 16 + i * 8192, R, C); const int Rb = Epi::PERM ? ((R & ~31) + perm32(R & 31)) : R;
        voffA[i] = (unsigned)(R * g.lda + C) * 2u; voffB[i] = (unsigned)(Rb * g.ldb + C) * 2u; }
    const size_t kstep = (size_t)(BK * 2);
    const size_t hstepA = (size_t)HALF * g.lda * 2, hstepB = (size_t)HALF * g.ldb * 2;
    const size_t tstepA = 2 * hstepA, tstepB = 2 * hstepB;
    const unsigned ldsw = (unsigned)wid * 1024u;
    const int aoff = lds_byte(wr * 64 + fr, fq * 8), boff = lds_byte(wc * 32 + fr, fq * 8);
#define PG8_SA(b, h) (((b) * 2 + (h)) * HTB)
#define PG8_SB(b, h) ((4 + (b) * 2 + (h)) * HTB)
#define PG8_STAGE(bufoff, gbase, voff) do { _Pragma("unroll") for (int _i = 0; _i < 2; ++_i) \
        __builtin_amdgcn_global_load_lds((const unsigned*)((const char*)(gbase) + (voff)[_i]), (LAS unsigned*)(lds + (bufoff) + ldsw + _i * 8192), 16, 0, 0); } while (0)
#define PG8_LDA(dst, b, h) do { _Pragma("unroll") for (int m = 0; m < 4; ++m) _Pragma("unroll") for (int k = 0; k < 2; ++k) dst[m][k] = *(const LAS bf16x8*)(lds + PG8_SA(b, h) + aoff + m * 2048 + k * 1024); } while (0)
#define PG8_LDB(dst, b, h) do { _Pragma("unroll") for (int n = 0; n < 2; ++n) _Pragma("unroll") for (int k = 0; k < 2; ++k) dst[n][k] = *(const LAS bf16x8*)(lds + PG8_SB(b, h) + boff + n * 2048 + k * 1024); } while (0)
#define PG8_MMA(ai, bj, At, Bt) do { __builtin_amdgcn_s_setprio(1); _Pragma("unroll") for (int m = 0; m < 4; ++m) _Pragma("unroll") for (int n = 0; n < 2; ++n) _Pragma("unroll") for (int k = 0; k < 2; ++k) \
        acc[ai][bj][m][n] = __builtin_amdgcn_mfma_f32_16x16x32_bf16(Bt[n][k], At[m][k], acc[ai][bj][m][n], 0, 0, 0); __builtin_amdgcn_s_setprio(0); } while (0)
#define PG8_WAIT_V(n) asm volatile("s_waitcnt vmcnt(" #n ")" ::: "memory")
#define PG8_WAIT_L(n) asm volatile("s_waitcnt lgkmcnt(" #n ")" ::: "memory")
#define PG8_BAR __builtin_amdgcn_s_barrier()
#define PG8_SCHED __builtin_amdgcn_sched_barrier(0)
    Unit cur, nxt; int ui = 0;
    if (!S.next(0, cur)) return;
    f32x4 acc[2][2][4][2];
#pragma unroll
    for (int a = 0; a < 2; ++a)
#pragma unroll
        for (int b = 0; b < 2; ++b)
#pragma unroll
            for (int m = 0; m < 4; ++m)
#pragma unroll
                for (int n = 0; n < 2; ++n) acc[a][b][m][n] = (f32x4){0.f, 0.f, 0.f, 0.f};
    bf16x8 At[4][2], B0[2][2], B1[2][2];
    const char* cA = (const char*)g.A + (size_t)cur.pm * tstepA + (size_t)cur.koff * 2; const char* cB = (const char*)g.Bt + (size_t)cur.pn * tstepB + (size_t)cur.koff * 2;
    PG8_STAGE(PG8_SB(0, 0), cB, voffB); PG8_STAGE(PG8_SA(0, 0), cA, voffA); PG8_STAGE(PG8_SB(0, 1), cB + hstepB, voffB); PG8_STAGE(PG8_SA(0, 1), cA + hstepA, voffA);
    if (wr == 1) PG8_BAR;
    PG8_WAIT_V(4); PG8_BAR;
    PG8_STAGE(PG8_SB(1, 0), cB + kstep, voffB); PG8_STAGE(PG8_SA(1, 0), cA + kstep, voffA); PG8_STAGE(PG8_SB(1, 1), cB + hstepB + kstep, voffB);
    PG8_WAIT_V(6); PG8_BAR;
    for (;;) {
        const bool has_next = S.next(ui + 1, nxt);
        const char* nA = has_next ? (const char*)g.A + (size_t)nxt.pm * tstepA + (size_t)nxt.koff * 2 : cA; const char* nB = has_next ? (const char*)g.Bt + (size_t)nxt.pn * tstepB + (size_t)nxt.koff * 2 : cB;
#pragma clang loop unroll(disable)
        for (int t = 0; t < nt; t += 2) {
            const bool last = (t == nt - 2);
            const char* a1 = cA + (size_t)(t + 1) * kstep;
            const char* a2 = last ? nA : cA + (size_t)(t + 2) * kstep; const char* b2 = last ? nB : cB + (size_t)(t + 2) * kstep;
            const char* a3 = a2 + kstep; const char* b3 = b2 + kstep;
            PG8_LDB(B0, 0, 0); PG8_SCHED; PG8_LDA(At, 0, 0); PG8_STAGE(PG8_SA(1, 1), a1 + hstepA, voffA);
            PG8_WAIT_L(8); PG8_BAR; PG8_WAIT_L(0); PG8_MMA(0, 0, At, B0); PG8_BAR; PG8_SCHED;
            PG8_LDB(B1, 0, 1); PG8_STAGE(PG8_SB(0, 0), b2, voffB);
            PG8_BAR; PG8_WAIT_L(0); PG8_MMA(0, 1, At, B1); PG8_BAR;
            PG8_LDA(At, 0, 1); PG8_STAGE(PG8_SA(0, 0), a2, voffA);
            PG8_BAR; PG8_WAIT_L(0); PG8_MMA(1, 0, At, B0); PG8_BAR; PG8_SCHED;
            PG8_STAGE(PG8_SB(0, 1), b2 + hstepB, voffB);
            PG8_WAIT_V(6); PG8_BAR; PG8_MMA(1, 1, At, B1); PG8_BAR;
            PG8_LDB(B0, 1, 0); PG8_SCHED; PG8_LDA(At, 1, 0); PG8_STAGE(PG8_SA(0, 1), a2 + hstepA, voffA);
            PG8_WAIT_L(8); PG8_BAR; PG8_WAIT_L(0); PG8_MMA(0, 0, At, B0); PG8_BAR; PG8_SCHED;
            PG8_LDB(B1, 1, 1); PG8_STAGE(PG8_SB(1, 0), b3, voffB);
            PG8_BAR; PG8_WAIT_L(0); PG8_MMA(0, 1, At, B1); PG8_BAR;
            PG8_LDA(At, 1, 1); PG8_STAGE(PG8_SA(1, 0), a3, voffA);
            PG8_BAR; PG8_WAIT_L(0); PG8_MMA(1, 0, At, B0); PG8_BAR; PG8_SCHED;
            PG8_STAGE(PG8_SB(1, 1), b3 + hstepB, voffB);
            PG8_WAIT_V(6); PG8_BAR; PG8_MMA(1, 1, At, B1); PG8_BAR;
        }
        E(acc, cur, wr, wc, fr, fq);
        if (!has_next) break;
#pragma unroll
        for (int a = 0; a < 2; ++a)
#pragma unroll
            for (int b = 0; b < 2; ++b)
#pragma unroll
                for (int m = 0; m < 4; ++m)
#pragma unroll
                    for (int n = 0; n < 2; ++n) acc[a][b][m][n] = (f32x4){0.f, 0.f, 0.f, 0.f};
        cur = nxt; cA = nA; cB = nB; ++ui;
    }
    PG8_WAIT_V(0);
    if (wr == 0) PG8_BAR;
    PG8_BAR;
#undef PG8_SA
#undef PG8_SB
#undef PG8_STAGE
#undef PG8_LDA
#undef PG8_LDB
#undef PG8_MMA
#undef PG8_WAIT_V
#undef PG8_WAIT_L
#undef PG8_BAR
#undef PG8_SCHED
}
}
using pg8::Unit;

template <int MODE> struct EpiBf16 {
    static constexpr bool PERM = true;
    bf16_t* O; int ldc; int coff; const float* vec;
    __device__ __forceinline__ void operator()(const f32x4 (&acc)[2][2][4][2], const Unit& u, int wr, int wc, int fr, int fq) const {
        const int row0 = u.pm * 256 + wr * 64 + fr, col0 = coff + u.pn * 256 + wc * 32 + 8 * fq;
#pragma unroll
        for (int bj = 0; bj < 2; ++bj) {
            const int c = col0 + bj * 128;
            f32x4 s0, s1;
            if (MODE == 0) { s0 = vec ? *(const f32x4*)(vec + c) : (f32x4){1.f, 1.f, 1.f, 1.f}; s1 = vec ? *(const f32x4*)(vec + c + 4) : (f32x4){1.f, 1.f, 1.f, 1.f}; }
            else { s0 = *(const f32x4*)(vec + c); s1 = *(const f32x4*)(vec + c + 4); }
#pragma unroll
            for (int ai = 0; ai < 2; ++ai)
#pragma unroll
                for (int m = 0; m < 4; ++m) {
                    f32x4 v0 = acc[ai][bj][m][0], v1 = acc[ai][bj][m][1];
                    if (MODE == 0) { v0 = v0 * s0; v1 = v1 * s1; }
                    else {
#pragma unroll
                        for (int j = 0; j < 4; ++j) { v0[j] = sigmoidf_(v0[j] + s0[j]); v1[j] = sigmoidf_(v1[j] + s1[j]); } }
                    u32x4 w; w.x = pk_bf16(v0[0], v0[1]); w.y = pk_bf16(v0[2], v0[3]); w.z = pk_bf16(v1[0], v1[1]); w.w = pk_bf16(v1[2], v1[3]);
                    *(u32x4*)(O + (size_t)(row0 + ai * 128 + m * 16) * ldc + c) = w;
                }
        }
    }
};
struct EpiP3 {
    static constexpr bool PERM = true;
    int mode; bf16_t* Ob; float* Of; int ldc, coff; const float* vec;
    __device__ __forceinline__ void operator()(const f32x4 (&acc)[2][2][4][2], const Unit& u, int wr, int wc, int fr, int fq) const {
        const int row0 = u.pm * 256 + wr * 64 + fr, col0 = coff + u.pn * 256 + wc * 32 + 8 * fq;
#pragma unroll
        for (int bj = 0; bj < 2; ++bj) {
            const int c = col0 + bj * 128;
            const f32x4 one = (f32x4){1.f, 1.f, 1.f, 1.f};
            const f32x4 s0 = vec ? *(const f32x4*)(vec + c) : one, s1 = vec ? *(const f32x4*)(vec + c + 4) : one;
#pragma unroll
            for (int ai = 0; ai < 2; ++ai)
#pragma unroll
                for (int m = 0; m < 4; ++m) {
                    const int row = row0 + ai * 128 + m * 16;
                    f32x4 v0 = acc[ai][bj][m][0], v1 = acc[ai][bj][m][1];
                    if (mode == 0) { v0 = v0 * s0; v1 = v1 * s1; }
                    else if (mode == 1) {
#pragma unroll
                        for (int j = 0; j < 4; ++j) { v0[j] = sigmoidf_(v0[j] + s0[j]); v1[j] = sigmoidf_(v1[j] + s1[j]); } }
                    else {
                        v0 = v0 + s0; v1 = v1 + s1;
#pragma unroll
                        for (int j = 0; j < 4; ++j) {
                            const float z0 = -v0[j], z1 = -v1[j];
                            const float sp0 = fmaxf(z0, 0.f) + __logf(1.0f + __expf(-fabsf(z0))), sp1 = fmaxf(z1, 0.f) + __logf(1.0f + __expf(-fabsf(z1)));
                            v0[j] = __expf(-__expf(-sp0 - 0.5f)); v1[j] = __expf(-__expf(-sp1 - 0.5f)); }
                    }
                    if (mode == 2) { if (row < MV) { float* p = Of + (size_t)row * ldc + c; *(f32x4*)p = v0; *(f32x4*)(p + 4) = v1; } }
                    else { u32x4 w; w.x = pk_bf16(v0[0], v0[1]); w.y = pk_bf16(v0[2], v0[3]); w.z = pk_bf16(v1[0], v1[1]); w.w = pk_bf16(v1[2], v1[3]);
                        *(u32x4*)(Ob + (size_t)row * ldc + c) = w; }
                }
        }
    }
};
struct EpiDecay {
    static constexpr bool PERM = false;
    float* O; const float* w0;
    __device__ __forceinline__ void operator()(const f32x4 (&acc)[2][2][4][2], const Unit& u, int wr, int wc, int fr, int fq) const {
        const int row0 = u.pm * 256 + wr * 64 + fr, col0 = u.pn * 256 + wc * 32 + 4 * fq;
#pragma unroll
        for (int bj = 0; bj < 2; ++bj)
#pragma unroll
            for (int n = 0; n < 2; ++n) {
                const int c = col0 + bj * 128 + n * 16; const f32x4 b = *(const f32x4*)(w0 + c);
#pragma unroll
                for (int ai = 0; ai < 2; ++ai)
#pragma unroll
                    for (int m = 0; m < 4; ++m) {
                        const int row = row0 + ai * 128 + m * 16; f32x4 v = acc[ai][bj][m][n] + b, o;
#pragma unroll
                        for (int j = 0; j < 4; ++j) { const float z = -v[j]; const float sp = fmaxf(z, 0.f) + __logf(1.0f + __expf(-fabsf(z))); o[j] = __expf(-__expf(-sp - 0.5f)); }
                        if (row < MV) *(f32x4*)(O + (size_t)row * CW + c) = o;
                    }
            }
    }
};
struct EpiOut {
    static constexpr bool PERM = false;
    const float* xp; const float* xs; float* out; bf16_t* h2; const float* g; float* rowsq;
    __device__ __forceinline__ void operator()(const f32x4 (&acc)[2][2][4][2], const Unit& u, int wr, int wc, int fr, int fq) const {
        const int row0 = u.pm * 256 + wr * 64 + fr, col0 = u.pn * 256 + wc * 32 + 4 * fq;
#pragma unroll
        for (int ai = 0; ai < 2; ++ai)
#pragma unroll
            for (int m = 0; m < 4; ++m) {
                const int row = row0 + ai * 128 + m * 16; const bool ok = row < MV;
                const float* xr = row < MPR ? xp + (size_t)row * D : xs + (size_t)(ok ? row - MPR : 0) * D;
                float s = 0.f;
#pragma unroll
                for (int bj = 0; bj < 2; ++bj)
#pragma unroll
                    for (int n = 0; n < 2; ++n) {
                        const int c = col0 + bj * 128 + n * 16;
                        f32x4 x1 = acc[ai][bj][m][n];
                        if (ok) { x1 = x1 + *(const f32x4*)(xr + c); *(f32x4*)(out + (size_t)row * D + c) = x1; }
                        s += (x1[0] * x1[0] + x1[1] * x1[1]) + (x1[2] * x1[2] + x1[3] * x1[3]);
                        const f32x4 gg = *(const f32x4*)(g + c); const f32x4 hv = x1 * gg;
                        u32x2 w; w.x = pk_bf16(hv[0], hv[1]); w.y = pk_bf16(hv[2], hv[3]);
                        *(u32x2*)(h2 + (size_t)row * D + c) = w;
                    }
                s += __shfl_xor(s, 16); s += __shfl_xor(s, 32);
                if (ok && fq == 0) unsafeAtomicAdd(rowsq + row, s);
            }
    }
};
struct EpiGU {
    static constexpr bool PERM = true;
    bf16_t* U; const float* rowsq;
    __device__ __forceinline__ void operator()(const f32x4 (&acc)[2][2][4][2], const Unit& u, int wr, int wc, int fr, int fq) const {
        const int row0 = u.pm * 256 + wr * 64 + fr, col0 = u.pn * 128 + wc * 32 + 8 * fq;
#pragma unroll
        for (int ai = 0; ai < 2; ++ai)
#pragma unroll
            for (int m = 0; m < 4; ++m) {
                const int row = row0 + ai * 128 + m * 16;
                const float rstd = rsqrtf(rowsq[row] * (1.0f / D) + RMS_EPS);
                f32x4 o[2];
#pragma unroll
                for (int n = 0; n < 2; ++n)
#pragma unroll
                    for (int j = 0; j < 4; ++j) { const float gt = acc[ai][0][m][n][j] * rstd, up = acc[ai][1][m][n][j] * rstd; o[n][j] = gt * sigmoidf_(gt) * up; }
                u32x4 w; w.x = pk_bf16(o[0][0], o[0][1]); w.y = pk_bf16(o[0][2], o[0][3]); w.z = pk_bf16(o[1][0], o[1][1]); w.w = pk_bf16(o[1][2], o[1][3]);
                *(u32x4*)(U + (size_t)row * DFF + col0) = w;
            }
    }
};
struct EpiDown {
    static constexpr bool PERM = false;
    float* out;
    __device__ __forceinline__ void operator()(const f32x4 (&acc)[2][2][4][2], const Unit& u, int wr, int wc, int fr, int fq) const {
        const int row0 = u.pm * 256 + wr * 64 + fr, col0 = u.pn * 256 + wc * 32 + 4 * fq;
#pragma unroll
        for (int ai = 0; ai < 2; ++ai)
#pragma unroll
            for (int m = 0; m < 4; ++m) {
                const int row = row0 + ai * 128 + m * 16;
#pragma unroll
                for (int bj = 0; bj < 2; ++bj)
#pragma unroll
                    for (int n = 0; n < 2; ++n) {
                        const int c = col0 + bj * 128 + n * 16; float* p = out + (size_t)row * D + c;
                        *(f32x4*)p = acc[ai][bj][m][n] + *(const f32x4*)p;
                    }
            }
    }
};
struct EpiPartial {
    static constexpr bool PERM = false;
    float* buf;
    __device__ __forceinline__ void operator()(const f32x4 (&acc)[2][2][4][2], const Unit& u, int wr, int wc, int fr, int fq) const {
        const int col0 = u.pn * 256 + wc * 32 + 4 * fq;
#pragma unroll
        for (int m = 0; m < 4; ++m) {
            const int lrow = wr * 64 + m * 16 + fr;
            float* p = buf + ((size_t)u.ks * MSA + lrow) * D + col0;
#pragma unroll
            for (int bj = 0; bj < 2; ++bj)
#pragma unroll
                for (int n = 0; n < 2; ++n) *(f32x4*)(p + bj * 128 + n * 16) = acc[0][bj][m][n];
        }
    }
};

template <int RM> __device__ __forceinline__ int rowmap(int n) { return RM == 0 ? n : (RM == 1 ? ((n >> 7) * 256 + (n & 127)) : ((n >> 7) * 256 + 128 + (n & 127))); }
template <int RM>
__device__ __forceinline__ void transpose_bf16(const float* src, int Ksrc, int Nsrc, int ld, bf16_t* dst, int Kdst, int Ndst, int rot) {
    const int lane = threadIdx.x & 63, gws = gridDim.x * 8, gw = (blockIdx.x * 8 + (threadIdx.x >> 6) + rot) % gws;
    const int nn = Ndst / 64, ntile = nn * (Kdst / 64);
    for (int t = gw; t < ntile; t += gws) {
        const int k0 = (t / nn) * 64, n = (t % nn) * 64 + lane;
        const bool nok = n < Nsrc;
        const float* sp = src + (nok ? n : 0);
        float v[64];
        const float mskn = nok ? 1.f : 0.f;
#pragma unroll
        for (int j = 0; j < 64; ++j) { const int k = k0 + j; v[j] = sp[(size_t)(k < Ksrc ? k : Ksrc - 1) * ld]; }
#pragma unroll
        for (int j = 0; j < 64; ++j) v[j] *= ((k0 + j) < Ksrc ? mskn : 0.f);
        bf16_t* dp = dst + (size_t)rowmap<RM>(n) * Kdst + k0;
#pragma unroll
        for (int q8 = 0; q8 < 8; ++q8) { u32x4 w; w.x = pk_bf16(v[q8 * 8 + 0], v[q8 * 8 + 1]); w.y = pk_bf16(v[q8 * 8 + 2], v[q8 * 8 + 3]); w.z = pk_bf16(v[q8 * 8 + 4], v[q8 * 8 + 5]); w.w = pk_bf16(v[q8 * 8 + 6], v[q8 * 8 + 7]);
            *(u32x4*)(dp + q8 * 8) = w; }
    }
}
template <int CTRL> __device__ __forceinline__ float dpp_(float x) { return __int_as_float(__builtin_amdgcn_update_dpp(0, __float_as_int(x), CTRL, 0xF, 0xF, true)); }
__device__ __forceinline__ float red8(float x) { x += dpp_<0x141>(x); x += dpp_<0xB1>(x); x += dpp_<0x4E>(x); return x; }

template <int W>
__device__ __forceinline__ void pool_block_prompt(const bf16_t* proj, bf16_t* pooled, int b, int t0, int c) {
    float ux[15 + W], uy[15 + W]; unsigned raw[15 + W];
#pragma unroll
    for (int j = 0; j < 15 + W; ++j) {
        const int t = t0 - (W - 1) + j;
        raw[j] = *(const unsigned*)(proj + (size_t)(b * TT + (t < 0 ? 0 : t)) * PJP + c);
    }
#pragma unroll
    for (int j = 0; j < 15 + W; ++j) {
        const int t = t0 - (W - 1) + j; const float zm = t < 0 ? 0.f : 1.f;
        ux[j] = bf2f(raw[j] & 0xffffu) * zm; uy[j] = bf2f(raw[j] >> 16) * zm;
    }
#pragma unroll
    for (int i = 0; i < 16; ++i) {
        const int t = t0 + i; float sx = 0.f, sy = 0.f;
#pragma unroll
        for (int j = 0; j < W; ++j) { sx += ux[i + j]; sy += uy[i + j]; }
        const float inv = 1.0f / (float)(t + 1 < W ? t + 1 : W);
        const float px = sx * inv - ux[i + W - 1], py = sy * inv - uy[i + W - 1];
        *(unsigned*)(pooled + (size_t)(b * TT + t) * PW + c) = pk_bf16(px, py);
    }
}

__global__ void __launch_bounds__(NTHR) hymba_fwd(Params P) {
    extern __shared__ __attribute__((aligned(16))) unsigned char lds_raw[];
    LAS unsigned char* lds = (LAS unsigned char*)lds_raw;
    const int G = gridDim.x, bid = blockIdx.x, gthreads = G * NTHR, gwaves = G * 8;
#define PHASE_IDS int tid = threadIdx.x; asm volatile("" : "+v"(tid)); const int lane = tid & 63, wave = tid >> 6, gtid = bid * NTHR + tid, gwave = bid * 8 + wave; (void)lane; (void)wave; (void)gtid; (void)gwave;
    unsigned char* ws = P.ws; float* out = P.out;
    const float* x_prompt = P.in[0]; const float* x_sample = P.in[1]; const float* state_pool = P.in[2]; const float* state_shift = P.in[3]; const float* state_wkv = P.in[4];
    const float* norm_mix = P.in[5]; const float* w_in = P.in[6]; const float* w_pool = P.in[7]; const float* pool_scale = P.in[8]; const float* mu_shift = P.in[9];
    const float* w0 = P.in[10]; const float* w2 = P.in[11]; const float* a0 = P.in[12]; const float* a2 = P.in[13]; const float* g2 = P.in[14];
    const float* k_k = P.in[15]; const float* k_a = P.in[16]; const float* r_k = P.in[17]; const float* gn_w = P.in[18]; const float* gn_b = P.in[19];
    const float* w_out = P.in[20]; const float* norm_ffn = P.in[21]; const float* w_gate = P.in[22]; const float* w_up = P.in[23]; const float* w_down = P.in[24]; const float* norm_final = P.in[25];
    bf16_t* WinT = (bf16_t*)(ws + WS_WIN); bf16_t* WoutT = (bf16_t*)(ws + WS_WOUT); bf16_t* WguT = (bf16_t*)(ws + WS_WGU); bf16_t* WdnT = (bf16_t*)(ws + WS_WDN);
    bf16_t* WpoolT = (bf16_t*)(ws + WS_WPOOL); bf16_t* WloraT = (bf16_t*)(ws + WS_WLORA);
    bf16_t* Hb = (bf16_t*)(ws + WS_R1); bf16_t* Pooled = (bf16_t*)(ws + WS_R1 + R1_POOLED); bf16_t* Lb = (bf16_t*)(ws + WS_R1 + R1_L); bf16_t* H2 = (bf16_t*)(ws + WS_R1);
    bf16_t* Proj = (bf16_t*)(ws + WS_PROJ); bf16_t* Ub = (bf16_t*)(ws + WS_PROJ); bf16_t* Ab = (bf16_t*)(ws + WS_A); bf16_t* Gb = (bf16_t*)(ws + WS_GATE);
    bf16_t* Mix = (bf16_t*)(ws + WS_MIX); float* rowsq1 = (float*)(ws + WS_ROWSQ); float* Bonus = (float*)(ws + WS_BONUS);
    unsigned* barctr = (unsigned*)(ws + WS_BAR);
    float* Yb = out + SCR_Y; float* Dec = out + SCR_DEC;
    float* Part6 = (float*)(ws + WS_A);
    float* Part8 = (float*)(ws + WS_R1);
    unsigned nbar = 0;
#ifndef P3SEL
#define P3SEL 15
#endif
#ifndef PHASE_MASK
#define PHASE_MASK 0x3ff
#endif
#define IN(k) (((PHASE_MASK >> (k)) & 1) && (!P.multi || P.phase == (k)))
#define SEAM() do { if (!P.multi) { ++nbar; grid_bar(barctr, nbar * (unsigned)G); } } while (0)

    if (IN(0)) {
        PHASE_IDS
        transpose_bf16<0>(w_in, D, PJ, PJ, WinT, D, PJP, 0);
        transpose_bf16<0>(w_out, D, D, D, WoutT, D, D, 256);
        transpose_bf16<1>(w_gate, D, DFF, DFF, WguT, D, DFF, 1280);
        transpose_bf16<2>(w_up, D, DFF, DFF, WguT, D, DFF, 2048 - 768);
        transpose_bf16<0>(w_down, DFF, D, D, WdnT, DFF, D, 512);
        for (int g = 0; g < 4; ++g) transpose_bf16<0>(w_pool + (size_t)g * 65536, 256, 256, 256, WpoolT + (size_t)g * 65536, 256, 256, 1280 + g * 16);
        transpose_bf16<0>(w2, 64, CW, CW, WloraT, 256, CW, 1344);
        transpose_bf16<0>(a2, 64, CW, CW, WloraT + (size_t)CW * 256, 256, CW, 1408);
        transpose_bf16<0>(g2, 160, CW, CW, WloraT + (size_t)2 * CW * 256, 256, CW, 1472);
        for (int i = gtid; i < MPAD; i += gthreads) rowsq1[i] = 0.f;
        for (int m = gwave; m < MPAD; m += gwaves) {
            bf16_t* hr = Hb + (size_t)m * D;
            if (m < MV) {
                const float* xr = m < MPR ? x_prompt + (size_t)m * D : x_sample + (size_t)(m - MPR) * D;
                f32x4 v[8]; float s = 0.f;
#pragma unroll
                for (int i = 0; i < 8; ++i) v[i] = *(const f32x4*)(xr + (i * 64 + lane) * 4);
#pragma unroll
                for (int i = 0; i < 8; ++i) s += (v[i][0] * v[i][0] + v[i][1] * v[i][1]) + (v[i][2] * v[i][2] + v[i][3] * v[i][3]);
                s = wsum(s); const float rstd = rsqrtf(s * (1.0f / D) + RMS_EPS);
#pragma unroll
                for (int i = 0; i < 8; ++i) { const int c = (i * 64 + lane) * 4; const f32x4 gg = *(const f32x4*)(norm_mix + c); const f32x4 o = v[i] * rstd * gg;
                    u32x2 w; w.x = pk_bf16(o[0], o[1]); w.y = pk_bf16(o[2], o[3]); *(u32x2*)(hr + c) = w; }
            } else {
#pragma unroll
                for (int i = 0; i < 8; ++i) *(u32x2*)(hr + (i * 64 + lane) * 4) = (u32x2){0u, 0u};
            }
        }
    }
    if (!P.multi) { cg::this_grid().sync(); }

    if (IN(1)) {
        PHASE_IDS
        pg8::Gemm g{Hb, WinT, D, D, D}; pg8::StaticOrder S; S.init(MPAD, PJP, G, bid);
        EpiBf16<0> E{Proj, PJP, 0, nullptr};
        pg8::gemm_phase(lds, g, S, E);
    }
    SEAM();

    if (IN(2)) {
        PHASE_IDS
        for (int rb = bid; rb < MPR / 16; rb += G) {
            const int b = rb >> 7, t0 = (rb & 127) * 16, c = tid * 2, gq = tid >> 7;
            if (gq == 0) pool_block_prompt<2>(Proj, Pooled, b, t0, c);
            else if (gq == 1) pool_block_prompt<4>(Proj, Pooled, b, t0, c);
            else if (gq == 2) pool_block_prompt<8>(Proj, Pooled, b, t0, c);
            else pool_block_prompt<16>(Proj, Pooled, b, t0, c);
        }
        for (int b = bid; b < MSA; b += G) {
            const int c = tid * 2, W = 2 << (tid >> 7);
            const unsigned v = *(const unsigned*)(Proj + (size_t)(MPR + b) * PJP + c); const float ux = bf2f(v & 0xffffu), uy = bf2f(v >> 16);
            float sx = ux, sy = uy;
            for (int j = 1; j < W; ++j) { const f32x2 p = *(const f32x2*)(state_pool + ((size_t)b * 15 + 15 - j) * PW + c); sx += p[0]; sy += p[1]; }
            const float inv = 1.0f / (float)W;
            *(unsigned*)(Pooled + (size_t)(MPR + b) * PW + c) = pk_bf16(sx * inv - ux, sy * inv - uy);
            float* np = out + OUT_POOLS + (size_t)b * 15 * PW;
            for (int j = 0; j < 14; ++j) *(f32x2*)(np + (size_t)j * PW + c) = *(const f32x2*)(state_pool + ((size_t)b * 15 + j + 1) * PW + c);
            *(f32x2*)(np + (size_t)14 * PW + c) = (f32x2){ux, uy};
        }
        {
            constexpr int NIT = MV * 144;
            for (int base = gtid; base < NIT; base += 3 * gthreads) {
                unsigned cv[3], pv[3]; f32x2 mu[3]; int mm[3], cpo[3], sg[3], pcs[3]; bool val[3];
#pragma unroll
                for (int u = 0; u < 3; ++u) {
                    const int idx = base + u * gthreads; val[u] = idx < NIT; const int id2 = val[u] ? idx : 0;
                    const int m = id2 / 144, jp = id2 - m * 144, seg = jp < 32 ? 0 : (jp < 64 ? 1 : 2);
                    const int j = (jp - (seg == 0 ? 0 : (seg == 1 ? 32 : 64))) * 2, pc = (seg == 0 ? 3072 : (seg == 1 ? 3136 : 3200)) + j;
                    mm[u] = m; sg[u] = seg; cpo[u] = seg * 256 + j; pcs[u] = pc;
                    const int mprev = (m >= MPR || (m & (TT - 1)) == 0) ? m : m - 1;
                    cv[u] = *(const unsigned*)(Proj + (size_t)m * PJP + PW + pc);
                    pv[u] = *(const unsigned*)(Proj + (size_t)mprev * PJP + PW + pc);
                    mu[u] = *(const f32x2*)(mu_shift + pc);
                }
#pragma unroll
                for (int u = 0; u < 3; ++u) {
                    const int m = mm[u]; const float cx = bf2f(cv[u] & 0xffffu), cy = bf2f(cv[u] >> 16);
                    const float fm = (m & (TT - 1)) == 0 ? 0.f : 1.f;
                    float px = bf2f(pv[u] & 0xffffu) * fm, py = bf2f(pv[u] >> 16) * fm;
                    if (m >= MPR) { const f32x2 p = *(const f32x2*)(state_shift + (size_t)(m - MPR) * SW + pcs[u]); px = p[0]; py = p[1]; }
                    float vx = cx + (px - cx) * mu[u][0], vy = cy + (py - cy) * mu[u][1];
                    if (sg[u] == 0) { vx = tanhf(vx); vy = tanhf(vy); } else if (sg[u] == 2) { vx = sigmoidf_(vx); vy = sigmoidf_(vy); }
                    if (val[u]) *(unsigned*)(Lb + (size_t)m * 768 + cpo[u]) = pk_bf16(vx, vy);
                }
            }
        }
        for (int i = gtid; i < 4 * SW; i += gthreads) { const int b = i / SW, j = i - b * SW; out[OUT_SHIFTP + i] = bf2f(Proj[(size_t)(b * TT + TT - 1) * PJP + PW + j]); }
        for (int i = gtid; i < MSA * SW; i += gthreads) { const int b = i / SW, j = i - b * SW; out[OUT_SHIFTS + i] = bf2f(Proj[(size_t)(MPR + b) * PJP + PW + j]); }
        for (int i = gtid; i < 4 * 15 * PW; i += gthreads) { const int b = i / (15 * PW), r = i - b * 15 * PW, j = r / PW, c = r - j * PW; out[OUT_POOLP + i] = bf2f(Proj[(size_t)(b * TT + TT - 15 + j) * PJP + c]); }
    }
    SEAM();

    if (IN(3)) {
        PHASE_IDS
#pragma clang loop unroll(disable)
        for (int job = 0; job < 7; ++job) {
            const bool pool = job < 4; const int sgm = job - 4;
            pg8::Gemm g{pool ? Pooled + job * 256 : Lb + sgm * 256, pool ? WpoolT + (size_t)job * 65536 : WloraT + (size_t)sgm * CW * 256, pool ? PW : 768, 256, 256};
            const int rot = pool ? job * 33 : (sgm == 0 ? 132 : (sgm == 1 ? 8 : 140));
            pg8::StaticOrder S; S.init(MPAD, pool ? 256 : CW, G, (bid + G - rot % G) % G);
            EpiP3 E{pool ? 0 : (sgm == 0 ? 2 : (sgm == 1 ? 1 : 0)), pool ? Mix : (sgm == 1 ? Ab : Gb), Dec, pool ? D : CW, pool ? job * 256 : 0,
                    pool ? pool_scale : (sgm == 0 ? w0 : (sgm == 1 ? a0 : (const float*)nullptr))};
            pg8::gemm_phase(lds, g, S, E);
        }
    }
    SEAM();

    if (IN(4)) {
        PHASE_IDS
        LAS float* ldf = (LAS float*)lds;
        constexpr int REC = 392, TB = 16, NPS = TB / 4;
        for (int unit = bid; unit < 256; unit += G) {
            const int s = unit >> 2, b = s >> 4, h = s & 15, q = unit & 3;
            const bool consumer = __builtin_amdgcn_readfirstlane(tid >> 6) < 4;
            if (consumer) {
              const int crow = (tid & 255) >> 4, kq = tid & 15;
              float S0 = 0.f, S1 = 0.f, S2 = 0.f, S3 = 0.f;
              const LAS float* recq0 = ldf + kq * 4; const LAS float* recv0 = ldf + 320 + q * 16 + crow;
              float* yp = Yb + (size_t)(b * TT + 15 - kq) * CW + h * 64 + q * 16 + crow;
              __syncthreads();
              for (int blk = 0; blk < TT / TB; ++blk) {
                    const int bo = (blk & 1) * (TB * REC);
                    const LAS float* recq = recq0 + bo; const LAS float* recv = recv0 + bo; const LAS float* recs = ldf + bo + 384;
                    f32x4 av = *(const LAS f32x4*)(recq), bv = *(const LAS f32x4*)(recq + 64), dw = *(const LAS f32x4*)(recq + 128), kt = *(const LAS f32x4*)(recq + 192), wrv = *(const LAS f32x4*)(recq + 256);
                    float vv = recv[0]; f32x2 sc = *(const LAS f32x2*)(recs);
                    float yacc = 0.f;
#pragma unroll
                    for (int st = 0; st < TB; ++st) {
                        const f32x4 av_ = av, bv_ = bv, dw_ = dw, kt_ = kt, wr_ = wrv; const float vv_ = vv; const f32x2 sc_ = sc;
                        if (st + 1 < TB) {
                            const int o = (st + 1) * REC;
                            av = *(const LAS f32x4*)(recq + o); bv = *(const LAS f32x4*)(recq + o + 64); dw = *(const LAS f32x4*)(recq + o + 128); kt = *(const LAS f32x4*)(recq + o + 192); wrv = *(const LAS f32x4*)(recq + o + 256);
                            vv = recv[o]; sc = *(const LAS f32x2*)(recs + o);
                        }
                        float da = (S0 * av_[0] + S1 * av_[1]) + (S2 * av_[2] + S3 * av_[3]);
                        float dy = (S0 * wr_[0] + S1 * wr_[1]) + (S2 * wr_[2] + S3 * wr_[3]);
                        da = red16(da); dy = red16(dy);
                        const float y = dy + da * sc_[0] + vv_ * sc_[1];
                        S0 = S0 * dw_[0] + da * bv_[0] + vv_ * kt_[0]; S1 = S1 * dw_[1] + da * bv_[1] + vv_ * kt_[1];
                        S2 = S2 * dw_[2] + da * bv_[2] + vv_ * kt_[2]; S3 = S3 * dw_[3] + da * bv_[3] + vv_ * kt_[3];
                        yacc = __int_as_float(__builtin_amdgcn_update_dpp(__float_as_int(y), __float_as_int(yacc), 0x111, 0xF, 0xF, false));
                    }
                    yp[(size_t)(blk * TB) * CW] = yacc;
                    __syncthreads();
              }
              *(f32x4*)(out + OUT_WKVP + ((size_t)(b * NH + h) * 64 + q * 16 + crow) * 64 + kq * 4) = (f32x4){S0, S1, S2, S3};
            } else {
              const int pw = wave - 4, ch = h * 64 + lane;
              const float c_kk = k_k[ch], c_ka = k_a[ch], c_rk = r_k[ch], mu_r = mu_shift[ch], mu_k = mu_shift[CW + ch], mu_v = mu_shift[2 * CW + ch];
              const bf16_t* pbase = Proj + (size_t)(b * TT) * PJP + PW + ch; const float* dbase = Dec + (size_t)(b * TT) * CW + ch; const bf16_t* abase = Ab + (size_t)(b * TT) * CW + ch;
              unsigned short rr[NPS + 1], kr_[NPS + 1], vr[NPS + 1], aa[NPS]; float dd[NPS]; float zmk = 1.f;
#define SCAN_LOAD(blk) do { const int t0_ = (blk) * TB + pw * NPS; const float zm_ = t0_ == 0 ? 0.f : 1.f; \
            _Pragma("unroll") for (int i_ = 0; i_ < NPS + 1; ++i_) { const unsigned t_ = (unsigned)((i_ == 0 && t0_ == 0) ? 0 : t0_ - 1 + i_); const bf16_t* pp_ = pbase + t_ * (unsigned)PJP; \
                rr[i_] = pp_[0]; kr_[i_] = pp_[CW]; vr[i_] = pp_[2 * CW]; } \
            zmk = zm_; \
            _Pragma("unroll") for (int i_ = 0; i_ < NPS; ++i_) { const unsigned mi_ = (unsigned)(t0_ + i_) * (unsigned)CW; dd[i_] = dbase[mi_]; aa[i_] = abase[mi_]; } } while (0)
#define SCAN_PRODUCE(blk) do { LAS float* bufp_ = ldf + ((blk) & 1) * (TB * REC); const int t0_ = (blk) * TB + pw * NPS; \
            _Pragma("unroll") for (int i_ = 0; i_ < NPS; ++i_) { \
                const float zz_ = i_ == 0 ? zmk : 1.f; \
                const float rc_ = bf2f(rr[i_ + 1]), kc_ = bf2f(kr_[i_ + 1]), vc_ = bf2f(vr[i_ + 1]), rp_ = bf2f(rr[i_]) * zz_, kp_ = bf2f(kr_[i_]) * zz_, vp_ = bf2f(vr[i_]) * zz_; \
                const float r_ = rc_ + (rp_ - rc_) * mu_r, k_ = kc_ + (kp_ - kc_) * mu_k, v_ = vc_ + (vp_ - vc_) * mu_v; \
                const float a_ = bf2f(aa[i_]), d_ = dd[i_]; \
                const float kkr_ = k_ * c_kk; const float n2_ = wsum(kkr_ * kkr_); const float kk_ = kkr_ * rsqrtf(fmaxf(n2_, 1e-24f)); \
                const float kt_ = k_ * (1.0f + (a_ - 1.0f) * c_ka); const float bv_ = kk_ * a_; \
                const float br_ = wsum(bv_ * r_), krs_ = wsum(kt_ * r_), bon_ = wsum(r_ * kt_ * c_rk); \
                LAS float* rec_ = bufp_ + (pw * NPS + i_) * REC; \
                rec_[lane] = -kk_; rec_[64 + lane] = bv_; rec_[128 + lane] = d_; rec_[192 + lane] = kt_; rec_[256 + lane] = d_ * r_; rec_[320 + lane] = v_; \
                if (lane == 0) { rec_[384] = br_; rec_[385] = krs_; if (q == 0) Bonus[(size_t)(b * TT + t0_ + i_) * NH + h] = bon_; } } } while (0)
              SCAN_LOAD(0); SCAN_PRODUCE(0); SCAN_LOAD(1);
              __syncthreads();
              for (int blk = 0; blk < TT / TB; ++blk) {
                if (blk + 1 < TT / TB) { SCAN_PRODUCE(blk + 1); if (blk + 2 < TT / TB) SCAN_LOAD(blk + 2); }
                __syncthreads();
              }
            }
#undef SCAN_LOAD
#undef SCAN_PRODUCE
        }
        __syncthreads();
        LAS float* wl = ldf + wave * 512;
        for (int p = gwave; p < MSA * NH; p += gwaves) {
            const int b = p >> 4, h = p & 15, m = MPR + b, ch = h * 64 + lane;
            const bf16_t* pp = Proj + (size_t)m * PJP + PW + ch; const float* sp = state_shift + (size_t)b * SW + ch;
            const float rc = bf2f(pp[0]), kc = bf2f(pp[CW]), vc = bf2f(pp[2 * CW]);
            const float r = rc + (sp[0] - rc) * mu_shift[ch], k = kc + (sp[CW] - kc) * mu_shift[CW + ch], v = vc + (sp[2 * CW] - vc) * mu_shift[2 * CW + ch];
            const float d = Dec[(size_t)m * CW + ch], a = bf2f(Ab[(size_t)m * CW + ch]);
            const float kkr = k * k_k[ch]; const float n2 = wsum(kkr * kkr); const float kk = kkr * rsqrtf(fmaxf(n2, 1e-24f));
            const float kt = k * (1.0f + (a - 1.0f) * k_a[ch]);
            const float bon = wsum(r * kt * r_k[ch]);
            wl[lane] = -kk; wl[64 + lane] = kk * a; wl[128 + lane] = d; wl[192 + lane] = kt; wl[256 + lane] = r; wl[320 + lane] = v;
            asm volatile("s_waitcnt lgkmcnt(0)" ::: "memory");
            const int kq = lane & 15, r4 = lane >> 4;
            const f32x4 av = *(const LAS f32x4*)(wl + kq * 4), bv = *(const LAS f32x4*)(wl + 64 + kq * 4), dw = *(const LAS f32x4*)(wl + 128 + kq * 4);
            const f32x4 ktv = *(const LAS f32x4*)(wl + 192 + kq * 4), rv = *(const LAS f32x4*)(wl + 256 + kq * 4);
            const float* sin_ = state_wkv + (size_t)(b * NH + h) * 4096; float* sout = out + OUT_WKVS + (size_t)(b * NH + h) * 4096;
#pragma unroll 4
            for (int j = 0; j < 16; ++j) {
                const int row = r4 + 4 * j; f32x4 Sv = *(const f32x4*)(sin_ + row * 64 + kq * 4);
                float da = (Sv[0] * av[0] + Sv[1] * av[1]) + (Sv[2] * av[2] + Sv[3] * av[3]); da = red16(da);
                const float vv = wl[320 + row];
                Sv = Sv * dw + da * bv + vv * ktv;
                *(f32x4*)(sout + row * 64 + kq * 4) = Sv;
                float dy = (Sv[0] * rv[0] + Sv[1] * rv[1]) + (Sv[2] * rv[2] + Sv[3] * rv[3]); dy = red16(dy);
                if (kq == 0) wl[384 + row] = dy;
            }
            asm volatile("s_waitcnt lgkmcnt(0)" ::: "memory");
            const float y = wl[384 + lane];
            const float mean = wsum(y) * (1.0f / 64.0f); const float dl = y - mean; const float var = wsum(dl * dl) * (1.0f / 64.0f);
            const float yn = dl * rsqrtf(var + GN_EPS) * gn_w[ch] + gn_b[ch];
            const float o = (yn + bon * v) * bf2f(Gb[(size_t)m * CW + ch]);
            Mix[(size_t)m * D + PW + ch] = (bf16_t)f2bf(o);
            asm volatile("s_waitcnt lgkmcnt(0)" ::: "memory");
        }
    }
    SEAM();

    if (IN(5)) {
        PHASE_IDS
        { pg8::Gemm g{Mix, WoutT, D, D, 256}; pg8::SplitKOrder S{8, KS6, 32, 256, G, (bid + G - 192 % G) % G};
          EpiPartial E{Part6}; pg8::gemm_phase(lds, g, S, E); }
        {
            const int half = gwave & 1, ch0 = half * 512 + lane * 8, h = ch0 >> 6;
            const f32x4 mu0 = *(const f32x4*)(mu_shift + 2 * CW + ch0), mu1 = *(const f32x4*)(mu_shift + 2 * CW + ch0 + 4);
            const f32x4 gw0 = *(const f32x4*)(gn_w + ch0), gw1 = *(const f32x4*)(gn_w + ch0 + 4), gb0 = *(const f32x4*)(gn_b + ch0), gb1 = *(const f32x4*)(gn_b + ch0 + 4);
            for (int it0 = gwave; it0 < MPR * 2; it0 += 2 * gwaves) {
                f32x4 y0[2], y1[2]; u32x4 vc[2], vp[2], gt[2]; float bon[2]; int mm[2]; bool val[2];
#pragma unroll
                for (int u = 0; u < 2; ++u) {
                    const int it = it0 + u * gwaves; val[u] = it < MPR * 2; const int m = val[u] ? (it >> 1) : 0; mm[u] = m;
                    const int mprev = (m & (TT - 1)) ? m - 1 : m;
                    y0[u] = *(const f32x4*)(Yb + (size_t)m * CW + ch0); y1[u] = *(const f32x4*)(Yb + (size_t)m * CW + ch0 + 4);
                    vc[u] = *(const u32x4*)(Proj + (size_t)m * PJP + PW + 2 * CW + ch0); vp[u] = *(const u32x4*)(Proj + (size_t)mprev * PJP + PW + 2 * CW + ch0);
                    gt[u] = *(const u32x4*)(Gb + (size_t)m * CW + ch0); bon[u] = Bonus[(size_t)m * NH + h];
                }
#pragma unroll
                for (int u = 0; u < 2; ++u) {
                    const int m = mm[u]; const float fm = (m & (TT - 1)) == 0 ? 0.f : 1.f;
                    float y[8] = {y0[u][0], y0[u][1], y0[u][2], y0[u][3], y1[u][0], y1[u][1], y1[u][2], y1[u][3]};
                    float s = ((y[0] + y[1]) + (y[2] + y[3])) + ((y[4] + y[5]) + (y[6] + y[7])); s = red8(s);
                    const float mean = s * (1.0f / 64.0f); float q2 = 0.f;
#pragma unroll
                    for (int j = 0; j < 8; ++j) { y[j] -= mean; q2 += y[j] * y[j]; }
                    q2 = red8(q2); const float rstd = rsqrtf(q2 * (1.0f / 64.0f) + GN_EPS);
                    unsigned ow[4];
#pragma unroll
                    for (int j2 = 0; j2 < 4; ++j2) {
                        float o2[2];
#pragma unroll
                        for (int e = 0; e < 2; ++e) {
                            const int j = j2 * 2 + e; const unsigned cw = vc[u][j2], pw_ = vp[u][j2], gw_ = gt[u][j2];
                            const float c_ = e ? bf2f(cw >> 16) : bf2f(cw & 0xffffu), p_ = fm * (e ? bf2f(pw_ >> 16) : bf2f(pw_ & 0xffffu)), g_ = e ? bf2f(gw_ >> 16) : bf2f(gw_ & 0xffffu);
                            const float mu_ = j < 4 ? mu0[j & 3] : mu1[j & 3], gnw = j < 4 ? gw0[j & 3] : gw1[j & 3], gnb = j < 4 ? gb0[j & 3] : gb1[j & 3];
                            const float v = c_ + (p_ - c_) * mu_;
                            o2[e] = (y[j] * rstd * gnw + gnb + bon[u] * v) * g_;
                        }
                        ow[j2] = pk_bf16(o2[0], o2[1]);
                    }
                    if (val[u]) *(u32x4*)(Mix + (size_t)m * D + PW + ch0) = (u32x4){ow[0], ow[1], ow[2], ow[3]};
                }
            }
        }
    }
    SEAM();

    if (IN(6)) {
        PHASE_IDS
        pg8::Gemm g{Mix, WoutT, D, D, D}; pg8::StaticOrder S; S.init(MPR, D, G, bid);
        EpiOut E{x_prompt, x_sample, out, H2, norm_ffn, rowsq1};
        pg8::gemm_phase(lds, g, S, E);
        for (int r = gwave; r < MSA; r += gwaves) {
            const int row = MPR + r; float s = 0.f;
#pragma unroll
            for (int i = 0; i < 8; ++i) {
                const int c = (i * 64 + lane) * 4; f32x4 x1 = *(const f32x4*)(x_sample + (size_t)r * D + c);
#pragma unroll
                for (int ks = 0; ks < KS6; ++ks) x1 = x1 + *(const f32x4*)(Part6 + ((size_t)ks * MSA + r) * D + c);
                *(f32x4*)(out + (size_t)row * D + c) = x1;
                s += (x1[0] * x1[0] + x1[1] * x1[1]) + (x1[2] * x1[2] + x1[3] * x1[3]);
                const f32x4 hv = x1 * *(const f32x4*)(norm_ffn + c);
                u32x2 w; w.x = pk_bf16(hv[0], hv[1]); w.y = pk_bf16(hv[2], hv[3]); *(u32x2*)(H2 + (size_t)row * D + c) = w;
            }
            s = wsum(s); if (lane == 0) rowsq1[row] = s;
        }
    }
    SEAM();

    if (IN(7)) {
        PHASE_IDS
        pg8::Gemm g{H2, WguT, D, D, D}; pg8::StaticOrder S; S.init(MPAD, 2 * DFF, G, bid);
        EpiGU E{Ub, rowsq1};
        pg8::gemm_phase(lds, g, S, E);
    }
    SEAM();

    if (IN(8)) {
        PHASE_IDS
        { pg8::Gemm g{Ub, WdnT, DFF, DFF, DFF}; pg8::StaticOrder S; S.init(MPR, D, G, bid);
          EpiDown E{out}; pg8::gemm_phase(lds, g, S, E); }
        { pg8::Gemm g{Ub, WdnT, DFF, DFF, 512}; pg8::SplitKOrder S{8, KS8, 32, 512, G, bid};
          EpiPartial E{Part8}; pg8::gemm_phase(lds, g, S, E); }
    }
    SEAM();

    if (IN(9)) {
        PHASE_IDS
        for (int row = gwave; row < MV; row += gwaves) {
            float* p = out + (size_t)row * D; f32x4 v[8]; float s = 0.f;
#pragma unroll
            for (int i = 0; i < 8; ++i) v[i] = *(const f32x4*)(p + (i * 64 + lane) * 4);
            if (row >= MPR) {
#pragma unroll
                for (int i = 0; i < 8; ++i)
#pragma unroll
                    for (int ks = 0; ks < KS8; ++ks) v[i] = v[i] + *(const f32x4*)(Part8 + ((size_t)ks * MSA + (row - MPR)) * D + (i * 64 + lane) * 4);
            }
#pragma unroll
            for (int i = 0; i < 8; ++i) s += (v[i][0] * v[i][0] + v[i][1] * v[i][1]) + (v[i][2] * v[i][2] + v[i][3] * v[i][3]);
            s = wsum(s); const float rstd = rsqrtf(s * (1.0f / D) + RMS_EPS);
#pragma unroll
            for (int i = 0; i < 8; ++i) { const int c = (i * 64 + lane) * 4; *(f32x4*)(p + c) = v[i] * rstd * *(const f32x4*)(norm_final + c); }
        }
    }
#undef IN
#undef SEAM
}

#ifndef HY_MULTI
#define HY_MULTI 0
#endif
#ifndef HY_REP
#define HY_REP 0x2C
#endif
extern "C" void kernel_launch(void* const* d_in, const int* in_sizes, int n_in, void* d_out, int out_size, void* d_ws, size_t ws_size, hipStream_t stream) {
    static int grid = 0;
    if (grid == 0) {
        if (n_in != 26 || ws_size < WS_END) { fprintf(stderr, "kernel_launch: need 26 inputs and >= %zu bytes of workspace (got %d, %zu)\n", (size_t)WS_END, n_in, ws_size); grid = -1; return; }
        int dev = 0, cus = 0, per_cu = 0;
        hipGetDevice(&dev); hipDeviceGetAttribute(&cus, hipDeviceAttributeMultiprocessorCount, dev);
        if (hipFuncSetAttribute((const void*)hymba_fwd, hipFuncAttributeMaxDynamicSharedMemorySize, LDS_BYTES) != hipSuccess) { fprintf(stderr, "kernel_launch: hipFuncSetAttribute failed\n"); grid = -1; return; }
        if (hipOccupancyMaxActiveBlocksPerMultiprocessor(&per_cu, (const void*)hymba_fwd, NTHR, LDS_BYTES) != hipSuccess || per_cu < 1) { fprintf(stderr, "kernel_launch: occupancy query says %d\n", per_cu); per_cu = 1; }
        (void)hipGetLastError();
        grid = cus;
        if (grid > 256) grid = 256;
    }
    if (grid < 0) return;
    Params p{};
    for (int i = 0; i < 26; ++i) p.in[i] = (const float*)d_in[i];
    p.out = (float*)d_out; p.ws = (unsigned char*)d_ws;
#if HY_MULTI
    p.multi = 1;
    for (int ph = 0; ph < 10; ++ph) { p.phase = ph; for (int r = 0; r < ((HY_REP >> ph) & 1) + 1; ++r) hipLaunchKernelGGL(hymba_fwd, dim3(grid), dim3(NTHR), LDS_BYTES, stream, p); }
#else
    p.multi = 0; p.phase = 0;
    hipMemsetAsync((char*)d_ws + WS_BAR, 0, 4096, stream);
    void* args[] = {&p};
    hipError_t e = hipLaunchCooperativeKernel((const void*)hymba_fwd, dim3(grid), dim3(NTHR), args, LDS_BYTES, stream);
    if (e != hipSuccess) fprintf(stderr, "cooperative launch failed: %s (grid %d)\n", hipGetErrorString(e), grid);
#endif
}
```

```cpp
#include <hip/hip_runtime.h>
#include <hip/hip_cooperative_groups.h>
#include <cstdio>
namespace cg = cooperative_groups;

#define LAS __attribute__((address_space(3)))
typedef unsigned short bf16_t;
typedef short bf16x8 __attribute__((ext_vector_type(8)));
typedef float f32x4 __attribute__((ext_vector_type(4)));
typedef float f32x2 __attribute__((ext_vector_type(2)));
typedef unsigned u32x4 __attribute__((ext_vector_type(4)));
typedef unsigned u32x2 __attribute__((ext_vector_type(2)));

constexpr int D = 2048, TT = 2048, MPR = 8192, MSA = 128, MV = 8320, MPAD = 8448;
constexpr int PW = 1024, SW = 3360, PJ = 4384, PJP = 4608, DFF = 5632, CW = 1024, NH = 16;
constexpr int NTHR = 512, LDS_BYTES = 131072;
constexpr float RMS_EPS = 1e-6f, GN_EPS = 64e-5f;

constexpr size_t WS_WIN = 0;
constexpr size_t WS_WOUT = WS_WIN + (size_t)PJP * D * 2;
constexpr size_t WS_WGU = WS_WOUT + (size_t)D * D * 2;
constexpr size_t WS_WDN = WS_WGU + (size_t)2 * DFF * D * 2;
constexpr size_t WS_WPOOL = WS_WDN + (size_t)D * DFF * 2;
constexpr size_t WS_WLORA = WS_WPOOL + (size_t)4 * 256 * 256 * 2;
constexpr size_t WS_R1 = WS_WLORA + (size_t)3 * 1024 * 256 * 2;
constexpr size_t WS_PROJ = WS_R1 + (size_t)MPAD * D * 2;
constexpr size_t WS_A = WS_PROJ + (size_t)MPAD * PJP * 2;
constexpr size_t WS_GATE = WS_A + (size_t)MPAD * CW * 2;
constexpr size_t WS_MIX = WS_GATE + (size_t)MPAD * CW * 2;
constexpr size_t WS_ROWSQ = WS_MIX + (size_t)MPAD * D * 2;
constexpr size_t WS_BONUS = WS_ROWSQ + (size_t)2 * MPAD * 4;
constexpr size_t WS_BAR = WS_BONUS + (size_t)MV * NH * 4;
constexpr size_t WS_END = WS_BAR + 4096;
static_assert((size_t)MPAD * DFF * 2 <= (WS_MIX - WS_PROJ), "U must fit in proj+a+gate");
constexpr size_t R1_POOLED = 0, R1_L = (size_t)MPAD * PW * 2;
constexpr int KS6 = 8, KS8 = 11;
static_assert((size_t)KS6 * MSA * D * 4 <= (size_t)MPAD * CW * 2 && (size_t)KS8 * MSA * D * 4 <= (size_t)MPAD * D * 2, "partial buffers alias WS_A / WS_R1");

constexpr size_t OUT_Y = 0;
constexpr size_t OUT_POOLP = (size_t)MV * D;
constexpr size_t OUT_SHIFTP = OUT_POOLP + (size_t)4 * 15 * PW;
constexpr size_t OUT_WKVP = OUT_SHIFTP + (size_t)4 * SW;
constexpr size_t OUT_POOLS = OUT_WKVP + (size_t)4 * NH * 64 * 64;
constexpr size_t OUT_SHIFTS = OUT_POOLS + (size_t)MSA * 15 * PW;
constexpr size_t OUT_WKVS = OUT_SHIFTS + (size_t)MSA * SW;
constexpr size_t SCR_Y = 0;
constexpr size_t SCR_DEC = (size_t)MPR * CW;
static_assert(SCR_DEC + (size_t)MV * CW <= OUT_POOLP, "scratch must fit in the y region");

struct Params { const float* in[26]; float* out; unsigned char* ws; int multi; int phase; };

__device__ __forceinline__ float bf2f(unsigned b) { return __uint_as_float(b << 16); }
__device__ __forceinline__ unsigned f2bf(float f) { unsigned u = __float_as_uint(f); u += 0x7FFFu + ((u >> 16) & 1u); return u >> 16; }
__device__ __forceinline__ unsigned pk_bf16(float lo, float hi) { unsigned r; asm volatile("v_cvt_pk_bf16_f32 %0, %1, %2" : "=v"(r) : "v"(lo), "v"(hi)); return r; }
template <int CTRL> __device__ __forceinline__ float dpp(float x) { return __int_as_float(__builtin_amdgcn_update_dpp(0, __float_as_int(x), CTRL, 0xF, 0xF, true)); }
__device__ __forceinline__ float red16(float x) {
    x += dpp<0x128>(x); x += dpp<0x124>(x); x += dpp<0x4E>(x); x += dpp<0xB1>(x); return x;
}
__device__ __forceinline__ float wsum(float x) { x = red16(x); x += __shfl_xor(x, 16); x += __shfl_xor(x, 32); return x; }
__device__ __forceinline__ float fma_(float a, float b, float c) { float d; asm("v_fma_f32 %0, %1, %2, %3" : "=v"(d) : "v"(a), "v"(b), "v"(c)); return d; }
__device__ __forceinline__ f32x2 pkmul_(f32x2 a, f32x2 b) { f32x2 d; asm("v_pk_mul_f32 %0, %1, %2" : "=v"(d) : "v"(a), "v"(b)); return d; }
__device__ __forceinline__ f32x2 pkfma_(f32x2 a, f32x2 b, f32x2 c) { f32x2 d; asm("v_pk_fma_f32 %0, %1, %2, %3" : "=v"(d) : "v"(a), "v"(b), "v"(c)); return d; }
__device__ __forceinline__ f32x2 pkfma_b(f32x2 a, f32x2 s, f32x2 c) { f32x2 d; asm("v_pk_fma_f32 %0, %1, %2, %3 op_sel_hi:[1,0,1]" : "=v"(d) : "v"(a), "v"(s), "v"(c)); return d; }
__device__ __forceinline__ f32x2 lo2(f32x4 v) { return __builtin_shufflevector(v, v, 0, 1); }
__device__ __forceinline__ f32x2 hi2(f32x4 v) { return __builtin_shufflevector(v, v, 2, 3); }
__device__ __forceinline__ float mul_(float a, float b) { float d; asm("v_mul_f32 %0, %1, %2" : "=v"(d) : "v"(a), "v"(b)); return d; }
__device__ __forceinline__ float sigmoidf_(float x) { return 1.0f / (1.0f + __expf(-x)); }

#define WG_BAR() do { asm volatile("s_waitcnt lgkmcnt(0)" ::: "memory"); __builtin_amdgcn_s_barrier(); asm volatile("" ::: "memory"); } while (0)

__device__ __forceinline__ void grid_bar(unsigned* ctr, unsigned target) {
    asm volatile("s_waitcnt vmcnt(0) lgkmcnt(0)" ::: "memory");
    __syncthreads();
    if (threadIdx.x == 0) {
        __builtin_amdgcn_fence(__ATOMIC_RELEASE, "agent");
        asm volatile("s_waitcnt vmcnt(0)" ::: "memory");
        __hip_atomic_fetch_add(ctr, 1u, __ATOMIC_RELAXED, __HIP_MEMORY_SCOPE_AGENT);
        while (__hip_atomic_load(ctr, __ATOMIC_RELAXED, __HIP_MEMORY_SCOPE_AGENT) < target) __builtin_amdgcn_s_sleep(4);
        __builtin_amdgcn_fence(__ATOMIC_ACQUIRE, "agent");
        asm volatile("s_waitcnt vmcnt(0)" ::: "memory");
    }
    __syncthreads();
}

namespace pg8 {
constexpr int BM = 256, BK = 64, HALF = 128, HTB = HALF * BK * 2, NXCD = 8, WGM = 8;
__device__ __forceinline__ int lds_byte(int r, int c) { const int st = (r >> 4) * 2 + (c >> 5), rr = r & 15, cc = c & 31, ob = rr * 64 + cc * 2; return st * 1024 + (ob ^ (((ob >> 9) & 1) << 5)); }
__device__ __forceinline__ void stage_rc(int b, int& R, int& C) { const int st = b / 1024, sb = b % 1024, swz = sb ^ (((sb >> 9) & 1) << 5); R = (st >> 1) * 16 + swz / 64; C = (st & 1) * 32 + (swz % 64) / 2; }
__device__ __forceinline__ int perm32(int rho) { const int n = rho >> 4, i = rho & 15; return 8 * (i >> 2) + 4 * n + (i & 3); }
struct Unit { int pm, pn, ks, koff; };
struct Gemm { const bf16_t* A; const bf16_t* Bt; int lda, ldb, K; };
struct StaticOrder {
    int nM, nN, nwg, G, c;
    __device__ void init(int M, int N, int G_, int c_) { nM = M / BM; nN = N / BM; nwg = nM * nN; G = G_; c = c_; }
    __device__ bool next(int i, Unit& u) const {
        const long L = (long)i * G + c; if (L >= nwg) return false;
        int wgid = (int)L; { const int q = nwg / NXCD, r = nwg % NXCD, xcd = wgid % NXCD, off = wgid / NXCD; wgid = (xcd < r ? xcd * (q + 1) : r * (q + 1) + (xcd - r) * q) + off; }
        const int nig = WGM * nN, gid = wgid / nig, fm = gid * WGM, gsz = (nM - fm) < WGM ? (nM - fm) : WGM;
        u.pm = fm + ((wgid % nig) % gsz); u.pn = (wgid % nig) / gsz; u.ks = 0; u.koff = 0; return true;
    }
};
struct SplitKOrder {
    int nN, nks, pm, kchunk, G, c;
    __device__ bool next(int i, Unit& u) const { const long L = (long)i * G + c; if (L >= (long)nN * nks) return false;
        u.pm = pm; u.pn = (int)(L % nN); u.ks = (int)(L / nN); u.koff = u.ks * kchunk; return true; }
};

template <class Epi, class Sched>
__device__ __forceinline__ void gemm_phase(LAS unsigned char* lds, const Gemm g, const Sched& S, const Epi& E) {
    const int tid = threadIdx.x, wid = __builtin_amdgcn_readfirstlane(tid >> 6), lane = tid & 63, wr = wid >> 2, wc = wid & 3, fr = lane & 15, fq = lane >> 4;
    const int K = g.K, nt = K / BK;
    unsigned voffA[2], voffB[2];
#pragma unroll
    for (int i = 0; i < 2; ++i) { int R, C; stage_rc(tid * 16 + i * 8192, R, C); const int Rb = Epi::PERM ? ((R & ~31) + perm32(R & 31)) : R;
        voffA[i] = (unsigned)(R * g.lda + C) * 2u; voffB[i] = (unsigned)(Rb * g.ldb + C) * 2u; }
    const size_t kstep = (size_t)(BK * 2);
    const size_t hstepA = (size_t)HALF * g.lda * 2, hstepB = (size_t)HALF * g.ldb * 2;
    const size_t tstepA = 2 * hstepA, tstepB = 2 * hstepB;
    const unsigned ldsw = (unsigned)wid * 1024u;
    const int aoff = lds_byte(wr * 64 + fr, fq * 8), boff = lds_byte(wc * 32 + fr, fq * 8);
#define PG8_SA(b, h) (((b) * 2 + (h)) * HTB)
#define PG8_SB(b, h) ((4 + (b) * 2 + (h)) * HTB)
#define PG8_STAGE(bufoff, gbase, voff) do { _Pragma("unroll") for (int _i = 0; _i < 2; ++_i) \
        __builtin_amdgcn_global_load_lds((const unsigned*)((const char*)(gbase) + (voff)[_i]), (LAS unsigned*)(lds + (bufoff) + ldsw + _i * 8192), 16, 0, 0); } while (0)
#define PG8_LDA(dst, b, h) do { _Pragma("unroll") for (int m = 0; m < 4; ++m) _Pragma("unroll") for (int k = 0; k < 2; ++k) dst[m][k] = *(const LAS bf16x8*)(lds + PG8_SA(b, h) + aoff + m * 2048 + k * 1024); } while (0)
#define PG8_LDB(dst, b, h) do { _Pragma("unroll") for (int n = 0; n < 2; ++n) _Pragma("unroll") for (int k = 0; k < 2; ++k) dst[n][k] = *(const LAS bf16x8*)(lds + PG8_SB(b, h) + boff + n * 2048 + k * 1024); } while (0)
#define PG8_MMA(ai, bj, At, Bt) do { __builtin_amdgcn_s_setprio(1); _Pragma("unroll") for (int m = 0; m < 4; ++m) _Pragma("unroll") for (int n = 0; n < 2; ++n) _Pragma("unroll") for (int k = 0; k < 2; ++k) \
        acc[ai][bj][m][n] = __builtin_amdgcn_mfma_f32_16x16x32_bf16(Bt[n][k], At[m][k], acc[ai][bj][m][n], 0, 0, 0); __builtin_amdgcn_s_setprio(0); } while (0)
#define PG8_WAIT_V(n) asm volatile("s_waitcnt vmcnt(" #n ")" ::: "memory")
#define PG8_WAIT_L(n) asm volatile("s_waitcnt lgkmcnt(" #n ")" ::: "memory")
#define PG8_BAR __builtin_amdgcn_s_barrier()
#define PG8_SCHED __builtin_amdgcn_sched_barrier(0)
    Unit cur, nxt; int ui = 0;
    if (!S.next(0, cur)) return;
    f32x4 acc[2][2][4][2];
#pragma unroll
    for (int a = 0; a < 2; ++a)
#pragma unroll
        for (int b = 0; b < 2; ++b)
#pragma unroll
            for (int m = 0; m < 4; ++m)
#pragma unroll
                for (int n = 0; n < 2; ++n) acc[a][b][m][n] = (f32x4){0.f, 0.f, 0.f, 0.f};
    bf16x8 At[4][2], B0[2][2], B1[2][2];
    const char* cA = (const char*)g.A + (size_t)cur.pm * tstepA + (size_t)cur.koff * 2; const char* cB = (const char*)g.Bt + (size_t)cur.pn * tstepB + (size_t)cur.koff * 2;
    PG8_STAGE(PG8_SB(0, 0), cB, voffB); PG8_STAGE(PG8_SA(0, 0), cA, voffA); PG8_STAGE(PG8_SB(0, 1), cB + hstepB, voffB); PG8_STAGE(PG8_SA(0, 1), cA + hstepA, voffA);
    if (wr == 1) PG8_BAR;
    PG8_WAIT_V(4); PG8_BAR;
    PG8_STAGE(PG8_SB(1, 0), cB + kstep, voffB); PG8_STAGE(PG8_SA(1, 0), cA + kstep, voffA); PG8_STAGE(PG8_SB(1, 1), cB + hstepB + kstep, voffB);
    PG8_WAIT_V(6); PG8_BAR;
    for (;;) {
        const bool has_next = S.next(ui + 1, nxt);
        const char* nA = has_next ? (const char*)g.A + (size_t)nxt.pm * tstepA + (size_t)nxt.koff * 2 : cA; const char* nB = has_next ? (const char*)g.Bt + (size_t)nxt.pn * tstepB + (size_t)nxt.koff * 2 : cB;
#pragma clang loop unroll(disable)
        for (int t = 0; t < nt; t += 2) {
            const bool last = (t == nt - 2);
            const char* a1 = cA + (size_t)(t + 1) * kstep;
            const char* a2 = last ? nA : cA + (size_t)(t + 2) * kstep; const char* b2 = last ? nB : cB + (size_t)(t + 2) * kstep;
            const char* a3 = a2 + kstep; const char* b3 = b2 + kstep;
            PG8_LDB(B0, 0, 0); PG8_SCHED; PG8_LDA(At, 0, 0); PG8_STAGE(PG8_SA(1, 1), a1 + hstepA, voffA);
            PG8_WAIT_L(8); PG8_BAR; PG8_WAIT_L(0); PG8_MMA(0, 0, At, B0); PG8_BAR; PG8_SCHED;
            PG8_LDB(B1, 0, 1); PG8_STAGE(PG8_SB(0, 0), b2, voffB);
            PG8_BAR; PG8_WAIT_L(0); PG8_MMA(0, 1, At, B1); PG8_BAR;
            PG8_LDA(At, 0, 1); PG8_STAGE(PG8_SA(0, 0), a2, voffA);
            PG8_BAR; PG8_WAIT_L(0); PG8_MMA(1, 0, At, B0); PG8_BAR; PG8_SCHED;
            PG8_STAGE(PG8_SB(0, 1), b2 + hstepB, voffB);
            PG8_WAIT_V(6); PG8_BAR; PG8_MMA(1, 1, At, B1); PG8_BAR;
            PG8_LDB(B0, 1, 0); PG8_SCHED; PG8_LDA(At, 1, 0); PG8_STAGE(PG8_SA(0, 1), a2 + hstepA, voffA);
            PG8_WAIT_L(8); PG8_BAR; PG8_WAIT_L(0); PG8_MMA(0, 0, At, B0); PG8_BAR; PG8_SCHED;
            PG8_LDB(B1, 1, 1); PG8_STAGE(PG8_SB(1, 0), b3, voffB);
            PG8_BAR; PG8_WAIT_L(0); PG8_MMA(0, 1, At, B1); PG8_BAR;
            PG8_LDA(At, 1, 1); PG8_STAGE(PG8_SA(1, 0), a3, voffA);
            PG8_BAR; PG8_WAIT_L(0); PG8_MMA(1, 0, At, B0); PG8_BAR; PG8_SCHED;
            PG8_STAGE(PG8_SB(1, 1), b3 + hstepB, voffB);
            PG8_WAIT_V(6); PG8_BAR; PG8_MMA(1, 1, At, B1); PG8_BAR;
        }
        E(acc, cur, wr, wc, fr, fq);
        if (!has_next) break;
#pragma unroll
        for (int a = 0; a < 2; ++a)
#pragma unroll
            for (int b = 0; b < 2; ++b)
#pragma unroll
                for (int m = 0; m < 4; ++m)
#pragma unroll
                    for (int n = 0; n < 2; ++n) acc[a][b][m][n] = (f32x4){0.f, 0.f, 0.f, 0.f};
        cur = nxt; cA = nA; cB = nB; ++ui;
    }
    PG8_WAIT_V(0);
    if (wr == 0) PG8_BAR;
    PG8_BAR;
#undef PG8_SA
#undef PG8_SB
#undef PG8_STAGE
#undef PG8_LDA
#undef PG8_LDB
#undef PG8_MMA
#undef PG8_WAIT_V
#undef PG8_WAIT_L
#undef PG8_BAR
#undef PG8_SCHED
}
}
using pg8::Unit;

template <int MODE> struct EpiBf16 {
    static constexpr bool PERM = true;
    bf16_t* O; int ldc; int coff; const float* vec;
    __device__ __forceinline__ void operator()(const f32x4 (&acc)[2][2][4][2], const Unit& u, int wr, int wc, int fr, int fq) const {
        const int row0 = u.pm * 256 + wr * 64 + fr, col0 = coff + u.pn * 256 + wc * 32 + 8 * fq;
#pragma unroll
        for (int bj = 0; bj < 2; ++bj) {
            const int c = col0 + bj * 128;
            f32x4 s0, s1;
            if (MODE == 0) { s0 = vec ? *(const f32x4*)(vec + c) : (f32x4){1.f, 1.f, 1.f, 1.f}; s1 = vec ? *(const f32x4*)(vec + c + 4) : (f32x4){1.f, 1.f, 1.f, 1.f}; }
            else { s0 = *(const f32x4*)(vec + c); s1 = *(const f32x4*)(vec + c + 4); }
#pragma unroll
            for (int ai = 0; ai < 2; ++ai)
#pragma unroll
                for (int m = 0; m < 4; ++m) {
                    f32x4 v0 = acc[ai][bj][m][0], v1 = acc[ai][bj][m][1];
                    if (MODE == 0) { v0 = v0 * s0; v1 = v1 * s1; }
                    else {
#pragma unroll
                        for (int j = 0; j < 4; ++j) { v0[j] = sigmoidf_(v0[j] + s0[j]); v1[j] = sigmoidf_(v1[j] + s1[j]); } }
                    u32x4 w; w.x = pk_bf16(v0[0], v0[1]); w.y = pk_bf16(v0[2], v0[3]); w.z = pk_bf16(v1[0], v1[1]); w.w = pk_bf16(v1[2], v1[3]);
                    *(u32x4*)(O + (size_t)(row0 + ai * 128 + m * 16) * ldc + c) = w;
                }
        }
    }
};
struct EpiP3 {
    static constexpr bool PERM = true;
    int mode; bf16_t* Ob; float* Of; int ldc, coff; const float* vec;
    __device__ __forceinline__ void operator()(const f32x4 (&acc)[2][2][4][2], const Unit& u, int wr, int wc, int fr, int fq) const {
        const int row0 = u.pm * 256 + wr * 64 + fr, col0 = coff + u.pn * 256 + wc * 32 + 8 * fq;
#pragma unroll
        for (int bj = 0; bj < 2; ++bj) {
            const int c = col0 + bj * 128;
            const f32x4 one = (f32x4){1.f, 1.f, 1.f, 1.f};
            const f32x4 s0 = vec ? *(const f32x4*)(vec + c) : one, s1 = vec ? *(const f32x4*)(vec + c + 4) : one;
#pragma unroll
            for (int ai = 0; ai < 2; ++ai)
#pragma unroll
                for (int m = 0; m < 4; ++m) {
                    const int row = row0 + ai * 128 + m * 16;
                    f32x4 v0 = acc[ai][bj][m][0], v1 = acc[ai][bj][m][1];
                    if (mode == 0) { v0 = v0 * s0; v1 = v1 * s1; }
                    else if (mode == 1) {
#pragma unroll
                        for (int j = 0; j < 4; ++j) { v0[j] = sigmoidf_(v0[j] + s0[j]); v1[j] = sigmoidf_(v1[j] + s1[j]); } }
                    else {
                        v0 = v0 + s0; v1 = v1 + s1;
#pragma unroll
                        for (int j = 0; j < 4; ++j) {
                            const float z0 = -v0[j], z1 = -v1[j];
                            const float sp0 = fmaxf(z0, 0.f) + __logf(1.0f + __expf(-fabsf(z0))), sp1 = fmaxf(z1, 0.f) + __logf(1.0f + __expf(-fabsf(z1)));
                            v0[j] = __expf(-__expf(-sp0 - 0.5f)); v1[j] = __expf(-__expf(-sp1 - 0.5f)); }
                    }
                    if (mode == 2) { if (row < MV) { float* p = Of + (size_t)row * ldc + c; *(f32x4*)p = v0; *(f32x4*)(p + 4) = v1; } }
                    else { u32x4 w; w.x = pk_bf16(v0[0], v0[1]); w.y = pk_bf16(v0[2], v0[3]); w.z = pk_bf16(v1[0], v1[1]); w.w = pk_bf16(v1[2], v1[3]);
                        *(u32x4*)(Ob + (size_t)row * ldc + c) = w; }
                }
        }
    }
};
struct EpiDecay {
    static constexpr bool PERM = false;
    float* O; const float* w0;
    __device__ __forceinline__ void operator()(const f32x4 (&acc)[2][2][4][2], const Unit& u, int wr, int wc, int fr, int fq) const {
        const int row0 = u.pm * 256 + wr * 64 + fr, col0 = u.pn * 256 + wc * 32 + 4 * fq;
#pragma unroll
        for (int bj = 0; bj < 2; ++bj)
#pragma unroll
            for (int n = 0; n < 2; ++n) {
                const int c = col0 + bj * 128 + n * 16; const f32x4 b = *(const f32x4*)(w0 + c);
#pragma unroll
                for (int ai = 0; ai < 2; ++ai)
#pragma unroll
                    for (int m = 0; m < 4; ++m) {
                        const int row = row0 + ai * 128 + m * 16; f32x4 v = acc[ai][bj][m][n] + b, o;
#pragma unroll
                        for (int j = 0; j < 4; ++j) { const float z = -v[j]; const float sp = fmaxf(z, 0.f) + __logf(1.0f + __expf(-fabsf(z))); o[j] = __expf(-__expf(-sp - 0.5f)); }
                        if (row < MV) *(f32x4*)(O + (size_t)row * CW + c) = o;
                    }
            }
    }
};
struct EpiOut {
    static constexpr bool PERM = false;
    const float* xp; const float* xs; float* out; bf16_t* h2; const float* g; float* rowsq;
    __device__ __forceinline__ void operator()(const f32x4 (&acc)[2][2][4][2], const Unit& u, int wr, int wc, int fr, int fq) const {
        const int row0 = u.pm * 256 + wr * 64 + fr, col0 = u.pn * 256 + wc * 32 + 4 * fq;
#pragma unroll
        for (int ai = 0; ai < 2; ++ai)
#pragma unroll
            for (int m = 0; m < 4; ++m) {
                const int row = row0 + ai * 128 + m * 16; const bool ok = row < MV;
                const float* xr = row < MPR ? xp + (size_t)row * D : xs + (size_t)(ok ? row - MPR : 0) * D;
                float s = 0.f;
#pragma unroll
                for (int bj = 0; bj < 2; ++bj)
#pragma unroll
                    for (int n = 0; n < 2; ++n) {
                        const int c = col0 + bj * 128 + n * 16;
                        f32x4 x1 = acc[ai][bj][m][n];
                        if (ok) { x1 = x1 + *(const f32x4*)(xr + c); *(f32x4*)(out + (size_t)row * D + c) = x1; }
                        s += (x1[0] * x1[0] + x1[1] * x1[1]) + (x1[2] * x1[2] + x1[3] * x1[3]);
                        const f32x4 gg = *(const f32x4*)(g + c); const f32x4 hv = x1 * gg;
                        u32x2 w; w.x = pk_bf16(hv[0], hv[1]); w.y = pk_bf16(hv[2], hv[3]);
                        *(u32x2*)(h2 + (size_t)row * D + c) = w;
                    }
                s += __shfl_xor(s, 16); s += __shfl_xor(s, 32);
                if (ok && fq == 0) unsafeAtomicAdd(rowsq + row, s);
            }
    }
};
struct EpiGU {
    static constexpr bool PERM = true;
    bf16_t* U; const float* rowsq;
    __device__ __forceinline__ void operator()(const f32x4 (&acc)[2][2][4][2], const Unit& u, int wr, int wc, int fr, int fq) const {
        const int row0 = u.pm * 256 + wr * 64 + fr, col0 = u.pn * 128 + wc * 32 + 8 * fq;
#pragma unroll
        for (int ai = 0; ai < 2; ++ai)
#pragma unroll
            for (int m = 0; m < 4; ++m) {
                const int row = row0 + ai * 128 + m * 16;
                const float rstd = rsqrtf(rowsq[row] * (1.0f / D) + RMS_EPS);
                f32x4 o[2];
#pragma unroll
                for (int n = 0; n < 2; ++n)
#pragma unroll
                    for (int j = 0; j < 4; ++j) { const float gt = acc[ai][0][m][n][j] * rstd, up = acc[ai][1][m][n][j] * rstd; o[n][j] = gt * sigmoidf_(gt) * up; }
                u32x4 w; w.x = pk_bf16(o[0][0], o[0][1]); w.y = pk_bf16(o[0][2], o[0][3]); w.z = pk_bf16(o[1][0], o[1][1]); w.w = pk_bf16(o[1][2], o[1][3]);
                *(u32x4*)(U + (size_t)row * DFF + col0) = w;
            }
    }
};
struct EpiDown {
    static constexpr bool PERM = false;
    float* out;
    __device__ __forceinline__ void operator()(const f32x4 (&acc)[2][2][4][2], const Unit& u, int wr, int wc, int fr, int fq) const {
        const int row0 = u.pm * 256 + wr * 64 + fr, col0 = u.pn * 256 + wc * 32 + 4 * fq;
#pragma unroll
        for (int ai = 0; ai < 2; ++ai)
#pragma unroll
            for (int m = 0; m < 4; ++m) {
                const int row = row0 + ai * 128 + m * 16;
#pragma unroll
                for (int bj = 0; bj < 2; ++bj)
#pragma unroll
                    for (int n = 0; n < 2; ++n) {
                        const int c = col0 + bj * 128 + n * 16; float* p = out + (size_t)row * D + c;
                        *(f32x4*)p = acc[ai][bj][m][n] + *(const f32x4*)p;
                    }
            }
    }
};
struct EpiPartial {
    static constexpr bool PERM = false;
    float* buf;
    __device__ __forceinline__ void operator()(const f32x4 (&acc)[2][2][4][2], const Unit& u, int wr, int wc, int fr, int fq) const {
        const int col0 = u.pn * 256 + wc * 32 + 4 * fq;
#pragma unroll
        for (int m = 0; m < 4; ++m) {
            const int lrow = wr * 64 + m * 16 + fr;
            float* p = buf + ((size_t)u.ks * MSA + lrow) * D + col0;
#pragma unroll
            for (int bj = 0; bj < 2; ++bj)
#pragma unroll
                for (int n = 0; n < 2; ++n) *(f32x4*)(p + bj * 128 + n * 16) = acc[0][bj][m][n];
        }
    }
};

template <int RM> __device__ __forceinline__ int rowmap(int n) { return RM == 0 ? n : (RM == 1 ? ((n >> 7) * 256 + (n & 127)) : ((n >> 7) * 256 + 128 + (n & 127))); }
template <int RM>
__device__ __forceinline__ void transpose_bf16(const float* src, int Ksrc, int Nsrc, int ld, bf16_t* dst, int Kdst, int Ndst, int rot, int vgw, int gws) {
    const int lane = threadIdx.x & 63, gw = (vgw + rot) % gws;
    const int nn = Ndst / 64, ntile = nn * (Kdst / 64);
    for (int t = gw; t < ntile; t += gws) {
        const int k0 = (t / nn) * 64, n = (t % nn) * 64 + lane;
        const bool nok = n < Nsrc;
        const float* sp = src + (nok ? n : 0);
        float v[64];
        const float mskn = nok ? 1.f : 0.f;
#pragma unroll
        for (int j = 0; j < 64; ++j) { const int k = k0 + j; v[j] = sp[(size_t)(k < Ksrc ? k : Ksrc - 1) * ld]; }
#pragma unroll
        for (int j = 0; j < 64; ++j) v[j] *= ((k0 + j) < Ksrc ? mskn : 0.f);
        bf16_t* dp = dst + (size_t)rowmap<RM>(n) * Kdst + k0;
#pragma unroll
        for (int q8 = 0; q8 < 8; ++q8) { u32x4 w; w.x = pk_bf16(v[q8 * 8 + 0], v[q8 * 8 + 1]); w.y = pk_bf16(v[q8 * 8 + 2], v[q8 * 8 + 3]); w.z = pk_bf16(v[q8 * 8 + 4], v[q8 * 8 + 5]); w.w = pk_bf16(v[q8 * 8 + 6], v[q8 * 8 + 7]);
            *(u32x4*)(dp + q8 * 8) = w; }
    }
}
template <int CTRL> __device__ __forceinline__ float dpp_(float x) { return __int_as_float(__builtin_amdgcn_update_dpp(0, __float_as_int(x), CTRL, 0xF, 0xF, true)); }
__device__ __forceinline__ float red8(float x) { x += dpp_<0x141>(x); x += dpp_<0xB1>(x); x += dpp_<0x4E>(x); return x; }

template <int W>
__device__ __forceinline__ void pool_block_prompt(const bf16_t* proj, bf16_t* pooled, int b, int t0, int c) {
    float ux[15 + W], uy[15 + W]; unsigned raw[15 + W];
#pragma unroll
    for (int j = 0; j < 15 + W; ++j) {
        const int t = t0 - (W - 1) + j;
        raw[j] = *(const unsigned*)(proj + (size_t)(b * TT + (t < 0 ? 0 : t)) * PJP + c);
    }
#pragma unroll
    for (int j = 0; j < 15 + W; ++j) {
        const int t = t0 - (W - 1) + j; const float zm = t < 0 ? 0.f : 1.f;
        ux[j] = bf2f(raw[j] & 0xffffu) * zm; uy[j] = bf2f(raw[j] >> 16) * zm;
    }
#pragma unroll
    for (int i = 0; i < 16; ++i) {
        const int t = t0 + i; float sx = 0.f, sy = 0.f;
#pragma unroll
        for (int j = 0; j < W; ++j) { sx += ux[i + j]; sy += uy[i + j]; }
        const float inv = 1.0f / (float)(t + 1 < W ? t + 1 : W);
        const float px = sx * inv - ux[i + W - 1], py = sy * inv - uy[i + W - 1];
        *(unsigned*)(pooled + (size_t)(b * TT + t) * PW + c) = pk_bf16(px, py);
    }
}

__global__ void __launch_bounds__(NTHR) hymba_fwd(Params P) {
    extern __shared__ __attribute__((aligned(16))) unsigned char lds_raw[];
    LAS unsigned char* lds = (LAS unsigned char*)lds_raw;
    const int G = gridDim.x, bid = blockIdx.x, gthreads = G * NTHR, gwaves = G * 8;
#define PHASE_IDS int tid = threadIdx.x; asm volatile("" : "+v"(tid)); const int lane = tid & 63, wave = tid >> 6, gtid = bid * NTHR + tid, gwave = bid * 8 + wave; (void)lane; (void)wave; (void)gtid; (void)gwave;
    unsigned char* ws = P.ws; float* out = P.out;
    const float* x_prompt = P.in[0]; const float* x_sample = P.in[1]; const float* state_pool = P.in[2]; const float* state_shift = P.in[3]; const float* state_wkv = P.in[4];
    const float* norm_mix = P.in[5]; const float* w_in = P.in[6]; const float* w_pool = P.in[7]; const float* pool_scale = P.in[8]; const float* mu_shift = P.in[9];
    const float* w0 = P.in[10]; const float* w2 = P.in[11]; const float* a0 = P.in[12]; const float* a2 = P.in[13]; const float* g2 = P.in[14];
    const float* k_k = P.in[15]; const float* k_a = P.in[16]; const float* r_k = P.in[17]; const float* gn_w = P.in[18]; const float* gn_b = P.in[19];
    const float* w_out = P.in[20]; const float* norm_ffn = P.in[21]; const float* w_gate = P.in[22]; const float* w_up = P.in[23]; const float* w_down = P.in[24]; const float* norm_final = P.in[25];
    bf16_t* WinT = (bf16_t*)(ws + WS_WIN); bf16_t* WoutT = (bf16_t*)(ws + WS_WOUT); bf16_t* WguT = (bf16_t*)(ws + WS_WGU); bf16_t* WdnT = (bf16_t*)(ws + WS_WDN);
    bf16_t* WpoolT = (bf16_t*)(ws + WS_WPOOL); bf16_t* WloraT = (bf16_t*)(ws + WS_WLORA);
    bf16_t* Hb = (bf16_t*)(ws + WS_R1); bf16_t* Pooled = (bf16_t*)(ws + WS_R1 + R1_POOLED); bf16_t* Lb = (bf16_t*)(ws + WS_R1 + R1_L); bf16_t* H2 = (bf16_t*)(ws + WS_R1);
    bf16_t* Proj = (bf16_t*)(ws + WS_PROJ); bf16_t* Ub = (bf16_t*)(ws + WS_PROJ); bf16_t* Ab = (bf16_t*)(ws + WS_A); bf16_t* Gb = (bf16_t*)(ws + WS_GATE);
    bf16_t* Mix = (bf16_t*)(ws + WS_MIX); float* rowsq1 = (float*)(ws + WS_ROWSQ); float* Bonus = (float*)(ws + WS_BONUS);
    unsigned* barctr = (unsigned*)(ws + WS_BAR);
    float* Yb = out + SCR_Y; float* Dec = out + SCR_DEC;
    float* Part6 = (float*)(ws + WS_A);
    float* Part8 = (float*)(ws + WS_R1);
    unsigned nbar = 0;
#ifndef P3SEL
#define P3SEL 15
#endif
#ifndef PHASE_MASK
#define PHASE_MASK 0x3ff
#endif
#define IN(k) (((PHASE_MASK >> (k)) & 1) && (!P.multi || P.phase == (k)))
#define SEAM() do { if (!P.multi) { ++nbar; grid_bar(barctr, nbar * (unsigned)G); } } while (0)

    if (IN(0)) {
        PHASE_IDS
        transpose_bf16<0>(w_in, D, PJ, PJ, WinT, D, PJP, 0, gwave, gwaves);
        transpose_bf16<0>(w_out, D, D, D, WoutT, D, D, 256, gwave, gwaves);
        for (int g = 0; g < 4; ++g) transpose_bf16<0>(w_pool + (size_t)g * 65536, 256, 256, 256, WpoolT + (size_t)g * 65536, 256, 256, 1280 + g * 16, gwave, gwaves);
        transpose_bf16<0>(w2, 64, CW, CW, WloraT, 256, CW, 1344, gwave, gwaves);
        transpose_bf16<0>(a2, 64, CW, CW, WloraT + (size_t)CW * 256, 256, CW, 1408, gwave, gwaves);
        transpose_bf16<0>(g2, 160, CW, CW, WloraT + (size_t)2 * CW * 256, 256, CW, 1472, gwave, gwaves);
        for (int i = gtid; i < MPAD; i += gthreads) rowsq1[i] = 0.f;
        for (int m = gwave; m < MPAD; m += gwaves) {
            bf16_t* hr = Hb + (size_t)m * D;
            if (m < MV) {
                const float* xr = m < MPR ? x_prompt + (size_t)m * D : x_sample + (size_t)(m - MPR) * D;
                f32x4 v[8]; float s = 0.f;
#pragma unroll
                for (int i = 0; i < 8; ++i) v[i] = *(const f32x4*)(xr + (i * 64 + lane) * 4);
#pragma unroll
                for (int i = 0; i < 8; ++i) s += (v[i][0] * v[i][0] + v[i][1] * v[i][1]) + (v[i][2] * v[i][2] + v[i][3] * v[i][3]);
                s = wsum(s); const float rstd = rsqrtf(s * (1.0f / D) + RMS_EPS);
#pragma unroll
                for (int i = 0; i < 8; ++i) { const int c = (i * 64 + lane) * 4; const f32x4 gg = *(const f32x4*)(norm_mix + c); const f32x4 o = v[i] * rstd * gg;
                    u32x2 w; w.x = pk_bf16(o[0], o[1]); w.y = pk_bf16(o[2], o[3]); *(u32x2*)(hr + c) = w; }
            } else {
#pragma unroll
                for (int i = 0; i < 8; ++i) *(u32x2*)(hr + (i * 64 + lane) * 4) = (u32x2){0u, 0u};
            }
        }
    }
    if (P.multi == 2) cg::this_grid().sync();
    SEAM();

    if (IN(1)) {
        PHASE_IDS
        pg8::Gemm g{Hb, WinT, D, D, D}; pg8::StaticOrder S; S.init(MPAD, PJP, G, bid);
        EpiBf16<0> E{Proj, PJP, 0, nullptr};
        pg8::gemm_phase(lds, g, S, E);
    }
    SEAM();

    if (IN(2)) {
        PHASE_IDS
        for (int rb = bid; rb < MPR / 16; rb += G) {
            const int b = rb >> 7, t0 = (rb & 127) * 16, c = tid * 2, gq = tid >> 7;
            if (gq == 0) pool_block_prompt<2>(Proj, Pooled, b, t0, c);
            else if (gq == 1) pool_block_prompt<4>(Proj, Pooled, b, t0, c);
            else if (gq == 2) pool_block_prompt<8>(Proj, Pooled, b, t0, c);
            else pool_block_prompt<16>(Proj, Pooled, b, t0, c);
        }
        for (int b = bid; b < MSA; b += G) {
            const int c = tid * 2, W = 2 << (tid >> 7);
            const unsigned v = *(const unsigned*)(Proj + (size_t)(MPR + b) * PJP + c); const float ux = bf2f(v & 0xffffu), uy = bf2f(v >> 16);
            float sx = ux, sy = uy;
            for (int j = 1; j < W; ++j) { const f32x2 p = *(const f32x2*)(state_pool + ((size_t)b * 15 + 15 - j) * PW + c); sx += p[0]; sy += p[1]; }
            const float inv = 1.0f / (float)W;
            *(unsigned*)(Pooled + (size_t)(MPR + b) * PW + c) = pk_bf16(sx * inv - ux, sy * inv - uy);
            float* np = out + OUT_POOLS + (size_t)b * 15 * PW;
            for (int j = 0; j < 14; ++j) *(f32x2*)(np + (size_t)j * PW + c) = *(const f32x2*)(state_pool + ((size_t)b * 15 + j + 1) * PW + c);
            *(f32x2*)(np + (size_t)14 * PW + c) = (f32x2){ux, uy};
        }
        {
            constexpr int NIT = MV * 144;
            for (int base = gtid; base < NIT; base += 3 * gthreads) {
                unsigned cv[3], pv[3]; f32x2 mu[3]; int mm[3], cpo[3], sg[3], pcs[3]; bool val[3];
#pragma unroll
                for (int u = 0; u < 3; ++u) {
                    const int idx = base + u * gthreads; val[u] = idx < NIT; const int id2 = val[u] ? idx : 0;
                    const int m = id2 / 144, jp = id2 - m * 144, seg = jp < 32 ? 0 : (jp < 64 ? 1 : 2);
                    const int j = (jp - (seg == 0 ? 0 : (seg == 1 ? 32 : 64))) * 2, pc = (seg == 0 ? 3072 : (seg == 1 ? 3136 : 3200)) + j;
                    mm[u] = m; sg[u] = seg; cpo[u] = seg * 256 + j; pcs[u] = pc;
                    const int mprev = (m >= MPR || (m & (TT - 1)) == 0) ? m : m - 1;
                    cv[u] = *(const unsigned*)(Proj + (size_t)m * PJP + PW + pc);
                    pv[u] = *(const unsigned*)(Proj + (size_t)mprev * PJP + PW + pc);
                    mu[u] = *(const f32x2*)(mu_shift + pc);
                }
#pragma unroll
                for (int u = 0; u < 3; ++u) {
                    const int m = mm[u]; const float cx = bf2f(cv[u] & 0xffffu), cy = bf2f(cv[u] >> 16);
                    const float fm = (m & (TT - 1)) == 0 ? 0.f : 1.f;
                    float px = bf2f(pv[u] & 0xffffu) * fm, py = bf2f(pv[u] >> 16) * fm;
                    if (m >= MPR) { const f32x2 p = *(const f32x2*)(state_shift + (size_t)(m - MPR) * SW + pcs[u]); px = p[0]; py = p[1]; }
                    float vx = cx + (px - cx) * mu[u][0], vy = cy + (py - cy) * mu[u][1];
                    if (sg[u] == 0) { vx = tanhf(vx); vy = tanhf(vy); } else if (sg[u] == 2) { vx = sigmoidf_(vx); vy = sigmoidf_(vy); }
                    if (val[u]) *(unsigned*)(Lb + (size_t)m * 768 + cpo[u]) = pk_bf16(vx, vy);
                }
            }
        }
        for (int i = gtid; i < 4 * SW; i += gthreads) { const int b = i / SW, j = i - b * SW; out[OUT_SHIFTP + i] = bf2f(Proj[(size_t)(b * TT + TT - 1) * PJP + PW + j]); }
        for (int i = gtid; i < MSA * SW; i += gthreads) { const int b = i / SW, j = i - b * SW; out[OUT_SHIFTS + i] = bf2f(Proj[(size_t)(MPR + b) * PJP + PW + j]); }
        for (int i = gtid; i < 4 * 15 * PW; i += gthreads) { const int b = i / (15 * PW), r = i - b * 15 * PW, j = r / PW, c = r - j * PW; out[OUT_POOLP + i] = bf2f(Proj[(size_t)(b * TT + TT - 15 + j) * PJP + c]); }
    }
    SEAM();

    if (IN(3)) {
        PHASE_IDS
#pragma clang loop unroll(disable)
        for (int job = 0; job < 7; ++job) {
            const bool pool = job < 4; const int sgm = job - 4;
            pg8::Gemm g{pool ? Pooled + job * 256 : Lb + sgm * 256, pool ? WpoolT + (size_t)job * 65536 : WloraT + (size_t)sgm * CW * 256, pool ? PW : 768, 256, 256};
            const int rot = pool ? job * 33 : (sgm == 0 ? 132 : (sgm == 1 ? 8 : 140));
            pg8::StaticOrder S; S.init(MPAD, pool ? 256 : CW, G, (bid + G - rot % G) % G);
            EpiP3 E{pool ? 0 : (sgm == 0 ? 2 : (sgm == 1 ? 1 : 0)), pool ? Mix : (sgm == 1 ? Ab : Gb), Dec, pool ? D : CW, pool ? job * 256 : 0,
                    pool ? pool_scale : (sgm == 0 ? w0 : (sgm == 1 ? a0 : (const float*)nullptr))};
            pg8::gemm_phase(lds, g, S, E);
        }
    }
    SEAM();

    if (IN(4)) {
        PHASE_IDS
        LAS float* ldf = (LAS float*)lds;
        constexpr int REC = 392, TB = 16, NPS = TB / 4;
        for (int unit = bid; unit < 256; unit += G) {
            const int s = unit >> 2, b = s >> 4, h = s & 15, q = unit & 3;
            const int wv = __builtin_amdgcn_readfirstlane(tid >> 6);
            if (wv < 2) {
              const int crow = wv * 8 + (lane >> 3), kq = lane & 7; const bool first8 = kq == 0;
              f32x2 S2[4];
#pragma unroll
              for (int e = 0; e < 4; ++e) S2[e] = (f32x2){0.f, 0.f};
              const LAS float* recq0 = ldf + kq * 8; const LAS float* recv0 = ldf + 320 + q * 16 + crow;
              float* yp = Yb + (size_t)(b * TT + 7 - kq) * CW + h * 64 + q * 16 + crow;
              WG_BAR();
              for (int blk = 0; blk < TT / TB; ++blk) {
                    const int bo = (blk & 1) * (TB * REC);
                    const LAS float* recq = recq0 + bo; const LAS float* recv = recv0 + bo; const LAS float* recs = ldf + bo + 384;
                    f32x4 av0 = *(const LAS f32x4*)(recq), av1 = *(const LAS f32x4*)(recq + 4), bv0 = *(const LAS f32x4*)(recq + 64), bv1 = *(const LAS f32x4*)(recq + 68);
                    f32x4 dw0 = *(const LAS f32x4*)(recq + 128), dw1 = *(const LAS f32x4*)(recq + 132), kt0 = *(const LAS f32x4*)(recq + 192), kt1 = *(const LAS f32x4*)(recq + 196);
                    f32x4 wr0 = *(const LAS f32x4*)(recq + 256), wr1 = *(const LAS f32x4*)(recq + 260);
                    float vv = recv[0]; f32x2 sc = *(const LAS f32x2*)(recs);
                    float yacc = 0.f;
#pragma unroll
                    for (int st = 0; st < TB; ++st) {
                        const f32x4 a0 = av0, a1 = av1, b0 = bv0, b1 = bv1, d0 = dw0, d1 = dw1, k0 = kt0, k1 = kt1, w0_ = wr0, w1_ = wr1; const float vv_ = vv; const f32x2 sc_ = sc;
                        if (st + 1 < TB) {
                            const int o = (st + 1) * REC;
                            av0 = *(const LAS f32x4*)(recq + o); av1 = *(const LAS f32x4*)(recq + o + 4); bv0 = *(const LAS f32x4*)(recq + o + 64); bv1 = *(const LAS f32x4*)(recq + o + 68);
                            dw0 = *(const LAS f32x4*)(recq + o + 128); dw1 = *(const LAS f32x4*)(recq + o + 132); kt0 = *(const LAS f32x4*)(recq + o + 192); kt1 = *(const LAS f32x4*)(recq + o + 196);
                            wr0 = *(const LAS f32x4*)(recq + o + 256); wr1 = *(const LAS f32x4*)(recq + o + 260);
                            vv = recv[o]; sc = *(const LAS f32x2*)(recs + o);
                        }
                        const f32x2 pa = pkfma_(S2[3], hi2(a1), pkfma_(S2[2], lo2(a1), pkfma_(S2[1], hi2(a0), pkmul_(S2[0], lo2(a0)))));
                        const f32x2 py = pkfma_(S2[3], hi2(w1_), pkfma_(S2[2], lo2(w1_), pkfma_(S2[1], hi2(w0_), pkmul_(S2[0], lo2(w0_)))));
                        float da = pa[0] + pa[1], dy = py[0] + py[1];
                        da = red8(da); dy = red8(dy);
                        const float y = dy + da * sc_[0] + vv_ * sc_[1];
                        { f32x2 dab, vvb; dab[0] = da; dab[1] = da; vvb[0] = vv_; vvb[1] = vv_;
                          S2[0] = pkfma_b(lo2(k0), vvb, pkfma_b(lo2(b0), dab, pkmul_(S2[0], lo2(d0)))); S2[1] = pkfma_b(hi2(k0), vvb, pkfma_b(hi2(b0), dab, pkmul_(S2[1], hi2(d0))));
                          S2[2] = pkfma_b(lo2(k1), vvb, pkfma_b(lo2(b1), dab, pkmul_(S2[2], lo2(d1)))); S2[3] = pkfma_b(hi2(k1), vvb, pkfma_b(hi2(b1), dab, pkmul_(S2[3], hi2(d1)))); }
                        const float sh = __int_as_float(__builtin_amdgcn_update_dpp(__float_as_int(y), __float_as_int(yacc), 0x111, 0xF, 0xF, false));
                        yacc = first8 ? y : sh;
                        if ((st & 7) == 7) yp[(size_t)(blk * TB + (st - 7)) * CW] = yacc;
                        asm volatile("" ::: "memory");
                    }
                    WG_BAR();
              }
              float* so = out + OUT_WKVP + ((size_t)(b * NH + h) * 64 + q * 16 + crow) * 64 + kq * 8;
              *(f32x4*)so = (f32x4){S2[0][0], S2[0][1], S2[1][0], S2[1][1]}; *(f32x4*)(so + 4) = (f32x4){S2[2][0], S2[2][1], S2[3][0], S2[3][1]};
            } else if (wv == 4 || wv == 5) {
              constexpr int CT_PER = 5632, CT_ALL = 3 * CT_PER;
              float cvv[32]; int ctile = unit * 2 + (wv - 4), cph = 0;
#define CONV_LOAD16(P0_) do { if (ctile < CT_ALL) { const int m_ = ctile / CT_PER, r_ = ctile - m_ * CT_PER; const float* sp_; unsigned ld_; \
                    if (m_ < 2) { sp_ = (m_ == 0 ? w_gate : w_up) + (size_t)((r_ / 88) * 32) * DFF + (r_ % 88) * 64; ld_ = DFF; } \
                    else { sp_ = w_down + (size_t)((r_ >> 5) * 32) * D + (r_ & 31) * 64; ld_ = D; } \
                    _Pragma("unroll") for (int j_ = (P0_); j_ < (P0_) + 16; ++j_) cvv[j_] = sp_[(unsigned)j_ * ld_ + lane]; } } while (0)
#define CONV_STORE() do { if (ctile < CT_ALL) { const int m_ = ctile / CT_PER, r_ = ctile - m_ * CT_PER; bf16_t* dp_; \
                    if (m_ < 2) { const int k0_ = (r_ / 88) * 32, n_ = (r_ % 88) * 64 + lane; dp_ = WguT + (size_t)((n_ >> 7) * 256 + (m_ == 1 ? 128 : 0) + (n_ & 127)) * D + k0_; } \
                    else { const int k0_ = (r_ >> 5) * 32, n_ = (r_ & 31) * 64 + lane; dp_ = WdnT + (size_t)n_ * DFF + k0_; } \
                    _Pragma("unroll") for (int q8_ = 0; q8_ < 4; ++q8_) { u32x4 w_; w_.x = pk_bf16(cvv[q8_ * 8 + 0], cvv[q8_ * 8 + 1]); w_.y = pk_bf16(cvv[q8_ * 8 + 2], cvv[q8_ * 8 + 3]); \
                        w_.z = pk_bf16(cvv[q8_ * 8 + 4], cvv[q8_ * 8 + 5]); w_.w = pk_bf16(cvv[q8_ * 8 + 6], cvv[q8_ * 8 + 7]); *(u32x4*)(dp_ + q8_ * 8) = w_; } \
                    ctile += 512; } } while (0)
              WG_BAR();
              for (int blk = 0; blk < TT / TB; ++blk) {
                if (cph == 0) CONV_LOAD16(0); else if (cph == 1) CONV_LOAD16(16); else CONV_STORE();
                cph = cph == 2 ? 0 : cph + 1;
                WG_BAR();
              }
              while (ctile < CT_ALL) {
                if (cph <= 0) CONV_LOAD16(0);
                if (cph <= 1) CONV_LOAD16(16);
                CONV_STORE(); cph = 0;
              }
#undef CONV_LOAD16
#undef CONV_STORE
            } else {
              const int pw = (wv & 1) + ((wv >> 2) << 1), ch = h * 64 + lane;
              const float c_kk = k_k[ch], c_ka = k_a[ch], c_rk = r_k[ch], mu_r = mu_shift[ch], mu_k = mu_shift[CW + ch], mu_v = mu_shift[2 * CW + ch];
              const bf16_t* pbase = Proj + (size_t)(b * TT) * PJP + PW + h * 64; const float* dbase = Dec + (size_t)(b * TT) * CW + h * 64; const bf16_t* abase = Ab + (size_t)(b * TT) * CW + h * 64;
              constexpr int PD = 4;
              unsigned short rr[PD][NPS + 1], kr_[PD][NPS + 1], vr[PD][NPS + 1], aa[PD][NPS]; float dd[PD][NPS];
#define SCAN_LOAD(blk, SET) do { const int t0_ = (blk) * TB + pw * NPS; \
            _Pragma("unroll") for (int i_ = 0; i_ < NPS + 1; ++i_) { const unsigned t_ = (unsigned)((i_ == 0 && t0_ == 0) ? 0 : t0_ - 1 + i_); const bf16_t* pp_ = pbase + t_ * (unsigned)PJP; \
                rr[SET][i_] = pp_[lane]; kr_[SET][i_] = pp_[CW + lane]; vr[SET][i_] = pp_[2 * CW + lane]; } \
            _Pragma("unroll") for (int i_ = 0; i_ < NPS; ++i_) { const unsigned mi_ = (unsigned)(t0_ + i_) * (unsigned)CW; dd[SET][i_] = dbase[mi_ + lane]; aa[SET][i_] = abase[mi_ + lane]; } } while (0)
#define SCAN_PRODUCE(blk, SET) do { LAS float* bufp_ = ldf + ((blk) & 1) * (TB * REC); const int t0_ = (blk) * TB + pw * NPS; \
            _Pragma("unroll") for (int i_ = 0; i_ < NPS; ++i_) { \
                const float zz_ = (i_ == 0 && t0_ == 0) ? 0.f : 1.f; \
                const float rc_ = bf2f(rr[SET][i_ + 1]), kc_ = bf2f(kr_[SET][i_ + 1]), vc_ = bf2f(vr[SET][i_ + 1]), rp_ = bf2f(rr[SET][i_]) * zz_, kp_ = bf2f(kr_[SET][i_]) * zz_, vp_ = bf2f(vr[SET][i_]) * zz_; \
                const float r_ = rc_ + (rp_ - rc_) * mu_r, k_ = kc_ + (kp_ - kc_) * mu_k, v_ = vc_ + (vp_ - vc_) * mu_v; \
                const float a_ = bf2f(aa[SET][i_]), d_ = dd[SET][i_]; \
                const float kkr_ = k_ * c_kk; const float n2_ = wsum(kkr_ * kkr_); const float kk_ = kkr_ * rsqrtf(fmaxf(n2_, 1e-24f)); \
                const float kt_ = k_ * (1.0f + (a_ - 1.0f) * c_ka); const float bv_ = kk_ * a_; \
                const float br_ = wsum(bv_ * r_), krs_ = wsum(kt_ * r_), bon_ = wsum(r_ * kt_ * c_rk); \
                LAS float* rec_ = bufp_ + (pw * NPS + i_) * REC; \
                rec_[lane] = -kk_; rec_[64 + lane] = bv_; rec_[128 + lane] = d_; rec_[192 + lane] = kt_; rec_[256 + lane] = d_ * r_; rec_[320 + lane] = v_; \
                if (lane == 0) { rec_[384] = br_; rec_[385] = krs_; if (q == 0) Bonus[(size_t)(b * TT + t0_ + i_) * NH + h] = bon_; } } } while (0)
              SCAN_LOAD(0, 0); SCAN_LOAD(1, 1); SCAN_LOAD(2, 2); SCAN_LOAD(3, 3);
              SCAN_PRODUCE(0, 0); SCAN_LOAD(4, 0);
              WG_BAR();
              static_assert((TT / TB) % PD == 0 && PD == 4, "block loop is unrolled by PD = 4");
              for (int blk0 = 0; blk0 < TT / TB; blk0 += PD) {
#define SCAN_ITER(D_, SET) do { const int blk = blk0 + (D_); if (blk + 1 < TT / TB) { SCAN_PRODUCE(blk + 1, SET); if (blk + 1 + PD < TT / TB) SCAN_LOAD(blk + 1 + PD, SET); } WG_BAR(); } while (0)
                SCAN_ITER(0, 1); SCAN_ITER(1, 2); SCAN_ITER(2, 3); SCAN_ITER(3, 0);
#undef SCAN_ITER
              }
            }
#undef SCAN_LOAD
#undef SCAN_PRODUCE
        }
        __syncthreads();
        LAS float* wl = ldf + wave * 512;
        for (int p = gwave; p < MSA * NH; p += gwaves) {
            const int b = p >> 4, h = p & 15, m = MPR + b, ch = h * 64 + lane;
            const bf16_t* pp = Proj + (size_t)m * PJP + PW + ch; const float* sp = state_shift + (size_t)b * SW + ch;
            const float rc = bf2f(pp[0]), kc = bf2f(pp[CW]), vc = bf2f(pp[2 * CW]);
            const float r = rc + (sp[0] - rc) * mu_shift[ch], k = kc + (sp[CW] - kc) * mu_shift[CW + ch], v = vc + (sp[2 * CW] - vc) * mu_shift[2 * CW + ch];
            const float d = Dec[(size_t)m * CW + ch], a = bf2f(Ab[(size_t)m * CW + ch]);
            const float kkr = k * k_k[ch]; const float n2 = wsum(kkr * kkr); const float kk = kkr * rsqrtf(fmaxf(n2, 1e-24f));
            const float kt = k * (1.0f + (a - 1.0f) * k_a[ch]);
            const float bon = wsum(r * kt * r_k[ch]);
            wl[lane] = -kk; wl[64 + lane] = kk * a; wl[128 + lane] = d; wl[192 + lane] = kt; wl[256 + lane] = r; wl[320 + lane] = v;
            asm volatile("s_waitcnt lgkmcnt(0)" ::: "memory");
            const int kq = lane & 15, r4 = lane >> 4;
            const f32x4 av = *(const LAS f32x4*)(wl + kq * 4), bv = *(const LAS f32x4*)(wl + 64 + kq * 4), dw = *(const LAS f32x4*)(wl + 128 + kq * 4);
            const f32x4 ktv = *(const LAS f32x4*)(wl + 192 + kq * 4), rv = *(const LAS f32x4*)(wl + 256 + kq * 4);
            const float* sin_ = state_wkv + (size_t)(b * NH + h) * 4096; float* sout = out + OUT_WKVS + (size_t)(b * NH + h) * 4096;
#pragma unroll 4
            for (int j = 0; j < 16; ++j) {
                const int row = r4 + 4 * j; f32x4 Sv = *(const f32x4*)(sin_ + row * 64 + kq * 4);
                float da = (Sv[0] * av[0] + Sv[1] * av[1]) + (Sv[2] * av[2] + Sv[3] * av[3]); da = red16(da);
                const float vv = wl[320 + row];
                Sv = Sv * dw + da * bv + vv * ktv;
                *(f32x4*)(sout + row * 64 + kq * 4) = Sv;
                float dy = (Sv[0] * rv[0] + Sv[1] * rv[1]) + (Sv[2] * rv[2] + Sv[3] * rv[3]); dy = red16(dy);
                if (kq == 0) wl[384 + row] = dy;
            }
            asm volatile("s_waitcnt lgkmcnt(0)" ::: "memory");
            const float y = wl[384 + lane];
            const float mean = wsum(y) * (1.0f / 64.0f); const float dl = y - mean; const float var = wsum(dl * dl) * (1.0f / 64.0f);
            const float yn = dl * rsqrtf(var + GN_EPS) * gn_w[ch] + gn_b[ch];
            const float o = (yn + bon * v) * bf2f(Gb[(size_t)m * CW + ch]);
            Mix[(size_t)m * D + PW + ch] = (bf16_t)f2bf(o);
            asm volatile("s_waitcnt lgkmcnt(0)" ::: "memory");
        }
    }
    SEAM();

    if (IN(5)) {
        PHASE_IDS
        { pg8::Gemm g{Mix, WoutT, D, D, 256}; pg8::SplitKOrder S{8, KS6, 32, 256, G, (bid + G - 192 % G) % G};
          EpiPartial E{Part6}; pg8::gemm_phase(lds, g, S, E); }
        {
            const int half = gwave & 1, ch0 = half * 512 + lane * 8, h = ch0 >> 6;
            const f32x4 mu0 = *(const f32x4*)(mu_shift + 2 * CW + ch0), mu1 = *(const f32x4*)(mu_shift + 2 * CW + ch0 + 4);
            const f32x4 gw0 = *(const f32x4*)(gn_w + ch0), gw1 = *(const f32x4*)(gn_w + ch0 + 4), gb0 = *(const f32x4*)(gn_b + ch0), gb1 = *(const f32x4*)(gn_b + ch0 + 4);
            for (int it0 = gwave; it0 < MPR * 2; it0 += 2 * gwaves) {
                f32x4 y0[2], y1[2]; u32x4 vc[2], vp[2], gt[2]; float bon[2]; int mm[2]; bool val[2];
#pragma unroll
                for (int u = 0; u < 2; ++u) {
                    const int it = it0 + u * gwaves; val[u] = it < MPR * 2; const int m = val[u] ? (it >> 1) : 0; mm[u] = m;
                    const int mprev = (m & (TT - 1)) ? m - 1 : m;
                    y0[u] = *(const f32x4*)(Yb + (size_t)m * CW + ch0); y1[u] = *(const f32x4*)(Yb + (size_t)m * CW + ch0 + 4);
                    vc[u] = *(const u32x4*)(Proj + (size_t)m * PJP + PW + 2 * CW + ch0); vp[u] = *(const u32x4*)(Proj + (size_t)mprev * PJP + PW + 2 * CW + ch0);
                    gt[u] = *(const u32x4*)(Gb + (size_t)m * CW + ch0); bon[u] = Bonus[(size_t)m * NH + h];
                }
#pragma unroll
                for (int u = 0; u < 2; ++u) {
                    const int m = mm[u]; const float fm = (m & (TT - 1)) == 0 ? 0.f : 1.f;
                    float y[8] = {y0[u][0], y0[u][1], y0[u][2], y0[u][3], y1[u][0], y1[u][1], y1[u][2], y1[u][3]};
                    float s = ((y[0] + y[1]) + (y[2] + y[3])) + ((y[4] + y[5]) + (y[6] + y[7])); s = red8(s);
                    const float mean = s * (1.0f / 64.0f); float q2 = 0.f;
#pragma unroll
                    for (int j = 0; j < 8; ++j) { y[j] -= mean; q2 += y[j] * y[j]; }
                    q2 = red8(q2); const float rstd = rsqrtf(q2 * (1.0f / 64.0f) + GN_EPS);
                    unsigned ow[4];
#pragma unroll
                    for (int j2 = 0; j2 < 4; ++j2) {
                        float o2[2];
#pragma unroll
                        for (int e = 0; e < 2; ++e) {
                            const int j = j2 * 2 + e; const unsigned cw = vc[u][j2], pw_ = vp[u][j2], gw_ = gt[u][j2];
                            const float c_ = e ? bf2f(cw >> 16) : bf2f(cw & 0xffffu), p_ = fm * (e ? bf2f(pw_ >> 16) : bf2f(pw_ & 0xffffu)), g_ = e ? bf2f(gw_ >> 16) : bf2f(gw_ & 0xffffu);
                            const float mu_ = j < 4 ? mu0[j & 3] : mu1[j & 3], gnw = j < 4 ? gw0[j & 3] : gw1[j & 3], gnb = j < 4 ? gb0[j & 3] : gb1[j & 3];
                            const float v = c_ + (p_ - c_) * mu_;
                            o2[e] = (y[j] * rstd * gnw + gnb + bon[u] * v) * g_;
                        }
                        ow[j2] = pk_bf16(o2[0], o2[1]);
                    }
                    if (val[u]) *(u32x4*)(Mix + (size_t)m * D + PW + ch0) = (u32x4){ow[0], ow[1], ow[2], ow[3]};
                }
            }
        }
    }
    SEAM();

    if (IN(6)) {
        PHASE_IDS
        pg8::Gemm g{Mix, WoutT, D, D, D}; pg8::StaticOrder S; S.init(MPR, D, G, bid);
        EpiOut E{x_prompt, x_sample, out, H2, norm_ffn, rowsq1};
        pg8::gemm_phase(lds, g, S, E);
        for (int r = gwave; r < MSA; r += gwaves) {
            const int row = MPR + r; float s = 0.f;
#pragma unroll
            for (int i = 0; i < 8; ++i) {
                const int c = (i * 64 + lane) * 4; f32x4 x1 = *(const f32x4*)(x_sample + (size_t)r * D + c);
#pragma unroll
                for (int ks = 0; ks < KS6; ++ks) x1 = x1 + *(const f32x4*)(Part6 + ((size_t)ks * MSA + r) * D + c);
                *(f32x4*)(out + (size_t)row * D + c) = x1;
                s += (x1[0] * x1[0] + x1[1] * x1[1]) + (x1[2] * x1[2] + x1[3] * x1[3]);
                const f32x4 hv = x1 * *(const f32x4*)(norm_ffn + c);
                u32x2 w; w.x = pk_bf16(hv[0], hv[1]); w.y = pk_bf16(hv[2], hv[3]); *(u32x2*)(H2 + (size_t)row * D + c) = w;
            }
            s = wsum(s); if (lane == 0) rowsq1[row] = s;
        }
    }
    SEAM();

    if (IN(7)) {
        PHASE_IDS
        pg8::Gemm g{H2, WguT, D, D, D}; pg8::StaticOrder S; S.init(MPAD, 2 * DFF, G, bid);
        EpiGU E{Ub, rowsq1};
        pg8::gemm_phase(lds, g, S, E);
    }
    SEAM();

    if (IN(8)) {
        PHASE_IDS
        { pg8::Gemm g{Ub, WdnT, DFF, DFF, DFF}; pg8::StaticOrder S; S.init(MPR, D, G, bid);
          EpiDown E{out}; pg8::gemm_phase(lds, g, S, E); }
        { pg8::Gemm g{Ub, WdnT, DFF, DFF, 512}; pg8::SplitKOrder S{8, KS8, 32, 512, G, bid};
          EpiPartial E{Part8}; pg8::gemm_phase(lds, g, S, E); }
    }
    SEAM();

    if (IN(9)) {
        PHASE_IDS
        for (int row = gwave; row < MV; row += gwaves) {
            float* p = out + (size_t)row * D; f32x4 v[8]; float s = 0.f;
#pragma unroll
            for (int i = 0; i < 8; ++i) v[i] = *(const f32x4*)(p + (i * 64 + lane) * 4);
            if (row >= MPR) {
#pragma unroll
                for (int i = 0; i < 8; ++i)
#pragma unroll
                    for (int ks = 0; ks < KS8; ++ks) v[i] = v[i] + *(const f32x4*)(Part8 + ((size_t)ks * MSA + (row - MPR)) * D + (i * 64 + lane) * 4);
            }
#pragma unroll
            for (int i = 0; i < 8; ++i) s += (v[i][0] * v[i][0] + v[i][1] * v[i][1]) + (v[i][2] * v[i][2] + v[i][3] * v[i][3]);
            s = wsum(s); const float rstd = rsqrtf(s * (1.0f / D) + RMS_EPS);
#pragma unroll
            for (int i = 0; i < 8; ++i) { const int c = (i * 64 + lane) * 4; *(f32x4*)(p + c) = v[i] * rstd * *(const f32x4*)(norm_final + c); }
        }
    }
#undef IN
#undef SEAM
}

#ifndef HY_MULTI
#define HY_MULTI 0
#endif
#ifndef HY_REP
#define HY_REP 0
#endif
extern "C" void kernel_launch(void* const* d_in, const int* in_sizes, int n_in, void* d_out, int out_size, void* d_ws, size_t ws_size, hipStream_t stream) {
    static int grid = 0;
    if (grid == 0) {
        if (n_in != 26 || ws_size < WS_END) { fprintf(stderr, "kernel_launch: need 26 inputs and >= %zu bytes of workspace (got %d, %zu)\n", (size_t)WS_END, n_in, ws_size); grid = -1; return; }
        int dev = 0, cus = 0, per_cu = 0;
        hipGetDevice(&dev); hipDeviceGetAttribute(&cus, hipDeviceAttributeMultiprocessorCount, dev);
        if (hipFuncSetAttribute((const void*)hymba_fwd, hipFuncAttributeMaxDynamicSharedMemorySize, LDS_BYTES) != hipSuccess) { fprintf(stderr, "kernel_launch: hipFuncSetAttribute failed\n"); grid = -1; return; }
        if (hipOccupancyMaxActiveBlocksPerMultiprocessor(&per_cu, (const void*)hymba_fwd, NTHR, LDS_BYTES) != hipSuccess || per_cu < 1) { fprintf(stderr, "kernel_launch: occupancy query says %d\n", per_cu); per_cu = 1; }
        (void)hipGetLastError();
        grid = cus;
        if (grid > 256) grid = 256;
    }
    if (grid < 0) return;
    Params p{};
    for (int i = 0; i < 26; ++i) p.in[i] = (const float*)d_in[i];
    p.out = (float*)d_out; p.ws = (unsigned char*)d_ws;
#if HY_MULTI
    p.multi = 1;
    for (int ph = 0; ph < 10; ++ph) { p.phase = ph; for (int r = 0; r < ((HY_REP >> ph) & 1) + 1; ++r) hipLaunchKernelGGL(hymba_fwd, dim3(grid), dim3(NTHR), LDS_BYTES, stream, p); }
#else
    p.multi = 0; p.phase = 0;
    hipMemsetAsync((char*)d_ws + WS_BAR, 0, 4096, stream);
    void* args[] = {&p};
    hipError_t e = hipLaunchCooperativeKernel((const void*)hymba_fwd, dim3(grid), dim3(NTHR), args, LDS_BYTES, stream);
    if (e != hipSuccess) fprintf(stderr, "cooperative launch failed: %s (grid %d)\n", hipGetErrorString(e), grid);
#endif
}
```

```cpp
#include <hip/hip_runtime.h>
#include <hip/hip_cooperative_groups.h>
#include <cstdio>
namespace cg = cooperative_groups;

#define LAS __attribute__((address_space(3)))
typedef unsigned short bf16_t;
typedef short bf16x8 __attribute__((ext_vector_type(8)));
typedef float f32x4 __attribute__((ext_vector_type(4)));
typedef float f32x2 __attribute__((ext_vector_type(2)));
typedef unsigned u32x4 __attribute__((ext_vector_type(4)));
typedef unsigned u32x2 __attribute__((ext_vector_type(2)));

constexpr int D = 2048, TT = 2048, MPR = 8192, MSA = 128, MV = 8320, MPAD = 8448;
constexpr int PW = 1024, SW = 3360, PJ = 4384, PJP = 4608, DFF = 5632, CW = 1024, NH = 16;
constexpr int NTHR = 512, LDS_BYTES = 131072 + 16, LDS_ST_OFF = 131072;
constexpr float RMS_EPS = 1e-6f, GN_EPS = 64e-5f;

constexpr size_t WS_WIN = 0;
constexpr size_t WS_WOUT = WS_WIN + (size_t)PJP * D * 2;
constexpr size_t WS_WGU = WS_WOUT + (size_t)D * D * 2;
constexpr size_t WS_WDN = WS_WGU + (size_t)2 * DFF * D * 2;
constexpr size_t WS_WPOOL = WS_WDN + (size_t)D * DFF * 2;
constexpr size_t WS_WLORA = WS_WPOOL + (size_t)4 * 256 * 256 * 2;
constexpr size_t WS_R1 = WS_WLORA + (size_t)3 * 1024 * 256 * 2;
constexpr size_t WS_PROJ = WS_R1 + (size_t)MPAD * D * 2;
constexpr size_t WS_A = WS_PROJ + (size_t)MPAD * PJP * 2;
constexpr size_t WS_GATE = WS_A + (size_t)MPAD * CW * 2;
constexpr size_t WS_MIX = WS_GATE + (size_t)MPAD * CW * 2;
constexpr size_t WS_ROWSQ = WS_MIX + (size_t)MPAD * D * 2;
constexpr size_t WS_BONUS = WS_ROWSQ + (size_t)2 * MPAD * 4;
constexpr size_t WS_BAR = WS_BONUS + (size_t)MV * NH * 4;
constexpr size_t WS_END = WS_BAR + 16384;
static_assert((size_t)MPAD * DFF * 2 <= (WS_MIX - WS_PROJ), "U must fit in proj+a+gate");
constexpr size_t R1_POOLED = 0, R1_L = (size_t)MPAD * PW * 2;
constexpr int KS6 = 8, KS8 = 11;
static_assert((size_t)KS6 * MSA * D * 4 <= (size_t)MPAD * CW * 2 && (size_t)KS8 * MSA * D * 4 <= (size_t)MPAD * D * 2, "partial buffers alias WS_A / WS_R1");

constexpr size_t OUT_Y = 0;
constexpr size_t OUT_POOLP = (size_t)MV * D;
constexpr size_t OUT_SHIFTP = OUT_POOLP + (size_t)4 * 15 * PW;
constexpr size_t OUT_WKVP = OUT_SHIFTP + (size_t)4 * SW;
constexpr size_t OUT_POOLS = OUT_WKVP + (size_t)4 * NH * 64 * 64;
constexpr size_t OUT_SHIFTS = OUT_POOLS + (size_t)MSA * 15 * PW;
constexpr size_t OUT_WKVS = OUT_SHIFTS + (size_t)MSA * SW;
constexpr size_t SCR_Y = 0;
constexpr size_t SCR_DEC = (size_t)MPR * CW;
static_assert(SCR_DEC + (size_t)MV * CW <= OUT_POOLP, "scratch must fit in the y region");

struct Params { const float* in[26]; float* out; unsigned char* ws; int multi; int phase; };

__device__ __forceinline__ float bf2f(unsigned b) { return __uint_as_float(b << 16); }
__device__ __forceinline__ unsigned f2bf(float f) { unsigned u = __float_as_uint(f); u += 0x7FFFu + ((u >> 16) & 1u); return u >> 16; }
__device__ __forceinline__ unsigned pk_bf16(float lo, float hi) { unsigned r; asm volatile("v_cvt_pk_bf16_f32 %0, %1, %2" : "=v"(r) : "v"(lo), "v"(hi)); return r; }
template <int CTRL> __device__ __forceinline__ float dpp(float x) { return __int_as_float(__builtin_amdgcn_update_dpp(0, __float_as_int(x), CTRL, 0xF, 0xF, true)); }
__device__ __forceinline__ float red16(float x) {
    x += dpp<0x128>(x); x += dpp<0x124>(x); x += dpp<0x4E>(x); x += dpp<0xB1>(x); return x;
}
__device__ __forceinline__ float wsum(float x) { x = red16(x); x += __shfl_xor(x, 16); x += __shfl_xor(x, 32); return x; }
__device__ __forceinline__ float fma_(float a, float b, float c) { float d; asm("v_fma_f32 %0, %1, %2, %3" : "=v"(d) : "v"(a), "v"(b), "v"(c)); return d; }
__device__ __forceinline__ f32x2 pkmul_(f32x2 a, f32x2 b) { f32x2 d; asm("v_pk_mul_f32 %0, %1, %2" : "=v"(d) : "v"(a), "v"(b)); return d; }
__device__ __forceinline__ f32x2 pkfma_(f32x2 a, f32x2 b, f32x2 c) { f32x2 d; asm("v_pk_fma_f32 %0, %1, %2, %3" : "=v"(d) : "v"(a), "v"(b), "v"(c)); return d; }
__device__ __forceinline__ f32x2 pkfma_b(f32x2 a, f32x2 s, f32x2 c) { f32x2 d; asm("v_pk_fma_f32 %0, %1, %2, %3 op_sel_hi:[1,0,1]" : "=v"(d) : "v"(a), "v"(s), "v"(c)); return d; }
__device__ __forceinline__ f32x2 lo2(f32x4 v) { return __builtin_shufflevector(v, v, 0, 1); }
__device__ __forceinline__ f32x2 hi2(f32x4 v) { return __builtin_shufflevector(v, v, 2, 3); }
__device__ __forceinline__ float mul_(float a, float b) { float d; asm("v_mul_f32 %0, %1, %2" : "=v"(d) : "v"(a), "v"(b)); return d; }
__device__ __forceinline__ float sigmoidf_(float x) { return 1.0f / (1.0f + __expf(-x)); }

#define WG_BAR() do { asm volatile("s_waitcnt lgkmcnt(0)" ::: "memory"); __builtin_amdgcn_s_barrier(); asm volatile("" ::: "memory"); } while (0)

#define XB_TMO      128
#define XB_XCNT(j)  (256  + 64 * (j))
#define XB_XSUB(j)  (1280 + 64 * (j))
#define XB_XGEN(j)  (2304 + 64 * (j))
#define XB_TOP      3328
#define XB_TOPGEN   3392
#define XCD_BAR_WORDS 3456
#define XB_SPIN_CAP (1u << 18)

__device__ __forceinline__ unsigned xb_ld(unsigned* p)              { return __hip_atomic_load(p, __ATOMIC_RELAXED, __HIP_MEMORY_SCOPE_AGENT); }
__device__ __forceinline__ unsigned xb_add(unsigned* p, unsigned v) { return __hip_atomic_fetch_add(p, v, __ATOMIC_RELAXED, __HIP_MEMORY_SCOPE_AGENT); }
__device__ __forceinline__ unsigned xb_xcc_id() { return (unsigned)__builtin_amdgcn_s_getreg((3 << 11) | 20) & 0xFu; }
#define XB_SPIN(cond, bar) do { unsigned _sp = 0; while (cond) { __builtin_amdgcn_s_sleep(1); \
    if ((++_sp & 255u) == 0u) { if (xb_ld(&(bar)[XB_TMO])) break; if (_sp > XB_SPIN_CAP) { atomicAdd(&(bar)[XB_TMO], 1u); break; } } } } while (0)

struct XcdBarrier {
    unsigned* bar; unsigned x;
    volatile LAS unsigned* st;
};

__device__ __forceinline__ XcdBarrier xcd_barrier_post(unsigned* bar, volatile LAS unsigned* st) {
    XcdBarrier b; b.bar = bar; b.x = xb_xcc_id(); b.st = st;
    if (threadIdx.x == 0) (void)xb_add(&bar[XB_XCNT(b.x)], 1u);
    return b;
}
__device__ __forceinline__ void xcd_barrier_complete(unsigned* bar, unsigned x, unsigned& nloc, unsigned& nx) {
    const unsigned G = gridDim.x * gridDim.y * gridDim.z;
    unsigned sum, cnt, mine, sp = 0u;
    for (;;) {
        sum = 0u; cnt = 0u; mine = 0u;
#pragma unroll
        for (unsigned j = 0; j < 16; ++j) { const unsigned c = xb_ld(&bar[XB_XCNT(j)]); sum += c; cnt += (c > 0u) ? 1u : 0u; mine = (j == x) ? c : mine; }
        if (sum == G) break;
        __builtin_amdgcn_s_sleep(1);
        if ((++sp & 255u) == 0u) { if (xb_ld(&bar[XB_TMO])) break; if (sp > XB_SPIN_CAP) { atomicAdd(&bar[XB_TMO], 1u); break; } }
    }
    nloc = mine > 0u ? mine : 1u; nx = cnt > 0u ? cnt : 1u;
}

__device__ __forceinline__ void xcd_barrier(const XcdBarrier& b) {
    asm volatile("s_waitcnt vmcnt(0)" ::: "memory");
    __syncthreads();
    if (threadIdx.x == 0) {
        unsigned* bar = b.bar;
        __builtin_amdgcn_s_waitcnt(0);
        unsigned nloc = b.st[0], nx = b.st[1];
        if (nloc == 0u) { xcd_barrier_complete(bar, b.x, nloc, nx); b.st[0] = nloc; b.st[1] = nx; }
        const unsigned old = xb_add(&bar[XB_XSUB(b.x)], 1u);
        const unsigned gen = old / nloc;
        if (old + 1u == (gen + 1u) * nloc) {
            __builtin_amdgcn_fence(__ATOMIC_RELEASE, "agent");
            asm volatile("s_waitcnt vmcnt(0)" ::: "memory");
            const unsigned og = xb_add(&bar[XB_TOP], 1u);
            const unsigned tg = og / nx;
            if (og + 1u == (tg + 1u) * nx) xb_add(&bar[XB_TOPGEN], 1u);
            else XB_SPIN(xb_ld(&bar[XB_TOPGEN]) == tg, bar);
            __builtin_amdgcn_fence(__ATOMIC_ACQUIRE, "agent");
            xb_add(&bar[XB_XGEN(b.x)], 1u);
            asm volatile("s_waitcnt vmcnt(0)" ::: "memory");
        } else {
            XB_SPIN(xb_ld(&bar[XB_XGEN(b.x)]) == gen, bar);
            __builtin_amdgcn_fence(__ATOMIC_ACQUIRE, "agent");
            asm volatile("s_waitcnt vmcnt(0)" ::: "memory");
        }
    }
    __syncthreads();
}

__device__ __forceinline__ void grid_bar(unsigned* ctr, unsigned target) {
    asm volatile("s_waitcnt vmcnt(0) lgkmcnt(0)" ::: "memory");
    __syncthreads();
    if (threadIdx.x == 0) {
        __builtin_amdgcn_fence(__ATOMIC_RELEASE, "agent");
        asm volatile("s_waitcnt vmcnt(0)" ::: "memory");
        __hip_atomic_fetch_add(ctr, 1u, __ATOMIC_RELAXED, __HIP_MEMORY_SCOPE_AGENT);
        while (__hip_atomic_load(ctr, __ATOMIC_RELAXED, __HIP_MEMORY_SCOPE_AGENT) < target) __builtin_amdgcn_s_sleep(4);
        __builtin_amdgcn_fence(__ATOMIC_ACQUIRE, "agent");
        asm volatile("s_waitcnt vmcnt(0)" ::: "memory");
    }
    __syncthreads();
}

namespace pg8 {
constexpr int BM = 256, BK = 64, HALF = 128, HTB = HALF * BK * 2, NXCD = 8, WGM = 8;
__device__ __forceinline__ int lds_byte(int r, int c) { const int st = (r >> 4) * 2 + (c >> 5), rr = r & 15, cc = c & 31, ob = rr * 64 + cc * 2; return st * 1024 + (ob ^ (((ob >> 9) & 1) << 5)); }
__device__ __forceinline__ void stage_rc(int b, int& R, int& C) { const int st = b / 1024, sb = b % 1024, swz = sb ^ (((sb >> 9) & 1) << 5); R = (st >> 1) * 16 + swz / 64; C = (st & 1) * 32 + (swz % 64) / 2; }
__device__ __forceinline__ int perm32(int rho) { const int n = rho >> 4, i = rho & 15; return 8 * (i >> 2) + 4 * n + (i & 3); }
struct Unit { int pm, pn, ks, koff; };
struct Gemm { const bf16_t* A; const bf16_t* Bt; int lda, ldb, K; };
struct StaticOrder {
    int nM, nN, nwg, G, c;
    __device__ void init(int M, int N, int G_, int c_) { nM = M / BM; nN = N / BM; nwg = nM * nN; G = G_; c = c_; }
    __device__ bool next(int i, Unit& u) const {
        const long L = (long)i * G + c; if (L >= nwg) return false;
        int wgid = (int)L; { const int q = nwg / NXCD, r = nwg % NXCD, xcd = wgid % NXCD, off = wgid / NXCD; wgid = (xcd < r ? xcd * (q + 1) : r * (q + 1) + (xcd - r) * q) + off; }
        const int nig = WGM * nN, gid = wgid / nig, fm = gid * WGM, gsz = (nM - fm) < WGM ? (nM - fm) : WGM;
        u.pm = fm + ((wgid % nig) % gsz); u.pn = (wgid % nig) / gsz; u.ks = 0; u.koff = 0; return true;
    }
};
struct SplitKOrder {
    int nN, nks, pm, kchunk, G, c;
    __device__ bool next(int i, Unit& u) const { const long L = (long)i * G + c; if (L >= (long)nN * nks) return false;
        u.pm = pm; u.pn = (int)(L % nN); u.ks = (int)(L / nN); u.koff = u.ks * kchunk; return true; }
};

template <class Epi, class Sched>
__device__ __forceinline__ void gemm_phase(LAS unsigned char* lds, const Gemm g, const Sched& S, const Epi& E) {
    const int tid = threadIdx.x, wid = __builtin_amdgcn_readfirstlane(tid >> 6), lane = tid & 63, wr = wid >> 2, wc = wid & 3, fr = lane & 15, fq = lane >> 4;
    const int K = g.K, nt = K / BK;
    unsigned voffA[2], voffB[2];
#pragma unroll
    for (int i = 0; i < 2; ++i) { int R, C; stage_rc(tid * 16 + i * 8192, R, C); const int Rb = Epi::PERM ? ((R & ~31) + perm32(R & 31)) : R;
        voffA[i] = (unsigned)(R * g.lda + C) * 2u; voffB[i] = (unsigned)(Rb * g.ldb + C) * 2u; }
    const size_t kstep = (size_t)(BK * 2);
    const size_t hstepA = (size_t)HALF * g.lda * 2, hstepB = (size_t)HALF * g.ldb * 2;
    const size_t tstepA = 2 * hstepA, tstepB = 2 * hstepB;
    const unsigned ldsw = (unsigned)wid * 1024u;
    const int aoff = lds_byte(wr * 64 + fr, fq * 8), boff = lds_byte(wc * 32 + fr, fq * 8);
#define PG8_SA(b, h) (((b) * 2 + (h)) * HTB)
#define PG8_SB(b, h) ((4 + (b) * 2 + (h)) * HTB)
#define PG8_STAGE(bufoff, gbase, voff) do { _Pragma("unroll") for (int _i = 0; _i < 2; ++_i) \
        __builtin_amdgcn_global_load_lds((const unsigned*)((const char*)(gbase) + (voff)[_i]), (LAS unsigned*)(lds + (bufoff) + ldsw + _i * 8192), 16, 0, 0); } while (0)
#define PG8_LDA(dst, b, h) do { _Pragma("unroll") for (int m = 0; m < 4; ++m) _Pragma("unroll") for (int k = 0; k < 2; ++k) dst[m][k] = *(const LAS bf16x8*)(lds + PG8_SA(b, h) + aoff + m * 2048 + k * 1024); } while (0)
#define PG8_LDB(dst, b, h) do { _Pragma("unroll") for (int n = 0; n < 2; ++n) _Pragma("unroll") for (int k = 0; k < 2; ++k) dst[n][k] = *(const LAS bf16x8*)(lds + PG8_SB(b, h) + boff + n * 2048 + k * 1024); } while (0)
#define PG8_MMA(ai, bj, At, Bt) do { __builtin_amdgcn_s_setprio(1); _Pragma("unroll") for (int m = 0; m < 4; ++m) _Pragma("unroll") for (int n = 0; n < 2; ++n) _Pragma("unroll") for (int k = 0; k < 2; ++k) \
        acc[ai][bj][m][n] = __builtin_amdgcn_mfma_f32_16x16x32_bf16(Bt[n][k], At[m][k], acc[ai][bj][m][n], 0, 0, 0); __builtin_amdgcn_s_setprio(0); } while (0)
#define PG8_WAIT_V(n) asm volatile("s_waitcnt vmcnt(" #n ")" ::: "memory")
#define PG8_WAIT_L(n) asm volatile("s_waitcnt lgkmcnt(" #n ")" ::: "memory")
#define PG8_BAR __builtin_amdgcn_s_barrier()
#define PG8_SCHED __builtin_amdgcn_sched_barrier(0)
    Unit cur, nxt; int ui = 0;
    if (!S.next(0, cur)) return;
    f32x4 acc[2][2][4][2];
#pragma unroll
    for (int a = 0; a < 2; ++a)
#pragma unroll
        for (int b = 0; b < 2; ++b)
#pragma unroll
            for (int m = 0; m < 4; ++m)
#pragma unroll
                for (int n = 0; n < 2; ++n) acc[a][b][m][n] = (f32x4){0.f, 0.f, 0.f, 0.f};
    bf16x8 At[4][2], B0[2][2], B1[2][2];
    const char* cA = (const char*)g.A + (size_t)cur.pm * tstepA + (size_t)cur.koff * 2; const char* cB = (const char*)g.Bt + (size_t)cur.pn * tstepB + (size_t)cur.koff * 2;
    PG8_STAGE(PG8_SB(0, 0), cB, voffB); PG8_STAGE(PG8_SA(0, 0), cA, voffA); PG8_STAGE(PG8_SB(0, 1), cB + hstepB, voffB); PG8_STAGE(PG8_SA(0, 1), cA + hstepA, voffA);
    if (wr == 1) PG8_BAR;
    PG8_WAIT_V(4); PG8_BAR;
    PG8_STAGE(PG8_SB(1, 0), cB + kstep, voffB); PG8_STAGE(PG8_SA(1, 0), cA + kstep, voffA); PG8_STAGE(PG8_SB(1, 1), cB + hstepB + kstep, voffB);
    PG8_WAIT_V(6); PG8_BAR;
    for (;;) {
        const bool has_next = S.next(ui + 1, nxt);
        const char* nA = has_next ? (const char*)g.A + (size_t)nxt.pm * tstepA + (size_t)nxt.koff * 2 : cA; const char* nB = has_next ? (const char*)g.Bt + (size_t)nxt.pn * tstepB + (size_t)nxt.koff * 2 : cB;
#pragma clang loop unroll(disable)
        for (int t = 0; t < nt; t += 2) {
            const bool last = (t == nt - 2);
            const char* a1 = cA + (size_t)(t + 1) * kstep;
            const char* a2 = last ? nA : cA + (size_t)(t + 2) * kstep; const char* b2 = last ? nB : cB + (size_t)(t + 2) * kstep;
            const char* a3 = a2 + kstep; const char* b3 = b2 + kstep;
            PG8_LDB(B0, 0, 0); PG8_SCHED; PG8_LDA(At, 0, 0); PG8_STAGE(PG8_SA(1, 1), a1 + hstepA, voffA);
            PG8_WAIT_L(8); PG8_BAR; PG8_WAIT_L(0); PG8_MMA(0, 0, At, B0); PG8_BAR; PG8_SCHED;
            PG8_LDB(B1, 0, 1); PG8_STAGE(PG8_SB(0, 0), b2, voffB);
            PG8_BAR; PG8_WAIT_L(0); PG8_MMA(0, 1, At, B1); PG8_BAR;
            PG8_LDA(At, 0, 1); PG8_STAGE(PG8_SA(0, 0), a2, voffA);
            PG8_BAR; PG8_WAIT_L(0); PG8_MMA(1, 0, At, B0); PG8_BAR; PG8_SCHED;
            PG8_STAGE(PG8_SB(0, 1), b2 + hstepB, voffB);
            PG8_WAIT_V(6); PG8_BAR; PG8_MMA(1, 1, At, B1); PG8_BAR;
            PG8_LDB(B0, 1, 0); PG8_SCHED; PG8_LDA(At, 1, 0); PG8_STAGE(PG8_SA(0, 1), a2 + hstepA, voffA);
            PG8_WAIT_L(8); PG8_BAR; PG8_WAIT_L(0); PG8_MMA(0, 0, At, B0); PG8_BAR; PG8_SCHED;
            PG8_LDB(B1, 1, 1); PG8_STAGE(PG8_SB(1, 0), b3, voffB);
            PG8_BAR; PG8_WAIT_L(0); PG8_MMA(0, 1, At, B1); PG8_BAR;
            PG8_LDA(At, 1, 1); PG8_STAGE(PG8_SA(1, 0), a3, voffA);
            PG8_BAR; PG8_WAIT_L(0); PG8_MMA(1, 0, At, B0); PG8_BAR; PG8_SCHED;
            PG8_STAGE(PG8_SB(1, 1), b3 + hstepB, voffB);
            PG8_WAIT_V(6); PG8_BAR; PG8_MMA(1, 1, At, B1); PG8_BAR;
        }
        E(acc, cur, wr, wc, fr, fq);
        if (!has_next) break;
#pragma unroll
        for (int a = 0; a < 2; ++a)
#pragma unroll
            for (int b = 0; b < 2; ++b)
#pragma unroll
                for (int m = 0; m < 4; ++m)
#pragma unroll
                    for (int n = 0; n < 2; ++n) acc[a][b][m][n] = (f32x4){0.f, 0.f, 0.f, 0.f};
        cur = nxt; cA = nA; cB = nB; ++ui;
    }
    PG8_WAIT_V(0);
    if (wr == 0) PG8_BAR;
    PG8_BAR;
#undef PG8_SA
#undef PG8_SB
#undef PG8_STAGE
#undef PG8_LDA
#undef PG8_LDB
#undef PG8_MMA
#undef PG8_WAIT_V
#undef PG8_WAIT_L
#undef PG8_BAR
#undef PG8_SCHED
}
}
using pg8::Unit;

template <int MODE> struct EpiBf16 {
    static constexpr bool PERM = true;
    bf16_t* O; int ldc; int coff; const float* vec;
    __device__ __forceinline__ void operator()(const f32x4 (&acc)[2][2][4][2], const Unit& u, int wr, int wc, int fr, int fq) const {
        const int row0 = u.pm * 256 + wr * 64 + fr, col0 = coff + u.pn * 256 + wc * 32 + 8 * fq;
#pragma unroll
        for (int bj = 0; bj < 2; ++bj) {
            const int c = col0 + bj * 128;
            f32x4 s0, s1;
            if (MODE == 0) { s0 = vec ? *(const f32x4*)(vec + c) : (f32x4){1.f, 1.f, 1.f, 1.f}; s1 = vec ? *(const f32x4*)(vec + c + 4) : (f32x4){1.f, 1.f, 1.f, 1.f}; }
            else { s0 = *(const f32x4*)(vec + c); s1 = *(const f32x4*)(vec + c + 4); }
#pragma unroll
            for (int ai = 0; ai < 2; ++ai)
#pragma unroll
                for (int m = 0; m < 4; ++m) {
                    f32x4 v0 = acc[ai][bj][m][0], v1 = acc[ai][bj][m][1];
                    if (MODE == 0) { v0 = v0 * s0; v1 = v1 * s1; }
                    else {
#pragma unroll
                        for (int j = 0; j < 4; ++j) { v0[j] = sigmoidf_(v0[j] + s0[j]); v1[j] = sigmoidf_(v1[j] + s1[j]); } }
                    u32x4 w; w.x = pk_bf16(v0[0], v0[1]); w.y = pk_bf16(v0[2], v0[3]); w.z = pk_bf16(v1[0], v1[1]); w.w = pk_bf16(v1[2], v1[3]);
                    *(u32x4*)(O + (size_t)(row0 + ai * 128 + m * 16) * ldc + c) = w;
                }
        }
    }
};
struct EpiP3 {
    static constexpr bool PERM = true;
    int mode; bf16_t* Ob; float* Of; int ldc, coff; const float* vec;
    __device__ __forceinline__ void operator()(const f32x4 (&acc)[2][2][4][2], const Unit& u, int wr, int wc, int fr, int fq) const {
        const int row0 = u.pm * 256 + wr * 64 + fr, col0 = coff + u.pn * 256 + wc * 32 + 8 * fq;
#pragma unroll
        for (int bj = 0; bj < 2; ++bj) {
            const int c = col0 + bj * 128;
            const f32x4 one = (f32x4){1.f, 1.f, 1.f, 1.f};
            const f32x4 s0 = vec ? *(const f32x4*)(vec + c) : one, s1 = vec ? *(const f32x4*)(vec + c + 4) : one;
#pragma unroll
            for (int ai = 0; ai < 2; ++ai)
#pragma unroll
                for (int m = 0; m < 4; ++m) {
                    const int row = row0 + ai * 128 + m * 16;
                    f32x4 v0 = acc[ai][bj][m][0], v1 = acc[ai][bj][m][1];
                    if (mode == 0) { v0 = v0 * s0; v1 = v1 * s1; }
                    else if (mode == 1) {
#pragma unroll
                        for (int j = 0; j < 4; ++j) { v0[j] = sigmoidf_(v0[j] + s0[j]); v1[j] = sigmoidf_(v1[j] + s1[j]); } }
                    else {
                        v0 = v0 + s0; v1 = v1 + s1;
#pragma unroll
                        for (int j = 0; j < 4; ++j) {
                            const float z0 = -v0[j], z1 = -v1[j];
                            const float sp0 = fmaxf(z0, 0.f) + __logf(1.0f + __expf(-fabsf(z0))), sp1 = fmaxf(z1, 0.f) + __logf(1.0f + __expf(-fabsf(z1)));
                            v0[j] = __expf(-__expf(-sp0 - 0.5f)); v1[j] = __expf(-__expf(-sp1 - 0.5f)); }
                    }
                    if (mode == 2) { if (row < MV) { float* p = Of + (size_t)row * ldc + c; *(f32x4*)p = v0; *(f32x4*)(p + 4) = v1; } }
                    else { u32x4 w; w.x = pk_bf16(v0[0], v0[1]); w.y = pk_bf16(v0[2], v0[3]); w.z = pk_bf16(v1[0], v1[1]); w.w = pk_bf16(v1[2], v1[3]);
                        *(u32x4*)(Ob + (size_t)row * ldc + c) = w; }
                }
        }
    }
};
struct EpiDecay {
    static constexpr bool PERM = false;
    float* O; const float* w0;
    __device__ __forceinline__ void operator()(const f32x4 (&acc)[2][2][4][2], const Unit& u, int wr, int wc, int fr, int fq) const {
        const int row0 = u.pm * 256 + wr * 64 + fr, col0 = u.pn * 256 + wc * 32 + 4 * fq;
#pragma unroll
        for (int bj = 0; bj < 2; ++bj)
#pragma unroll
            for (int n = 0; n < 2; ++n) {
                const int c = col0 + bj * 128 + n * 16; const f32x4 b = *(const f32x4*)(w0 + c);
#pragma unroll
                for (int ai = 0; ai < 2; ++ai)
#pragma unroll
                    for (int m = 0; m < 4; ++m) {
                        const int row = row0 + ai * 128 + m * 16; f32x4 v = acc[ai][bj][m][n] + b, o;
#pragma unroll
                        for (int j = 0; j < 4; ++j) { const float z = -v[j]; const float sp = fmaxf(z, 0.f) + __logf(1.0f + __expf(-fabsf(z))); o[j] = __expf(-__expf(-sp - 0.5f)); }
                        if (row < MV) *(f32x4*)(O + (size_t)row * CW + c) = o;
                    }
            }
    }
};
struct EpiOut {
    static constexpr bool PERM = false;
    const float* xp; const float* xs; float* out; bf16_t* h2; const float* g; float* rowsq;
    __device__ __forceinline__ void operator()(const f32x4 (&acc)[2][2][4][2], const Unit& u, int wr, int wc, int fr, int fq) const {
        const int row0 = u.pm * 256 + wr * 64 + fr, col0 = u.pn * 256 + wc * 32 + 4 * fq;
#pragma unroll
        for (int ai = 0; ai < 2; ++ai)
#pragma unroll
            for (int m = 0; m < 4; ++m) {
                const int row = row0 + ai * 128 + m * 16; const bool ok = row < MV;
                const float* xr = row < MPR ? xp + (size_t)row * D : xs + (size_t)(ok ? row - MPR : 0) * D;
                float s = 0.f;
#pragma unroll
                for (int bj = 0; bj < 2; ++bj)
#pragma unroll
                    for (int n = 0; n < 2; ++n) {
                        const int c = col0 + bj * 128 + n * 16;
                        f32x4 x1 = acc[ai][bj][m][n];
                        if (ok) { x1 = x1 + *(const f32x4*)(xr + c); *(f32x4*)(out + (size_t)row * D + c) = x1; }
                        s += (x1[0] * x1[0] + x1[1] * x1[1]) + (x1[2] * x1[2] + x1[3] * x1[3]);
                        const f32x4 gg = *(const f32x4*)(g + c); const f32x4 hv = x1 * gg;
                        u32x2 w; w.x = pk_bf16(hv[0], hv[1]); w.y = pk_bf16(hv[2], hv[3]);
                        *(u32x2*)(h2 + (size_t)row * D + c) = w;
                    }
                s += __shfl_xor(s, 16); s += __shfl_xor(s, 32);
                if (ok && fq == 0) unsafeAtomicAdd(rowsq + row, s);
            }
    }
};
struct EpiGU {
    static constexpr bool PERM = true;
    bf16_t* U; const float* rowsq;
    __device__ __forceinline__ void operator()(const f32x4 (&acc)[2][2][4][2], const Unit& u, int wr, int wc, int fr, int fq) const {
        const int row0 = u.pm * 256 + wr * 64 + fr, col0 = u.pn * 128 + wc * 32 + 8 * fq;
#pragma unroll
        for (int ai = 0; ai < 2; ++ai)
#pragma unroll
            for (int m = 0; m < 4; ++m) {
                const int row = row0 + ai * 128 + m * 16;
                const float rstd = rsqrtf(rowsq[row] * (1.0f / D) + RMS_EPS);
                f32x4 o[2];
#pragma unroll
                for (int n = 0; n < 2; ++n)
#pragma unroll
                    for (int j = 0; j < 4; ++j) { const float gt = acc[ai][0][m][n][j] * rstd, up = acc[ai][1][m][n][j] * rstd; o[n][j] = gt * sigmoidf_(gt) * up; }
                u32x4 w; w.x = pk_bf16(o[0][0], o[0][1]); w.y = pk_bf16(o[0][2], o[0][3]); w.z = pk_bf16(o[1][0], o[1][1]); w.w = pk_bf16(o[1][2], o[1][3]);
                *(u32x4*)(U + (size_t)row * DFF + col0) = w;
            }
    }
};
struct EpiDown {
    static constexpr bool PERM = false;
    float* out;
    __device__ __forceinline__ void operator()(const f32x4 (&acc)[2][2][4][2], const Unit& u, int wr, int wc, int fr, int fq) const {
        const int row0 = u.pm * 256 + wr * 64 + fr, col0 = u.pn * 256 + wc * 32 + 4 * fq;
#pragma unroll
        for (int ai = 0; ai < 2; ++ai)
#pragma unroll
            for (int m = 0; m < 4; ++m) {
                const int row = row0 + ai * 128 + m * 16;
#pragma unroll
                for (int bj = 0; bj < 2; ++bj)
#pragma unroll
                    for (int n = 0; n < 2; ++n) {
                        const int c = col0 + bj * 128 + n * 16; float* p = out + (size_t)row * D + c;
                        *(f32x4*)p = acc[ai][bj][m][n] + *(const f32x4*)p;
                    }
            }
    }
};
struct EpiPartial {
    static constexpr bool PERM = false;
    float* buf;
    __device__ __forceinline__ void operator()(const f32x4 (&acc)[2][2][4][2], const Unit& u, int wr, int wc, int fr, int fq) const {
        const int col0 = u.pn * 256 + wc * 32 + 4 * fq;
#pragma unroll
        for (int m = 0; m < 4; ++m) {
            const int lrow = wr * 64 + m * 16 + fr;
            float* p = buf + ((size_t)u.ks * MSA + lrow) * D + col0;
#pragma unroll
            for (int bj = 0; bj < 2; ++bj)
#pragma unroll
                for (int n = 0; n < 2; ++n) *(f32x4*)(p + bj * 128 + n * 16) = acc[0][bj][m][n];
        }
    }
};

template <int RM> __device__ __forceinline__ int rowmap(int n) { return RM == 0 ? n : (RM == 1 ? ((n >> 7) * 256 + (n & 127)) : ((n >> 7) * 256 + 128 + (n & 127))); }
template <int RM>
__device__ __forceinline__ void transpose_bf16(const float* src, int Ksrc, int Nsrc, int ld, bf16_t* dst, int Kdst, int Ndst, int rot, int vgw, int gws) {
    const int lane = threadIdx.x & 63, gw = (vgw + rot) % gws;
    const int nn = Ndst / 64, ntile = nn * (Kdst / 64);
    for (int t = gw; t < ntile; t += gws) {
        const int k0 = (t / nn) * 64, n = (t % nn) * 64 + lane;
        const bool nok = n < Nsrc;
        const float* sp = src + (nok ? n : 0);
        float v[64];
        const float mskn = nok ? 1.f : 0.f;
#pragma unroll
        for (int j = 0; j < 64; ++j) { const int k = k0 + j; v[j] = sp[(size_t)(k < Ksrc ? k : Ksrc - 1) * ld]; }
#pragma unroll
        for (int j = 0; j < 64; ++j) v[j] *= ((k0 + j) < Ksrc ? mskn : 0.f);
        bf16_t* dp = dst + (size_t)rowmap<RM>(n) * Kdst + k0;
#pragma unroll
        for (int q8 = 0; q8 < 8; ++q8) { u32x4 w; w.x = pk_bf16(v[q8 * 8 + 0], v[q8 * 8 + 1]); w.y = pk_bf16(v[q8 * 8 + 2], v[q8 * 8 + 3]); w.z = pk_bf16(v[q8 * 8 + 4], v[q8 * 8 + 5]); w.w = pk_bf16(v[q8 * 8 + 6], v[q8 * 8 + 7]);
            *(u32x4*)(dp + q8 * 8) = w; }
    }
}
template <int CTRL> __device__ __forceinline__ float dpp_(float x) { return __int_as_float(__builtin_amdgcn_update_dpp(0, __float_as_int(x), CTRL, 0xF, 0xF, true)); }
__device__ __forceinline__ float red8(float x) { x += dpp_<0x141>(x); x += dpp_<0xB1>(x); x += dpp_<0x4E>(x); return x; }

template <int W>
__device__ __forceinline__ void pool_block_prompt(const bf16_t* proj, bf16_t* pooled, int b, int t0, int c) {
    float ux[15 + W], uy[15 + W]; unsigned raw[15 + W];
#pragma unroll
    for (int j = 0; j < 15 + W; ++j) {
        const int t = t0 - (W - 1) + j;
        raw[j] = *(const unsigned*)(proj + (size_t)(b * TT + (t < 0 ? 0 : t)) * PJP + c);
    }
#pragma unroll
    for (int j = 0; j < 15 + W; ++j) {
        const int t = t0 - (W - 1) + j; const float zm = t < 0 ? 0.f : 1.f;
        ux[j] = bf2f(raw[j] & 0xffffu) * zm; uy[j] = bf2f(raw[j] >> 16) * zm;
    }
#pragma unroll
    for (int i = 0; i < 16; ++i) {
        const int t = t0 + i; float sx = 0.f, sy = 0.f;
#pragma unroll
        for (int j = 0; j < W; ++j) { sx += ux[i + j]; sy += uy[i + j]; }
        const float inv = 1.0f / (float)(t + 1 < W ? t + 1 : W);
        const float px = sx * inv - ux[i + W - 1], py = sy * inv - uy[i + W - 1];
        *(unsigned*)(pooled + (size_t)(b * TT + t) * PW + c) = pk_bf16(px, py);
    }
}

__global__ void __launch_bounds__(NTHR) hymba_fwd(Params P) {
    extern __shared__ __attribute__((aligned(16))) unsigned char lds_raw[];
    LAS unsigned char* lds = (LAS unsigned char*)lds_raw;
    const int G = gridDim.x, bid = blockIdx.x, gthreads = G * NTHR, gwaves = G * 8;
#define PHASE_IDS int tid = threadIdx.x; asm volatile("" : "+v"(tid)); const int lane = tid & 63, wave = tid >> 6, gtid = bid * NTHR + tid, gwave = bid * 8 + wave; (void)lane; (void)wave; (void)gtid; (void)gwave;
    unsigned char* ws = P.ws; float* out = P.out;
    const float* x_prompt = P.in[0]; const float* x_sample = P.in[1]; const float* state_pool = P.in[2]; const float* state_shift = P.in[3]; const float* state_wkv = P.in[4];
    const float* norm_mix = P.in[5]; const float* w_in = P.in[6]; const float* w_pool = P.in[7]; const float* pool_scale = P.in[8]; const float* mu_shift = P.in[9];
    const float* w0 = P.in[10]; const float* w2 = P.in[11]; const float* a0 = P.in[12]; const float* a2 = P.in[13]; const float* g2 = P.in[14];
    const float* k_k = P.in[15]; const float* k_a = P.in[16]; const float* r_k = P.in[17]; const float* gn_w = P.in[18]; const float* gn_b = P.in[19];
    const float* w_out = P.in[20]; const float* norm_ffn = P.in[21]; const float* w_gate = P.in[22]; const float* w_up = P.in[23]; const float* w_down = P.in[24]; const float* norm_final = P.in[25];
    bf16_t* WinT = (bf16_t*)(ws + WS_WIN); bf16_t* WoutT = (bf16_t*)(ws + WS_WOUT); bf16_t* WguT = (bf16_t*)(ws + WS_WGU); bf16_t* WdnT = (bf16_t*)(ws + WS_WDN);
    bf16_t* WpoolT = (bf16_t*)(ws + WS_WPOOL); bf16_t* WloraT = (bf16_t*)(ws + WS_WLORA);
    bf16_t* Hb = (bf16_t*)(ws + WS_R1); bf16_t* Pooled = (bf16_t*)(ws + WS_R1 + R1_POOLED); bf16_t* Lb = (bf16_t*)(ws + WS_R1 + R1_L); bf16_t* H2 = (bf16_t*)(ws + WS_R1);
    bf16_t* Proj = (bf16_t*)(ws + WS_PROJ); bf16_t* Ub = (bf16_t*)(ws + WS_PROJ); bf16_t* Ab = (bf16_t*)(ws + WS_A); bf16_t* Gb = (bf16_t*)(ws + WS_GATE);
    bf16_t* Mix = (bf16_t*)(ws + WS_MIX); float* rowsq1 = (float*)(ws + WS_ROWSQ); float* Bonus = (float*)(ws + WS_BONUS);
    unsigned* barctr = (unsigned*)(ws + WS_BAR);
    float* Yb = out + SCR_Y; float* Dec = out + SCR_DEC;
    float* Part6 = (float*)(ws + WS_A);
    float* Part8 = (float*)(ws + WS_R1);
    { LAS unsigned* st0 = (LAS unsigned*)(lds + LDS_ST_OFF); if (threadIdx.x < 2) st0[threadIdx.x] = 0u; }
    __syncthreads();
    const XcdBarrier xbar = xcd_barrier_post(barctr, (volatile LAS unsigned*)(lds + LDS_ST_OFF));
#ifndef P3SEL
#define P3SEL 15
#endif
#ifndef PHASE_MASK
#define PHASE_MASK 0x3ff
#endif
#define IN(k) (((PHASE_MASK >> (k)) & 1) && (!P.multi || P.phase == (k)))
#define SEAM() do { if (!P.multi) xcd_barrier(xbar); } while (0)

    if (IN(0)) {
        PHASE_IDS
        transpose_bf16<0>(w_in, D, PJ, PJ, WinT, D, PJP, 0, gwave, gwaves);
        transpose_bf16<0>(w_out, D, D, D, WoutT, D, D, 256, gwave, gwaves);
        for (int g = 0; g < 4; ++g) transpose_bf16<0>(w_pool + (size_t)g * 65536, 256, 256, 256, WpoolT + (size_t)g * 65536, 256, 256, 1280 + g * 16, gwave, gwaves);
        transpose_bf16<0>(w2, 64, CW, CW, WloraT, 256, CW, 1344, gwave, gwaves);
        transpose_bf16<0>(a2, 64, CW, CW, WloraT + (size_t)CW * 256, 256, CW, 1408, gwave, gwaves);
        transpose_bf16<0>(g2, 160, CW, CW, WloraT + (size_t)2 * CW * 256, 256, CW, 1472, gwave, gwaves);
        for (int i = gtid; i < MPAD; i += gthreads) rowsq1[i] = 0.f;
        for (int m = gwave; m < MPAD; m += gwaves) {
            bf16_t* hr = Hb + (size_t)m * D;
            if (m < MV) {
                const float* xr = m < MPR ? x_prompt + (size_t)m * D : x_sample + (size_t)(m - MPR) * D;
                f32x4 v[8]; float s = 0.f;
#pragma unroll
                for (int i = 0; i < 8; ++i) v[i] = *(const f32x4*)(xr + (i * 64 + lane) * 4);
#pragma unroll
                for (int i = 0; i < 8; ++i) s += (v[i][0] * v[i][0] + v[i][1] * v[i][1]) + (v[i][2] * v[i][2] + v[i][3] * v[i][3]);
                s = wsum(s); const float rstd = rsqrtf(s * (1.0f / D) + RMS_EPS);
#pragma unroll
                for (int i = 0; i < 8; ++i) { const int c = (i * 64 + lane) * 4; const f32x4 gg = *(const f32x4*)(norm_mix + c); const f32x4 o = v[i] * rstd * gg;
                    u32x2 w; w.x = pk_bf16(o[0], o[1]); w.y = pk_bf16(o[2], o[3]); *(u32x2*)(hr + c) = w; }
            } else {
#pragma unroll
                for (int i = 0; i < 8; ++i) *(u32x2*)(hr + (i * 64 + lane) * 4) = (u32x2){0u, 0u};
            }
        }
    }
    if (P.multi == 2) cg::this_grid().sync();
    SEAM();

    if (IN(1)) {
        PHASE_IDS
        pg8::Gemm g{Hb, WinT, D, D, D}; pg8::StaticOrder S; S.init(MPAD, PJP, G, bid);
        EpiBf16<0> E{Proj, PJP, 0, nullptr};
        pg8::gemm_phase(lds, g, S, E);
    }
    SEAM();

    if (IN(2)) {
        PHASE_IDS
        for (int rb = bid; rb < MPR / 16; rb += G) {
            const int b = rb >> 7, t0 = (rb & 127) * 16, c = tid * 2, gq = tid >> 7;
            if (gq == 0) pool_block_prompt<2>(Proj, Pooled, b, t0, c);
            else if (gq == 1) pool_block_prompt<4>(Proj, Pooled, b, t0, c);
            else if (gq == 2) pool_block_prompt<8>(Proj, Pooled, b, t0, c);
            else pool_block_prompt<16>(Proj, Pooled, b, t0, c);
        }
        for (int b = bid; b < MSA; b += G) {
            const int c = tid * 2, W = 2 << (tid >> 7);
            const unsigned v = *(const unsigned*)(Proj + (size_t)(MPR + b) * PJP + c); const float ux = bf2f(v & 0xffffu), uy = bf2f(v >> 16);
            f32x2 pr[15];
#pragma unroll
            for (int j = 0; j < 15; ++j) pr[j] = *(const f32x2*)(state_pool + ((size_t)b * 15 + j) * PW + c);
            float sx = ux, sy = uy;
#pragma unroll
            for (int j = 1; j < 16; ++j) { const float mk = j < W ? 1.f : 0.f; sx += pr[15 - j][0] * mk; sy += pr[15 - j][1] * mk; }
            const float inv = 1.0f / (float)W;
            *(unsigned*)(Pooled + (size_t)(MPR + b) * PW + c) = pk_bf16(sx * inv - ux, sy * inv - uy);
            float* np = out + OUT_POOLS + (size_t)b * 15 * PW;
#pragma unroll
            for (int j = 0; j < 14; ++j) *(f32x2*)(np + (size_t)j * PW + c) = pr[j + 1];
            *(f32x2*)(np + (size_t)14 * PW + c) = (f32x2){ux, uy};
        }
        {
            constexpr int NIT = MV * 144;
            for (int base = gtid; base < NIT; base += 5 * gthreads) {
                unsigned cv[5], pv[5]; f32x2 mu[5]; int mm[5], cpo[5], sg[5], pcs[5]; bool val[5];
#pragma unroll
                for (int u = 0; u < 5; ++u) {
                    const int idx = base + u * gthreads; val[u] = idx < NIT; const int id2 = val[u] ? idx : 0;
                    const int m = id2 / 144, jp = id2 - m * 144, seg = jp < 32 ? 0 : (jp < 64 ? 1 : 2);
                    const int j = (jp - (seg == 0 ? 0 : (seg == 1 ? 32 : 64))) * 2, pc = (seg == 0 ? 3072 : (seg == 1 ? 3136 : 3200)) + j;
                    mm[u] = m; sg[u] = seg; cpo[u] = seg * 256 + j; pcs[u] = pc;
                    const int mprev = (m >= MPR || (m & (TT - 1)) == 0) ? m : m - 1;
                    cv[u] = *(const unsigned*)(Proj + (size_t)m * PJP + PW + pc);
                    pv[u] = *(const unsigned*)(Proj + (size_t)mprev * PJP + PW + pc);
                    mu[u] = *(const f32x2*)(mu_shift + pc);
                }
#pragma unroll
                for (int u = 0; u < 5; ++u) {
                    const int m = mm[u]; const float cx = bf2f(cv[u] & 0xffffu), cy = bf2f(cv[u] >> 16);
                    const float fm = (m & (TT - 1)) == 0 ? 0.f : 1.f;
                    float px = bf2f(pv[u] & 0xffffu) * fm, py = bf2f(pv[u] >> 16) * fm;
                    if (m >= MPR) { const f32x2 p = *(const f32x2*)(state_shift + (size_t)(m - MPR) * SW + pcs[u]); px = p[0]; py = p[1]; }
                    float vx = cx + (px - cx) * mu[u][0], vy = cy + (py - cy) * mu[u][1];
                    if (sg[u] == 0) { vx = tanhf(vx); vy = tanhf(vy); } else if (sg[u] == 2) { vx = sigmoidf_(vx); vy = sigmoidf_(vy); }
                    if (val[u]) *(unsigned*)(Lb + (size_t)m * 768 + cpo[u]) = pk_bf16(vx, vy);
                }
            }
        }
        for (int i = gtid; i < 4 * SW; i += gthreads) { const int b = i / SW, j = i - b * SW; out[OUT_SHIFTP + i] = bf2f(Proj[(size_t)(b * TT + TT - 1) * PJP + PW + j]); }
        for (int i = gtid; i < MSA * SW / 2; i += gthreads) { const int b = i / (SW / 2), j = (i - b * (SW / 2)) * 2; const unsigned v = *(const unsigned*)(Proj + (size_t)(MPR + b) * PJP + PW + j);
            *(f32x2*)(out + OUT_SHIFTS + (size_t)b * SW + j) = (f32x2){bf2f(v & 0xffffu), bf2f(v >> 16)}; }
        for (int i = gtid; i < 4 * 15 * PW; i += gthreads) { const int b = i / (15 * PW), r = i - b * 15 * PW, j = r / PW, c = r - j * PW; out[OUT_POOLP + i] = bf2f(Proj[(size_t)(b * TT + TT - 15 + j) * PJP + c]); }
    }
    SEAM();

    if (IN(3)) {
        PHASE_IDS
#pragma clang loop unroll(disable)
        for (int job = 0; job < 7; ++job) {
            const bool pool = job < 4; const int sgm = job - 4;
            pg8::Gemm g{pool ? Pooled + job * 256 : Lb + sgm * 256, pool ? WpoolT + (size_t)job * 65536 : WloraT + (size_t)sgm * CW * 256, pool ? PW : 768, 256, 256};
            const int rot = pool ? job * 33 : (sgm == 0 ? 132 : (sgm == 1 ? 8 : 140));
            pg8::StaticOrder S; S.init(MPAD, pool ? 256 : CW, G, (bid + G - rot % G) % G);
            EpiP3 E{pool ? 0 : (sgm == 0 ? 2 : (sgm == 1 ? 1 : 0)), pool ? Mix : (sgm == 1 ? Ab : Gb), Dec, pool ? D : CW, pool ? job * 256 : 0,
                    pool ? pool_scale : (sgm == 0 ? w0 : (sgm == 1 ? a0 : (const float*)nullptr))};
            pg8::gemm_phase(lds, g, S, E);
        }
    }
    SEAM();

    if (IN(4)) {
        PHASE_IDS
        LAS float* ldf = (LAS float*)lds;
        constexpr int REC = 392, TB = 16, NPS = TB / 4;
        for (int unit = bid; unit < 256; unit += G) {
            const int s = unit >> 2, b = s >> 4, h = s & 15, q = unit & 3;
            const int wv = __builtin_amdgcn_readfirstlane(tid >> 6);
            if (wv < 2) {
              const int crow = wv * 8 + (lane >> 3), kq = lane & 7; const bool first8 = kq == 0;
              f32x2 S2[4];
#pragma unroll
              for (int e = 0; e < 4; ++e) S2[e] = (f32x2){0.f, 0.f};
              const LAS float* recq0 = ldf + kq * 8; const LAS float* recv0 = ldf + 320 + q * 16 + crow;
              float* yp = Yb + (size_t)(b * TT + 7 - kq) * CW + h * 64 + q * 16 + crow;
              WG_BAR();
              for (int blk = 0; blk < TT / TB; ++blk) {
                    const int bo = (blk & 1) * (TB * REC);
                    const LAS float* recq = recq0 + bo; const LAS float* recv = recv0 + bo; const LAS float* recs = ldf + bo + 384;
                    f32x4 av0 = *(const LAS f32x4*)(recq), av1 = *(const LAS f32x4*)(recq + 4), bv0 = *(const LAS f32x4*)(recq + 64), bv1 = *(const LAS f32x4*)(recq + 68);
                    f32x4 dw0 = *(const LAS f32x4*)(recq + 128), dw1 = *(const LAS f32x4*)(recq + 132), kt0 = *(const LAS f32x4*)(recq + 192), kt1 = *(const LAS f32x4*)(recq + 196);
                    f32x4 wr0 = *(const LAS f32x4*)(recq + 256), wr1 = *(const LAS f32x4*)(recq + 260);
                    float vv = recv[0]; f32x2 sc = *(const LAS f32x2*)(recs);
                    float yacc = 0.f;
#pragma unroll
                    for (int st = 0; st < TB; ++st) {
                        const f32x4 a0 = av0, a1 = av1, b0 = bv0, b1 = bv1, d0 = dw0, d1 = dw1, k0 = kt0, k1 = kt1, w0_ = wr0, w1_ = wr1; const float vv_ = vv; const f32x2 sc_ = sc;
                        if (st + 1 < TB) {
                            const int o = (st + 1) * REC;
                            av0 = *(const LAS f32x4*)(recq + o); av1 = *(const LAS f32x4*)(recq + o + 4); bv0 = *(const LAS f32x4*)(recq + o + 64); bv1 = *(const LAS f32x4*)(recq + o + 68);
                            dw0 = *(const LAS f32x4*)(recq + o + 128); dw1 = *(const LAS f32x4*)(recq + o + 132); kt0 = *(const LAS f32x4*)(recq + o + 192); kt1 = *(const LAS f32x4*)(recq + o + 196);
                            wr0 = *(const LAS f32x4*)(recq + o + 256); wr1 = *(const LAS f32x4*)(recq + o + 260);
                            vv = recv[o]; sc = *(const LAS f32x2*)(recs + o);
                        }
                        const f32x2 pa = pkfma_(S2[3], hi2(a1), pkfma_(S2[2], lo2(a1), pkfma_(S2[1], hi2(a0), pkmul_(S2[0], lo2(a0)))));
                        const f32x2 py = pkfma_(S2[3], hi2(w1_), pkfma_(S2[2], lo2(w1_), pkfma_(S2[1], hi2(w0_), pkmul_(S2[0], lo2(w0_)))));
                        float da = pa[0] + pa[1], dy = py[0] + py[1];
                        da = red8(da); dy = red8(dy);
                        const float y = dy + da * sc_[0] + vv_ * sc_[1];
                        { f32x2 dab, vvb; dab[0] = da; dab[1] = da; vvb[0] = vv_; vvb[1] = vv_;
                          S2[0] = pkfma_b(lo2(k0), vvb, pkfma_b(lo2(b0), dab, pkmul_(S2[0], lo2(d0)))); S2[1] = pkfma_b(hi2(k0), vvb, pkfma_b(hi2(b0), dab, pkmul_(S2[1], hi2(d0))));
                          S2[2] = pkfma_b(lo2(k1), vvb, pkfma_b(lo2(b1), dab, pkmul_(S2[2], lo2(d1)))); S2[3] = pkfma_b(hi2(k1), vvb, pkfma_b(hi2(b1), dab, pkmul_(S2[3], hi2(d1)))); }
                        const float sh = __int_as_float(__builtin_amdgcn_update_dpp(__float_as_int(y), __float_as_int(yacc), 0x111, 0xF, 0xF, false));
                        yacc = first8 ? y : sh;
                        if ((st & 7) == 7) yp[(size_t)(blk * TB + (st - 7)) * CW] = yacc;
                        asm volatile("" ::: "memory");
                    }
                    WG_BAR();
              }
              float* so = out + OUT_WKVP + ((size_t)(b * NH + h) * 64 + q * 16 + crow) * 64 + kq * 8;
              *(f32x4*)so = (f32x4){S2[0][0], S2[0][1], S2[1][0], S2[1][1]}; *(f32x4*)(so + 4) = (f32x4){S2[2][0], S2[2][1], S2[3][0], S2[3][1]};
            } else if (wv == 4 || wv == 5) {
              constexpr int CT_PER = 5632, CT_ALL = 3 * CT_PER;
              float cvv[32]; int ctile = unit * 2 + (wv - 4), cph = 0;
#define CONV_LOAD16(P0_) do { if (ctile < CT_ALL) { const int m_ = ctile / CT_PER, r_ = ctile - m_ * CT_PER; const float* sp_; unsigned ld_; \
                    if (m_ < 2) { sp_ = (m_ == 0 ? w_gate : w_up) + (size_t)((r_ / 88) * 32) * DFF + (r_ % 88) * 64; ld_ = DFF; } \
                    else { sp_ = w_down + (size_t)((r_ >> 5) * 32) * D + (r_ & 31) * 64; ld_ = D; } \
                    _Pragma("unroll") for (int j_ = (P0_); j_ < (P0_) + 16; ++j_) cvv[j_] = sp_[(unsigned)j_ * ld_ + lane]; } } while (0)
#define CONV_STORE() do { if (ctile < CT_ALL) { const int m_ = ctile / CT_PER, r_ = ctile - m_ * CT_PER; bf16_t* dp_; \
                    if (m_ < 2) { const int k0_ = (r_ / 88) * 32, n_ = (r_ % 88) * 64 + lane; dp_ = WguT + (size_t)((n_ >> 7) * 256 + (m_ == 1 ? 128 : 0) + (n_ & 127)) * D + k0_; } \
                    else { const int k0_ = (r_ >> 5) * 32, n_ = (r_ & 31) * 64 + lane; dp_ = WdnT + (size_t)n_ * DFF + k0_; } \
                    _Pragma("unroll") for (int q8_ = 0; q8_ < 4; ++q8_) { u32x4 w_; w_.x = pk_bf16(cvv[q8_ * 8 + 0], cvv[q8_ * 8 + 1]); w_.y = pk_bf16(cvv[q8_ * 8 + 2], cvv[q8_ * 8 + 3]); \
                        w_.z = pk_bf16(cvv[q8_ * 8 + 4], cvv[q8_ * 8 + 5]); w_.w = pk_bf16(cvv[q8_ * 8 + 6], cvv[q8_ * 8 + 7]); *(u32x4*)(dp_ + q8_ * 8) = w_; } \
                    ctile += 512; } } while (0)
              WG_BAR();
              for (int blk = 0; blk < TT / TB; ++blk) {
                if (cph == 0) CONV_LOAD16(0); else if (cph == 1) CONV_LOAD16(16); else CONV_STORE();
                cph = cph == 2 ? 0 : cph + 1;
                WG_BAR();
              }
              while (ctile < CT_ALL) {
                if (cph <= 0) CONV_LOAD16(0);
                if (cph <= 1) CONV_LOAD16(16);
                CONV_STORE(); cph = 0;
              }
#undef CONV_LOAD16
#undef CONV_STORE
            } else {
              const int pw = (wv & 1) + ((wv >> 2) << 1), ch = h * 64 + lane;
              const float c_kk = k_k[ch], c_ka = k_a[ch], c_rk = r_k[ch], mu_r = mu_shift[ch], mu_k = mu_shift[CW + ch], mu_v = mu_shift[2 * CW + ch];
              const bf16_t* pbase = Proj + (size_t)(b * TT) * PJP + PW + h * 64; const float* dbase = Dec + (size_t)(b * TT) * CW + h * 64; const bf16_t* abase = Ab + (size_t)(b * TT) * CW + h * 64;
              constexpr int PD = 4;
              unsigned short rr[PD][NPS + 1], kr_[PD][NPS + 1], vr[PD][NPS + 1], aa[PD][NPS]; float dd[PD][NPS];
#define SCAN_LOAD(blk, SET) do { const int t0_ = (blk) * TB + pw * NPS; \
            _Pragma("unroll") for (int i_ = 0; i_ < NPS + 1; ++i_) { const unsigned t_ = (unsigned)((i_ == 0 && t0_ == 0) ? 0 : t0_ - 1 + i_); const bf16_t* pp_ = pbase + t_ * (unsigned)PJP; \
                rr[SET][i_] = pp_[lane]; kr_[SET][i_] = pp_[CW + lane]; vr[SET][i_] = pp_[2 * CW + lane]; } \
            _Pragma("unroll") for (int i_ = 0; i_ < NPS; ++i_) { const unsigned mi_ = (unsigned)(t0_ + i_) * (unsigned)CW; dd[SET][i_] = dbase[mi_ + lane]; aa[SET][i_] = abase[mi_ + lane]; } } while (0)
#define SCAN_PRODUCE(blk, SET) do { LAS float* bufp_ = ldf + ((blk) & 1) * (TB * REC); const int t0_ = (blk) * TB + pw * NPS; \
            _Pragma("unroll") for (int i_ = 0; i_ < NPS; ++i_) { \
                const float zz_ = (i_ == 0 && t0_ == 0) ? 0.f : 1.f; \
                const float rc_ = bf2f(rr[SET][i_ + 1]), kc_ = bf2f(kr_[SET][i_ + 1]), vc_ = bf2f(vr[SET][i_ + 1]), rp_ = bf2f(rr[SET][i_]) * zz_, kp_ = bf2f(kr_[SET][i_]) * zz_, vp_ = bf2f(vr[SET][i_]) * zz_; \
                const float r_ = rc_ + (rp_ - rc_) * mu_r, k_ = kc_ + (kp_ - kc_) * mu_k, v_ = vc_ + (vp_ - vc_) * mu_v; \
                const float a_ = bf2f(aa[SET][i_]), d_ = dd[SET][i_]; \
                const float kkr_ = k_ * c_kk; const float n2_ = wsum(kkr_ * kkr_); const float kk_ = kkr_ * rsqrtf(fmaxf(n2_, 1e-24f)); \
                const float kt_ = k_ * (1.0f + (a_ - 1.0f) * c_ka); const float bv_ = kk_ * a_; \
                const float br_ = wsum(bv_ * r_), krs_ = wsum(kt_ * r_), bon_ = wsum(r_ * kt_ * c_rk); \
                LAS float* rec_ = bufp_ + (pw * NPS + i_) * REC; \
                rec_[lane] = -kk_; rec_[64 + lane] = bv_; rec_[128 + lane] = d_; rec_[192 + lane] = kt_; rec_[256 + lane] = d_ * r_; rec_[320 + lane] = v_; \
                if (lane == 0) { rec_[384] = br_; rec_[385] = krs_; if (q == 0) Bonus[(size_t)(b * TT + t0_ + i_) * NH + h] = bon_; } } } while (0)
              SCAN_LOAD(0, 0); SCAN_LOAD(1, 1); SCAN_LOAD(2, 2); SCAN_LOAD(3, 3);
              SCAN_PRODUCE(0, 0); SCAN_LOAD(4, 0);
              WG_BAR();
              static_assert((TT / TB) % PD == 0 && PD == 4, "block loop is unrolled by PD = 4");
              for (int blk0 = 0; blk0 < TT / TB; blk0 += PD) {
#define SCAN_ITER(D_, SET) do { const int blk = blk0 + (D_); if (blk + 1 < TT / TB) { SCAN_PRODUCE(blk + 1, SET); if (blk + 1 + PD < TT / TB) SCAN_LOAD(blk + 1 + PD, SET); } WG_BAR(); } while (0)
                SCAN_ITER(0, 1); SCAN_ITER(1, 2); SCAN_ITER(2, 3); SCAN_ITER(3, 0);
#undef SCAN_ITER
              }
            }
#undef SCAN_LOAD
#undef SCAN_PRODUCE
        }
        __syncthreads();
        LAS float* wl = ldf + wave * 512;
        for (int p = gwave; p < MSA * NH; p += gwaves) {
            const int b = p >> 4, h = p & 15, m = MPR + b, ch = h * 64 + lane;
            const bf16_t* pp = Proj + (size_t)m * PJP + PW + ch; const float* sp = state_shift + (size_t)b * SW + ch;
            const float rc = bf2f(pp[0]), kc = bf2f(pp[CW]), vc = bf2f(pp[2 * CW]);
            const float r = rc + (sp[0] - rc) * mu_shift[ch], k = kc + (sp[CW] - kc) * mu_shift[CW + ch], v = vc + (sp[2 * CW] - vc) * mu_shift[2 * CW + ch];
            const float d = Dec[(size_t)m * CW + ch], a = bf2f(Ab[(size_t)m * CW + ch]);
            const float kkr = k * k_k[ch]; const float n2 = wsum(kkr * kkr); const float kk = kkr * rsqrtf(fmaxf(n2, 1e-24f));
            const float kt = k * (1.0f + (a - 1.0f) * k_a[ch]);
            const float bon = wsum(r * kt * r_k[ch]);
            wl[lane] = -kk; wl[64 + lane] = kk * a; wl[128 + lane] = d; wl[192 + lane] = kt; wl[256 + lane] = r; wl[320 + lane] = v;
            asm volatile("s_waitcnt lgkmcnt(0)" ::: "memory");
            const int kq = lane & 15, r4 = lane >> 4;
            const f32x4 av = *(const LAS f32x4*)(wl + kq * 4), bv = *(const LAS f32x4*)(wl + 64 + kq * 4), dw = *(const LAS f32x4*)(wl + 128 + kq * 4);
            const f32x4 ktv = *(const LAS f32x4*)(wl + 192 + kq * 4), rv = *(const LAS f32x4*)(wl + 256 + kq * 4);
            const float* sin_ = state_wkv + (size_t)(b * NH + h) * 4096; float* sout = out + OUT_WKVS + (size_t)(b * NH + h) * 4096;
#pragma unroll 4
            for (int j = 0; j < 16; ++j) {
                const int row = r4 + 4 * j; f32x4 Sv = *(const f32x4*)(sin_ + row * 64 + kq * 4);
                float da = (Sv[0] * av[0] + Sv[1] * av[1]) + (Sv[2] * av[2] + Sv[3] * av[3]); da = red16(da);
                const float vv = wl[320 + row];
                Sv = Sv * dw + da * bv + vv * ktv;
                *(f32x4*)(sout + row * 64 + kq * 4) = Sv;
                float dy = (Sv[0] * rv[0] + Sv[1] * rv[1]) + (Sv[2] * rv[2] + Sv[3] * rv[3]); dy = red16(dy);
                if (kq == 0) wl[384 + row] = dy;
            }
            asm volatile("s_waitcnt lgkmcnt(0)" ::: "memory");
            const float y = wl[384 + lane];
            const float mean = wsum(y) * (1.0f / 64.0f); const float dl = y - mean; const float var = wsum(dl * dl) * (1.0f / 64.0f);
            const float yn = dl * rsqrtf(var + GN_EPS) * gn_w[ch] + gn_b[ch];
            const float o = (yn + bon * v) * bf2f(Gb[(size_t)m * CW + ch]);
            Mix[(size_t)m * D + PW + ch] = (bf16_t)f2bf(o);
            asm volatile("s_waitcnt lgkmcnt(0)" ::: "memory");
        }
    }
    SEAM();

    if (IN(5)) {
        PHASE_IDS
        { pg8::Gemm g{Mix, WoutT, D, D, 256}; pg8::SplitKOrder S{8, KS6, 32, 256, G, (bid + G - 192 % G) % G};
          EpiPartial E{Part6}; pg8::gemm_phase(lds, g, S, E); }
        {
            const int half = gwave & 1, ch0 = half * 512 + lane * 8, h = ch0 >> 6;
            const f32x4 mu0 = *(const f32x4*)(mu_shift + 2 * CW + ch0), mu1 = *(const f32x4*)(mu_shift + 2 * CW + ch0 + 4);
            const f32x4 gw0 = *(const f32x4*)(gn_w + ch0), gw1 = *(const f32x4*)(gn_w + ch0 + 4), gb0 = *(const f32x4*)(gn_b + ch0), gb1 = *(const f32x4*)(gn_b + ch0 + 4);
            for (int it0 = gwave; it0 < MPR * 2; it0 += 2 * gwaves) {
                f32x4 y0[2], y1[2]; u32x4 vc[2], vp[2], gt[2]; float bon[2]; int mm[2]; bool val[2];
#pragma unroll
                for (int u = 0; u < 2; ++u) {
                    const int it = it0 + u * gwaves; val[u] = it < MPR * 2; const int m = val[u] ? (it >> 1) : 0; mm[u] = m;
                    const int mprev = (m & (TT - 1)) ? m - 1 : m;
                    y0[u] = *(const f32x4*)(Yb + (size_t)m * CW + ch0); y1[u] = *(const f32x4*)(Yb + (size_t)m * CW + ch0 + 4);
                    vc[u] = *(const u32x4*)(Proj + (size_t)m * PJP + PW + 2 * CW + ch0); vp[u] = *(const u32x4*)(Proj + (size_t)mprev * PJP + PW + 2 * CW + ch0);
                    gt[u] = *(const u32x4*)(Gb + (size_t)m * CW + ch0); bon[u] = Bonus[(size_t)m * NH + h];
                }
#pragma unroll
                for (int u = 0; u < 2; ++u) {
                    const int m = mm[u]; const float fm = (m & (TT - 1)) == 0 ? 0.f : 1.f;
                    float y[8] = {y0[u][0], y0[u][1], y0[u][2], y0[u][3], y1[u][0], y1[u][1], y1[u][2], y1[u][3]};
                    float s = ((y[0] + y[1]) + (y[2] + y[3])) + ((y[4] + y[5]) + (y[6] + y[7])); s = red8(s);
                    const float mean = s * (1.0f / 64.0f); float q2 = 0.f;
#pragma unroll
                    for (int j = 0; j < 8; ++j) { y[j] -= mean; q2 += y[j] * y[j]; }
                    q2 = red8(q2); const float rstd = rsqrtf(q2 * (1.0f / 64.0f) + GN_EPS);
                    unsigned ow[4];
#pragma unroll
                    for (int j2 = 0; j2 < 4; ++j2) {
                        float o2[2];
#pragma unroll
                        for (int e = 0; e < 2; ++e) {
                            const int j = j2 * 2 + e; const unsigned cw = vc[u][j2], pw_ = vp[u][j2], gw_ = gt[u][j2];
                            const float c_ = e ? bf2f(cw >> 16) : bf2f(cw & 0xffffu), p_ = fm * (e ? bf2f(pw_ >> 16) : bf2f(pw_ & 0xffffu)), g_ = e ? bf2f(gw_ >> 16) : bf2f(gw_ & 0xffffu);
                            const float mu_ = j < 4 ? mu0[j & 3] : mu1[j & 3], gnw = j < 4 ? gw0[j & 3] : gw1[j & 3], gnb = j < 4 ? gb0[j & 3] : gb1[j & 3];
                            const float v = c_ + (p_ - c_) * mu_;
                            o2[e] = (y[j] * rstd * gnw + gnb + bon[u] * v) * g_;
                        }
                        ow[j2] = pk_bf16(o2[0], o2[1]);
                    }
                    if (val[u]) *(u32x4*)(Mix + (size_t)m * D + PW + ch0) = (u32x4){ow[0], ow[1], ow[2], ow[3]};
                }
            }
        }
    }
    SEAM();

    if (IN(6)) {
        PHASE_IDS
        pg8::Gemm g{Mix, WoutT, D, D, D}; pg8::StaticOrder S; S.init(MPR, D, G, bid);
        EpiOut E{x_prompt, x_sample, out, H2, norm_ffn, rowsq1};
        pg8::gemm_phase(lds, g, S, E);
        for (int r = gwave; r < MSA; r += gwaves) {
            const int row = MPR + r; float s = 0.f;
#pragma unroll
            for (int i = 0; i < 8; ++i) {
                const int c = (i * 64 + lane) * 4; f32x4 x1 = *(const f32x4*)(x_sample + (size_t)r * D + c);
#pragma unroll
                for (int ks = 0; ks < KS6; ++ks) x1 = x1 + *(const f32x4*)(Part6 + ((size_t)ks * MSA + r) * D + c);
                *(f32x4*)(out + (size_t)row * D + c) = x1;
                s += (x1[0] * x1[0] + x1[1] * x1[1]) + (x1[2] * x1[2] + x1[3] * x1[3]);
                const f32x4 hv = x1 * *(const f32x4*)(norm_ffn + c);
                u32x2 w; w.x = pk_bf16(hv[0], hv[1]); w.y = pk_bf16(hv[2], hv[3]); *(u32x2*)(H2 + (size_t)row * D + c) = w;
            }
            s = wsum(s); if (lane == 0) rowsq1[row] = s;
        }
    }
    SEAM();

    if (IN(7)) {
        PHASE_IDS
        pg8::Gemm g{H2, WguT, D, D, D}; pg8::StaticOrder S; S.init(MPAD, 2 * DFF, G, bid);
        EpiGU E{Ub, rowsq1};
        pg8::gemm_phase(lds, g, S, E);
    }
    SEAM();

    if (IN(8)) {
        PHASE_IDS
        { pg8::Gemm g{Ub, WdnT, DFF, DFF, DFF}; pg8::StaticOrder S; S.init(MPR, D, G, bid);
          EpiDown E{out}; pg8::gemm_phase(lds, g, S, E); }
        { pg8::Gemm g{Ub, WdnT, DFF, DFF, 512}; pg8::SplitKOrder S{8, KS8, 32, 512, G, bid};
          EpiPartial E{Part8}; pg8::gemm_phase(lds, g, S, E); }
    }
    SEAM();

    if (IN(9)) {
        PHASE_IDS
        for (int row = gwave; row < MV; row += gwaves) {
            float* p = out + (size_t)row * D; f32x4 v[8]; float s = 0.f;
#pragma unroll
            for (int i = 0; i < 8; ++i) v[i] = *(const f32x4*)(p + (i * 64 + lane) * 4);
            if (row >= MPR) {
#pragma unroll
                for (int i = 0; i < 8; ++i)
#pragma unroll
                    for (int ks = 0; ks < KS8; ++ks) v[i] = v[i] + *(const f32x4*)(Part8 + ((size_t)ks * MSA + (row - MPR)) * D + (i * 64 + lane) * 4);
            }
#pragma unroll
            for (int i = 0; i < 8; ++i) s += (v[i][0] * v[i][0] + v[i][1] * v[i][1]) + (v[i][2] * v[i][2] + v[i][3] * v[i][3]);
            s = wsum(s); const float rstd = rsqrtf(s * (1.0f / D) + RMS_EPS);
#pragma unroll
            for (int i = 0; i < 8; ++i) { const int c = (i * 64 + lane) * 4; *(f32x4*)(p + c) = v[i] * rstd * *(const f32x4*)(norm_final + c); }
        }
    }
#undef IN
#undef SEAM
}

#ifndef HY_MULTI
#define HY_MULTI 0
#endif
#ifndef HY_REP
#define HY_REP 0
#endif
extern "C" void kernel_launch(void* const* d_in, const int* in_sizes, int n_in, void* d_out, int out_size, void* d_ws, size_t ws_size, hipStream_t stream) {
    static int grid = 0;
    if (grid == 0) {
        if (n_in != 26 || ws_size < WS_END) { fprintf(stderr, "kernel_launch: need 26 inputs and >= %zu bytes of workspace (got %d, %zu)\n", (size_t)WS_END, n_in, ws_size); grid = -1; return; }
        int dev = 0, cus = 0, per_cu = 0;
        hipGetDevice(&dev); hipDeviceGetAttribute(&cus, hipDeviceAttributeMultiprocessorCount, dev);
        if (hipFuncSetAttribute((const void*)hymba_fwd, hipFuncAttributeMaxDynamicSharedMemorySize, LDS_BYTES) != hipSuccess) { fprintf(stderr, "kernel_launch: hipFuncSetAttribute failed\n"); grid = -1; return; }
        if (hipOccupancyMaxActiveBlocksPerMultiprocessor(&per_cu, (const void*)hymba_fwd, NTHR, LDS_BYTES) != hipSuccess || per_cu < 1) { fprintf(stderr, "kernel_launch: occupancy query says %d\n", per_cu); per_cu = 1; }
        (void)hipGetLastError();
        grid = cus;
        if (grid > 256) grid = 256;
    }
    if (grid < 0) return;
    Params p{};
    for (int i = 0; i < 26; ++i) p.in[i] = (const float*)d_in[i];
    p.out = (float*)d_out; p.ws = (unsigned char*)d_ws;
#if HY_MULTI
    p.multi = 1;
    for (int ph = 0; ph < 10; ++ph) { p.phase = ph; for (int r = 0; r < ((HY_REP >> ph) & 1) + 1; ++r) hipLaunchKernelGGL(hymba_fwd, dim3(grid), dim3(NTHR), LDS_BYTES, stream, p); }
#else
    p.multi = 0; p.phase = 0;
    hipMemsetAsync((char*)d_ws + WS_BAR, 0, 16384, stream);
    void* args[] = {&p};
    hipError_t e = hipLaunchCooperativeKernel((const void*)hymba_fwd, dim3(grid), dim3(NTHR), args, LDS_BYTES, stream);
    if (e != hipSuccess) fprintf(stderr, "cooperative launch failed: %s (grid %d)\n", hipGetErrorString(e), grid);
#endif
}
```

```cpp
#include <hip/hip_runtime.h>
#include <hip/hip_cooperative_groups.h>
#include <cstdio>
namespace cg = cooperative_groups;

#define LAS __attribute__((address_space(3)))
typedef unsigned short bf16_t;
typedef short bf16x8 __attribute__((ext_vector_type(8)));
typedef float f32x4 __attribute__((ext_vector_type(4)));
typedef float f32x2 __attribute__((ext_vector_type(2)));
typedef unsigned u32x4 __attribute__((ext_vector_type(4)));
typedef unsigned u32x2 __attribute__((ext_vector_type(2)));

constexpr int D = 2048, TT = 2048, MPR = 8192, MSA = 128, MV = 8320, MPAD = 8448;
constexpr int PW = 1024, SW = 3360, PJ = 4384, PJP = 4608, DFF = 5632, CW = 1024, NH = 16;
constexpr int NTHR = 512, LDS_BYTES = 131072 + 16, LDS_ST_OFF = 131072;
constexpr float RMS_EPS = 1e-6f, GN_EPS = 64e-5f;

constexpr size_t WS_WIN = 0;
constexpr size_t WS_WOUT = WS_WIN + (size_t)PJP * D * 2;
constexpr size_t WS_WGU = WS_WOUT + (size_t)D * D * 2;
constexpr size_t WS_WDN = WS_WGU + (size_t)2 * DFF * D * 2;
constexpr size_t WS_WPOOL = WS_WDN + (size_t)D * DFF * 2;
constexpr size_t WS_WLORA = WS_WPOOL + (size_t)4 * 256 * 256 * 2;
constexpr size_t WS_R1 = WS_WLORA + (size_t)3 * 1024 * 256 * 2;
constexpr size_t WS_PROJ = WS_R1 + (size_t)MPAD * D * 2;
constexpr size_t WS_A = WS_PROJ + (size_t)MPAD * PJP * 2;
constexpr size_t WS_GATE = WS_A + (size_t)MPAD * CW * 2;
constexpr size_t WS_MIX = WS_GATE + (size_t)MPAD * CW * 2;
constexpr size_t WS_ROWSQ = WS_MIX + (size_t)MPAD * D * 2;
constexpr size_t WS_BONUS = WS_ROWSQ + (size_t)2 * MPAD * 4;
constexpr size_t WS_BAR = WS_BONUS + (size_t)MV * NH * 4;
constexpr size_t WS_END = WS_BAR + 16384;
static_assert((size_t)MPAD * DFF * 2 <= (WS_MIX - WS_PROJ), "U must fit in proj+a+gate");
constexpr int XLD = 1792;
static_assert((size_t)MPAD * XLD * 2 <= (size_t)MPAD * D * 2, "X fits in WS_R1");
constexpr int KS6 = 8, KS8 = 11;
static_assert((size_t)KS6 * MSA * D * 4 <= (size_t)MPAD * CW * 2 && (size_t)KS8 * MSA * D * 4 <= (size_t)MPAD * D * 2, "partial buffers alias WS_A / WS_R1");

constexpr size_t OUT_Y = 0;
constexpr size_t OUT_POOLP = (size_t)MV * D;
constexpr size_t OUT_SHIFTP = OUT_POOLP + (size_t)4 * 15 * PW;
constexpr size_t OUT_WKVP = OUT_SHIFTP + (size_t)4 * SW;
constexpr size_t OUT_POOLS = OUT_WKVP + (size_t)4 * NH * 64 * 64;
constexpr size_t OUT_SHIFTS = OUT_POOLS + (size_t)MSA * 15 * PW;
constexpr size_t OUT_WKVS = OUT_SHIFTS + (size_t)MSA * SW;
constexpr size_t SCR_Y = 0;
constexpr size_t SCR_DEC = (size_t)MPR * CW;
static_assert(SCR_DEC + (size_t)MV * CW <= OUT_POOLP, "scratch must fit in the y region");

struct Params { const float* in[26]; float* out; unsigned char* ws; int multi; int phase; };

__device__ __forceinline__ float bf2f(unsigned b) { return __uint_as_float(b << 16); }
__device__ __forceinline__ unsigned f2bf(float f) { unsigned u = __float_as_uint(f); u += 0x7FFFu + ((u >> 16) & 1u); return u >> 16; }
__device__ __forceinline__ unsigned pk_bf16(float lo, float hi) { unsigned r; asm volatile("v_cvt_pk_bf16_f32 %0, %1, %2" : "=v"(r) : "v"(lo), "v"(hi)); return r; }
template <int CTRL> __device__ __forceinline__ float dpp(float x) { return __int_as_float(__builtin_amdgcn_update_dpp(0, __float_as_int(x), CTRL, 0xF, 0xF, true)); }
__device__ __forceinline__ float red16(float x) {
    x += dpp<0x128>(x); x += dpp<0x124>(x); x += dpp<0x4E>(x); x += dpp<0xB1>(x); return x;
}
__device__ __forceinline__ float wsum(float x) {
    x = red16(x);
    x += __int_as_float(__builtin_amdgcn_update_dpp(0, __float_as_int(x), 0x142, 0xA, 0xF, false));
    x += __int_as_float(__builtin_amdgcn_update_dpp(0, __float_as_int(x), 0x143, 0xC, 0xF, false));
    return __int_as_float(__builtin_amdgcn_readlane(__float_as_int(x), 63));
}
__device__ __forceinline__ float fma_(float a, float b, float c) { float d; asm("v_fma_f32 %0, %1, %2, %3" : "=v"(d) : "v"(a), "v"(b), "v"(c)); return d; }
__device__ __forceinline__ f32x2 pkmul_(f32x2 a, f32x2 b) { f32x2 d; asm("v_pk_mul_f32 %0, %1, %2" : "=v"(d) : "v"(a), "v"(b)); return d; }
__device__ __forceinline__ f32x2 pkfma_(f32x2 a, f32x2 b, f32x2 c) { f32x2 d; asm("v_pk_fma_f32 %0, %1, %2, %3" : "=v"(d) : "v"(a), "v"(b), "v"(c)); return d; }
__device__ __forceinline__ f32x2 pkfma_b(f32x2 a, f32x2 s, f32x2 c) { f32x2 d; asm("v_pk_fma_f32 %0, %1, %2, %3 op_sel_hi:[1,0,1]" : "=v"(d) : "v"(a), "v"(s), "v"(c)); return d; }
__device__ __forceinline__ f32x2 lo2(f32x4 v) { return __builtin_shufflevector(v, v, 0, 1); }
__device__ __forceinline__ f32x2 hi2(f32x4 v) { return __builtin_shufflevector(v, v, 2, 3); }
__device__ __forceinline__ float mul_(float a, float b) { float d; asm("v_mul_f32 %0, %1, %2" : "=v"(d) : "v"(a), "v"(b)); return d; }
__device__ __forceinline__ float sigmoidf_(float x) { return 1.0f / (1.0f + __expf(-x)); }

#define WG_BAR() do { asm volatile("s_waitcnt lgkmcnt(0)" ::: "memory"); __builtin_amdgcn_s_barrier(); asm volatile("" ::: "memory"); } while (0)

#define XB_TMO      128
#define XB_XCNT(j)  (256  + 64 * (j))
#define XB_XSUB(j)  (1280 + 64 * (j))
#define XB_XGEN(j)  (2304 + 64 * (j))
#define XB_TOP      3328
#define XB_TOPGEN   3392
#define XCD_BAR_WORDS 3456
#define XB_SPIN_CAP (1u << 18)

__device__ __forceinline__ unsigned xb_ld(unsigned* p)              { return __hip_atomic_load(p, __ATOMIC_RELAXED, __HIP_MEMORY_SCOPE_AGENT); }
__device__ __forceinline__ unsigned xb_add(unsigned* p, unsigned v) { return __hip_atomic_fetch_add(p, v, __ATOMIC_RELAXED, __HIP_MEMORY_SCOPE_AGENT); }
__device__ __forceinline__ unsigned xb_xcc_id() { return (unsigned)__builtin_amdgcn_s_getreg((3 << 11) | 20) & 0xFu; }
#define XB_SPIN(cond, bar) do { unsigned _sp = 0; while (cond) { __builtin_amdgcn_s_sleep(1); \
    if ((++_sp & 255u) == 0u) { if (xb_ld(&(bar)[XB_TMO])) break; if (_sp > XB_SPIN_CAP) { atomicAdd(&(bar)[XB_TMO], 1u); break; } } } } while (0)

struct XcdBarrier {
    unsigned* bar; unsigned x;
    volatile LAS unsigned* st;
};

__device__ __forceinline__ XcdBarrier xcd_barrier_post(unsigned* bar, volatile LAS unsigned* st) {
    XcdBarrier b; b.bar = bar; b.x = xb_xcc_id(); b.st = st;
    if (threadIdx.x == 0) (void)xb_add(&bar[XB_XCNT(b.x)], 1u);
    return b;
}
__device__ __forceinline__ void xcd_barrier_complete(unsigned* bar, unsigned x, unsigned& nloc, unsigned& nx) {
    const unsigned G = gridDim.x * gridDim.y * gridDim.z;
    unsigned sum, cnt, mine, sp = 0u;
    for (;;) {
        sum = 0u; cnt = 0u; mine = 0u;
#pragma unroll
        for (unsigned j = 0; j < 16; ++j) { const unsigned c = xb_ld(&bar[XB_XCNT(j)]); sum += c; cnt += (c > 0u) ? 1u : 0u; mine = (j == x) ? c : mine; }
        if (sum == G) break;
        __builtin_amdgcn_s_sleep(1);
        if ((++sp & 255u) == 0u) { if (xb_ld(&bar[XB_TMO])) break; if (sp > XB_SPIN_CAP) { atomicAdd(&bar[XB_TMO], 1u); break; } }
    }
    nloc = mine > 0u ? mine : 1u; nx = cnt > 0u ? cnt : 1u;
}

__device__ __forceinline__ void xcd_barrier(const XcdBarrier& b) {
    asm volatile("s_waitcnt vmcnt(0)" ::: "memory");
    __syncthreads();
    if (threadIdx.x == 0) {
        unsigned* bar = b.bar;
        __builtin_amdgcn_s_waitcnt(0);
        unsigned nloc = b.st[0], nx = b.st[1];
        if (nloc == 0u) { xcd_barrier_complete(bar, b.x, nloc, nx); b.st[0] = nloc; b.st[1] = nx; }
        const unsigned old = xb_add(&bar[XB_XSUB(b.x)], 1u);
        const unsigned gen = old / nloc;
        if (old + 1u == (gen + 1u) * nloc) {
            __builtin_amdgcn_fence(__ATOMIC_RELEASE, "agent");
            asm volatile("s_waitcnt vmcnt(0)" ::: "memory");
            const unsigned og = xb_add(&bar[XB_TOP], 1u);
            const unsigned tg = og / nx;
            if (og + 1u == (tg + 1u) * nx) xb_add(&bar[XB_TOPGEN], 1u);
            else XB_SPIN(xb_ld(&bar[XB_TOPGEN]) == tg, bar);
            __builtin_amdgcn_fence(__ATOMIC_ACQUIRE, "agent");
            xb_add(&bar[XB_XGEN(b.x)], 1u);
            asm volatile("s_waitcnt vmcnt(0)" ::: "memory");
        } else {
            XB_SPIN(xb_ld(&bar[XB_XGEN(b.x)]) == gen, bar);
            __builtin_amdgcn_fence(__ATOMIC_ACQUIRE, "agent");
            asm volatile("s_waitcnt vmcnt(0)" ::: "memory");
        }
    }
    __syncthreads();
}

__device__ __forceinline__ void grid_bar(unsigned* ctr, unsigned target) {
    asm volatile("s_waitcnt vmcnt(0) lgkmcnt(0)" ::: "memory");
    __syncthreads();
    if (threadIdx.x == 0) {
        __builtin_amdgcn_fence(__ATOMIC_RELEASE, "agent");
        asm volatile("s_waitcnt vmcnt(0)" ::: "memory");
        __hip_atomic_fetch_add(ctr, 1u, __ATOMIC_RELAXED, __HIP_MEMORY_SCOPE_AGENT);
        while (__hip_atomic_load(ctr, __ATOMIC_RELAXED, __HIP_MEMORY_SCOPE_AGENT) < target) __builtin_amdgcn_s_sleep(4);
        __builtin_amdgcn_fence(__ATOMIC_ACQUIRE, "agent");
        asm volatile("s_waitcnt vmcnt(0)" ::: "memory");
    }
    __syncthreads();
}

namespace pg8 {
constexpr int BM = 256, BK = 64, HALF = 128, HTB = HALF * BK * 2, NXCD = 8, WGM = 8;
__device__ __forceinline__ int lds_byte(int r, int c) { const int st = (r >> 4) * 2 + (c >> 5), rr = r & 15, cc = c & 31, ob = rr * 64 + cc * 2; return st * 1024 + (ob ^ (((ob >> 9) & 1) << 5)); }
__device__ __forceinline__ void stage_rc(int b, int& R, int& C) { const int st = b / 1024, sb = b % 1024, swz = sb ^ (((sb >> 9) & 1) << 5); R = (st >> 1) * 16 + swz / 64; C = (st & 1) * 32 + (swz % 64) / 2; }
__device__ __forceinline__ int perm32(int rho) { const int n = rho >> 4, i = rho & 15; return 8 * (i >> 2) + 4 * n + (i & 3); }
struct Unit { int pm, pn, ks, koffA, koffB; };
struct Gemm { const bf16_t* A; const bf16_t* Bt; int lda, ldb, K; };
struct StaticOrder {
    int nM, nN, nwg, G, c;
    __device__ void init(int M, int N, int G_, int c_) { nM = M / BM; nN = N / BM; nwg = nM * nN; G = G_; c = c_; }
    __device__ bool next(int i, Unit& u) const {
        const long L = (long)i * G + c; if (L >= nwg) return false;
        int wgid = (int)L; { const int q = nwg / NXCD, r = nwg % NXCD, xcd = wgid % NXCD, off = wgid / NXCD; wgid = (xcd < r ? xcd * (q + 1) : r * (q + 1) + (xcd - r) * q) + off; }
        const int nig = WGM * nN, gid = wgid / nig, fm = gid * WGM, gsz = (nM - fm) < WGM ? (nM - fm) : WGM;
        u.pm = fm + ((wgid % nig) % gsz); u.pn = (wgid % nig) / gsz; u.ks = 0; u.koffA = 0; u.koffB = 0; return true;
    }
};
struct SplitKOrder {
    int nN, nks, pm, kchunk, G, c;
    __device__ bool next(int i, Unit& u) const { const long L = (long)i * G + c; if (L >= (long)nN * nks) return false;
        u.pm = pm; u.pn = (int)(L % nN); u.ks = (int)(L / nN); u.koffA = u.ks * kchunk; u.koffB = u.koffA; return true; }
};

struct P3Order {
    int G, c;
    __device__ bool next(int i, Unit& u) const { const int L = i * G + c; if (L >= 16 * 33) return false;
        u.pn = L / 33; u.pm = L - u.pn * 33; u.ks = 0; u.koffB = 0; u.koffA = u.pn < 4 ? u.pn * 256 : 1024 + ((u.pn - 4) >> 2) * 256; return true; }
};
template <class Epi, class Sched>
__device__ __forceinline__ void gemm_phase(LAS unsigned char* lds, const Gemm g, const Sched& S, const Epi& E) {
    const int tid = threadIdx.x, wid = __builtin_amdgcn_readfirstlane(tid >> 6), lane = tid & 63, wr = wid >> 2, wc = wid & 3, fr = lane & 15, fq = lane >> 4;
    const int K = g.K, nt = K / BK;
    unsigned voffA[2], voffB[2];
#pragma unroll
    for (int i = 0; i < 2; ++i) { int R, C; stage_rc(tid * 16 + i * 8192, R, C); const int Rb = Epi::PERM ? ((R & ~31) + perm32(R & 31)) : R;
        voffA[i] = (unsigned)(R * g.lda + C) * 2u; voffB[i] = (unsigned)(Rb * g.ldb + C) * 2u; }
    const size_t kstep = (size_t)(BK * 2);
    const size_t hstepA = (size_t)HALF * g.lda * 2, hstepB = (size_t)HALF * g.ldb * 2;
    const size_t tstepA = 2 * hstepA, tstepB = 2 * hstepB;
    const unsigned ldsw = (unsigned)wid * 1024u;
    const int aoff = lds_byte(wr * 64 + fr, fq * 8), boff = lds_byte(wc * 32 + fr, fq * 8);
#define PG8_SA(b, h) (((b) * 2 + (h)) * HTB)
#define PG8_SB(b, h) ((4 + (b) * 2 + (h)) * HTB)
#define PG8_STAGE(bufoff, gbase, voff) do { _Pragma("unroll") for (int _i = 0; _i < 2; ++_i) \
        __builtin_amdgcn_global_load_lds((const unsigned*)((const char*)(gbase) + (voff)[_i]), (LAS unsigned*)(lds + (bufoff) + ldsw + _i * 8192), 16, 0, 0); } while (0)
#define PG8_LDA(dst, b, h) do { _Pragma("unroll") for (int m = 0; m < 4; ++m) _Pragma("unroll") for (int k = 0; k < 2; ++k) dst[m][k] = *(const LAS bf16x8*)(lds + PG8_SA(b, h) + aoff + m * 2048 + k * 1024); } while (0)
#define PG8_LDB(dst, b, h) do { _Pragma("unroll") for (int n = 0; n < 2; ++n) _Pragma("unroll") for (int k = 0; k < 2; ++k) dst[n][k] = *(const LAS bf16x8*)(lds + PG8_SB(b, h) + boff + n * 2048 + k * 1024); } while (0)
#define PG8_MMA(ai, bj, At, Bt) do { __builtin_amdgcn_s_setprio(1); _Pragma("unroll") for (int m = 0; m < 4; ++m) _Pragma("unroll") for (int n = 0; n < 2; ++n) _Pragma("unroll") for (int k = 0; k < 2; ++k) \
        acc[ai][bj][m][n] = __builtin_amdgcn_mfma_f32_16x16x32_bf16(Bt[n][k], At[m][k], acc[ai][bj][m][n], 0, 0, 0); __builtin_amdgcn_s_setprio(0); } while (0)
#define PG8_WAIT_V(n) asm volatile("s_waitcnt vmcnt(" #n ")" ::: "memory")
#define PG8_WAIT_L(n) asm volatile("s_waitcnt lgkmcnt(" #n ")" ::: "memory")
#define PG8_BAR __builtin_amdgcn_s_barrier()
#define PG8_SCHED __builtin_amdgcn_sched_barrier(0)
    Unit cur, nxt; int ui = 0;
    if (!S.next(0, cur)) return;
    f32x4 acc[2][2][4][2];
#pragma unroll
    for (int a = 0; a < 2; ++a)
#pragma unroll
        for (int b = 0; b < 2; ++b)
#pragma unroll
            for (int m = 0; m < 4; ++m)
#pragma unroll
                for (int n = 0; n < 2; ++n) acc[a][b][m][n] = (f32x4){0.f, 0.f, 0.f, 0.f};
    bf16x8 At[4][2], B0[2][2], B1[2][2];
    const char* cA = (const char*)g.A + (size_t)cur.pm * tstepA + (size_t)cur.koffA * 2; const char* cB = (const char*)g.Bt + (size_t)cur.pn * tstepB + (size_t)cur.koffB * 2;
    PG8_STAGE(PG8_SB(0, 0), cB, voffB); PG8_STAGE(PG8_SA(0, 0), cA, voffA); PG8_STAGE(PG8_SB(0, 1), cB + hstepB, voffB); PG8_STAGE(PG8_SA(0, 1), cA + hstepA, voffA);
    if (wr == 1) PG8_BAR;
    PG8_WAIT_V(4); PG8_BAR;
    PG8_STAGE(PG8_SB(1, 0), cB + kstep, voffB); PG8_STAGE(PG8_SA(1, 0), cA + kstep, voffA); PG8_STAGE(PG8_SB(1, 1), cB + hstepB + kstep, voffB);
    PG8_WAIT_V(6); PG8_BAR;
    for (;;) {
        const bool has_next = S.next(ui + 1, nxt);
        const char* nA = has_next ? (const char*)g.A + (size_t)nxt.pm * tstepA + (size_t)nxt.koffA * 2 : cA; const char* nB = has_next ? (const char*)g.Bt + (size_t)nxt.pn * tstepB + (size_t)nxt.koffB * 2 : cB;
#pragma clang loop unroll(disable)
        for (int t = 0; t < nt; t += 2) {
            const bool last = (t == nt - 2);
            const char* a1 = cA + (size_t)(t + 1) * kstep;
            const char* a2 = last ? nA : cA + (size_t)(t + 2) * kstep; const char* b2 = last ? nB : cB + (size_t)(t + 2) * kstep;
            const char* a3 = a2 + kstep; const char* b3 = b2 + kstep;
            PG8_LDB(B0, 0, 0); PG8_SCHED; PG8_LDA(At, 0, 0); PG8_STAGE(PG8_SA(1, 1), a1 + hstepA, voffA);
            PG8_WAIT_L(8); PG8_BAR; PG8_WAIT_L(0); PG8_MMA(0, 0, At, B0); PG8_BAR; PG8_SCHED;
            PG8_LDB(B1, 0, 1); PG8_STAGE(PG8_SB(0, 0), b2, voffB);
            PG8_BAR; PG8_WAIT_L(0); PG8_MMA(0, 1, At, B1); PG8_BAR;
            PG8_LDA(At, 0, 1); PG8_STAGE(PG8_SA(0, 0), a2, voffA);
            PG8_BAR; PG8_WAIT_L(0); PG8_MMA(1, 0, At, B0); PG8_BAR; PG8_SCHED;
            PG8_STAGE(PG8_SB(0, 1), b2 + hstepB, voffB);
            PG8_WAIT_V(6); PG8_BAR; PG8_MMA(1, 1, At, B1); PG8_BAR;
            PG8_LDB(B0, 1, 0); PG8_SCHED; PG8_LDA(At, 1, 0); PG8_STAGE(PG8_SA(0, 1), a2 + hstepA, voffA);
            PG8_WAIT_L(8); PG8_BAR; PG8_WAIT_L(0); PG8_MMA(0, 0, At, B0); PG8_BAR; PG8_SCHED;
            PG8_LDB(B1, 1, 1); PG8_STAGE(PG8_SB(1, 0), b3, voffB);
            PG8_BAR; PG8_WAIT_L(0); PG8_MMA(0, 1, At, B1); PG8_BAR;
            PG8_LDA(At, 1, 1); PG8_STAGE(PG8_SA(1, 0), a3, voffA);
            PG8_BAR; PG8_WAIT_L(0); PG8_MMA(1, 0, At, B0); PG8_BAR; PG8_SCHED;
            PG8_STAGE(PG8_SB(1, 1), b3 + hstepB, voffB);
            PG8_WAIT_V(6); PG8_BAR; PG8_MMA(1, 1, At, B1); PG8_BAR;
        }
        E(acc, cur, wr, wc, fr, fq);
        if (!has_next) break;
#pragma unroll
        for (int a = 0; a < 2; ++a)
#pragma unroll
            for (int b = 0; b < 2; ++b)
#pragma unroll
                for (int m = 0; m < 4; ++m)
#pragma unroll
                    for (int n = 0; n < 2; ++n) acc[a][b][m][n] = (f32x4){0.f, 0.f, 0.f, 0.f};
        cur = nxt; cA = nA; cB = nB; ++ui;
    }
    PG8_WAIT_V(0);
    if (wr == 0) PG8_BAR;
    PG8_BAR;
#undef PG8_SA
#undef PG8_SB
#undef PG8_STAGE
#undef PG8_LDA
#undef PG8_LDB
#undef PG8_MMA
#undef PG8_WAIT_V
#undef PG8_WAIT_L
#undef PG8_BAR
#undef PG8_SCHED
}
}
using pg8::Unit;

template <int MODE> struct EpiBf16 {
    static constexpr bool PERM = true;
    bf16_t* O; int ldc; int coff; const float* vec;
    __device__ __forceinline__ void operator()(const f32x4 (&acc)[2][2][4][2], const Unit& u, int wr, int wc, int fr, int fq) const {
        const int row0 = u.pm * 256 + wr * 64 + fr, col0 = coff + u.pn * 256 + wc * 32 + 8 * fq;
#pragma unroll
        for (int bj = 0; bj < 2; ++bj) {
            const int c = col0 + bj * 128;
            f32x4 s0, s1;
            if (MODE == 0) { s0 = vec ? *(const f32x4*)(vec + c) : (f32x4){1.f, 1.f, 1.f, 1.f}; s1 = vec ? *(const f32x4*)(vec + c + 4) : (f32x4){1.f, 1.f, 1.f, 1.f}; }
            else { s0 = *(const f32x4*)(vec + c); s1 = *(const f32x4*)(vec + c + 4); }
#pragma unroll
            for (int ai = 0; ai < 2; ++ai)
#pragma unroll
                for (int m = 0; m < 4; ++m) {
                    f32x4 v0 = acc[ai][bj][m][0], v1 = acc[ai][bj][m][1];
                    if (MODE == 0) { v0 = v0 * s0; v1 = v1 * s1; }
                    else {
#pragma unroll
                        for (int j = 0; j < 4; ++j) { v0[j] = sigmoidf_(v0[j] + s0[j]); v1[j] = sigmoidf_(v1[j] + s1[j]); } }
                    u32x4 w; w.x = pk_bf16(v0[0], v0[1]); w.y = pk_bf16(v0[2], v0[3]); w.z = pk_bf16(v1[0], v1[1]); w.w = pk_bf16(v1[2], v1[3]);
                    *(u32x4*)(O + (size_t)(row0 + ai * 128 + m * 16) * ldc + c) = w;
                }
        }
    }
};
struct EpiP3 {
    static constexpr bool PERM = true;
    bf16_t* MixO; float* DecO; bf16_t* AO; bf16_t* GO; const float* pscale; const float* w0v; const float* a0v;
    __device__ __forceinline__ void operator()(const f32x4 (&acc)[2][2][4][2], const Unit& u, int wr, int wc, int fr, int fq) const {
        const bool pool = u.pn < 4; const int sgm = (u.pn - 4) >> 2;
        const int mode = pool ? 0 : (sgm == 0 ? 2 : (sgm == 1 ? 1 : 0)), ldc = pool ? D : CW;
        bf16_t* o0 = MixO; bf16_t* o1 = AO; bf16_t* o2 = GO; const float* v0 = pscale; const float* v1 = w0v; const float* v2 = a0v;
        asm volatile("" : "+s"(o0), "+s"(o1), "+s"(o2), "+s"(v0), "+s"(v1), "+s"(v2));
        bf16_t* Ob = pool ? o0 : (sgm == 1 ? o1 : o2); float* Of = DecO;
        const float* vec = pool ? v0 : (sgm == 0 ? v1 : (sgm == 1 ? v2 : (const float*)nullptr));
        const int row0 = u.pm * 256 + wr * 64 + fr, col0 = (pool ? u.pn * 256 : ((u.pn - 4) & 3) * 256) + wc * 32 + 8 * fq;
#pragma unroll
        for (int bj = 0; bj < 2; ++bj) {
            const int c = col0 + bj * 128;
            const f32x4 one = (f32x4){1.f, 1.f, 1.f, 1.f};
            const f32x4 s0 = vec ? *(const f32x4*)(vec + c) : one, s1 = vec ? *(const f32x4*)(vec + c + 4) : one;
#pragma unroll
            for (int ai = 0; ai < 2; ++ai)
#pragma unroll
                for (int m = 0; m < 4; ++m) {
                    const int row = row0 + ai * 128 + m * 16;
                    f32x4 v0 = acc[ai][bj][m][0], v1 = acc[ai][bj][m][1];
                    if (mode == 0) { v0 = v0 * s0; v1 = v1 * s1; }
                    else if (mode == 1) {
#pragma unroll
                        for (int j = 0; j < 4; ++j) { v0[j] = sigmoidf_(v0[j] + s0[j]); v1[j] = sigmoidf_(v1[j] + s1[j]); } }
                    else {
                        v0 = v0 + s0; v1 = v1 + s1;
#pragma unroll
                        for (int j = 0; j < 4; ++j) {
                            const float z0 = -v0[j], z1 = -v1[j];
                            const float sp0 = fmaxf(z0, 0.f) + __logf(1.0f + __expf(-fabsf(z0))), sp1 = fmaxf(z1, 0.f) + __logf(1.0f + __expf(-fabsf(z1)));
                            v0[j] = __expf(-__expf(-sp0 - 0.5f)); v1[j] = __expf(-__expf(-sp1 - 0.5f)); }
                    }
                    if (mode == 2) { if (row < MV) { float* p = Of + (size_t)row * ldc + c; *(f32x4*)p = v0; *(f32x4*)(p + 4) = v1; } }
                    else { u32x4 w; w.x = pk_bf16(v0[0], v0[1]); w.y = pk_bf16(v0[2], v0[3]); w.z = pk_bf16(v1[0], v1[1]); w.w = pk_bf16(v1[2], v1[3]);
                        *(u32x4*)(Ob + (size_t)row * ldc + c) = w; }
                }
        }
    }
};
struct EpiDecay {
    static constexpr bool PERM = false;
    float* O; const float* w0;
    __device__ __forceinline__ void operator()(const f32x4 (&acc)[2][2][4][2], const Unit& u, int wr, int wc, int fr, int fq) const {
        const int row0 = u.pm * 256 + wr * 64 + fr, col0 = u.pn * 256 + wc * 32 + 4 * fq;
#pragma unroll
        for (int bj = 0; bj < 2; ++bj)
#pragma unroll
            for (int n = 0; n < 2; ++n) {
                const int c = col0 + bj * 128 + n * 16; const f32x4 b = *(const f32x4*)(w0 + c);
#pragma unroll
                for (int ai = 0; ai < 2; ++ai)
#pragma unroll
                    for (int m = 0; m < 4; ++m) {
                        const int row = row0 + ai * 128 + m * 16; f32x4 v = acc[ai][bj][m][n] + b, o;
#pragma unroll
                        for (int j = 0; j < 4; ++j) { const float z = -v[j]; const float sp = fmaxf(z, 0.f) + __logf(1.0f + __expf(-fabsf(z))); o[j] = __expf(-__expf(-sp - 0.5f)); }
                        if (row < MV) *(f32x4*)(O + (size_t)row * CW + c) = o;
                    }
            }
    }
};
struct EpiOut {
    static constexpr bool PERM = false;
    const float* xp; const float* xs; float* out; bf16_t* h2; const float* g; float* rowsq;
    __device__ __forceinline__ void operator()(const f32x4 (&acc)[2][2][4][2], const Unit& u, int wr, int wc, int fr, int fq) const {
        const int row0 = u.pm * 256 + wr * 64 + fr, col0 = u.pn * 256 + wc * 32 + 4 * fq;
#pragma unroll
        for (int ai = 0; ai < 2; ++ai)
#pragma unroll
            for (int m = 0; m < 4; ++m) {
                const int row = row0 + ai * 128 + m * 16; const bool ok = row < MV;
                const float* xr = row < MPR ? xp + (size_t)row * D : xs + (size_t)(ok ? row - MPR : 0) * D;
                float s = 0.f;
#pragma unroll
                for (int bj = 0; bj < 2; ++bj)
#pragma unroll
                    for (int n = 0; n < 2; ++n) {
                        const int c = col0 + bj * 128 + n * 16;
                        f32x4 x1 = acc[ai][bj][m][n];
                        if (ok) { x1 = x1 + *(const f32x4*)(xr + c); *(f32x4*)(out + (size_t)row * D + c) = x1; }
                        s += (x1[0] * x1[0] + x1[1] * x1[1]) + (x1[2] * x1[2] + x1[3] * x1[3]);
                        const f32x4 gg = *(const f32x4*)(g + c); const f32x4 hv = x1 * gg;
                        u32x2 w; w.x = pk_bf16(hv[0], hv[1]); w.y = pk_bf16(hv[2], hv[3]);
                        *(u32x2*)(h2 + (size_t)row * D + c) = w;
                    }
                s += __shfl_xor(s, 16); s += __shfl_xor(s, 32);
                if (ok && fq == 0) unsafeAtomicAdd(rowsq + row, s);
            }
    }
};
struct EpiGU {
    static constexpr bool PERM = true;
    bf16_t* U; const float* rowsq;
    __device__ __forceinline__ void operator()(const f32x4 (&acc)[2][2][4][2], const Unit& u, int wr, int wc, int fr, int fq) const {
        const int row0 = u.pm * 256 + wr * 64 + fr, col0 = u.pn * 128 + wc * 32 + 8 * fq;
#pragma unroll
        for (int ai = 0; ai < 2; ++ai)
#pragma unroll
            for (int m = 0; m < 4; ++m) {
                const int row = row0 + ai * 128 + m * 16;
                const float rstd = rsqrtf(rowsq[row] * (1.0f / D) + RMS_EPS);
                f32x4 o[2];
#pragma unroll
                for (int n = 0; n < 2; ++n)
#pragma unroll
                    for (int j = 0; j < 4; ++j) { const float gt = acc[ai][0][m][n][j] * rstd, up = acc[ai][1][m][n][j] * rstd; o[n][j] = gt * sigmoidf_(gt) * up; }
                u32x4 w; w.x = pk_bf16(o[0][0], o[0][1]); w.y = pk_bf16(o[0][2], o[0][3]); w.z = pk_bf16(o[1][0], o[1][1]); w.w = pk_bf16(o[1][2], o[1][3]);
                *(u32x4*)(U + (size_t)row * DFF + col0) = w;
            }
    }
};
struct EpiDown {
    static constexpr bool PERM = false;
    float* out;
    __device__ __forceinline__ void operator()(const f32x4 (&acc)[2][2][4][2], const Unit& u, int wr, int wc, int fr, int fq) const {
        const int row0 = u.pm * 256 + wr * 64 + fr, col0 = u.pn * 256 + wc * 32 + 4 * fq;
#pragma unroll
        for (int ai = 0; ai < 2; ++ai)
#pragma unroll
            for (int m = 0; m < 4; ++m) {
                const int row = row0 + ai * 128 + m * 16;
#pragma unroll
                for (int bj = 0; bj < 2; ++bj)
#pragma unroll
                    for (int n = 0; n < 2; ++n) {
                        const int c = col0 + bj * 128 + n * 16; float* p = out + (size_t)row * D + c;
                        *(f32x4*)p = acc[ai][bj][m][n] + *(const f32x4*)p;
                    }
            }
    }
};
struct EpiPartial {
    static constexpr bool PERM = false;
    float* buf;
    __device__ __forceinline__ void operator()(const f32x4 (&acc)[2][2][4][2], const Unit& u, int wr, int wc, int fr, int fq) const {
        const int col0 = u.pn * 256 + wc * 32 + 4 * fq;
#pragma unroll
        for (int m = 0; m < 4; ++m) {
            const int lrow = wr * 64 + m * 16 + fr;
            float* p = buf + ((size_t)u.ks * MSA + lrow) * D + col0;
#pragma unroll
            for (int bj = 0; bj < 2; ++bj)
#pragma unroll
                for (int n = 0; n < 2; ++n) *(f32x4*)(p + bj * 128 + n * 16) = acc[0][bj][m][n];
        }
    }
};

template <int RM> __device__ __forceinline__ int rowmap(int n) { return RM == 0 ? n : (RM == 1 ? ((n >> 7) * 256 + (n & 127)) : ((n >> 7) * 256 + 128 + (n & 127))); }
template <int RM>
__device__ __forceinline__ void transpose_bf16(const float* src, int Ksrc, int Nsrc, int ld, bf16_t* dst, int Kdst, int Ndst, int rot, int vgw, int gws) {
    const int lane = threadIdx.x & 63, gw = (vgw + rot) % gws;
    const int nn = Ndst / 64, ntile = nn * (Kdst / 64);
    for (int t = gw; t < ntile; t += gws) {
        const int k0 = (t / nn) * 64, n = (t % nn) * 64 + lane;
        const bool nok = n < Nsrc;
        const float* sp = src + (nok ? n : 0);
        float v[64];
        const float mskn = nok ? 1.f : 0.f;
#pragma unroll
        for (int j = 0; j < 64; ++j) { const int k = k0 + j; v[j] = sp[(size_t)(k < Ksrc ? k : Ksrc - 1) * ld]; }
#pragma unroll
        for (int j = 0; j < 64; ++j) v[j] *= ((k0 + j) < Ksrc ? mskn : 0.f);
        bf16_t* dp = dst + (size_t)rowmap<RM>(n) * Kdst + k0;
#pragma unroll
        for (int q8 = 0; q8 < 8; ++q8) { u32x4 w; w.x = pk_bf16(v[q8 * 8 + 0], v[q8 * 8 + 1]); w.y = pk_bf16(v[q8 * 8 + 2], v[q8 * 8 + 3]); w.z = pk_bf16(v[q8 * 8 + 4], v[q8 * 8 + 5]); w.w = pk_bf16(v[q8 * 8 + 6], v[q8 * 8 + 7]);
            *(u32x4*)(dp + q8 * 8) = w; }
    }
}
template <int CTRL> __device__ __forceinline__ float dpp_(float x) { return __int_as_float(__builtin_amdgcn_update_dpp(0, __float_as_int(x), CTRL, 0xF, 0xF, true)); }
__device__ __forceinline__ float red8(float x) { x += dpp_<0x141>(x); x += dpp_<0xB1>(x); x += dpp_<0x4E>(x); return x; }

template <int W>
__device__ __forceinline__ void pool_block_prompt(const bf16_t* proj, bf16_t* pooled, int b, int t0, int c) {
    float ux[15 + W], uy[15 + W]; unsigned raw[15 + W];
#pragma unroll
    for (int j = 0; j < 15 + W; ++j) {
        const int t = t0 - (W - 1) + j;
        raw[j] = *(const unsigned*)(proj + (size_t)(b * TT + (t < 0 ? 0 : t)) * PJP + c);
    }
#pragma unroll
    for (int j = 0; j < 15 + W; ++j) {
        const int t = t0 - (W - 1) + j; const float zm = t < 0 ? 0.f : 1.f;
        ux[j] = bf2f(raw[j] & 0xffffu) * zm; uy[j] = bf2f(raw[j] >> 16) * zm;
    }
#pragma unroll
    for (int i = 0; i < 16; ++i) {
        const int t = t0 + i; float sx = 0.f, sy = 0.f;
#pragma unroll
        for (int j = 0; j < W; ++j) { sx += ux[i + j]; sy += uy[i + j]; }
        const float inv = 1.0f / (float)(t + 1 < W ? t + 1 : W);
        const float px = sx * inv - ux[i + W - 1], py = sy * inv - uy[i + W - 1];
        *(unsigned*)(pooled + (size_t)(b * TT + t) * XLD + c) = pk_bf16(px, py);
    }
}

__global__ void __launch_bounds__(NTHR) hymba_fwd(Params P) {
    extern __shared__ __attribute__((aligned(16))) unsigned char lds_raw[];
    LAS unsigned char* lds = (LAS unsigned char*)lds_raw;
    const int G = gridDim.x, bid = blockIdx.x, gthreads = G * NTHR, gwaves = G * 8;
#define PHASE_IDS int tid = threadIdx.x; asm volatile("" : "+v"(tid)); const int lane = tid & 63, wave = tid >> 6, gtid = bid * NTHR + tid, gwave = bid * 8 + wave; (void)lane; (void)wave; (void)gtid; (void)gwave;
    unsigned char* ws = P.ws; float* out = P.out;
    const float* x_prompt = P.in[0]; const float* x_sample = P.in[1]; const float* state_pool = P.in[2]; const float* state_shift = P.in[3]; const float* state_wkv = P.in[4];
    const float* norm_mix = P.in[5]; const float* w_in = P.in[6]; const float* w_pool = P.in[7]; const float* pool_scale = P.in[8]; const float* mu_shift = P.in[9];
    const float* w0 = P.in[10]; const float* w2 = P.in[11]; const float* a0 = P.in[12]; const float* a2 = P.in[13]; const float* g2 = P.in[14];
    const float* k_k = P.in[15]; const float* k_a = P.in[16]; const float* r_k = P.in[17]; const float* gn_w = P.in[18]; const float* gn_b = P.in[19];
    const float* w_out = P.in[20]; const float* norm_ffn = P.in[21]; const float* w_gate = P.in[22]; const float* w_up = P.in[23]; const float* w_down = P.in[24]; const float* norm_final = P.in[25];
    bf16_t* WinT = (bf16_t*)(ws + WS_WIN); bf16_t* WoutT = (bf16_t*)(ws + WS_WOUT); bf16_t* WguT = (bf16_t*)(ws + WS_WGU); bf16_t* WdnT = (bf16_t*)(ws + WS_WDN);
    bf16_t* WpoolT = (bf16_t*)(ws + WS_WPOOL); bf16_t* WloraT = (bf16_t*)(ws + WS_WLORA);
    bf16_t* Hb = (bf16_t*)(ws + WS_R1); bf16_t* Xb = (bf16_t*)(ws + WS_R1); bf16_t* H2 = (bf16_t*)(ws + WS_R1);
    bf16_t* Proj = (bf16_t*)(ws + WS_PROJ); bf16_t* Ub = (bf16_t*)(ws + WS_PROJ); bf16_t* Ab = (bf16_t*)(ws + WS_A); bf16_t* Gb = (bf16_t*)(ws + WS_GATE);
    bf16_t* Mix = (bf16_t*)(ws + WS_MIX); float* rowsq1 = (float*)(ws + WS_ROWSQ); float* Bonus = (float*)(ws + WS_BONUS);
    unsigned* barctr = (unsigned*)(ws + WS_BAR);
    float* Yb = out + SCR_Y; float* Dec = out + SCR_DEC;
    float* Part6 = (float*)(ws + WS_A);
    float* Part8 = (float*)(ws + WS_R1);
    { LAS unsigned* st0 = (LAS unsigned*)(lds + LDS_ST_OFF); if (threadIdx.x < 2) st0[threadIdx.x] = 0u; }
    __syncthreads();
    const XcdBarrier xbar = xcd_barrier_post(barctr, (volatile LAS unsigned*)(lds + LDS_ST_OFF));
#ifndef P3SEL
#define P3SEL 15
#endif
#ifndef PHASE_MASK
#define PHASE_MASK 0x3ff
#endif
#define IN(k) (((PHASE_MASK >> (k)) & 1) && (!P.multi || P.phase == (k)))
#define SEAM() do { if (!P.multi) xcd_barrier(xbar); } while (0)

    if (IN(0)) {
        PHASE_IDS
        transpose_bf16<0>(w_in, D, PJ, PJ, WinT, D, PJP, 0, gwave, gwaves);
        transpose_bf16<0>(w_out, D, D, D, WoutT, D, D, 256, gwave, gwaves);
        for (int g = 0; g < 4; ++g) transpose_bf16<0>(w_pool + (size_t)g * 65536, 256, 256, 256, WpoolT + (size_t)g * 65536, 256, 256, 1280 + g * 16, gwave, gwaves);
        transpose_bf16<0>(w2, 64, CW, CW, WloraT, 256, CW, 1344, gwave, gwaves);
        transpose_bf16<0>(a2, 64, CW, CW, WloraT + (size_t)CW * 256, 256, CW, 1408, gwave, gwaves);
        transpose_bf16<0>(g2, 160, CW, CW, WloraT + (size_t)2 * CW * 256, 256, CW, 1472, gwave, gwaves);
        for (int i = gtid; i < MPAD; i += gthreads) rowsq1[i] = 0.f;
        for (int m = gwave; m < MPAD; m += gwaves) {
            bf16_t* hr = Hb + (size_t)m * D;
            if (m < MV) {
                const float* xr = m < MPR ? x_prompt + (size_t)m * D : x_sample + (size_t)(m - MPR) * D;
                f32x4 v[8]; float s = 0.f;
#pragma unroll
                for (int i = 0; i < 8; ++i) v[i] = *(const f32x4*)(xr + (i * 64 + lane) * 4);
#pragma unroll
                for (int i = 0; i < 8; ++i) s += (v[i][0] * v[i][0] + v[i][1] * v[i][1]) + (v[i][2] * v[i][2] + v[i][3] * v[i][3]);
                s = wsum(s); const float rstd = rsqrtf(s * (1.0f / D) + RMS_EPS);
#pragma unroll
                for (int i = 0; i < 8; ++i) { const int c = (i * 64 + lane) * 4; const f32x4 gg = *(const f32x4*)(norm_mix + c); const f32x4 o = v[i] * rstd * gg;
                    u32x2 w; w.x = pk_bf16(o[0], o[1]); w.y = pk_bf16(o[2], o[3]); *(u32x2*)(hr + c) = w; }
            } else {
#pragma unroll
                for (int i = 0; i < 8; ++i) *(u32x2*)(hr + (i * 64 + lane) * 4) = (u32x2){0u, 0u};
            }
        }
    }
    if (P.multi == 2) cg::this_grid().sync();
    SEAM();

    if (IN(1)) {
        PHASE_IDS
        pg8::Gemm g{Hb, WinT, D, D, D}; pg8::StaticOrder S; S.init(MPAD, PJP, G, bid);
        EpiBf16<0> E{Proj, PJP, 0, nullptr};
        pg8::gemm_phase(lds, g, S, E);
    }
    SEAM();

    if (IN(2)) {
        PHASE_IDS
        for (int rb = bid; rb < MPR / 16; rb += G) {
            const int b = rb >> 7, t0 = (rb & 127) * 16, c = tid * 2, gq = tid >> 7;
            if (gq == 0) pool_block_prompt<2>(Proj, Xb, b, t0, c);
            else if (gq == 1) pool_block_prompt<4>(Proj, Xb, b, t0, c);
            else if (gq == 2) pool_block_prompt<8>(Proj, Xb, b, t0, c);
            else pool_block_prompt<16>(Proj, Xb, b, t0, c);
        }
        for (int b = bid; b < MSA; b += G) {
            const int c = tid * 2, W = 2 << (tid >> 7);
            const unsigned v = *(const unsigned*)(Proj + (size_t)(MPR + b) * PJP + c); const float ux = bf2f(v & 0xffffu), uy = bf2f(v >> 16);
            f32x2 pr[15];
#pragma unroll
            for (int j = 0; j < 15; ++j) pr[j] = *(const f32x2*)(state_pool + ((size_t)b * 15 + j) * PW + c);
            float sx = ux, sy = uy;
#pragma unroll
            for (int j = 1; j < 16; ++j) { const float mk = j < W ? 1.f : 0.f; sx += pr[15 - j][0] * mk; sy += pr[15 - j][1] * mk; }
            const float inv = 1.0f / (float)W;
            *(unsigned*)(Xb + (size_t)(MPR + b) * XLD + c) = pk_bf16(sx * inv - ux, sy * inv - uy);
            float* np = out + OUT_POOLS + (size_t)b * 15 * PW;
#pragma unroll
            for (int j = 0; j < 14; ++j) *(f32x2*)(np + (size_t)j * PW + c) = pr[j + 1];
            *(f32x2*)(np + (size_t)14 * PW + c) = (f32x2){ux, uy};
        }
        {
            constexpr int NIT = MV * 144;
            for (int base = gtid; base < NIT; base += 5 * gthreads) {
                unsigned cv[5], pv[5]; f32x2 mu[5]; int mm[5], cpo[5], sg[5], pcs[5]; bool val[5];
#pragma unroll
                for (int u = 0; u < 5; ++u) {
                    const int idx = base + u * gthreads; val[u] = idx < NIT; const int id2 = val[u] ? idx : 0;
                    const int m = id2 / 144, jp = id2 - m * 144, seg = jp < 32 ? 0 : (jp < 64 ? 1 : 2);
                    const int j = (jp - (seg == 0 ? 0 : (seg == 1 ? 32 : 64))) * 2, pc = (seg == 0 ? 3072 : (seg == 1 ? 3136 : 3200)) + j;
                    mm[u] = m; sg[u] = seg; cpo[u] = seg * 256 + j; pcs[u] = pc;
                    const int mprev = (m >= MPR || (m & (TT - 1)) == 0) ? m : m - 1;
                    cv[u] = *(const unsigned*)(Proj + (size_t)m * PJP + PW + pc);
                    pv[u] = *(const unsigned*)(Proj + (size_t)mprev * PJP + PW + pc);
                    mu[u] = *(const f32x2*)(mu_shift + pc);
                }
#pragma unroll
                for (int u = 0; u < 5; ++u) {
                    const int m = mm[u]; const float cx = bf2f(cv[u] & 0xffffu), cy = bf2f(cv[u] >> 16);
                    const float fm = (m & (TT - 1)) == 0 ? 0.f : 1.f;
                    float px = bf2f(pv[u] & 0xffffu) * fm, py = bf2f(pv[u] >> 16) * fm;
                    if (m >= MPR) { const f32x2 p = *(const f32x2*)(state_shift + (size_t)(m - MPR) * SW + pcs[u]); px = p[0]; py = p[1]; }
                    float vx = cx + (px - cx) * mu[u][0], vy = cy + (py - cy) * mu[u][1];
                    if (sg[u] == 0) { vx = tanhf(vx); vy = tanhf(vy); } else if (sg[u] == 2) { vx = sigmoidf_(vx); vy = sigmoidf_(vy); }
                    if (val[u]) *(unsigned*)(Xb + (size_t)m * XLD + 1024 + cpo[u]) = pk_bf16(vx, vy);
                }
            }
        }
        for (int i = gtid; i < 4 * SW; i += gthreads) { const int b = i / SW, j = i - b * SW; out[OUT_SHIFTP + i] = bf2f(Proj[(size_t)(b * TT + TT - 1) * PJP + PW + j]); }
        for (int i = gtid; i < MSA * SW / 2; i += gthreads) { const int b = i / (SW / 2), j = (i - b * (SW / 2)) * 2; const unsigned v = *(const unsigned*)(Proj + (size_t)(MPR + b) * PJP + PW + j);
            *(f32x2*)(out + OUT_SHIFTS + (size_t)b * SW + j) = (f32x2){bf2f(v & 0xffffu), bf2f(v >> 16)}; }
        for (int i = gtid; i < 4 * 15 * PW; i += gthreads) { const int b = i / (15 * PW), r = i - b * 15 * PW, j = r / PW, c = r - j * PW; out[OUT_POOLP + i] = bf2f(Proj[(size_t)(b * TT + TT - 15 + j) * PJP + c]); }
    }
    SEAM();

    if (IN(3)) {
        PHASE_IDS
        { pg8::Gemm g{Xb, WpoolT, XLD, 256, 256}; pg8::P3Order S{G, bid};
          EpiP3 E{Mix, Dec, Ab, Gb, pool_scale, w0, a0}; pg8::gemm_phase(lds, g, S, E); }
    }
    SEAM();

    if (IN(4)) {
        PHASE_IDS
        LAS float* ldf = (LAS float*)lds;
        constexpr int REC = 392, TB = 16, NPS = TB / 4;
        for (int unit = bid; unit < 256; unit += G) {
            const int s = unit >> 2, b = s >> 4, h = s & 15, q = unit & 3;
            const int wv = __builtin_amdgcn_readfirstlane(tid >> 6);
            if (wv < 2) {
              const int crow = wv * 8 + (lane >> 3), kq = lane & 7; const bool first8 = kq == 0;
              f32x2 S2[4];
#pragma unroll
              for (int e = 0; e < 4; ++e) S2[e] = (f32x2){0.f, 0.f};
              const LAS float* recq0 = ldf + kq * 8; const LAS float* recv0 = ldf + 320 + q * 16 + crow;
              float* yp = Yb + (size_t)(b * TT + 7 - kq) * CW + h * 64 + q * 16 + crow;
              __builtin_amdgcn_s_setprio(3);
              WG_BAR();
              for (int blk = 0; blk < TT / TB; ++blk) {
                    const int bo = (blk & 1) * (TB * REC);
                    const LAS float* recq = recq0 + bo; const LAS float* recv = recv0 + bo; const LAS float* recs = ldf + bo + 384;
#define LDSTEP(o_, A0, A1, B0, B1, D0, D1, K0, K1, W0, W1, VV, SC) do { A0 = *(const LAS f32x4*)(recq + (o_)); A1 = *(const LAS f32x4*)(recq + (o_) + 4); B0 = *(const LAS f32x4*)(recq + (o_) + 64); B1 = *(const LAS f32x4*)(recq + (o_) + 68); \
                        D0 = *(const LAS f32x4*)(recq + (o_) + 128); D1 = *(const LAS f32x4*)(recq + (o_) + 132); K0 = *(const LAS f32x4*)(recq + (o_) + 192); K1 = *(const LAS f32x4*)(recq + (o_) + 196); \
                        W0 = *(const LAS f32x4*)(recq + (o_) + 256); W1 = *(const LAS f32x4*)(recq + (o_) + 260); VV = recv[(o_)]; SC = *(const LAS f32x2*)(recs + (o_)); } while (0)
                    f32x4 av0, av1, bv0, bv1, dw0, dw1, kt0, kt1, wr0, wr1; float vv; f32x2 sc;
                    f32x4 nav0, nav1, nbv0, nbv1, ndw0, ndw1, nkt0, nkt1, nwr0, nwr1; float nvv; f32x2 nsc;
                    f32x4 a0, a1, b0, b1, d0, d1, k0, k1, w0_, w1_; float vv_; f32x2 sc_;
                    LDSTEP(0, a0, a1, b0, b1, d0, d1, k0, k1, w0_, w1_, vv_, sc_);
                    LDSTEP(REC, av0, av1, bv0, bv1, dw0, dw1, kt0, kt1, wr0, wr1, vv, sc);
                    float yacc = 0.f;
#pragma unroll
                    for (int st = 0; st < TB; ++st) {
                        if (st + 2 < TB) LDSTEP((st + 2) * REC, nav0, nav1, nbv0, nbv1, ndw0, ndw1, nkt0, nkt1, nwr0, nwr1, nvv, nsc);
                        __builtin_amdgcn_sched_barrier(0);
                        const f32x2 pa = pkfma_(S2[3], hi2(a1), pkfma_(S2[2], lo2(a1), pkfma_(S2[1], hi2(a0), pkmul_(S2[0], lo2(a0)))));
                        const f32x2 py = pkfma_(S2[3], hi2(w1_), pkfma_(S2[2], lo2(w1_), pkfma_(S2[1], hi2(w0_), pkmul_(S2[0], lo2(w0_)))));
                        float da = pa[0] + pa[1], dy = py[0] + py[1];
                        da = red8(da); dy = red8(dy);
                        const float y = dy + da * sc_[0] + vv_ * sc_[1];
                        { f32x2 dab, vvb; dab[0] = da; dab[1] = da; vvb[0] = vv_; vvb[1] = vv_;
                          S2[0] = pkfma_b(lo2(k0), vvb, pkfma_b(lo2(b0), dab, pkmul_(S2[0], lo2(d0)))); S2[1] = pkfma_b(hi2(k0), vvb, pkfma_b(hi2(b0), dab, pkmul_(S2[1], hi2(d0))));
                          S2[2] = pkfma_b(lo2(k1), vvb, pkfma_b(lo2(b1), dab, pkmul_(S2[2], lo2(d1)))); S2[3] = pkfma_b(hi2(k1), vvb, pkfma_b(hi2(b1), dab, pkmul_(S2[3], hi2(d1)))); }
                        const float sh = __int_as_float(__builtin_amdgcn_update_dpp(__float_as_int(y), __float_as_int(yacc), 0x111, 0xF, 0xF, false));
                        yacc = first8 ? y : sh;
                        if ((st & 7) == 7) yp[(size_t)(blk * TB + (st - 7)) * CW] = yacc;
                        a0 = av0; a1 = av1; b0 = bv0; b1 = bv1; d0 = dw0; d1 = dw1; k0 = kt0; k1 = kt1; w0_ = wr0; w1_ = wr1; vv_ = vv; sc_ = sc;
                        av0 = nav0; av1 = nav1; bv0 = nbv0; bv1 = nbv1; dw0 = ndw0; dw1 = ndw1; kt0 = nkt0; kt1 = nkt1; wr0 = nwr0; wr1 = nwr1; vv = nvv; sc = nsc;
                        asm volatile("" ::: "memory");
                    }
#undef LDSTEP
                    WG_BAR();
              }
              __builtin_amdgcn_s_setprio(0);
              float* so = out + OUT_WKVP + ((size_t)(b * NH + h) * 64 + q * 16 + crow) * 64 + kq * 8;
              *(f32x4*)so = (f32x4){S2[0][0], S2[0][1], S2[1][0], S2[1][1]}; *(f32x4*)(so + 4) = (f32x4){S2[2][0], S2[2][1], S2[3][0], S2[3][1]};
            } else if (wv == 4 || wv == 5) {
              constexpr int CT_PER = 5632, CT_ALL = 3 * CT_PER;
              float cvv[32]; int ctile = unit * 2 + (wv - 4), cph = 0;
#define CONV_LOAD16(P0_) do { if (ctile < CT_ALL) { const int m_ = ctile / CT_PER, r_ = ctile - m_ * CT_PER; const float* sp_; unsigned ld_; \
                    if (m_ < 2) { sp_ = (m_ == 0 ? w_gate : w_up) + (size_t)((r_ / 88) * 32) * DFF + (r_ % 88) * 64; ld_ = DFF; } \
                    else { sp_ = w_down + (size_t)((r_ >> 5) * 32) * D + (r_ & 31) * 64; ld_ = D; } \
                    _Pragma("unroll") for (int j_ = (P0_); j_ < (P0_) + 16; ++j_) cvv[j_] = sp_[(unsigned)j_ * ld_ + lane]; } } while (0)
#define CONV_STORE() do { if (ctile < CT_ALL) { const int m_ = ctile / CT_PER, r_ = ctile - m_ * CT_PER; bf16_t* dp_; \
                    if (m_ < 2) { const int k0_ = (r_ / 88) * 32, n_ = (r_ % 88) * 64 + lane; dp_ = WguT + (size_t)((n_ >> 7) * 256 + (m_ == 1 ? 128 : 0) + (n_ & 127)) * D + k0_; } \
                    else { const int k0_ = (r_ >> 5) * 32, n_ = (r_ & 31) * 64 + lane; dp_ = WdnT + (size_t)n_ * DFF + k0_; } \
                    _Pragma("unroll") for (int q8_ = 0; q8_ < 4; ++q8_) { u32x4 w_; w_.x = pk_bf16(cvv[q8_ * 8 + 0], cvv[q8_ * 8 + 1]); w_.y = pk_bf16(cvv[q8_ * 8 + 2], cvv[q8_ * 8 + 3]); \
                        w_.z = pk_bf16(cvv[q8_ * 8 + 4], cvv[q8_ * 8 + 5]); w_.w = pk_bf16(cvv[q8_ * 8 + 6], cvv[q8_ * 8 + 7]); *(u32x4*)(dp_ + q8_ * 8) = w_; } \
                    ctile += 512; } } while (0)
              WG_BAR();
              for (int blk = 0; blk < TT / TB; ++blk) {
                if (cph == 0) CONV_LOAD16(0); else if (cph == 1) CONV_LOAD16(16); else CONV_STORE();
                cph = cph == 2 ? 0 : cph + 1;
                WG_BAR();
              }
              while (ctile < CT_ALL) {
                if (cph <= 0) CONV_LOAD16(0);
                if (cph <= 1) CONV_LOAD16(16);
                CONV_STORE(); cph = 0;
              }
#undef CONV_LOAD16
#undef CONV_STORE
            } else {
              const int pw = (wv & 1) + ((wv >> 2) << 1), ch = h * 64 + lane;
              const float c_kk = k_k[ch], c_ka = k_a[ch], c_rk = r_k[ch], mu_r = mu_shift[ch], mu_k = mu_shift[CW + ch], mu_v = mu_shift[2 * CW + ch];
              const bf16_t* pbase = Proj + (size_t)(b * TT) * PJP + PW + h * 64; const float* dbase = Dec + (size_t)(b * TT) * CW + h * 64; const bf16_t* abase = Ab + (size_t)(b * TT) * CW + h * 64;
              constexpr int PD = 4;
              unsigned short rr[PD][NPS + 1], kr_[PD][NPS + 1], vr[PD][NPS + 1], aa[PD][NPS]; float dd[PD][NPS];
#define SCAN_LOAD(blk, SET) do { const int t0_ = (blk) * TB + pw * NPS; \
            _Pragma("unroll") for (int i_ = 0; i_ < NPS + 1; ++i_) { const unsigned t_ = (unsigned)((i_ == 0 && t0_ == 0) ? 0 : t0_ - 1 + i_); const bf16_t* pp_ = pbase + t_ * (unsigned)PJP; \
                rr[SET][i_] = pp_[lane]; kr_[SET][i_] = pp_[CW + lane]; vr[SET][i_] = pp_[2 * CW + lane]; } \
            _Pragma("unroll") for (int i_ = 0; i_ < NPS; ++i_) { const unsigned mi_ = (unsigned)(t0_ + i_) * (unsigned)CW; dd[SET][i_] = dbase[mi_ + lane]; aa[SET][i_] = abase[mi_ + lane]; } } while (0)
#define SCAN_PRODUCE(blk, SET) do { LAS float* bufp_ = ldf + ((blk) & 1) * (TB * REC); const int t0_ = (blk) * TB + pw * NPS; \
            _Pragma("unroll") for (int i_ = 0; i_ < NPS; ++i_) { \
                const float zz_ = (i_ == 0 && t0_ == 0) ? 0.f : 1.f; \
                const float rc_ = bf2f(rr[SET][i_ + 1]), kc_ = bf2f(kr_[SET][i_ + 1]), vc_ = bf2f(vr[SET][i_ + 1]), rp_ = bf2f(rr[SET][i_]) * zz_, kp_ = bf2f(kr_[SET][i_]) * zz_, vp_ = bf2f(vr[SET][i_]) * zz_; \
                const float r_ = rc_ + (rp_ - rc_) * mu_r, k_ = kc_ + (kp_ - kc_) * mu_k, v_ = vc_ + (vp_ - vc_) * mu_v; \
                const float a_ = bf2f(aa[SET][i_]), d_ = dd[SET][i_]; \
                const float kkr_ = k_ * c_kk; const float n2_ = wsum(kkr_ * kkr_); const float kk_ = kkr_ * rsqrtf(fmaxf(n2_, 1e-24f)); \
                const float kt_ = k_ * (1.0f + (a_ - 1.0f) * c_ka); const float bv_ = kk_ * a_; \
                const float br_ = wsum(bv_ * r_), krs_ = wsum(kt_ * r_), bon_ = wsum(r_ * kt_ * c_rk); \
                LAS float* rec_ = bufp_ + (pw * NPS + i_) * REC; \
                rec_[lane] = -kk_; rec_[64 + lane] = bv_; rec_[128 + lane] = d_; rec_[192 + lane] = kt_; rec_[256 + lane] = d_ * r_; rec_[320 + lane] = v_; \
                if (lane == 0) { rec_[384] = br_; rec_[385] = krs_; if (q == 0) Bonus[(size_t)(b * TT + t0_ + i_) * NH + h] = bon_; } } } while (0)
              SCAN_LOAD(0, 0); SCAN_LOAD(1, 1); SCAN_LOAD(2, 2); SCAN_LOAD(3, 3);
              SCAN_PRODUCE(0, 0); SCAN_LOAD(4, 0);
              WG_BAR();
              static_assert((TT / TB) % PD == 0 && PD == 4, "block loop is unrolled by PD = 4");
              for (int blk0 = 0; blk0 < TT / TB; blk0 += PD) {
#define SCAN_ITER(D_, SET) do { const int blk = blk0 + (D_); if (blk + 1 < TT / TB) { SCAN_PRODUCE(blk + 1, SET); if (blk + 1 + PD < TT / TB) SCAN_LOAD(blk + 1 + PD, SET); } WG_BAR(); } while (0)
                SCAN_ITER(0, 1); SCAN_ITER(1, 2); SCAN_ITER(2, 3); SCAN_ITER(3, 0);
#undef SCAN_ITER
              }
            }
#undef SCAN_LOAD
#undef SCAN_PRODUCE
        }
        __syncthreads();
        LAS float* wl = ldf + wave * 512;
        for (int p = gwave; p < MSA * NH; p += gwaves) {
            const int b = p >> 4, h = p & 15, m = MPR + b, ch = h * 64 + lane;
            const bf16_t* pp = Proj + (size_t)m * PJP + PW + ch; const float* sp = state_shift + (size_t)b * SW + ch;
            const float rc = bf2f(pp[0]), kc = bf2f(pp[CW]), vc = bf2f(pp[2 * CW]);
            const float r = rc + (sp[0] - rc) * mu_shift[ch], k = kc + (sp[CW] - kc) * mu_shift[CW + ch], v = vc + (sp[2 * CW] - vc) * mu_shift[2 * CW + ch];
            const float d = Dec[(size_t)m * CW + ch], a = bf2f(Ab[(size_t)m * CW + ch]);
            const float kkr = k * k_k[ch]; const float n2 = wsum(kkr * kkr); const float kk = kkr * rsqrtf(fmaxf(n2, 1e-24f));
            const float kt = k * (1.0f + (a - 1.0f) * k_a[ch]);
            const float bon = wsum(r * kt * r_k[ch]);
            wl[lane] = -kk; wl[64 + lane] = kk * a; wl[128 + lane] = d; wl[192 + lane] = kt; wl[256 + lane] = r; wl[320 + lane] = v;
            asm volatile("s_waitcnt lgkmcnt(0)" ::: "memory");
            const int kq = lane & 15, r4 = lane >> 4;
            const f32x4 av = *(const LAS f32x4*)(wl + kq * 4), bv = *(const LAS f32x4*)(wl + 64 + kq * 4), dw = *(const LAS f32x4*)(wl + 128 + kq * 4);
            const f32x4 ktv = *(const LAS f32x4*)(wl + 192 + kq * 4), rv = *(const LAS f32x4*)(wl + 256 + kq * 4);
            const float* sin_ = state_wkv + (size_t)(b * NH + h) * 4096; float* sout = out + OUT_WKVS + (size_t)(b * NH + h) * 4096;
#pragma unroll 4
            for (int j = 0; j < 16; ++j) {
                const int row = r4 + 4 * j; f32x4 Sv = *(const f32x4*)(sin_ + row * 64 + kq * 4);
                float da = (Sv[0] * av[0] + Sv[1] * av[1]) + (Sv[2] * av[2] + Sv[3] * av[3]); da = red16(da);
                const float vv = wl[320 + row];
                Sv = Sv * dw + da * bv + vv * ktv;
                *(f32x4*)(sout + row * 64 + kq * 4) = Sv;
                float dy = (Sv[0] * rv[0] + Sv[1] * rv[1]) + (Sv[2] * rv[2] + Sv[3] * rv[3]); dy = red16(dy);
                if (kq == 0) wl[384 + row] = dy;
            }
            asm volatile("s_waitcnt lgkmcnt(0)" ::: "memory");
            const float y = wl[384 + lane];
            const float mean = wsum(y) * (1.0f / 64.0f); const float dl = y - mean; const float var = wsum(dl * dl) * (1.0f / 64.0f);
            const float yn = dl * rsqrtf(var + GN_EPS) * gn_w[ch] + gn_b[ch];
            const float o = (yn + bon * v) * bf2f(Gb[(size_t)m * CW + ch]);
            Mix[(size_t)m * D + PW + ch] = (bf16_t)f2bf(o);
            asm volatile("s_waitcnt lgkmcnt(0)" ::: "memory");
        }
    }
    SEAM();

    if (IN(5)) {
        PHASE_IDS
        { pg8::Gemm g{Mix, WoutT, D, D, 256}; pg8::SplitKOrder S{8, KS6, 32, 256, G, (bid + G - 192 % G) % G};
          EpiPartial E{Part6}; pg8::gemm_phase(lds, g, S, E); }
        {
            const int half = gwave & 1, ch0 = half * 512 + lane * 8, h = ch0 >> 6;
            const f32x4 mu0 = *(const f32x4*)(mu_shift + 2 * CW + ch0), mu1 = *(const f32x4*)(mu_shift + 2 * CW + ch0 + 4);
            const f32x4 gw0 = *(const f32x4*)(gn_w + ch0), gw1 = *(const f32x4*)(gn_w + ch0 + 4), gb0 = *(const f32x4*)(gn_b + ch0), gb1 = *(const f32x4*)(gn_b + ch0 + 4);
            for (int it0 = gwave; it0 < MPR * 2; it0 += 2 * gwaves) {
                f32x4 y0[2], y1[2]; u32x4 vc[2], vp[2], gt[2]; float bon[2]; int mm[2]; bool val[2];
#pragma unroll
                for (int u = 0; u < 2; ++u) {
                    const int it = it0 + u * gwaves; val[u] = it < MPR * 2; const int m = val[u] ? (it >> 1) : 0; mm[u] = m;
                    const int mprev = (m & (TT - 1)) ? m - 1 : m;
                    y0[u] = *(const f32x4*)(Yb + (size_t)m * CW + ch0); y1[u] = *(const f32x4*)(Yb + (size_t)m * CW + ch0 + 4);
                    vc[u] = *(const u32x4*)(Proj + (size_t)m * PJP + PW + 2 * CW + ch0); vp[u] = *(const u32x4*)(Proj + (size_t)mprev * PJP + PW + 2 * CW + ch0);
                    gt[u] = *(const u32x4*)(Gb + (size_t)m * CW + ch0); bon[u] = Bonus[(size_t)m * NH + h];
                }
#pragma unroll
                for (int u = 0; u < 2; ++u) {
                    const int m = mm[u]; const float fm = (m & (TT - 1)) == 0 ? 0.f : 1.f;
                    float y[8] = {y0[u][0], y0[u][1], y0[u][2], y0[u][3], y1[u][0], y1[u][1], y1[u][2], y1[u][3]};
                    float s = ((y[0] + y[1]) + (y[2] + y[3])) + ((y[4] + y[5]) + (y[6] + y[7])); s = red8(s);
                    const float mean = s * (1.0f / 64.0f); float q2 = 0.f;
#pragma unroll
                    for (int j = 0; j < 8; ++j) { y[j] -= mean; q2 += y[j] * y[j]; }
                    q2 = red8(q2); const float rstd = rsqrtf(q2 * (1.0f / 64.0f) + GN_EPS);
                    unsigned ow[4];
#pragma unroll
                    for (int j2 = 0; j2 < 4; ++j2) {
                        float o2[2];
#pragma unroll
                        for (int e = 0; e < 2; ++e) {
                            const int j = j2 * 2 + e; const unsigned cw = vc[u][j2], pw_ = vp[u][j2], gw_ = gt[u][j2];
                            const float c_ = e ? bf2f(cw >> 16) : bf2f(cw & 0xffffu), p_ = fm * (e ? bf2f(pw_ >> 16) : bf2f(pw_ & 0xffffu)), g_ = e ? bf2f(gw_ >> 16) : bf2f(gw_ & 0xffffu);
                            const float mu_ = j < 4 ? mu0[j & 3] : mu1[j & 3], gnw = j < 4 ? gw0[j & 3] : gw1[j & 3], gnb = j < 4 ? gb0[j & 3] : gb1[j & 3];
                            const float v = c_ + (p_ - c_) * mu_;
                            o2[e] = (y[j] * rstd * gnw + gnb + bon[u] * v) * g_;
                        }
                        ow[j2] = pk_bf16(o2[0], o2[1]);
                    }
                    if (val[u]) *(u32x4*)(Mix + (size_t)m * D + PW + ch0) = (u32x4){ow[0], ow[1], ow[2], ow[3]};
                }
            }
        }
    }
    SEAM();

    if (IN(6)) {
        PHASE_IDS
        pg8::Gemm g{Mix, WoutT, D, D, D}; pg8::StaticOrder S; S.init(MPR, D, G, bid);
        EpiOut E{x_prompt, x_sample, out, H2, norm_ffn, rowsq1};
        pg8::gemm_phase(lds, g, S, E);
        for (int r = gwave; r < MSA; r += gwaves) {
            const int row = MPR + r; float s = 0.f;
#pragma unroll
            for (int i = 0; i < 8; ++i) {
                const int c = (i * 64 + lane) * 4; f32x4 x1 = *(const f32x4*)(x_sample + (size_t)r * D + c);
#pragma unroll
                for (int ks = 0; ks < KS6; ++ks) x1 = x1 + *(const f32x4*)(Part6 + ((size_t)ks * MSA + r) * D + c);
                *(f32x4*)(out + (size_t)row * D + c) = x1;
                s += (x1[0] * x1[0] + x1[1] * x1[1]) + (x1[2] * x1[2] + x1[3] * x1[3]);
                const f32x4 hv = x1 * *(const f32x4*)(norm_ffn + c);
                u32x2 w; w.x = pk_bf16(hv[0], hv[1]); w.y = pk_bf16(hv[2], hv[3]); *(u32x2*)(H2 + (size_t)row * D + c) = w;
            }
            s = wsum(s); if (lane == 0) rowsq1[row] = s;
        }
    }
    SEAM();

    if (IN(7)) {
        PHASE_IDS
        pg8::Gemm g{H2, WguT, D, D, D}; pg8::StaticOrder S; S.init(MPAD, 2 * DFF, G, bid);
        EpiGU E{Ub, rowsq1};
        pg8::gemm_phase(lds, g, S, E);
    }
    SEAM();

    if (IN(8)) {
        PHASE_IDS
        { pg8::Gemm g{Ub, WdnT, DFF, DFF, DFF}; pg8::StaticOrder S; S.init(MPR, D, G, bid);
          EpiDown E{out}; pg8::gemm_phase(lds, g, S, E); }
        { pg8::Gemm g{Ub, WdnT, DFF, DFF, 512}; pg8::SplitKOrder S{8, KS8, 32, 512, G, bid};
          EpiPartial E{Part8}; pg8::gemm_phase(lds, g, S, E); }
    }
    SEAM();

    if (IN(9)) {
        PHASE_IDS
        for (int row = gwave; row < MV; row += gwaves) {
            float* p = out + (size_t)row * D; f32x4 v[8]; float s = 0.f;
#pragma unroll
            for (int i = 0; i < 8; ++i) v[i] = *(const f32x4*)(p + (i * 64 + lane) * 4);
            if (row >= MPR) {
#pragma unroll
                for (int i = 0; i < 8; ++i)
#pragma unroll
                    for (int ks = 0; ks < KS8; ++ks) v[i] = v[i] + *(const f32x4*)(Part8 + ((size_t)ks * MSA + (row - MPR)) * D + (i * 64 + lane) * 4);
            }
#pragma unroll
            for (int i = 0; i < 8; ++i) s += (v[i][0] * v[i][0] + v[i][1] * v[i][1]) + (v[i][2] * v[i][2] + v[i][3] * v[i][3]);
            s = wsum(s); const float rstd = rsqrtf(s * (1.0f / D) + RMS_EPS);
#pragma unroll
            for (int i = 0; i < 8; ++i) { const int c = (i * 64 + lane) * 4; *(f32x4*)(p + c) = v[i] * rstd * *(const f32x4*)(norm_final + c); }
        }
    }
#undef IN
#undef SEAM
}

#ifndef HY_MULTI
#define HY_MULTI 0
#endif
#ifndef HY_REP
#define HY_REP 0
#endif
extern "C" void kernel_launch(void* const* d_in, const int* in_sizes, int n_in, void* d_out, int out_size, void* d_ws, size_t ws_size, hipStream_t stream) {
    static int grid = 0;
    if (grid == 0) {
        if (n_in != 26 || ws_size < WS_END) { fprintf(stderr, "kernel_launch: need 26 inputs and >= %zu bytes of workspace (got %d, %zu)\n", (size_t)WS_END, n_in, ws_size); grid = -1; return; }
        int dev = 0, cus = 0, per_cu = 0;
        hipGetDevice(&dev); hipDeviceGetAttribute(&cus, hipDeviceAttributeMultiprocessorCount, dev);
        if (hipFuncSetAttribute((const void*)hymba_fwd, hipFuncAttributeMaxDynamicSharedMemorySize, LDS_BYTES) != hipSuccess) { fprintf(stderr, "kernel_launch: hipFuncSetAttribute failed\n"); grid = -1; return; }
        if (hipOccupancyMaxActiveBlocksPerMultiprocessor(&per_cu, (const void*)hymba_fwd, NTHR, LDS_BYTES) != hipSuccess || per_cu < 1) { fprintf(stderr, "kernel_launch: occupancy query says %d\n", per_cu); per_cu = 1; }
        (void)hipGetLastError();
        grid = cus;
        if (grid > 256) grid = 256;
    }
    if (grid < 0) return;
    Params p{};
    for (int i = 0; i < 26; ++i) p.in[i] = (const float*)d_in[i];
    p.out = (float*)d_out; p.ws = (unsigned char*)d_ws;
#if HY_MULTI
    p.multi = 1;
    for (int ph = 0; ph < 10; ++ph) { p.phase = ph; for (int r = 0; r < ((HY_REP >> ph) & 1) + 1; ++r) hipLaunchKernelGGL(hymba_fwd, dim3(grid), dim3(NTHR), LDS_BYTES, stream, p); }
#else
    p.multi = 0; p.phase = 0;
    hipMemsetAsync((char*)d_ws + WS_BAR, 0, 16384, stream);
    void* args[] = {&p};
    hipError_t e = hipLaunchCooperativeKernel((const void*)hymba_fwd, dim3(grid), dim3(NTHR), args, LDS_BYTES, stream);
    if (e != hipSuccess) fprintf(stderr, "cooperative launch failed: %s (grid %d)\n", hipGetErrorString(e), grid);
#endif
}
```

```cpp
#include <hip/hip_runtime.h>
#include <hip/hip_cooperative_groups.h>
#include <cstdio>
namespace cg = cooperative_groups;

#define LAS __attribute__((address_space(3)))
typedef unsigned short bf16_t;
typedef short bf16x8 __attribute__((ext_vector_type(8)));
typedef float f32x4 __attribute__((ext_vector_type(4)));
typedef float f32x2 __attribute__((ext_vector_type(2)));
typedef unsigned u32x4 __attribute__((ext_vector_type(4)));
typedef unsigned u32x2 __attribute__((ext_vector_type(2)));

constexpr int D = 2048, TT = 2048, MPR = 8192, MSA = 128, MV = 8320, MPAD = 8448;
constexpr int PW = 1024, SW = 3360, PJ = 4384, PJP = 4608, DFF = 5632, CW = 1024, NH = 16;
constexpr int NTHR = 512, LDS_BYTES = 131072 + 16, LDS_ST_OFF = 131072;
constexpr float RMS_EPS = 1e-6f, GN_EPS = 64e-5f;

constexpr size_t WS_WIN = 0;
constexpr size_t WS_WOUT = WS_WIN + (size_t)PJP * D * 2;
constexpr size_t WS_WGU = WS_WOUT + (size_t)D * D * 2;
constexpr size_t WS_WDN = WS_WGU + (size_t)2 * DFF * D * 2;
constexpr size_t WS_WPOOL = WS_WDN + (size_t)D * DFF * 2;
constexpr size_t WS_WLORA = WS_WPOOL + (size_t)4 * 256 * 256 * 2;
constexpr size_t WS_R1 = WS_WLORA + (size_t)3 * 1024 * 256 * 2;
constexpr size_t WS_PROJ = WS_R1 + (size_t)MPAD * D * 2;
constexpr size_t WS_A = WS_PROJ + (size_t)MPAD * PJP * 2;
constexpr size_t WS_GATE = WS_A + (size_t)MPAD * CW * 2;
constexpr size_t WS_MIX = WS_GATE + (size_t)MPAD * CW * 2;
constexpr size_t WS_ROWSQ = WS_MIX + (size_t)MPAD * D * 2;
constexpr size_t WS_BONUS = WS_ROWSQ + (size_t)2 * MPAD * 4;
constexpr size_t WS_BAR = WS_BONUS + (size_t)MV * NH * 4;
constexpr size_t WS_PCNT = WS_BAR + 16384;
constexpr size_t WS_END = WS_PCNT + 8192;
static_assert((size_t)MPAD * DFF * 2 <= (WS_MIX - WS_PROJ), "U must fit in proj+a+gate");
constexpr int XLD = 1792;
static_assert((size_t)MPAD * XLD * 2 <= (size_t)MPAD * D * 2, "X fits in WS_R1");
constexpr int KS6 = 8, KS8 = 11;
static_assert((size_t)KS6 * MSA * D * 4 <= (size_t)MPAD * CW * 2 && (size_t)KS8 * MSA * D * 4 <= (size_t)MPAD * D * 2, "partial buffers alias WS_A / WS_R1");

constexpr size_t OUT_Y = 0;
constexpr size_t OUT_POOLP = (size_t)MV * D;
constexpr size_t OUT_SHIFTP = OUT_POOLP + (size_t)4 * 15 * PW;
constexpr size_t OUT_WKVP = OUT_SHIFTP + (size_t)4 * SW;
constexpr size_t OUT_POOLS = OUT_WKVP + (size_t)4 * NH * 64 * 64;
constexpr size_t OUT_SHIFTS = OUT_POOLS + (size_t)MSA * 15 * PW;
constexpr size_t OUT_WKVS = OUT_SHIFTS + (size_t)MSA * SW;
constexpr size_t SCR_Y = 0;
constexpr size_t SCR_DEC = (size_t)MPR * CW;
static_assert(SCR_DEC + (size_t)MV * CW <= OUT_POOLP, "scratch must fit in the y region");

struct Params { const float* in[26]; float* out; unsigned char* ws; int multi; int phase; };

__device__ __forceinline__ float bf2f(unsigned b) { return __uint_as_float(b << 16); }
__device__ __forceinline__ unsigned f2bf(float f) { unsigned u = __float_as_uint(f); u += 0x7FFFu + ((u >> 16) & 1u); return u >> 16; }
__device__ __forceinline__ unsigned pk_bf16(float lo, float hi) { unsigned r; asm volatile("v_cvt_pk_bf16_f32 %0, %1, %2" : "=v"(r) : "v"(lo), "v"(hi)); return r; }
template <int CTRL> __device__ __forceinline__ float dpp(float x) { return __int_as_float(__builtin_amdgcn_update_dpp(0, __float_as_int(x), CTRL, 0xF, 0xF, true)); }
__device__ __forceinline__ float red16(float x) {
    x += dpp<0x128>(x); x += dpp<0x124>(x); x += dpp<0x4E>(x); x += dpp<0xB1>(x); return x;
}
__device__ __forceinline__ float wsum(float x) {
    x = red16(x);
    x += __int_as_float(__builtin_amdgcn_update_dpp(0, __float_as_int(x), 0x142, 0xA, 0xF, false));
    x += __int_as_float(__builtin_amdgcn_update_dpp(0, __float_as_int(x), 0x143, 0xC, 0xF, false));
    return __int_as_float(__builtin_amdgcn_readlane(__float_as_int(x), 63));
}
__device__ __forceinline__ float fma_(float a, float b, float c) { float d; asm("v_fma_f32 %0, %1, %2, %3" : "=v"(d) : "v"(a), "v"(b), "v"(c)); return d; }
__device__ __forceinline__ f32x2 pkmul_(f32x2 a, f32x2 b) { f32x2 d; asm("v_pk_mul_f32 %0, %1, %2" : "=v"(d) : "v"(a), "v"(b)); return d; }
__device__ __forceinline__ f32x2 pkfma_(f32x2 a, f32x2 b, f32x2 c) { f32x2 d; asm("v_pk_fma_f32 %0, %1, %2, %3" : "=v"(d) : "v"(a), "v"(b), "v"(c)); return d; }
__device__ __forceinline__ f32x2 pkfma_b(f32x2 a, f32x2 s, f32x2 c) { f32x2 d; asm("v_pk_fma_f32 %0, %1, %2, %3 op_sel_hi:[1,0,1]" : "=v"(d) : "v"(a), "v"(s), "v"(c)); return d; }
__device__ __forceinline__ f32x2 lo2(f32x4 v) { return __builtin_shufflevector(v, v, 0, 1); }
__device__ __forceinline__ f32x2 hi2(f32x4 v) { return __builtin_shufflevector(v, v, 2, 3); }
__device__ __forceinline__ float mul_(float a, float b) { float d; asm("v_mul_f32 %0, %1, %2" : "=v"(d) : "v"(a), "v"(b)); return d; }
__device__ __forceinline__ float sigmoidf_(float x) { return 1.0f / (1.0f + __expf(-x)); }

#define WG_BAR() do { asm volatile("s_waitcnt lgkmcnt(0)" ::: "memory"); __builtin_amdgcn_s_barrier(); asm volatile("" ::: "memory"); } while (0)

#define XB_TMO      128
#define XB_XCNT(j)  (256  + 64 * (j))
#define XB_XSUB(j)  (1280 + 64 * (j))
#define XB_XGEN(j)  (2304 + 64 * (j))
#define XB_TOP      3328
#define XB_TOPGEN   3392
#define XCD_BAR_WORDS 3456
#define XB_SPIN_CAP (1u << 18)

__device__ __forceinline__ unsigned xb_ld(unsigned* p)              { return __hip_atomic_load(p, __ATOMIC_RELAXED, __HIP_MEMORY_SCOPE_AGENT); }
__device__ __forceinline__ unsigned xb_add(unsigned* p, unsigned v) { return __hip_atomic_fetch_add(p, v, __ATOMIC_RELAXED, __HIP_MEMORY_SCOPE_AGENT); }
__device__ __forceinline__ unsigned xb_xcc_id() { return (unsigned)__builtin_amdgcn_s_getreg((3 << 11) | 20) & 0xFu; }
#define XB_SPIN(cond, bar) do { unsigned _sp = 0; while (cond) { __builtin_amdgcn_s_sleep(1); \
    if ((++_sp & 255u) == 0u) { if (xb_ld(&(bar)[XB_TMO])) break; if (_sp > XB_SPIN_CAP) { atomicAdd(&(bar)[XB_TMO], 1u); break; } } } } while (0)

struct XcdBarrier {
    unsigned* bar; unsigned x;
    volatile LAS unsigned* st;
};

__device__ __forceinline__ XcdBarrier xcd_barrier_post(unsigned* bar, volatile LAS unsigned* st) {
    XcdBarrier b; b.bar = bar; b.x = xb_xcc_id(); b.st = st;
    if (threadIdx.x == 0) (void)xb_add(&bar[XB_XCNT(b.x)], 1u);
    return b;
}
__device__ __forceinline__ void xcd_barrier_complete(unsigned* bar, unsigned x, unsigned& nloc, unsigned& nx) {
    const unsigned G = gridDim.x * gridDim.y * gridDim.z;
    unsigned sum, cnt, mine, sp = 0u;
    for (;;) {
        sum = 0u; cnt = 0u; mine = 0u;
#pragma unroll
        for (unsigned j = 0; j < 16; ++j) { const unsigned c = xb_ld(&bar[XB_XCNT(j)]); sum += c; cnt += (c > 0u) ? 1u : 0u; mine = (j == x) ? c : mine; }
        if (sum == G) break;
        __builtin_amdgcn_s_sleep(1);
        if ((++sp & 255u) == 0u) { if (xb_ld(&bar[XB_TMO])) break; if (sp > XB_SPIN_CAP) { atomicAdd(&bar[XB_TMO], 1u); break; } }
    }
    nloc = mine > 0u ? mine : 1u; nx = cnt > 0u ? cnt : 1u;
}

__device__ __forceinline__ void xcd_barrier(const XcdBarrier& b) {
    asm volatile("s_waitcnt vmcnt(0)" ::: "memory");
    __syncthreads();
    if (threadIdx.x == 0) {
        unsigned* bar = b.bar;
        __builtin_amdgcn_s_waitcnt(0);
        unsigned nloc = b.st[0], nx = b.st[1];
        if (nloc == 0u) { xcd_barrier_complete(bar, b.x, nloc, nx); b.st[0] = nloc; b.st[1] = nx; }
        const unsigned old = xb_add(&bar[XB_XSUB(b.x)], 1u);
        const unsigned gen = old / nloc;
        if (old + 1u == (gen + 1u) * nloc) {
            __builtin_amdgcn_fence(__ATOMIC_RELEASE, "agent");
            asm volatile("s_waitcnt vmcnt(0)" ::: "memory");
            const unsigned og = xb_add(&bar[XB_TOP], 1u);
            const unsigned tg = og / nx;
            if (og + 1u == (tg + 1u) * nx) xb_add(&bar[XB_TOPGEN], 1u);
            else XB_SPIN(xb_ld(&bar[XB_TOPGEN]) == tg, bar);
            __builtin_amdgcn_fence(__ATOMIC_ACQUIRE, "agent");
            xb_add(&bar[XB_XGEN(b.x)], 1u);
            asm volatile("s_waitcnt vmcnt(0)" ::: "memory");
        } else {
            XB_SPIN(xb_ld(&bar[XB_XGEN(b.x)]) == gen, bar);
            __builtin_amdgcn_fence(__ATOMIC_ACQUIRE, "agent");
            asm volatile("s_waitcnt vmcnt(0)" ::: "memory");
        }
    }
    __syncthreads();
}

__device__ __forceinline__ void grid_bar(unsigned* ctr, unsigned target) {
    asm volatile("s_waitcnt vmcnt(0) lgkmcnt(0)" ::: "memory");
    __syncthreads();
    if (threadIdx.x == 0) {
        __builtin_amdgcn_fence(__ATOMIC_RELEASE, "agent");
        asm volatile("s_waitcnt vmcnt(0)" ::: "memory");
        __hip_atomic_fetch_add(ctr, 1u, __ATOMIC_RELAXED, __HIP_MEMORY_SCOPE_AGENT);
        while (__hip_atomic_load(ctr, __ATOMIC_RELAXED, __HIP_MEMORY_SCOPE_AGENT) < target) __builtin_amdgcn_s_sleep(4);
        __builtin_amdgcn_fence(__ATOMIC_ACQUIRE, "agent");
        asm volatile("s_waitcnt vmcnt(0)" ::: "memory");
    }
    __syncthreads();
}

namespace pg8 {
constexpr int BM = 256, BK = 64, HALF = 128, HTB = HALF * BK * 2, NXCD = 8, WGM = 8;
__device__ __forceinline__ int lds_byte(int r, int c) { const int st = (r >> 4) * 2 + (c >> 5), rr = r & 15, cc = c & 31, ob = rr * 64 + cc * 2; return st * 1024 + (ob ^ (((ob >> 9) & 1) << 5)); }
__device__ __forceinline__ void stage_rc(int b, int& R, int& C) { const int st = b / 1024, sb = b % 1024, swz = sb ^ (((sb >> 9) & 1) << 5); R = (st >> 1) * 16 + swz / 64; C = (st & 1) * 32 + (swz % 64) / 2; }
__device__ __forceinline__ int perm32(int rho) { const int n = rho >> 4, i = rho & 15; return 8 * (i >> 2) + 4 * n + (i & 3); }
struct Unit { int pm, pn, ks, koffA, koffB; };
struct Gemm { const bf16_t* A; const bf16_t* Bt; int lda, ldb, K; };
struct StaticOrder {
    int nM, nN, nwg, G, c;
    __device__ void init(int M, int N, int G_, int c_) { nM = M / BM; nN = N / BM; nwg = nM * nN; G = G_; c = c_; }
    __device__ bool next(int i, Unit& u) const {
        const long L = (long)i * G + c; if (L >= nwg) return false;
        int wgid = (int)L; { const int q = nwg / NXCD, r = nwg % NXCD, xcd = wgid % NXCD, off = wgid / NXCD; wgid = (xcd < r ? xcd * (q + 1) : r * (q + 1) + (xcd - r) * q) + off; }
        const int nig = WGM * nN, gid = wgid / nig, fm = gid * WGM, gsz = (nM - fm) < WGM ? (nM - fm) : WGM;
        u.pm = fm + ((wgid % nig) % gsz); u.pn = (wgid % nig) / gsz; u.ks = 0; u.koffA = 0; u.koffB = 0; return true;
    }
};
struct SplitKOrder {
    int nN, nks, pm, kchunk, G, c;
    __device__ bool next(int i, Unit& u) const { const long L = (long)i * G + c; if (L >= (long)nN * nks) return false;
        u.pm = pm; u.pn = (int)(L % nN); u.ks = (int)(L / nN); u.koffA = u.ks * kchunk; u.koffB = u.koffA; return true; }
};

struct P3Order {
    int G, c;
    __device__ bool next(int i, Unit& u) const { const int L = i * G + c; if (L >= 16 * 33) return false;
        u.pn = L / 33; u.pm = L - u.pn * 33; u.ks = 0; u.koffB = 0; u.koffA = u.pn < 4 ? u.pn * 256 : 1024 + ((u.pn - 4) >> 2) * 256; return true; }
};
template <class Epi, class Sched>
__device__ __forceinline__ void gemm_phase(LAS unsigned char* lds, const Gemm g, const Sched& S, const Epi& E) {
    const int tid = threadIdx.x, wid = __builtin_amdgcn_readfirstlane(tid >> 6), lane = tid & 63, wr = wid >> 2, wc = wid & 3, fr = lane & 15, fq = lane >> 4;
    const int K = g.K, nt = K / BK;
    unsigned voffA[2], voffB[2];
#pragma unroll
    for (int i = 0; i < 2; ++i) { int R, C; stage_rc(tid * 16 + i * 8192, R, C); const int Rb = Epi::PERM ? ((R & ~31) + perm32(R & 31)) : R;
        voffA[i] = (unsigned)(R * g.lda + C) * 2u; voffB[i] = (unsigned)(Rb * g.ldb + C) * 2u; }
    const size_t kstep = (size_t)(BK * 2);
    const size_t hstepA = (size_t)HALF * g.lda * 2, hstepB = (size_t)HALF * g.ldb * 2;
    const size_t tstepA = 2 * hstepA, tstepB = 2 * hstepB;
    const unsigned ldsw = (unsigned)wid * 1024u;
    const int aoff = lds_byte(wr * 64 + fr, fq * 8), boff = lds_byte(wc * 32 + fr, fq * 8);
#define PG8_SA(b, h) (((b) * 2 + (h)) * HTB)
#define PG8_SB(b, h) ((4 + (b) * 2 + (h)) * HTB)
#define PG8_STAGE(bufoff, gbase, voff) do { _Pragma("unroll") for (int _i = 0; _i < 2; ++_i) \
        __builtin_amdgcn_global_load_lds((const unsigned*)((const char*)(gbase) + (voff)[_i]), (LAS unsigned*)(lds + (bufoff) + ldsw + _i * 8192), 16, 0, 0); } while (0)
#define PG8_LDA(dst, b, h) do { _Pragma("unroll") for (int m = 0; m < 4; ++m) _Pragma("unroll") for (int k = 0; k < 2; ++k) dst[m][k] = *(const LAS bf16x8*)(lds + PG8_SA(b, h) + aoff + m * 2048 + k * 1024); } while (0)
#define PG8_LDB(dst, b, h) do { _Pragma("unroll") for (int n = 0; n < 2; ++n) _Pragma("unroll") for (int k = 0; k < 2; ++k) dst[n][k] = *(const LAS bf16x8*)(lds + PG8_SB(b, h) + boff + n * 2048 + k * 1024); } while (0)
#define PG8_MMA(ai, bj, At, Bt) do { __builtin_amdgcn_s_setprio(1); _Pragma("unroll") for (int m = 0; m < 4; ++m) _Pragma("unroll") for (int n = 0; n < 2; ++n) _Pragma("unroll") for (int k = 0; k < 2; ++k) \
        acc[ai][bj][m][n] = __builtin_amdgcn_mfma_f32_16x16x32_bf16(Bt[n][k], At[m][k], acc[ai][bj][m][n], 0, 0, 0); __builtin_amdgcn_s_setprio(0); } while (0)
#define PG8_WAIT_V(n) asm volatile("s_waitcnt vmcnt(" #n ")" ::: "memory")
#define PG8_WAIT_L(n) asm volatile("s_waitcnt lgkmcnt(" #n ")" ::: "memory")
#define PG8_BAR __builtin_amdgcn_s_barrier()
#define PG8_SCHED __builtin_amdgcn_sched_barrier(0)
    Unit cur, nxt; int ui = 0;
    if (!S.next(0, cur)) return;
    f32x4 acc[2][2][4][2];
#pragma unroll
    for (int a = 0; a < 2; ++a)
#pragma unroll
        for (int b = 0; b < 2; ++b)
#pragma unroll
            for (int m = 0; m < 4; ++m)
#pragma unroll
                for (int n = 0; n < 2; ++n) acc[a][b][m][n] = (f32x4){0.f, 0.f, 0.f, 0.f};
    bf16x8 At[4][2], B0[2][2], B1[2][2];
    const char* cA = (const char*)g.A + (size_t)cur.pm * tstepA + (size_t)cur.koffA * 2; const char* cB = (const char*)g.Bt + (size_t)cur.pn * tstepB + (size_t)cur.koffB * 2;
    PG8_STAGE(PG8_SB(0, 0), cB, voffB); PG8_STAGE(PG8_SA(0, 0), cA, voffA); PG8_STAGE(PG8_SB(0, 1), cB + hstepB, voffB); PG8_STAGE(PG8_SA(0, 1), cA + hstepA, voffA);
    if (wr == 1) PG8_BAR;
    PG8_WAIT_V(4); PG8_BAR;
    PG8_STAGE(PG8_SB(1, 0), cB + kstep, voffB); PG8_STAGE(PG8_SA(1, 0), cA + kstep, voffA); PG8_STAGE(PG8_SB(1, 1), cB + hstepB + kstep, voffB);
    PG8_WAIT_V(6); PG8_BAR;
    for (;;) {
        const bool has_next = S.next(ui + 1, nxt);
        const char* nA = has_next ? (const char*)g.A + (size_t)nxt.pm * tstepA + (size_t)nxt.koffA * 2 : cA; const char* nB = has_next ? (const char*)g.Bt + (size_t)nxt.pn * tstepB + (size_t)nxt.koffB * 2 : cB;
#pragma clang loop unroll(disable)
        for (int t = 0; t < nt; t += 2) {
            const bool last = (t == nt - 2);
            const char* a1 = cA + (size_t)(t + 1) * kstep;
            const char* a2 = last ? nA : cA + (size_t)(t + 2) * kstep; const char* b2 = last ? nB : cB + (size_t)(t + 2) * kstep;
            const char* a3 = a2 + kstep; const char* b3 = b2 + kstep;
            PG8_LDB(B0, 0, 0); PG8_SCHED; PG8_LDA(At, 0, 0); PG8_STAGE(PG8_SA(1, 1), a1 + hstepA, voffA);
            PG8_WAIT_L(8); PG8_BAR; PG8_WAIT_L(0); PG8_MMA(0, 0, At, B0); PG8_BAR; PG8_SCHED;
            PG8_LDB(B1, 0, 1); PG8_STAGE(PG8_SB(0, 0), b2, voffB);
            PG8_BAR; PG8_WAIT_L(0); PG8_MMA(0, 1, At, B1); PG8_BAR;
            PG8_LDA(At, 0, 1); PG8_STAGE(PG8_SA(0, 0), a2, voffA);
            PG8_BAR; PG8_WAIT_L(0); PG8_MMA(1, 0, At, B0); PG8_BAR; PG8_SCHED;
            PG8_STAGE(PG8_SB(0, 1), b2 + hstepB, voffB);
            PG8_WAIT_V(6); PG8_BAR; PG8_MMA(1, 1, At, B1); PG8_BAR;
            PG8_LDB(B0, 1, 0); PG8_SCHED; PG8_LDA(At, 1, 0); PG8_STAGE(PG8_SA(0, 1), a2 + hstepA, voffA);
            PG8_WAIT_L(8); PG8_BAR; PG8_WAIT_L(0); PG8_MMA(0, 0, At, B0); PG8_BAR; PG8_SCHED;
            PG8_LDB(B1, 1, 1); PG8_STAGE(PG8_SB(1, 0), b3, voffB);
            PG8_BAR; PG8_WAIT_L(0); PG8_MMA(0, 1, At, B1); PG8_BAR;
            PG8_LDA(At, 1, 1); PG8_STAGE(PG8_SA(1, 0), a3, voffA);
            PG8_BAR; PG8_WAIT_L(0); PG8_MMA(1, 0, At, B0); PG8_BAR; PG8_SCHED;
            PG8_STAGE(PG8_SB(1, 1), b3 + hstepB, voffB);
            PG8_WAIT_V(6); PG8_BAR; PG8_MMA(1, 1, At, B1); PG8_BAR;
        }
        if constexpr (!Epi::AFTER_DRAIN) E(acc, cur, wr, wc, fr, fq);
        if (!has_next) break;
#pragma unroll
        for (int a = 0; a < 2; ++a)
#pragma unroll
            for (int b = 0; b < 2; ++b)
#pragma unroll
                for (int m = 0; m < 4; ++m)
#pragma unroll
                    for (int n = 0; n < 2; ++n) acc[a][b][m][n] = (f32x4){0.f, 0.f, 0.f, 0.f};
        cur = nxt; cA = nA; cB = nB; ++ui;
    }
    PG8_WAIT_V(0);
    if (wr == 0) PG8_BAR;
    PG8_BAR;
    if constexpr (Epi::AFTER_DRAIN) E(acc, cur, wr, wc, fr, fq);
#undef PG8_SA
#undef PG8_SB
#undef PG8_STAGE
#undef PG8_LDA
#undef PG8_LDB
#undef PG8_MMA
#undef PG8_WAIT_V
#undef PG8_WAIT_L
#undef PG8_BAR
#undef PG8_SCHED
}
}
using pg8::Unit;

template <int MODE> struct EpiBf16 {
    static constexpr bool PERM = true, AFTER_DRAIN = false;
    bf16_t* O; int ldc; int coff; const float* vec;
    __device__ __forceinline__ void operator()(const f32x4 (&acc)[2][2][4][2], const Unit& u, int wr, int wc, int fr, int fq) const {
        const int row0 = u.pm * 256 + wr * 64 + fr, col0 = coff + u.pn * 256 + wc * 32 + 8 * fq;
#pragma unroll
        for (int bj = 0; bj < 2; ++bj) {
            const int c = col0 + bj * 128;
            f32x4 s0, s1;
            if (MODE == 0) { s0 = vec ? *(const f32x4*)(vec + c) : (f32x4){1.f, 1.f, 1.f, 1.f}; s1 = vec ? *(const f32x4*)(vec + c + 4) : (f32x4){1.f, 1.f, 1.f, 1.f}; }
            else { s0 = *(const f32x4*)(vec + c); s1 = *(const f32x4*)(vec + c + 4); }
#pragma unroll
            for (int ai = 0; ai < 2; ++ai)
#pragma unroll
                for (int m = 0; m < 4; ++m) {
                    f32x4 v0 = acc[ai][bj][m][0], v1 = acc[ai][bj][m][1];
                    if (MODE == 0) { v0 = v0 * s0; v1 = v1 * s1; }
                    else {
#pragma unroll
                        for (int j = 0; j < 4; ++j) { v0[j] = sigmoidf_(v0[j] + s0[j]); v1[j] = sigmoidf_(v1[j] + s1[j]); } }
                    u32x4 w; w.x = pk_bf16(v0[0], v0[1]); w.y = pk_bf16(v0[2], v0[3]); w.z = pk_bf16(v1[0], v1[1]); w.w = pk_bf16(v1[2], v1[3]);
                    *(u32x4*)(O + (size_t)(row0 + ai * 128 + m * 16) * ldc + c) = w;
                }
        }
    }
};
struct EpiP3 {
    static constexpr bool PERM = true, AFTER_DRAIN = false;
    bf16_t* MixO; float* DecO; bf16_t* AO; bf16_t* GO; const float* pscale; const float* w0v; const float* a0v;
    __device__ __forceinline__ void operator()(const f32x4 (&acc)[2][2][4][2], const Unit& u, int wr, int wc, int fr, int fq) const {
        const bool pool = u.pn < 4; const int sgm = (u.pn - 4) >> 2;
        const int mode = pool ? 0 : (sgm == 0 ? 2 : (sgm == 1 ? 1 : 0)), ldc = pool ? D : CW;
        bf16_t* o0 = MixO; bf16_t* o1 = AO; bf16_t* o2 = GO; const float* v0 = pscale; const float* v1 = w0v; const float* v2 = a0v;
        asm volatile("" : "+s"(o0), "+s"(o1), "+s"(o2), "+s"(v0), "+s"(v1), "+s"(v2));
        bf16_t* Ob = pool ? o0 : (sgm == 1 ? o1 : o2); float* Of = DecO;
        const float* vec = pool ? v0 : (sgm == 0 ? v1 : (sgm == 1 ? v2 : (const float*)nullptr));
        const int row0 = u.pm * 256 + wr * 64 + fr, col0 = (pool ? u.pn * 256 : ((u.pn - 4) & 3) * 256) + wc * 32 + 8 * fq;
#pragma unroll
        for (int bj = 0; bj < 2; ++bj) {
            const int c = col0 + bj * 128;
            const f32x4 one = (f32x4){1.f, 1.f, 1.f, 1.f};
            const f32x4 s0 = vec ? *(const f32x4*)(vec + c) : one, s1 = vec ? *(const f32x4*)(vec + c + 4) : one;
#pragma unroll
            for (int ai = 0; ai < 2; ++ai)
#pragma unroll
                for (int m = 0; m < 4; ++m) {
                    const int row = row0 + ai * 128 + m * 16;
                    f32x4 v0 = acc[ai][bj][m][0], v1 = acc[ai][bj][m][1];
                    if (mode == 0) { v0 = v0 * s0; v1 = v1 * s1; }
                    else if (mode == 1) {
#pragma unroll
                        for (int j = 0; j < 4; ++j) { v0[j] = sigmoidf_(v0[j] + s0[j]); v1[j] = sigmoidf_(v1[j] + s1[j]); } }
                    else {
                        v0 = v0 + s0; v1 = v1 + s1;
#pragma unroll
                        for (int j = 0; j < 4; ++j) {
                            const float z0 = -v0[j], z1 = -v1[j];
                            const float sp0 = fmaxf(z0, 0.f) + __logf(1.0f + __expf(-fabsf(z0))), sp1 = fmaxf(z1, 0.f) + __logf(1.0f + __expf(-fabsf(z1)));
                            v0[j] = __expf(-__expf(-sp0 - 0.5f)); v1[j] = __expf(-__expf(-sp1 - 0.5f)); }
                    }
                    if (mode == 2) { if (row < MV) { float* p = Of + (size_t)row * ldc + c; *(f32x4*)p = v0; *(f32x4*)(p + 4) = v1; } }
                    else { u32x4 w; w.x = pk_bf16(v0[0], v0[1]); w.y = pk_bf16(v0[2], v0[3]); w.z = pk_bf16(v1[0], v1[1]); w.w = pk_bf16(v1[2], v1[3]);
                        *(u32x4*)(Ob + (size_t)row * ldc + c) = w; }
                }
        }
    }
};
struct EpiDecay {
    static constexpr bool PERM = false, AFTER_DRAIN = false;
    float* O; const float* w0;
    __device__ __forceinline__ void operator()(const f32x4 (&acc)[2][2][4][2], const Unit& u, int wr, int wc, int fr, int fq) const {
        const int row0 = u.pm * 256 + wr * 64 + fr, col0 = u.pn * 256 + wc * 32 + 4 * fq;
#pragma unroll
        for (int bj = 0; bj < 2; ++bj)
#pragma unroll
            for (int n = 0; n < 2; ++n) {
                const int c = col0 + bj * 128 + n * 16; const f32x4 b = *(const f32x4*)(w0 + c);
#pragma unroll
                for (int ai = 0; ai < 2; ++ai)
#pragma unroll
                    for (int m = 0; m < 4; ++m) {
                        const int row = row0 + ai * 128 + m * 16; f32x4 v = acc[ai][bj][m][n] + b, o;
#pragma unroll
                        for (int j = 0; j < 4; ++j) { const float z = -v[j]; const float sp = fmaxf(z, 0.f) + __logf(1.0f + __expf(-fabsf(z))); o[j] = __expf(-__expf(-sp - 0.5f)); }
                        if (row < MV) *(f32x4*)(O + (size_t)row * CW + c) = o;
                    }
            }
    }
};
struct EpiOut {
    static constexpr bool PERM = false, AFTER_DRAIN = false;
    const float* xp; const float* xs; float* out; bf16_t* h2; const float* g; float* rowsq;
    __device__ __forceinline__ void operator()(const f32x4 (&acc)[2][2][4][2], const Unit& u, int wr, int wc, int fr, int fq) const {
        const int row0 = u.pm * 256 + wr * 64 + fr, col0 = u.pn * 256 + wc * 32 + 4 * fq;
#pragma unroll
        for (int ai = 0; ai < 2; ++ai)
#pragma unroll
            for (int m = 0; m < 4; ++m) {
                const int row = row0 + ai * 128 + m * 16; const bool ok = row < MV;
                const float* xr = row < MPR ? xp + (size_t)row * D : xs + (size_t)(ok ? row - MPR : 0) * D;
                float s = 0.f;
#pragma unroll
                for (int bj = 0; bj < 2; ++bj)
#pragma unroll
                    for (int n = 0; n < 2; ++n) {
                        const int c = col0 + bj * 128 + n * 16;
                        f32x4 x1 = acc[ai][bj][m][n];
                        if (ok) { x1 = x1 + *(const f32x4*)(xr + c); *(f32x4*)(out + (size_t)row * D + c) = x1; }
                        s += (x1[0] * x1[0] + x1[1] * x1[1]) + (x1[2] * x1[2] + x1[3] * x1[3]);
                        const f32x4 gg = *(const f32x4*)(g + c); const f32x4 hv = x1 * gg;
                        u32x2 w; w.x = pk_bf16(hv[0], hv[1]); w.y = pk_bf16(hv[2], hv[3]);
                        *(u32x2*)(h2 + (size_t)row * D + c) = w;
                    }
                s += __shfl_xor(s, 16); s += __shfl_xor(s, 32);
                if (ok && fq == 0) unsafeAtomicAdd(rowsq + row, s);
            }
    }
};
struct EpiGU {
    static constexpr bool PERM = true, AFTER_DRAIN = false;
    bf16_t* U; const float* rowsq;
    __device__ __forceinline__ void operator()(const f32x4 (&acc)[2][2][4][2], const Unit& u, int wr, int wc, int fr, int fq) const {
        const int row0 = u.pm * 256 + wr * 64 + fr, col0 = u.pn * 128 + wc * 32 + 8 * fq;
#pragma unroll
        for (int ai = 0; ai < 2; ++ai)
#pragma unroll
            for (int m = 0; m < 4; ++m) {
                const int row = row0 + ai * 128 + m * 16;
                const float rstd = rsqrtf(rowsq[row] * (1.0f / D) + RMS_EPS);
                f32x4 o[2];
#pragma unroll
                for (int n = 0; n < 2; ++n)
#pragma unroll
                    for (int j = 0; j < 4; ++j) { const float gt = acc[ai][0][m][n][j] * rstd, up = acc[ai][1][m][n][j] * rstd; o[n][j] = gt * sigmoidf_(gt) * up; }
                u32x4 w; w.x = pk_bf16(o[0][0], o[0][1]); w.y = pk_bf16(o[0][2], o[0][3]); w.z = pk_bf16(o[1][0], o[1][1]); w.w = pk_bf16(o[1][2], o[1][3]);
                *(u32x4*)(U + (size_t)row * DFF + col0) = w;
            }
    }
};
struct EpiDown {
    static constexpr bool PERM = false, AFTER_DRAIN = false;
    float* out;
    __device__ __forceinline__ void operator()(const f32x4 (&acc)[2][2][4][2], const Unit& u, int wr, int wc, int fr, int fq) const {
        const int row0 = u.pm * 256 + wr * 64 + fr, col0 = u.pn * 256 + wc * 32 + 4 * fq;
#pragma unroll
        for (int ai = 0; ai < 2; ++ai)
#pragma unroll
            for (int m = 0; m < 4; ++m) {
                const int row = row0 + ai * 128 + m * 16;
#pragma unroll
                for (int bj = 0; bj < 2; ++bj)
#pragma unroll
                    for (int n = 0; n < 2; ++n) {
                        const int c = col0 + bj * 128 + n * 16; float* p = out + (size_t)row * D + c;
                        *(f32x4*)p = acc[ai][bj][m][n] + *(const f32x4*)p;
                    }
            }
    }
};
struct EpiDownNorm {
    static constexpr bool PERM = false, AFTER_DRAIN = true;
    float* out; float* rowsq; unsigned* cnt; const float* g;
    __device__ __forceinline__ void operator()(f32x4 (&acc)[2][2][4][2], const Unit& u, int wr, int wc, int fr, int fq) const {
        const int row0 = u.pm * 256 + wr * 64 + fr, col0 = u.pn * 256 + wc * 32 + 4 * fq;
        float chk = 0.f;
#pragma unroll
        for (int ai = 0; ai < 2; ++ai)
#pragma unroll
            for (int m = 0; m < 4; ++m) {
                const int row = row0 + ai * 128 + m * 16; float s = 0.f;
#pragma unroll
                for (int bj = 0; bj < 2; ++bj)
#pragma unroll
                    for (int n = 0; n < 2; ++n) {
                        const f32x4 x2 = acc[ai][bj][m][n] + *(const f32x4*)(out + (size_t)row * D + col0 + bj * 128 + n * 16); acc[ai][bj][m][n] = x2;
                        s += (x2[0] * x2[0] + x2[1] * x2[1]) + (x2[2] * x2[2] + x2[3] * x2[3]);
                    }
                s += __shfl_xor(s, 16); s += __shfl_xor(s, 32);
                if (fq == 0) chk += unsafeAtomicAdd(rowsq + row, s);
            }
        asm volatile("s_waitcnt vmcnt(0)" :: "v"(chk) : "memory");
        unsigned* pc = cnt + 64 * u.pm;
        if ((threadIdx.x & 63) == 0) __hip_atomic_fetch_add(pc, 1u, __ATOMIC_RELAXED, __HIP_MEMORY_SCOPE_AGENT);
        { unsigned spins = 0; while (__hip_atomic_load(pc, __ATOMIC_RELAXED, __HIP_MEMORY_SCOPE_AGENT) < 64u) { __builtin_amdgcn_s_sleep(2); if (++spins > (1u << 22)) break; } }
        __builtin_amdgcn_fence(__ATOMIC_ACQUIRE, "agent");
        asm volatile("s_waitcnt vmcnt(0)" ::: "memory");
#pragma unroll
        for (int ai = 0; ai < 2; ++ai)
#pragma unroll
            for (int m = 0; m < 4; ++m) {
                const int row = row0 + ai * 128 + m * 16;
                const float rstd = rsqrtf(__hip_atomic_load(rowsq + row, __ATOMIC_RELAXED, __HIP_MEMORY_SCOPE_AGENT) * (1.0f / D) + RMS_EPS);
#pragma unroll
                for (int bj = 0; bj < 2; ++bj)
#pragma unroll
                    for (int n = 0; n < 2; ++n) { const int c = col0 + bj * 128 + n * 16; *(f32x4*)(out + (size_t)row * D + c) = acc[ai][bj][m][n] * rstd * *(const f32x4*)(g + c); }
            }
    }
};
struct EpiPartial {
    static constexpr bool PERM = false, AFTER_DRAIN = false;
    float* buf;
    __device__ __forceinline__ void operator()(const f32x4 (&acc)[2][2][4][2], const Unit& u, int wr, int wc, int fr, int fq) const {
        const int col0 = u.pn * 256 + wc * 32 + 4 * fq;
#pragma unroll
        for (int m = 0; m < 4; ++m) {
            const int lrow = wr * 64 + m * 16 + fr;
            float* p = buf + ((size_t)u.ks * MSA + lrow) * D + col0;
#pragma unroll
            for (int bj = 0; bj < 2; ++bj)
#pragma unroll
                for (int n = 0; n < 2; ++n) *(f32x4*)(p + bj * 128 + n * 16) = acc[0][bj][m][n];
        }
    }
};

template <int RM> __device__ __forceinline__ int rowmap(int n) { return RM == 0 ? n : (RM == 1 ? ((n >> 7) * 256 + (n & 127)) : ((n >> 7) * 256 + 128 + (n & 127))); }
template <int RM>
__device__ __forceinline__ void transpose_bf16(const float* src, int Ksrc, int Nsrc, int ld, bf16_t* dst, int Kdst, int Ndst, int rot, int vgw, int gws) {
    const int lane = threadIdx.x & 63, gw = (vgw + rot) % gws;
    const int nn = Ndst / 64, ntile = nn * (Kdst / 64);
    for (int t = gw; t < ntile; t += gws) {
        const int k0 = (t / nn) * 64, n = (t % nn) * 64 + lane;
        const bool nok = n < Nsrc;
        const float* sp = src + (nok ? n : 0);
        float v[64];
        const float mskn = nok ? 1.f : 0.f;
#pragma unroll
        for (int j = 0; j < 64; ++j) { const int k = k0 + j; v[j] = sp[(size_t)(k < Ksrc ? k : Ksrc - 1) * ld]; }
#pragma unroll
        for (int j = 0; j < 64; ++j) v[j] *= ((k0 + j) < Ksrc ? mskn : 0.f);
        bf16_t* dp = dst + (size_t)rowmap<RM>(n) * Kdst + k0;
#pragma unroll
        for (int q8 = 0; q8 < 8; ++q8) { u32x4 w; w.x = pk_bf16(v[q8 * 8 + 0], v[q8 * 8 + 1]); w.y = pk_bf16(v[q8 * 8 + 2], v[q8 * 8 + 3]); w.z = pk_bf16(v[q8 * 8 + 4], v[q8 * 8 + 5]); w.w = pk_bf16(v[q8 * 8 + 6], v[q8 * 8 + 7]);
            *(u32x4*)(dp + q8 * 8) = w; }
    }
}
template <int CTRL> __device__ __forceinline__ float dpp_(float x) { return __int_as_float(__builtin_amdgcn_update_dpp(0, __float_as_int(x), CTRL, 0xF, 0xF, true)); }
__device__ __forceinline__ float red8(float x) { x += dpp_<0x141>(x); x += dpp_<0xB1>(x); x += dpp_<0x4E>(x); return x; }

template <int W>
__device__ __forceinline__ void pool_block_prompt(const bf16_t* proj, bf16_t* pooled, int b, int t0, int c) {
    float ux[15 + W], uy[15 + W]; unsigned raw[15 + W];
#pragma unroll
    for (int j = 0; j < 15 + W; ++j) {
        const int t = t0 - (W - 1) + j;
        raw[j] = *(const unsigned*)(proj + (size_t)(b * TT + (t < 0 ? 0 : t)) * PJP + c);
    }
#pragma unroll
    for (int j = 0; j < 15 + W; ++j) {
        const int t = t0 - (W - 1) + j; const float zm = t < 0 ? 0.f : 1.f;
        ux[j] = bf2f(raw[j] & 0xffffu) * zm; uy[j] = bf2f(raw[j] >> 16) * zm;
    }
#pragma unroll
    for (int i = 0; i < 16; ++i) {
        const int t = t0 + i; float sx = 0.f, sy = 0.f;
#pragma unroll
        for (int j = 0; j < W; ++j) { sx += ux[i + j]; sy += uy[i + j]; }
        const float inv = 1.0f / (float)(t + 1 < W ? t + 1 : W);
        const float px = sx * inv - ux[i + W - 1], py = sy * inv - uy[i + W - 1];
        *(unsigned*)(pooled + (size_t)(b * TT + t) * XLD + c) = pk_bf16(px, py);
    }
}

__global__ void __launch_bounds__(NTHR) hymba_fwd(Params P) {
    extern __shared__ __attribute__((aligned(16))) unsigned char lds_raw[];
    LAS unsigned char* lds = (LAS unsigned char*)lds_raw;
    const int G = gridDim.x, bid = blockIdx.x, gthreads = G * NTHR, gwaves = G * 8;
#define PHASE_IDS int tid = threadIdx.x; asm volatile("" : "+v"(tid)); const int lane = tid & 63, wave = tid >> 6, gtid = bid * NTHR + tid, gwave = bid * 8 + wave; (void)lane; (void)wave; (void)gtid; (void)gwave;
    unsigned char* ws = P.ws; float* out = P.out;
    const float* x_prompt = P.in[0]; const float* x_sample = P.in[1]; const float* state_pool = P.in[2]; const float* state_shift = P.in[3]; const float* state_wkv = P.in[4];
    const float* norm_mix = P.in[5]; const float* w_in = P.in[6]; const float* w_pool = P.in[7]; const float* pool_scale = P.in[8]; const float* mu_shift = P.in[9];
    const float* w0 = P.in[10]; const float* w2 = P.in[11]; const float* a0 = P.in[12]; const float* a2 = P.in[13]; const float* g2 = P.in[14];
    const float* k_k = P.in[15]; const float* k_a = P.in[16]; const float* r_k = P.in[17]; const float* gn_w = P.in[18]; const float* gn_b = P.in[19];
    const float* w_out = P.in[20]; const float* norm_ffn = P.in[21]; const float* w_gate = P.in[22]; const float* w_up = P.in[23]; const float* w_down = P.in[24]; const float* norm_final = P.in[25];
    bf16_t* WinT = (bf16_t*)(ws + WS_WIN); bf16_t* WoutT = (bf16_t*)(ws + WS_WOUT); bf16_t* WguT = (bf16_t*)(ws + WS_WGU); bf16_t* WdnT = (bf16_t*)(ws + WS_WDN);
    bf16_t* WpoolT = (bf16_t*)(ws + WS_WPOOL); bf16_t* WloraT = (bf16_t*)(ws + WS_WLORA);
    bf16_t* Hb = (bf16_t*)(ws + WS_R1); bf16_t* Xb = (bf16_t*)(ws + WS_R1); bf16_t* H2 = (bf16_t*)(ws + WS_R1);
    bf16_t* Proj = (bf16_t*)(ws + WS_PROJ); bf16_t* Ub = (bf16_t*)(ws + WS_PROJ); bf16_t* Ab = (bf16_t*)(ws + WS_A); bf16_t* Gb = (bf16_t*)(ws + WS_GATE);
    bf16_t* Mix = (bf16_t*)(ws + WS_MIX); float* rowsq1 = (float*)(ws + WS_ROWSQ); float* rowsq2 = rowsq1 + MPAD; unsigned* pcnt = (unsigned*)(ws + WS_PCNT); float* Bonus = (float*)(ws + WS_BONUS);
    unsigned* barctr = (unsigned*)(ws + WS_BAR);
    float* Yb = out + SCR_Y; float* Dec = out + SCR_DEC;
    float* Part6 = (float*)(ws + WS_A);
    float* Part8 = (float*)(ws + WS_R1);
    { LAS unsigned* st0 = (LAS unsigned*)(lds + LDS_ST_OFF); if (threadIdx.x < 2) st0[threadIdx.x] = 0u; }
    __syncthreads();
    const XcdBarrier xbar = xcd_barrier_post(barctr, (volatile LAS unsigned*)(lds + LDS_ST_OFF));
#ifndef P3SEL
#define P3SEL 15
#endif
#ifndef PHASE_MASK
#define PHASE_MASK 0x3ff
#endif
#define IN(k) (((PHASE_MASK >> (k)) & 1) && (!P.multi || P.phase == (k)))
#define SEAM() do { if (!P.multi) xcd_barrier(xbar); } while (0)

    if (IN(0)) {
        PHASE_IDS
        transpose_bf16<0>(w_in, D, PJ, PJ, WinT, D, PJP, 0, gwave, gwaves);
        for (int g = 0; g < 4; ++g) transpose_bf16<0>(w_pool + (size_t)g * 65536, 256, 256, 256, WpoolT + (size_t)g * 65536, 256, 256, 1280 + g * 16, gwave, gwaves);
        transpose_bf16<0>(w2, 64, CW, CW, WloraT, 256, CW, 1344, gwave, gwaves);
        transpose_bf16<0>(a2, 64, CW, CW, WloraT + (size_t)CW * 256, 256, CW, 1408, gwave, gwaves);
        transpose_bf16<0>(g2, 160, CW, CW, WloraT + (size_t)2 * CW * 256, 256, CW, 1472, gwave, gwaves);
        for (int i = gtid; i < 2 * MPAD; i += gthreads) rowsq1[i] = 0.f;
        for (int m = gwave; m < MPAD; m += gwaves) {
            bf16_t* hr = Hb + (size_t)m * D;
            if (m < MV) {
                const float* xr = m < MPR ? x_prompt + (size_t)m * D : x_sample + (size_t)(m - MPR) * D;
                f32x4 v[8]; float s = 0.f;
#pragma unroll
                for (int i = 0; i < 8; ++i) v[i] = *(const f32x4*)(xr + (i * 64 + lane) * 4);
#pragma unroll
                for (int i = 0; i < 8; ++i) s += (v[i][0] * v[i][0] + v[i][1] * v[i][1]) + (v[i][2] * v[i][2] + v[i][3] * v[i][3]);
                s = wsum(s); const float rstd = rsqrtf(s * (1.0f / D) + RMS_EPS);
#pragma unroll
                for (int i = 0; i < 8; ++i) { const int c = (i * 64 + lane) * 4; const f32x4 gg = *(const f32x4*)(norm_mix + c); const f32x4 o = v[i] * rstd * gg;
                    u32x2 w; w.x = pk_bf16(o[0], o[1]); w.y = pk_bf16(o[2], o[3]); *(u32x2*)(hr + c) = w; }
            } else {
#pragma unroll
                for (int i = 0; i < 8; ++i) *(u32x2*)(hr + (i * 64 + lane) * 4) = (u32x2){0u, 0u};
            }
        }
    }
    if (P.multi == 2) cg::this_grid().sync();
    SEAM();

    if (IN(1)) {
        PHASE_IDS
        pg8::Gemm g{Hb, WinT, D, D, D}; pg8::StaticOrder S; S.init(MPAD, PJP, G, bid);
        EpiBf16<0> E{Proj, PJP, 0, nullptr};
        pg8::gemm_phase(lds, g, S, E);
    }
    SEAM();

    if (IN(2)) {
        PHASE_IDS
        for (int rb = bid; rb < MPR / 16; rb += G) {
            const int b = rb >> 7, t0 = (rb & 127) * 16, c = tid * 2, gq = tid >> 7;
            if (gq == 0) pool_block_prompt<2>(Proj, Xb, b, t0, c);
            else if (gq == 1) pool_block_prompt<4>(Proj, Xb, b, t0, c);
            else if (gq == 2) pool_block_prompt<8>(Proj, Xb, b, t0, c);
            else pool_block_prompt<16>(Proj, Xb, b, t0, c);
        }
        for (int b = bid; b < MSA; b += G) {
            const int c = tid * 2, W = 2 << (tid >> 7);
            const unsigned v = *(const unsigned*)(Proj + (size_t)(MPR + b) * PJP + c); const float ux = bf2f(v & 0xffffu), uy = bf2f(v >> 16);
            f32x2 pr[15];
#pragma unroll
            for (int j = 0; j < 15; ++j) pr[j] = *(const f32x2*)(state_pool + ((size_t)b * 15 + j) * PW + c);
            float sx = ux, sy = uy;
#pragma unroll
            for (int j = 1; j < 16; ++j) { const float mk = j < W ? 1.f : 0.f; sx += pr[15 - j][0] * mk; sy += pr[15 - j][1] * mk; }
            const float inv = 1.0f / (float)W;
            *(unsigned*)(Xb + (size_t)(MPR + b) * XLD + c) = pk_bf16(sx * inv - ux, sy * inv - uy);
            float* np = out + OUT_POOLS + (size_t)b * 15 * PW;
#pragma unroll
            for (int j = 0; j < 14; ++j) *(f32x2*)(np + (size_t)j * PW + c) = pr[j + 1];
            *(f32x2*)(np + (size_t)14 * PW + c) = (f32x2){ux, uy};
        }
        {
            constexpr int NIT = MV * 144;
            for (int base = gtid; base < NIT; base += 5 * gthreads) {
                unsigned cv[5], pv[5]; f32x2 mu[5]; int mm[5], cpo[5], sg[5], pcs[5]; bool val[5];
#pragma unroll
                for (int u = 0; u < 5; ++u) {
                    const int idx = base + u * gthreads; val[u] = idx < NIT; const int id2 = val[u] ? idx : 0;
                    const int m = id2 / 144, jp = id2 - m * 144, seg = jp < 32 ? 0 : (jp < 64 ? 1 : 2);
                    const int j = (jp - (seg == 0 ? 0 : (seg == 1 ? 32 : 64))) * 2, pc = (seg == 0 ? 3072 : (seg == 1 ? 3136 : 3200)) + j;
                    mm[u] = m; sg[u] = seg; cpo[u] = seg * 256 + j; pcs[u] = pc;
                    const int mprev = (m >= MPR || (m & (TT - 1)) == 0) ? m : m - 1;
                    cv[u] = *(const unsigned*)(Proj + (size_t)m * PJP + PW + pc);
                    pv[u] = *(const unsigned*)(Proj + (size_t)mprev * PJP + PW + pc);
                    mu[u] = *(const f32x2*)(mu_shift + pc);
                }
#pragma unroll
                for (int u = 0; u < 5; ++u) {
                    const int m = mm[u]; const float cx = bf2f(cv[u] & 0xffffu), cy = bf2f(cv[u] >> 16);
                    const float fm = (m & (TT - 1)) == 0 ? 0.f : 1.f;
                    float px = bf2f(pv[u] & 0xffffu) * fm, py = bf2f(pv[u] >> 16) * fm;
                    if (m >= MPR) { const f32x2 p = *(const f32x2*)(state_shift + (size_t)(m - MPR) * SW + pcs[u]); px = p[0]; py = p[1]; }
                    float vx = cx + (px - cx) * mu[u][0], vy = cy + (py - cy) * mu[u][1];
                    if (sg[u] == 0) { vx = tanhf(vx); vy = tanhf(vy); } else if (sg[u] == 2) { vx = sigmoidf_(vx); vy = sigmoidf_(vy); }
                    if (val[u]) *(unsigned*)(Xb + (size_t)m * XLD + 1024 + cpo[u]) = pk_bf16(vx, vy);
                }
            }
        }
        for (int i = gtid; i < 4 * SW; i += gthreads) { const int b = i / SW, j = i - b * SW; out[OUT_SHIFTP + i] = bf2f(Proj[(size_t)(b * TT + TT - 1) * PJP + PW + j]); }
        for (int i = gtid; i < MSA * SW / 2; i += gthreads) { const int b = i / (SW / 2), j = (i - b * (SW / 2)) * 2; const unsigned v = *(const unsigned*)(Proj + (size_t)(MPR + b) * PJP + PW + j);
            *(f32x2*)(out + OUT_SHIFTS + (size_t)b * SW + j) = (f32x2){bf2f(v & 0xffffu), bf2f(v >> 16)}; }
        for (int i = gtid; i < 4 * 15 * PW; i += gthreads) { const int b = i / (15 * PW), r = i - b * 15 * PW, j = r / PW, c = r - j * PW; out[OUT_POOLP + i] = bf2f(Proj[(size_t)(b * TT + TT - 15 + j) * PJP + c]); }
    }
    SEAM();

    if (IN(3)) {
        PHASE_IDS
        { pg8::Gemm g{Xb, WpoolT, XLD, 256, 256}; pg8::P3Order S{G, bid};
          EpiP3 E{Mix, Dec, Ab, Gb, pool_scale, w0, a0}; pg8::gemm_phase(lds, g, S, E); }
    }
    SEAM();

    if (IN(4)) {
        PHASE_IDS
        LAS float* ldf = (LAS float*)lds;
        constexpr int REC = 392, TB = 16, NPS = TB / 4;
        for (int unit = bid; unit < 256; unit += G) {
            const int s = unit >> 2, b = s >> 4, h = s & 15, q = unit & 3;
            const int wv = __builtin_amdgcn_readfirstlane(tid >> 6);
            if (wv < 2) {
              const int crow = wv * 8 + (lane >> 3), kq = lane & 7; const bool first8 = kq == 0;
              f32x2 S2[4];
#pragma unroll
              for (int e = 0; e < 4; ++e) S2[e] = (f32x2){0.f, 0.f};
              const LAS float* recq0 = ldf + kq * 8; const LAS float* recv0 = ldf + 320 + q * 16 + crow;
              float* yp = Yb + (size_t)(b * TT + 7 - kq) * CW + h * 64 + q * 16 + crow;
              __builtin_amdgcn_s_setprio(3);
              WG_BAR();
              for (int blk = 0; blk < TT / TB; ++blk) {
                    const int bo = (blk & 1) * (TB * REC);
                    const LAS float* recq = recq0 + bo; const LAS float* recv = recv0 + bo; const LAS float* recs = ldf + bo + 384;
#define LDSTEP(o_, A0, A1, B0, B1, D0, D1, K0, K1, W0, W1, VV, SC) do { A0 = *(const LAS f32x4*)(recq + (o_)); A1 = *(const LAS f32x4*)(recq + (o_) + 4); B0 = *(const LAS f32x4*)(recq + (o_) + 64); B1 = *(const LAS f32x4*)(recq + (o_) + 68); \
                        D0 = *(const LAS f32x4*)(recq + (o_) + 128); D1 = *(const LAS f32x4*)(recq + (o_) + 132); K0 = *(const LAS f32x4*)(recq + (o_) + 192); K1 = *(const LAS f32x4*)(recq + (o_) + 196); \
                        W0 = *(const LAS f32x4*)(recq + (o_) + 256); W1 = *(const LAS f32x4*)(recq + (o_) + 260); VV = recv[(o_)]; SC = *(const LAS f32x2*)(recs + (o_)); } while (0)
                    f32x4 av0, av1, bv0, bv1, dw0, dw1, kt0, kt1, wr0, wr1; float vv; f32x2 sc;
                    f32x4 nav0, nav1, nbv0, nbv1, ndw0, ndw1, nkt0, nkt1, nwr0, nwr1; float nvv; f32x2 nsc;
                    f32x4 a0, a1, b0, b1, d0, d1, k0, k1, w0_, w1_; float vv_; f32x2 sc_;
                    LDSTEP(0, a0, a1, b0, b1, d0, d1, k0, k1, w0_, w1_, vv_, sc_);
                    LDSTEP(REC, av0, av1, bv0, bv1, dw0, dw1, kt0, kt1, wr0, wr1, vv, sc);
                    float yacc = 0.f;
#pragma unroll
                    for (int st = 0; st < TB; ++st) {
                        if (st + 2 < TB) LDSTEP((st + 2) * REC, nav0, nav1, nbv0, nbv1, ndw0, ndw1, nkt0, nkt1, nwr0, nwr1, nvv, nsc);
                        __builtin_amdgcn_sched_barrier(0);
                        const f32x2 pa = pkfma_(S2[3], hi2(a1), pkfma_(S2[2], lo2(a1), pkfma_(S2[1], hi2(a0), pkmul_(S2[0], lo2(a0)))));
                        const f32x2 py = pkfma_(S2[3], hi2(w1_), pkfma_(S2[2], lo2(w1_), pkfma_(S2[1], hi2(w0_), pkmul_(S2[0], lo2(w0_)))));
                        float da = pa[0] + pa[1], dy = py[0] + py[1];
                        da = red8(da); dy = red8(dy);
                        const float y = dy + da * sc_[0] + vv_ * sc_[1];
                        { f32x2 dab, vvb; dab[0] = da; dab[1] = da; vvb[0] = vv_; vvb[1] = vv_;
                          S2[0] = pkfma_b(lo2(k0), vvb, pkfma_b(lo2(b0), dab, pkmul_(S2[0], lo2(d0)))); S2[1] = pkfma_b(hi2(k0), vvb, pkfma_b(hi2(b0), dab, pkmul_(S2[1], hi2(d0))));
                          S2[2] = pkfma_b(lo2(k1), vvb, pkfma_b(lo2(b1), dab, pkmul_(S2[2], lo2(d1)))); S2[3] = pkfma_b(hi2(k1), vvb, pkfma_b(hi2(b1), dab, pkmul_(S2[3], hi2(d1)))); }
                        const float sh = __int_as_float(__builtin_amdgcn_update_dpp(__float_as_int(y), __float_as_int(yacc), 0x111, 0xF, 0xF, false));
                        yacc = first8 ? y : sh;
                        if ((st & 7) == 7) yp[(size_t)(blk * TB + (st - 7)) * CW] = yacc;
                        a0 = av0; a1 = av1; b0 = bv0; b1 = bv1; d0 = dw0; d1 = dw1; k0 = kt0; k1 = kt1; w0_ = wr0; w1_ = wr1; vv_ = vv; sc_ = sc;
                        av0 = nav0; av1 = nav1; bv0 = nbv0; bv1 = nbv1; dw0 = ndw0; dw1 = ndw1; kt0 = nkt0; kt1 = nkt1; wr0 = nwr0; wr1 = nwr1; vv = nvv; sc = nsc;
                        asm volatile("" ::: "memory");
                    }
#undef LDSTEP
                    WG_BAR();
              }
              __builtin_amdgcn_s_setprio(0);
              float* so = out + OUT_WKVP + ((size_t)(b * NH + h) * 64 + q * 16 + crow) * 64 + kq * 8;
              *(f32x4*)so = (f32x4){S2[0][0], S2[0][1], S2[1][0], S2[1][1]}; *(f32x4*)(so + 4) = (f32x4){S2[2][0], S2[2][1], S2[3][0], S2[3][1]};
            } else if (wv == 4 || wv == 5) {
              constexpr int CT_PER = 5632, CT_ALL = 3 * CT_PER + 2048;
              float cvv[32]; int ctile = unit * 2 + (wv - 4), cph = 0;
#define CONV_LOAD16(P0_) do { if (ctile < CT_ALL) { const int m_ = ctile / CT_PER, r_ = ctile - m_ * CT_PER; const float* sp_; unsigned ld_; \
                    if (m_ < 2) { sp_ = (m_ == 0 ? w_gate : w_up) + (size_t)((r_ / 88) * 32) * DFF + (r_ % 88) * 64; ld_ = DFF; } \
                    else { sp_ = (m_ == 2 ? w_down : w_out) + (size_t)((r_ >> 5) * 32) * D + (r_ & 31) * 64; ld_ = D; } \
                    _Pragma("unroll") for (int j_ = (P0_); j_ < (P0_) + 16; ++j_) cvv[j_] = sp_[(unsigned)j_ * ld_ + lane]; } } while (0)
#define CONV_STORE() do { if (ctile < CT_ALL) { const int m_ = ctile / CT_PER, r_ = ctile - m_ * CT_PER; bf16_t* dp_; \
                    if (m_ < 2) { const int k0_ = (r_ / 88) * 32, n_ = (r_ % 88) * 64 + lane; dp_ = WguT + (size_t)((n_ >> 7) * 256 + (m_ == 1 ? 128 : 0) + (n_ & 127)) * D + k0_; } \
                    else { const int k0_ = (r_ >> 5) * 32, n_ = (r_ & 31) * 64 + lane; dp_ = m_ == 2 ? WdnT + (size_t)n_ * DFF + k0_ : WoutT + (size_t)n_ * D + k0_; } \
                    _Pragma("unroll") for (int q8_ = 0; q8_ < 4; ++q8_) { u32x4 w_; w_.x = pk_bf16(cvv[q8_ * 8 + 0], cvv[q8_ * 8 + 1]); w_.y = pk_bf16(cvv[q8_ * 8 + 2], cvv[q8_ * 8 + 3]); \
                        w_.z = pk_bf16(cvv[q8_ * 8 + 4], cvv[q8_ * 8 + 5]); w_.w = pk_bf16(cvv[q8_ * 8 + 6], cvv[q8_ * 8 + 7]); *(u32x4*)(dp_ + q8_ * 8) = w_; } \
                    ctile += 512; } } while (0)
              WG_BAR();
              for (int blk = 0; blk < TT / TB; ++blk) {
                if (cph == 0) CONV_LOAD16(0); else if (cph == 1) CONV_LOAD16(16); else CONV_STORE();
                cph = cph == 2 ? 0 : cph + 1;
                WG_BAR();
              }
              while (ctile < CT_ALL) {
                if (cph <= 0) CONV_LOAD16(0);
                if (cph <= 1) CONV_LOAD16(16);
                CONV_STORE(); cph = 0;
              }
#undef CONV_LOAD16
#undef CONV_STORE
            } else {
              const int pw = (wv & 1) + ((wv >> 2) << 1), ch = h * 64 + lane;
              const float c_kk = k_k[ch], c_ka = k_a[ch], c_rk = r_k[ch], mu_r = mu_shift[ch], mu_k = mu_shift[CW + ch], mu_v = mu_shift[2 * CW + ch];
              const bf16_t* pbase = Proj + (size_t)(b * TT) * PJP + PW + h * 64; const float* dbase = Dec + (size_t)(b * TT) * CW + h * 64; const bf16_t* abase = Ab + (size_t)(b * TT) * CW + h * 64;
              constexpr int PD = 4;
              unsigned short rr[PD][NPS + 1], kr_[PD][NPS + 1], vr[PD][NPS + 1], aa[PD][NPS]; float dd[PD][NPS];
#define SCAN_LOAD(blk, SET) do { const int t0_ = (blk) * TB + pw * NPS; \
            _Pragma("unroll") for (int i_ = 0; i_ < NPS + 1; ++i_) { const unsigned t_ = (unsigned)((i_ == 0 && t0_ == 0) ? 0 : t0_ - 1 + i_); const bf16_t* pp_ = pbase + t_ * (unsigned)PJP; \
                rr[SET][i_] = pp_[lane]; kr_[SET][i_] = pp_[CW + lane]; vr[SET][i_] = pp_[2 * CW + lane]; } \
            _Pragma("unroll") for (int i_ = 0; i_ < NPS; ++i_) { const unsigned mi_ = (unsigned)(t0_ + i_) * (unsigned)CW; dd[SET][i_] = dbase[mi_ + lane]; aa[SET][i_] = abase[mi_ + lane]; } } while (0)
#define SCAN_PRODUCE(blk, SET) do { LAS float* bufp_ = ldf + ((blk) & 1) * (TB * REC); const int t0_ = (blk) * TB + pw * NPS; \
            _Pragma("unroll") for (int i_ = 0; i_ < NPS; ++i_) { \
                const float zz_ = (i_ == 0 && t0_ == 0) ? 0.f : 1.f; \
                const float rc_ = bf2f(rr[SET][i_ + 1]), kc_ = bf2f(kr_[SET][i_ + 1]), vc_ = bf2f(vr[SET][i_ + 1]), rp_ = bf2f(rr[SET][i_]) * zz_, kp_ = bf2f(kr_[SET][i_]) * zz_, vp_ = bf2f(vr[SET][i_]) * zz_; \
                const float r_ = rc_ + (rp_ - rc_) * mu_r, k_ = kc_ + (kp_ - kc_) * mu_k, v_ = vc_ + (vp_ - vc_) * mu_v; \
                const float a_ = bf2f(aa[SET][i_]), d_ = dd[SET][i_]; \
                const float kkr_ = k_ * c_kk; const float n2_ = wsum(kkr_ * kkr_); const float kk_ = kkr_ * rsqrtf(fmaxf(n2_, 1e-24f)); \
                const float kt_ = k_ * (1.0f + (a_ - 1.0f) * c_ka); const float bv_ = kk_ * a_; \
                const float br_ = wsum(bv_ * r_), krs_ = wsum(kt_ * r_), bon_ = wsum(r_ * kt_ * c_rk); \
                LAS float* rec_ = bufp_ + (pw * NPS + i_) * REC; \
                rec_[lane] = -kk_; rec_[64 + lane] = bv_; rec_[128 + lane] = d_; rec_[192 + lane] = kt_; rec_[256 + lane] = d_ * r_; rec_[320 + lane] = v_; \
                if (lane == 0) { rec_[384] = br_; rec_[385] = krs_; if (q == 0) Bonus[(size_t)(b * TT + t0_ + i_) * NH + h] = bon_; } } } while (0)
              SCAN_LOAD(0, 0); SCAN_LOAD(1, 1); SCAN_LOAD(2, 2); SCAN_LOAD(3, 3);
              SCAN_PRODUCE(0, 0); SCAN_LOAD(4, 0);
              WG_BAR();
              static_assert((TT / TB) % PD == 0 && PD == 4, "block loop is unrolled by PD = 4");
              for (int blk0 = 0; blk0 < TT / TB; blk0 += PD) {
#define SCAN_ITER(D_, SET) do { const int blk = blk0 + (D_); if (blk + 1 < TT / TB) { SCAN_PRODUCE(blk + 1, SET); if (blk + 1 + PD < TT / TB) SCAN_LOAD(blk + 1 + PD, SET); } WG_BAR(); } while (0)
                SCAN_ITER(0, 1); SCAN_ITER(1, 2); SCAN_ITER(2, 3); SCAN_ITER(3, 0);
#undef SCAN_ITER
              }
            }
#undef SCAN_LOAD
#undef SCAN_PRODUCE
        }
        __syncthreads();
        LAS float* wl = ldf + wave * 512;
        for (int p = gwave; p < MSA * NH; p += gwaves) {
            const int b = p >> 4, h = p & 15, m = MPR + b, ch = h * 64 + lane;
            const bf16_t* pp = Proj + (size_t)m * PJP + PW + ch; const float* sp = state_shift + (size_t)b * SW + ch;
            const float rc = bf2f(pp[0]), kc = bf2f(pp[CW]), vc = bf2f(pp[2 * CW]);
            const float r = rc + (sp[0] - rc) * mu_shift[ch], k = kc + (sp[CW] - kc) * mu_shift[CW + ch], v = vc + (sp[2 * CW] - vc) * mu_shift[2 * CW + ch];
            const float d = Dec[(size_t)m * CW + ch], a = bf2f(Ab[(size_t)m * CW + ch]);
            const float kkr = k * k_k[ch]; const float n2 = wsum(kkr * kkr); const float kk = kkr * rsqrtf(fmaxf(n2, 1e-24f));
            const float kt = k * (1.0f + (a - 1.0f) * k_a[ch]);
            const float bon = wsum(r * kt * r_k[ch]);
            wl[lane] = -kk; wl[64 + lane] = kk * a; wl[128 + lane] = d; wl[192 + lane] = kt; wl[256 + lane] = r; wl[320 + lane] = v;
            asm volatile("s_waitcnt lgkmcnt(0)" ::: "memory");
            const int kq = lane & 15, r4 = lane >> 4;
            const f32x4 av = *(const LAS f32x4*)(wl + kq * 4), bv = *(const LAS f32x4*)(wl + 64 + kq * 4), dw = *(const LAS f32x4*)(wl + 128 + kq * 4);
            const f32x4 ktv = *(const LAS f32x4*)(wl + 192 + kq * 4), rv = *(const LAS f32x4*)(wl + 256 + kq * 4);
            const float* sin_ = state_wkv + (size_t)(b * NH + h) * 4096; float* sout = out + OUT_WKVS + (size_t)(b * NH + h) * 4096;
#pragma unroll 4
            for (int j = 0; j < 16; ++j) {
                const int row = r4 + 4 * j; f32x4 Sv = *(const f32x4*)(sin_ + row * 64 + kq * 4);
                float da = (Sv[0] * av[0] + Sv[1] * av[1]) + (Sv[2] * av[2] + Sv[3] * av[3]); da = red16(da);
                const float vv = wl[320 + row];
                Sv = Sv * dw + da * bv + vv * ktv;
                *(f32x4*)(sout + row * 64 + kq * 4) = Sv;
                float dy = (Sv[0] * rv[0] + Sv[1] * rv[1]) + (Sv[2] * rv[2] + Sv[3] * rv[3]); dy = red16(dy);
                if (kq == 0) wl[384 + row] = dy;
            }
            asm volatile("s_waitcnt lgkmcnt(0)" ::: "memory");
            const float y = wl[384 + lane];
            const float mean = wsum(y) * (1.0f / 64.0f); const float dl = y - mean; const float var = wsum(dl * dl) * (1.0f / 64.0f);
            const float yn = dl * rsqrtf(var + GN_EPS) * gn_w[ch] + gn_b[ch];
            const float o = (yn + bon * v) * bf2f(Gb[(size_t)m * CW + ch]);
            Mix[(size_t)m * D + PW + ch] = (bf16_t)f2bf(o);
            asm volatile("s_waitcnt lgkmcnt(0)" ::: "memory");
        }
    }
    SEAM();

    if (IN(5)) {
        PHASE_IDS
        { pg8::Gemm g{Mix, WoutT, D, D, 256}; pg8::SplitKOrder S{8, KS6, 32, 256, G, (bid + G - 192 % G) % G};
          EpiPartial E{Part6}; pg8::gemm_phase(lds, g, S, E); }
        {
            const int half = gwave & 1, ch0 = half * 512 + lane * 8, h = ch0 >> 6;
            const f32x4 mu0 = *(const f32x4*)(mu_shift + 2 * CW + ch0), mu1 = *(const f32x4*)(mu_shift + 2 * CW + ch0 + 4);
            const f32x4 gw0 = *(const f32x4*)(gn_w + ch0), gw1 = *(const f32x4*)(gn_w + ch0 + 4), gb0 = *(const f32x4*)(gn_b + ch0), gb1 = *(const f32x4*)(gn_b + ch0 + 4);
            for (int it0 = gwave; it0 < MPR * 2; it0 += 2 * gwaves) {
                f32x4 y0[2], y1[2]; u32x4 vc[2], vp[2], gt[2]; float bon[2]; int mm[2]; bool val[2];
#pragma unroll
                for (int u = 0; u < 2; ++u) {
                    const int it = it0 + u * gwaves; val[u] = it < MPR * 2; const int m = val[u] ? (it >> 1) : 0; mm[u] = m;
                    const int mprev = (m & (TT - 1)) ? m - 1 : m;
                    y0[u] = *(const f32x4*)(Yb + (size_t)m * CW + ch0); y1[u] = *(const f32x4*)(Yb + (size_t)m * CW + ch0 + 4);
                    vc[u] = *(const u32x4*)(Proj + (size_t)m * PJP + PW + 2 * CW + ch0); vp[u] = *(const u32x4*)(Proj + (size_t)mprev * PJP + PW + 2 * CW + ch0);
                    gt[u] = *(const u32x4*)(Gb + (size_t)m * CW + ch0); bon[u] = Bonus[(size_t)m * NH + h];
                }
#pragma unroll
                for (int u = 0; u < 2; ++u) {
                    const int m = mm[u]; const float fm = (m & (TT - 1)) == 0 ? 0.f : 1.f;
                    float y[8] = {y0[u][0], y0[u][1], y0[u][2], y0[u][3], y1[u][0], y1[u][1], y1[u][2], y1[u][3]};
                    float s = ((y[0] + y[1]) + (y[2] + y[3])) + ((y[4] + y[5]) + (y[6] + y[7])); s = red8(s);
                    const float mean = s * (1.0f / 64.0f); float q2 = 0.f;
#pragma unroll
                    for (int j = 0; j < 8; ++j) { y[j] -= mean; q2 += y[j] * y[j]; }
                    q2 = red8(q2); const float rstd = rsqrtf(q2 * (1.0f / 64.0f) + GN_EPS);
                    unsigned ow[4];
#pragma unroll
                    for (int j2 = 0; j2 < 4; ++j2) {
                        float o2[2];
#pragma unroll
                        for (int e = 0; e < 2; ++e) {
                            const int j = j2 * 2 + e; const unsigned cw = vc[u][j2], pw_ = vp[u][j2], gw_ = gt[u][j2];
                            const float c_ = e ? bf2f(cw >> 16) : bf2f(cw & 0xffffu), p_ = fm * (e ? bf2f(pw_ >> 16) : bf2f(pw_ & 0xffffu)), g_ = e ? bf2f(gw_ >> 16) : bf2f(gw_ & 0xffffu);
                            const float mu_ = j < 4 ? mu0[j & 3] : mu1[j & 3], gnw = j < 4 ? gw0[j & 3] : gw1[j & 3], gnb = j < 4 ? gb0[j & 3] : gb1[j & 3];
                            const float v = c_ + (p_ - c_) * mu_;
                            o2[e] = (y[j] * rstd * gnw + gnb + bon[u] * v) * g_;
                        }
                        ow[j2] = pk_bf16(o2[0], o2[1]);
                    }
                    if (val[u]) *(u32x4*)(Mix + (size_t)m * D + PW + ch0) = (u32x4){ow[0], ow[1], ow[2], ow[3]};
                }
            }
        }
    }
    SEAM();

    if (IN(6)) {
        PHASE_IDS
        pg8::Gemm g{Mix, WoutT, D, D, D}; pg8::StaticOrder S; S.init(MPR, D, G, bid);
        EpiOut E{x_prompt, x_sample, out, H2, norm_ffn, rowsq1};
        pg8::gemm_phase(lds, g, S, E);
        for (int r = gwave; r < MSA; r += gwaves) {
            const int row = MPR + r; float s = 0.f;
#pragma unroll
            for (int i = 0; i < 8; ++i) {
                const int c = (i * 64 + lane) * 4; f32x4 x1 = *(const f32x4*)(x_sample + (size_t)r * D + c);
#pragma unroll
                for (int ks = 0; ks < KS6; ++ks) x1 = x1 + *(const f32x4*)(Part6 + ((size_t)ks * MSA + r) * D + c);
                *(f32x4*)(out + (size_t)row * D + c) = x1;
                s += (x1[0] * x1[0] + x1[1] * x1[1]) + (x1[2] * x1[2] + x1[3] * x1[3]);
                const f32x4 hv = x1 * *(const f32x4*)(norm_ffn + c);
                u32x2 w; w.x = pk_bf16(hv[0], hv[1]); w.y = pk_bf16(hv[2], hv[3]); *(u32x2*)(H2 + (size_t)row * D + c) = w;
            }
            s = wsum(s); if (lane == 0) rowsq1[row] = s;
        }
    }
    SEAM();

    if (IN(7)) {
        PHASE_IDS
        pg8::Gemm g{H2, WguT, D, D, D}; pg8::StaticOrder S; S.init(MPAD, 2 * DFF, G, bid);
        EpiGU E{Ub, rowsq1};
        pg8::gemm_phase(lds, g, S, E);
    }
    SEAM();

    if (IN(8)) {
        PHASE_IDS
        if (G == 256) { pg8::Gemm g{Ub, WdnT, DFF, DFF, DFF}; pg8::StaticOrder S; S.init(MPR, D, G, bid);
          EpiDownNorm E{out, rowsq2, pcnt, norm_final}; pg8::gemm_phase(lds, g, S, E); }
        else { pg8::Gemm g{Ub, WdnT, DFF, DFF, DFF}; pg8::StaticOrder S; S.init(MPR, D, G, bid);
          EpiDown E{out}; pg8::gemm_phase(lds, g, S, E); }
        { pg8::Gemm g{Ub, WdnT, DFF, DFF, 512}; pg8::SplitKOrder S{8, KS8, 32, 512, G, bid};
          EpiPartial E{Part8}; pg8::gemm_phase(lds, g, S, E); }
    }
    SEAM();

    if (IN(9)) {
        PHASE_IDS
        for (int row = (G == 256 ? MPR : 0) + gwave; row < MV; row += gwaves) {
            float* p = out + (size_t)row * D; f32x4 v[8]; float s = 0.f;
#pragma unroll
            for (int i = 0; i < 8; ++i) v[i] = *(const f32x4*)(p + (i * 64 + lane) * 4);
            if (row >= MPR) {
#pragma unroll
                for (int i = 0; i < 8; ++i)
#pragma unroll
                    for (int ks = 0; ks < KS8; ++ks) v[i] = v[i] + *(const f32x4*)(Part8 + ((size_t)ks * MSA + (row - MPR)) * D + (i * 64 + lane) * 4);
            }
#pragma unroll
            for (int i = 0; i < 8; ++i) s += (v[i][0] * v[i][0] + v[i][1] * v[i][1]) + (v[i][2] * v[i][2] + v[i][3] * v[i][3]);
            s = wsum(s); const float rstd = rsqrtf(s * (1.0f / D) + RMS_EPS);
#pragma unroll
            for (int i = 0; i < 8; ++i) { const int c = (i * 64 + lane) * 4; *(f32x4*)(p + c) = v[i] * rstd * *(const f32x4*)(norm_final + c); }
        }
    }
#undef IN
#undef SEAM
}

#ifndef HY_MULTI
#define HY_MULTI 0
#endif
#ifndef HY_REP
#define HY_REP 0
#endif
extern "C" void kernel_launch(void* const* d_in, const int* in_sizes, int n_in, void* d_out, int out_size, void* d_ws, size_t ws_size, hipStream_t stream) {
    static int grid = 0;
    if (grid == 0) {
        if (n_in != 26 || ws_size < WS_END) { fprintf(stderr, "kernel_launch: need 26 inputs and >= %zu bytes of workspace (got %d, %zu)\n", (size_t)WS_END, n_in, ws_size); grid = -1; return; }
        int dev = 0, cus = 0, per_cu = 0;
        hipGetDevice(&dev); hipDeviceGetAttribute(&cus, hipDeviceAttributeMultiprocessorCount, dev);
        if (hipFuncSetAttribute((const void*)hymba_fwd, hipFuncAttributeMaxDynamicSharedMemorySize, LDS_BYTES) != hipSuccess) { fprintf(stderr, "kernel_launch: hipFuncSetAttribute failed\n"); grid = -1; return; }
        if (hipOccupancyMaxActiveBlocksPerMultiprocessor(&per_cu, (const void*)hymba_fwd, NTHR, LDS_BYTES) != hipSuccess || per_cu < 1) { fprintf(stderr, "kernel_launch: occupancy query says %d\n", per_cu); per_cu = 1; }
        (void)hipGetLastError();
        grid = cus;
        if (grid > 256) grid = 256;
    }
    if (grid < 0) return;
    Params p{};
    for (int i = 0; i < 26; ++i) p.in[i] = (const float*)d_in[i];
    p.out = (float*)d_out; p.ws = (unsigned char*)d_ws;
#if HY_MULTI
    p.multi = 1;
    for (int ph = 0; ph < 10; ++ph) { p.phase = ph; for (int r = 0; r < ((HY_REP >> ph) & 1) + 1; ++r) hipLaunchKernelGGL(hymba_fwd, dim3(grid), dim3(NTHR), LDS_BYTES, stream, p); }
#else
    p.multi = 0; p.phase = 0;
    hipMemsetAsync((char*)d_ws + WS_BAR, 0, 16384 + 8192, stream);
    void* args[] = {&p};
    hipError_t e = hipLaunchCooperativeKernel((const void*)hymba_fwd, dim3(grid), dim3(NTHR), args, LDS_BYTES, stream);
    if (e != hipSuccess) fprintf(stderr, "cooperative launch failed: %s (grid %d)\n", hipGetErrorString(e), grid);
#endif
}
```

```cpp
#include <hip/hip_runtime.h>
#include <hip/hip_cooperative_groups.h>
#include <cstdio>
namespace cg = cooperative_groups;

#define LAS __attribute__((address_space(3)))
typedef unsigned short bf16_t;
typedef short bf16x8 __attribute__((ext_vector_type(8)));
typedef float f32x4 __attribute__((ext_vector_type(4)));
typedef float f32x2 __attribute__((ext_vector_type(2)));
typedef unsigned u32x4 __attribute__((ext_vector_type(4)));
typedef unsigned u32x2 __attribute__((ext_vector_type(2)));

constexpr int D = 2048, TT = 2048, MPR = 8192, MSA = 128, MV = 8320, MPAD = 8448;
constexpr int PW = 1024, SW = 3360, PJ = 4384, PJP = 4608, DFF = 5632, CW = 1024, NH = 16;
constexpr int NTHR = 512, LDS_BYTES = 131072 + 16, LDS_ST_OFF = 131072;
constexpr float RMS_EPS = 1e-6f, GN_EPS = 64e-5f;

constexpr size_t WS_WIN = 0;
constexpr size_t WS_WOUT = WS_WIN + (size_t)PJP * D * 2;
constexpr size_t WS_WGU = WS_WOUT + (size_t)D * D * 2;
constexpr size_t WS_WDN = WS_WGU + (size_t)2 * DFF * D * 2;
constexpr size_t WS_WPOOL = WS_WDN + (size_t)D * DFF * 2;
constexpr size_t WS_WLORA = WS_WPOOL + (size_t)4 * 256 * 256 * 2;
constexpr size_t WS_R1 = WS_WLORA + (size_t)3 * 1024 * 256 * 2;
constexpr size_t WS_PROJ = WS_R1 + (size_t)MPAD * D * 2;
constexpr size_t WS_A = WS_PROJ + (size_t)MPAD * PJP * 2;
constexpr size_t WS_GATE = WS_A + (size_t)MPAD * CW * 2;
constexpr size_t WS_MIX = WS_GATE + (size_t)MPAD * CW * 2;
constexpr size_t WS_ROWSQ = WS_MIX + (size_t)MPAD * D * 2;
constexpr size_t WS_BONUS = WS_ROWSQ + (size_t)2 * MPAD * 4;
constexpr size_t WS_BAR = WS_BONUS + (size_t)MV * NH * 4;
constexpr size_t WS_PCNT = WS_BAR + 16384;
constexpr size_t WS_END = WS_PCNT + 8192;
static_assert((size_t)MPAD * DFF * 2 <= (WS_MIX - WS_PROJ), "U must fit in proj+a+gate");
constexpr int XLD = 1792;
static_assert((size_t)MPAD * XLD * 2 <= (size_t)MPAD * D * 2, "X fits in WS_R1");
constexpr int KS6 = 8, KS8 = 11;
static_assert((size_t)KS6 * MSA * D * 4 <= (size_t)MPAD * CW * 2 && (size_t)KS8 * MSA * D * 4 <= (size_t)MPAD * D * 2, "partial buffers alias WS_A / WS_R1");

constexpr size_t OUT_Y = 0;
constexpr size_t OUT_POOLP = (size_t)MV * D;
constexpr size_t OUT_SHIFTP = OUT_POOLP + (size_t)4 * 15 * PW;
constexpr size_t OUT_WKVP = OUT_SHIFTP + (size_t)4 * SW;
constexpr size_t OUT_POOLS = OUT_WKVP + (size_t)4 * NH * 64 * 64;
constexpr size_t OUT_SHIFTS = OUT_POOLS + (size_t)MSA * 15 * PW;
constexpr size_t OUT_WKVS = OUT_SHIFTS + (size_t)MSA * SW;
constexpr size_t SCR_Y = 0;
constexpr size_t SCR_DEC = (size_t)MPR * CW;
static_assert(SCR_DEC + (size_t)MV * CW <= OUT_POOLP, "scratch must fit in the y region");

struct Params { const float* in[26]; float* out; unsigned char* ws; int multi; int phase; };

__device__ __forceinline__ float bf2f(unsigned b) { return __uint_as_float(b << 16); }
__device__ __forceinline__ unsigned f2bf(float f) { unsigned u = __float_as_uint(f); u += 0x7FFFu + ((u >> 16) & 1u); return u >> 16; }
__device__ __forceinline__ unsigned pk_bf16(float lo, float hi) { unsigned r; asm volatile("v_cvt_pk_bf16_f32 %0, %1, %2" : "=v"(r) : "v"(lo), "v"(hi)); return r; }
template <int CTRL> __device__ __forceinline__ float dpp(float x) { return __int_as_float(__builtin_amdgcn_update_dpp(0, __float_as_int(x), CTRL, 0xF, 0xF, true)); }
__device__ __forceinline__ float red16(float x) {
    x += dpp<0x128>(x); x += dpp<0x124>(x); x += dpp<0x4E>(x); x += dpp<0xB1>(x); return x;
}
__device__ __forceinline__ float wsum(float x) {
    x = red16(x);
    x += __int_as_float(__builtin_amdgcn_update_dpp(0, __float_as_int(x), 0x142, 0xA, 0xF, false));
    x += __int_as_float(__builtin_amdgcn_update_dpp(0, __float_as_int(x), 0x143, 0xC, 0xF, false));
    return __int_as_float(__builtin_amdgcn_readlane(__float_as_int(x), 63));
}
__device__ __forceinline__ float fma_(float a, float b, float c) { float d; asm("v_fma_f32 %0, %1, %2, %3" : "=v"(d) : "v"(a), "v"(b), "v"(c)); return d; }
__device__ __forceinline__ f32x2 pkmul_(f32x2 a, f32x2 b) { f32x2 d; asm("v_pk_mul_f32 %0, %1, %2" : "=v"(d) : "v"(a), "v"(b)); return d; }
__device__ __forceinline__ f32x2 pkfma_(f32x2 a, f32x2 b, f32x2 c) { f32x2 d; asm("v_pk_fma_f32 %0, %1, %2, %3" : "=v"(d) : "v"(a), "v"(b), "v"(c)); return d; }
__device__ __forceinline__ f32x2 pkfma_b(f32x2 a, f32x2 s, f32x2 c) { f32x2 d; asm("v_pk_fma_f32 %0, %1, %2, %3 op_sel_hi:[1,0,1]" : "=v"(d) : "v"(a), "v"(s), "v"(c)); return d; }
__device__ __forceinline__ f32x2 lo2(f32x4 v) { return __builtin_shufflevector(v, v, 0, 1); }
__device__ __forceinline__ f32x2 hi2(f32x4 v) { return __builtin_shufflevector(v, v, 2, 3); }
__device__ __forceinline__ float mul_(float a, float b) { float d; asm("v_mul_f32 %0, %1, %2" : "=v"(d) : "v"(a), "v"(b)); return d; }
__device__ __forceinline__ float sigmoidf_(float x) { return 1.0f / (1.0f + __expf(-x)); }

#define WG_BAR() do { asm volatile("s_waitcnt lgkmcnt(0)" ::: "memory"); __builtin_amdgcn_s_barrier(); asm volatile("" ::: "memory"); } while (0)

#define XB_TMO      128
#define XB_XCNT(j)  (256  + 64 * (j))
#define XB_XSUB(j)  (1280 + 64 * (j))
#define XB_XGEN(j)  (2304 + 64 * (j))
#define XB_TOP      3328
#define XB_TOPGEN   3392
#define XCD_BAR_WORDS 3456
#define XB_SPIN_CAP (1u << 18)

__device__ __forceinline__ unsigned xb_ld(unsigned* p)              { return __hip_atomic_load(p, __ATOMIC_RELAXED, __HIP_MEMORY_SCOPE_AGENT); }
__device__ __forceinline__ unsigned xb_add(unsigned* p, unsigned v) { return __hip_atomic_fetch_add(p, v, __ATOMIC_RELAXED, __HIP_MEMORY_SCOPE_AGENT); }
__device__ __forceinline__ unsigned xb_xcc_id() { return (unsigned)__builtin_amdgcn_s_getreg((3 << 11) | 20) & 0xFu; }
#define XB_SPIN(cond, bar) do { unsigned _sp = 0; while (cond) { __builtin_amdgcn_s_sleep(1); \
    if ((++_sp & 255u) == 0u) { if (xb_ld(&(bar)[XB_TMO])) break; if (_sp > XB_SPIN_CAP) { atomicAdd(&(bar)[XB_TMO], 1u); break; } } } } while (0)

struct XcdBarrier {
    unsigned* bar; unsigned x;
    volatile LAS unsigned* st;
};

__device__ __forceinline__ XcdBarrier xcd_barrier_post(unsigned* bar, volatile LAS unsigned* st) {
    XcdBarrier b; b.bar = bar; b.x = xb_xcc_id(); b.st = st;
    if (threadIdx.x == 0) (void)xb_add(&bar[XB_XCNT(b.x)], 1u);
    return b;
}
__device__ __forceinline__ void xcd_barrier_complete(unsigned* bar, unsigned x, unsigned& nloc, unsigned& nx) {
    const unsigned G = gridDim.x * gridDim.y * gridDim.z;
    unsigned sum, cnt, mine, sp = 0u;
    for (;;) {
        sum = 0u; cnt = 0u; mine = 0u;
#pragma unroll
        for (unsigned j = 0; j < 16; ++j) { const unsigned c = xb_ld(&bar[XB_XCNT(j)]); sum += c; cnt += (c > 0u) ? 1u : 0u; mine = (j == x) ? c : mine; }
        if (sum == G) break;
        __builtin_amdgcn_s_sleep(1);
        if ((++sp & 255u) == 0u) { if (xb_ld(&bar[XB_TMO])) break; if (sp > XB_SPIN_CAP) { atomicAdd(&bar[XB_TMO], 1u); break; } }
    }
    nloc = mine > 0u ? mine : 1u; nx = cnt > 0u ? cnt : 1u;
}

__device__ __forceinline__ void xcd_barrier(const XcdBarrier& b) {
    asm volatile("s_waitcnt vmcnt(0)" ::: "memory");
    __syncthreads();
    if (threadIdx.x == 0) {
        unsigned* bar = b.bar;
        __builtin_amdgcn_s_waitcnt(0);
        unsigned nloc = b.st[0], nx = b.st[1];
        if (nloc == 0u) { xcd_barrier_complete(bar, b.x, nloc, nx); b.st[0] = nloc; b.st[1] = nx; }
        const unsigned old = xb_add(&bar[XB_XSUB(b.x)], 1u);
        const unsigned gen = old / nloc;
        if (old + 1u == (gen + 1u) * nloc) {
            __builtin_amdgcn_fence(__ATOMIC_RELEASE, "agent");
            asm volatile("s_waitcnt vmcnt(0)" ::: "memory");
            const unsigned og = xb_add(&bar[XB_TOP], 1u);
            const unsigned tg = og / nx;
            if (og + 1u == (tg + 1u) * nx) xb_add(&bar[XB_TOPGEN], 1u);
            else XB_SPIN(xb_ld(&bar[XB_TOPGEN]) == tg, bar);
            __builtin_amdgcn_fence(__ATOMIC_ACQUIRE, "agent");
            xb_add(&bar[XB_XGEN(b.x)], 1u);
            asm volatile("s_waitcnt vmcnt(0)" ::: "memory");
        } else {
            XB_SPIN(xb_ld(&bar[XB_XGEN(b.x)]) == gen, bar);
            __builtin_amdgcn_fence(__ATOMIC_ACQUIRE, "agent");
            asm volatile("s_waitcnt vmcnt(0)" ::: "memory");
        }
    }
    __syncthreads();
}

__device__ __forceinline__ void grid_bar(unsigned* ctr, unsigned target) {
    asm volatile("s_waitcnt vmcnt(0) lgkmcnt(0)" ::: "memory");
    __syncthreads();
    if (threadIdx.x == 0) {
        __builtin_amdgcn_fence(__ATOMIC_RELEASE, "agent");
        asm volatile("s_waitcnt vmcnt(0)" ::: "memory");
        __hip_atomic_fetch_add(ctr, 1u, __ATOMIC_RELAXED, __HIP_MEMORY_SCOPE_AGENT);
        while (__hip_atomic_load(ctr, __ATOMIC_RELAXED, __HIP_MEMORY_SCOPE_AGENT) < target) __builtin_amdgcn_s_sleep(4);
        __builtin_amdgcn_fence(__ATOMIC_ACQUIRE, "agent");
        asm volatile("s_waitcnt vmcnt(0)" ::: "memory");
    }
    __syncthreads();
}

namespace pg8 {
constexpr int BM = 256, BK = 64, HALF = 128, HTB = HALF * BK * 2, NXCD = 8, WGM = 8;
__device__ __forceinline__ int lds_byte(int r, int c) { const int st = (r >> 4) * 2 + (c >> 5), rr = r & 15, cc = c & 31, ob = rr * 64 + cc * 2; return st * 1024 + (ob ^ (((ob >> 9) & 1) << 5)); }
__device__ __forceinline__ void stage_rc(int b, int& R, int& C) { const int st = b / 1024, sb = b % 1024, swz = sb ^ (((sb >> 9) & 1) << 5); R = (st >> 1) * 16 + swz / 64; C = (st & 1) * 32 + (swz % 64) / 2; }
__device__ __forceinline__ int perm32(int rho) { const int n = rho >> 4, i = rho & 15; return 8 * (i >> 2) + 4 * n + (i & 3); }
struct Unit { int pm, pn, ks, koffA, koffB; };
struct Gemm { const bf16_t* A; const bf16_t* Bt; int lda, ldb, K; };
struct StaticOrder {
    int nM, nN, nwg, G, c;
    __device__ void init(int M, int N, int G_, int c_) { nM = M / BM; nN = N / BM; nwg = nM * nN; G = G_; c = c_; }
    __device__ bool next(int i, Unit& u) const {
        const long L = (long)i * G + c; if (L >= nwg) return false;
        int wgid = (int)L; { const int q = nwg / NXCD, r = nwg % NXCD, xcd = wgid % NXCD, off = wgid / NXCD; wgid = (xcd < r ? xcd * (q + 1) : r * (q + 1) + (xcd - r) * q) + off; }
        const int nig = WGM * nN, gid = wgid / nig, fm = gid * WGM, gsz = (nM - fm) < WGM ? (nM - fm) : WGM;
        u.pm = fm + ((wgid % nig) % gsz); u.pn = (wgid % nig) / gsz; u.ks = 0; u.koffA = 0; u.koffB = 0; return true;
    }
};
struct SplitKOrder {
    int nN, nks, pm, kchunk, G, c;
    __device__ bool next(int i, Unit& u) const { const long L = (long)i * G + c; if (L >= (long)nN * nks) return false;
        u.pm = pm; u.pn = (int)(L % nN); u.ks = (int)(L / nN); u.koffA = u.ks * kchunk; u.koffB = u.koffA; return true; }
};

struct P3Order {
    int G, c;
    __device__ bool next(int i, Unit& u) const { const int L = i * G + c; if (L >= 16 * 33) return false;
        u.pn = L / 33; u.pm = L - u.pn * 33; u.ks = 0; u.koffB = 0; u.koffA = u.pn < 4 ? u.pn * 256 : 1024 + ((u.pn - 4) >> 2) * 256; return true; }
};
template <class Epi, class Sched>
__device__ __forceinline__ void gemm_phase(LAS unsigned char* lds, const Gemm g, const Sched& S, const Epi& E) {
    const int tid = threadIdx.x, wid = __builtin_amdgcn_readfirstlane(tid >> 6), lane = tid & 63, wr = wid >> 2, wc = wid & 3, fr = lane & 15, fq = lane >> 4;
    const int K = g.K, nt = K / BK;
    unsigned voffA[2], voffB[2];
#pragma unroll
    for (int i = 0; i < 2; ++i) { int R, C; stage_rc(tid * 16 + i * 8192, R, C); const int Rb = Epi::PERM ? ((R & ~31) + perm32(R & 31)) : R;
        voffA[i] = (unsigned)(R * g.lda + C) * 2u; voffB[i] = (unsigned)(Rb * g.ldb + C) * 2u; }
    const size_t kstep = (size_t)(BK * 2);
    const size_t hstepA = (size_t)HALF * g.lda * 2, hstepB = (size_t)HALF * g.ldb * 2;
    const size_t tstepA = 2 * hstepA, tstepB = 2 * hstepB;
    const unsigned ldsw = (unsigned)wid * 1024u;
    const int aoff = lds_byte(wr * 64 + fr, fq * 8), boff = lds_byte(wc * 32 + fr, fq * 8);
#define PG8_SA(b, h) (((b) * 2 + (h)) * HTB)
#define PG8_SB(b, h) ((4 + (b) * 2 + (h)) * HTB)
#define PG8_STAGE(bufoff, gbase, voff) do { _Pragma("unroll") for (int _i = 0; _i < 2; ++_i) \
        __builtin_amdgcn_global_load_lds((const unsigned*)((const char*)(gbase) + (voff)[_i]), (LAS unsigned*)(lds + (bufoff) + ldsw + _i * 8192), 16, 0, 0); } while (0)
#define PG8_LDA(dst, b, h) do { _Pragma("unroll") for (int m = 0; m < 4; ++m) _Pragma("unroll") for (int k = 0; k < 2; ++k) dst[m][k] = *(const LAS bf16x8*)(lds + PG8_SA(b, h) + aoff + m * 2048 + k * 1024); } while (0)
#define PG8_LDB(dst, b, h) do { _Pragma("unroll") for (int n = 0; n < 2; ++n) _Pragma("unroll") for (int k = 0; k < 2; ++k) dst[n][k] = *(const LAS bf16x8*)(lds + PG8_SB(b, h) + boff + n * 2048 + k * 1024); } while (0)
#define PG8_MMA(ai, bj, At, Bt) do { __builtin_amdgcn_s_setprio(1); _Pragma("unroll") for (int m = 0; m < 4; ++m) _Pragma("unroll") for (int n = 0; n < 2; ++n) _Pragma("unroll") for (int k = 0; k < 2; ++k) \
        acc[ai][bj][m][n] = __builtin_amdgcn_mfma_f32_16x16x32_bf16(Bt[n][k], At[m][k], acc[ai][bj][m][n], 0, 0, 0); __builtin_amdgcn_s_setprio(0); } while (0)
#define PG8_WAIT_V(n) asm volatile("s_waitcnt vmcnt(" #n ")" ::: "memory")
#define PG8_WAIT_L(n) asm volatile("s_waitcnt lgkmcnt(" #n ")" ::: "memory")
#define PG8_BAR __builtin_amdgcn_s_barrier()
#define PG8_SCHED __builtin_amdgcn_sched_barrier(0)
    Unit cur, nxt; int ui = 0;
    if (!S.next(0, cur)) return;
    f32x4 acc[2][2][4][2];
#pragma unroll
    for (int a = 0; a < 2; ++a)
#pragma unroll
        for (int b = 0; b < 2; ++b)
#pragma unroll
            for (int m = 0; m < 4; ++m)
#pragma unroll
                for (int n = 0; n < 2; ++n) acc[a][b][m][n] = (f32x4){0.f, 0.f, 0.f, 0.f};
    bf16x8 At[4][2], B0[2][2], B1[2][2];
    const char* cA = (const char*)g.A + (size_t)cur.pm * tstepA + (size_t)cur.koffA * 2; const char* cB = (const char*)g.Bt + (size_t)cur.pn * tstepB + (size_t)cur.koffB * 2;
    PG8_STAGE(PG8_SB(0, 0), cB, voffB); PG8_STAGE(PG8_SA(0, 0), cA, voffA); PG8_STAGE(PG8_SB(0, 1), cB + hstepB, voffB); PG8_STAGE(PG8_SA(0, 1), cA + hstepA, voffA);
    if (wr == 1) PG8_BAR;
    PG8_WAIT_V(4); PG8_BAR;
    PG8_STAGE(PG8_SB(1, 0), cB + kstep, voffB); PG8_STAGE(PG8_SA(1, 0), cA + kstep, voffA); PG8_STAGE(PG8_SB(1, 1), cB + hstepB + kstep, voffB);
    PG8_WAIT_V(6); PG8_BAR;
    for (;;) {
        const bool has_next = S.next(ui + 1, nxt);
        const char* nA = has_next ? (const char*)g.A + (size_t)nxt.pm * tstepA + (size_t)nxt.koffA * 2 : cA; const char* nB = has_next ? (const char*)g.Bt + (size_t)nxt.pn * tstepB + (size_t)nxt.koffB * 2 : cB;
#pragma clang loop unroll(disable)
        for (int t = 0; t < nt; t += 2) {
            const bool last = (t == nt - 2);
            const char* a1 = cA + (size_t)(t + 1) * kstep;
            const char* a2 = last ? nA : cA + (size_t)(t + 2) * kstep; const char* b2 = last ? nB : cB + (size_t)(t + 2) * kstep;
            const char* a3 = a2 + kstep; const char* b3 = b2 + kstep;
            PG8_LDB(B0, 0, 0); PG8_SCHED; PG8_LDA(At, 0, 0); PG8_STAGE(PG8_SA(1, 1), a1 + hstepA, voffA);
            PG8_WAIT_L(8); PG8_BAR; PG8_WAIT_L(0); PG8_MMA(0, 0, At, B0); PG8_BAR; PG8_SCHED;
            PG8_LDB(B1, 0, 1); PG8_STAGE(PG8_SB(0, 0), b2, voffB);
            PG8_BAR; PG8_WAIT_L(0); PG8_MMA(0, 1, At, B1); PG8_BAR;
            PG8_LDA(At, 0, 1); PG8_STAGE(PG8_SA(0, 0), a2, voffA);
            PG8_BAR; PG8_WAIT_L(0); PG8_MMA(1, 0, At, B0); PG8_BAR; PG8_SCHED;
            PG8_STAGE(PG8_SB(0, 1), b2 + hstepB, voffB);
            PG8_WAIT_V(6); PG8_BAR; PG8_MMA(1, 1, At, B1); PG8_BAR;
            PG8_LDB(B0, 1, 0); PG8_SCHED; PG8_LDA(At, 1, 0); PG8_STAGE(PG8_SA(0, 1), a2 + hstepA, voffA);
            PG8_WAIT_L(8); PG8_BAR; PG8_WAIT_L(0); PG8_MMA(0, 0, At, B0); PG8_BAR; PG8_SCHED;
            PG8_LDB(B1, 1, 1); PG8_STAGE(PG8_SB(1, 0), b3, voffB);
            PG8_BAR; PG8_WAIT_L(0); PG8_MMA(0, 1, At, B1); PG8_BAR;
            PG8_LDA(At, 1, 1); PG8_STAGE(PG8_SA(1, 0), a3, voffA);
            PG8_BAR; PG8_WAIT_L(0); PG8_MMA(1, 0, At, B0); PG8_BAR; PG8_SCHED;
            PG8_STAGE(PG8_SB(1, 1), b3 + hstepB, voffB);
            PG8_WAIT_V(6); PG8_BAR; PG8_MMA(1, 1, At, B1); PG8_BAR;
        }
        if constexpr (!Epi::AFTER_DRAIN) E(acc, cur, wr, wc, fr, fq);
        if (!has_next) break;
#pragma unroll
        for (int a = 0; a < 2; ++a)
#pragma unroll
            for (int b = 0; b < 2; ++b)
#pragma unroll
                for (int m = 0; m < 4; ++m)
#pragma unroll
                    for (int n = 0; n < 2; ++n) acc[a][b][m][n] = (f32x4){0.f, 0.f, 0.f, 0.f};
        cur = nxt; cA = nA; cB = nB; ++ui;
    }
    PG8_WAIT_V(0);
    if (wr == 0) PG8_BAR;
    PG8_BAR;
    if constexpr (Epi::AFTER_DRAIN) E(acc, cur, wr, wc, fr, fq);
#undef PG8_SA
#undef PG8_SB
#undef PG8_STAGE
#undef PG8_LDA
#undef PG8_LDB
#undef PG8_MMA
#undef PG8_WAIT_V
#undef PG8_WAIT_L
#undef PG8_BAR
#undef PG8_SCHED
}
}
using pg8::Unit;

template <int MODE> struct EpiBf16 {
    static constexpr bool PERM = true, AFTER_DRAIN = false;
    bf16_t* O; int ldc; int coff; const float* vec;
    __device__ __forceinline__ void operator()(const f32x4 (&acc)[2][2][4][2], const Unit& u, int wr, int wc, int fr, int fq) const {
        const int row0 = u.pm * 256 + wr * 64 + fr, col0 = coff + u.pn * 256 + wc * 32 + 8 * fq;
#pragma unroll
        for (int bj = 0; bj < 2; ++bj) {
            const int c = col0 + bj * 128;
            f32x4 s0, s1;
            if (MODE == 0) { s0 = vec ? *(const f32x4*)(vec + c) : (f32x4){1.f, 1.f, 1.f, 1.f}; s1 = vec ? *(const f32x4*)(vec + c + 4) : (f32x4){1.f, 1.f, 1.f, 1.f}; }
            else { s0 = *(const f32x4*)(vec + c); s1 = *(const f32x4*)(vec + c + 4); }
#pragma unroll
            for (int ai = 0; ai < 2; ++ai)
#pragma unroll
                for (int m = 0; m < 4; ++m) {
                    f32x4 v0 = acc[ai][bj][m][0], v1 = acc[ai][bj][m][1];
                    if (MODE == 0) { v0 = v0 * s0; v1 = v1 * s1; }
                    else {
#pragma unroll
                        for (int j = 0; j < 4; ++j) { v0[j] = sigmoidf_(v0[j] + s0[j]); v1[j] = sigmoidf_(v1[j] + s1[j]); } }
                    u32x4 w; w.x = pk_bf16(v0[0], v0[1]); w.y = pk_bf16(v0[2], v0[3]); w.z = pk_bf16(v1[0], v1[1]); w.w = pk_bf16(v1[2], v1[3]);
                    *(u32x4*)(O + (size_t)(row0 + ai * 128 + m * 16) * ldc + c) = w;
                }
        }
    }
};
struct EpiP3 {
    static constexpr bool PERM = true, AFTER_DRAIN = false;
    bf16_t* MixO; float* DecO; bf16_t* AO; bf16_t* GO; const float* pscale; const float* w0v; const float* a0v;
    __device__ __forceinline__ void operator()(const f32x4 (&acc)[2][2][4][2], const Unit& u, int wr, int wc, int fr, int fq) const {
        const bool pool = u.pn < 4; const int sgm = (u.pn - 4) >> 2;
        const int mode = pool ? 0 : (sgm == 0 ? 2 : (sgm == 1 ? 1 : 0)), ldc = pool ? D : CW;
        bf16_t* o0 = MixO; bf16_t* o1 = AO; bf16_t* o2 = GO; const float* v0 = pscale; const float* v1 = w0v; const float* v2 = a0v;
        asm volatile("" : "+s"(o0), "+s"(o1), "+s"(o2), "+s"(v0), "+s"(v1), "+s"(v2));
        bf16_t* Ob = pool ? o0 : (sgm == 1 ? o1 : o2); float* Of = DecO;
        const float* vec = pool ? v0 : (sgm == 0 ? v1 : (sgm == 1 ? v2 : (const float*)nullptr));
        const int row0 = u.pm * 256 + wr * 64 + fr, col0 = (pool ? u.pn * 256 : ((u.pn - 4) & 3) * 256) + wc * 32 + 8 * fq;
#pragma unroll
        for (int bj = 0; bj < 2; ++bj) {
            const int c = col0 + bj * 128;
            const f32x4 one = (f32x4){1.f, 1.f, 1.f, 1.f};
            const f32x4 s0 = vec ? *(const f32x4*)(vec + c) : one, s1 = vec ? *(const f32x4*)(vec + c + 4) : one;
#pragma unroll
            for (int ai = 0; ai < 2; ++ai)
#pragma unroll
                for (int m = 0; m < 4; ++m) {
                    const int row = row0 + ai * 128 + m * 16;
                    f32x4 v0 = acc[ai][bj][m][0], v1 = acc[ai][bj][m][1];
                    if (mode == 0) { v0 = v0 * s0; v1 = v1 * s1; }
                    else if (mode == 1) {
#pragma unroll
                        for (int j = 0; j < 4; ++j) { v0[j] = sigmoidf_(v0[j] + s0[j]); v1[j] = sigmoidf_(v1[j] + s1[j]); } }
                    else {
                        v0 = v0 + s0; v1 = v1 + s1;
#pragma unroll
                        for (int j = 0; j < 4; ++j) {
                            const float z0 = -v0[j], z1 = -v1[j];
                            const float sp0 = fmaxf(z0, 0.f) + __logf(1.0f + __expf(-fabsf(z0))), sp1 = fmaxf(z1, 0.f) + __logf(1.0f + __expf(-fabsf(z1)));
                            v0[j] = __expf(-__expf(-sp0 - 0.5f)); v1[j] = __expf(-__expf(-sp1 - 0.5f)); }
                    }
                    if (mode == 2) { if (row < MV) { float* p = Of + (size_t)row * ldc + c; *(f32x4*)p = v0; *(f32x4*)(p + 4) = v1; } }
                    else { u32x4 w; w.x = pk_bf16(v0[0], v0[1]); w.y = pk_bf16(v0[2], v0[3]); w.z = pk_bf16(v1[0], v1[1]); w.w = pk_bf16(v1[2], v1[3]);
                        *(u32x4*)(Ob + (size_t)row * ldc + c) = w; }
                }
        }
    }
};
struct EpiDecay {
    static constexpr bool PERM = false, AFTER_DRAIN = false;
    float* O; const float* w0;
    __device__ __forceinline__ void operator()(const f32x4 (&acc)[2][2][4][2], const Unit& u, int wr, int wc, int fr, int fq) const {
        const int row0 = u.pm * 256 + wr * 64 + fr, col0 = u.pn * 256 + wc * 32 + 4 * fq;
#pragma unroll
        for (int bj = 0; bj < 2; ++bj)
#pragma unroll
            for (int n = 0; n < 2; ++n) {
                const int c = col0 + bj * 128 + n * 16; const f32x4 b = *(const f32x4*)(w0 + c);
#pragma unroll
                for (int ai = 0; ai < 2; ++ai)
#pragma unroll
                    for (int m = 0; m < 4; ++m) {
                        const int row = row0 + ai * 128 + m * 16; f32x4 v = acc[ai][bj][m][n] + b, o;
#pragma unroll
                        for (int j = 0; j < 4; ++j) { const float z = -v[j]; const float sp = fmaxf(z, 0.f) + __logf(1.0f + __expf(-fabsf(z))); o[j] = __expf(-__expf(-sp - 0.5f)); }
                        if (row < MV) *(f32x4*)(O + (size_t)row * CW + c) = o;
                    }
            }
    }
};
struct EpiOut {
    static constexpr bool PERM = false, AFTER_DRAIN = false;
    const float* xp; const float* xs; float* out; bf16_t* h2; const float* g; float* rowsq;
    __device__ __forceinline__ void operator()(const f32x4 (&acc)[2][2][4][2], const Unit& u, int wr, int wc, int fr, int fq) const {
        const int row0 = u.pm * 256 + wr * 64 + fr, col0 = u.pn * 256 + wc * 32 + 4 * fq;
#pragma unroll
        for (int ai = 0; ai < 2; ++ai)
#pragma unroll
            for (int m = 0; m < 4; ++m) {
                const int row = row0 + ai * 128 + m * 16; const bool ok = row < MV;
                const float* xr = row < MPR ? xp + (size_t)row * D : xs + (size_t)(ok ? row - MPR : 0) * D;
                float s = 0.f;
#pragma unroll
                for (int bj = 0; bj < 2; ++bj)
#pragma unroll
                    for (int n = 0; n < 2; ++n) {
                        const int c = col0 + bj * 128 + n * 16;
                        f32x4 x1 = acc[ai][bj][m][n];
                        if (ok) { x1 = x1 + *(const f32x4*)(xr + c); *(f32x4*)(out + (size_t)row * D + c) = x1; }
                        s += (x1[0] * x1[0] + x1[1] * x1[1]) + (x1[2] * x1[2] + x1[3] * x1[3]);
                        const f32x4 gg = *(const f32x4*)(g + c); const f32x4 hv = x1 * gg;
                        u32x2 w; w.x = pk_bf16(hv[0], hv[1]); w.y = pk_bf16(hv[2], hv[3]);
                        *(u32x2*)(h2 + (size_t)row * D + c) = w;
                    }
                s += __shfl_xor(s, 16); s += __shfl_xor(s, 32);
                if (ok && fq == 0) unsafeAtomicAdd(rowsq + row, s);
            }
    }
};
struct EpiGU {
    static constexpr bool PERM = true, AFTER_DRAIN = false;
    bf16_t* U; const float* rowsq;
    __device__ __forceinline__ void operator()(const f32x4 (&acc)[2][2][4][2], const Unit& u, int wr, int wc, int fr, int fq) const {
        const int row0 = u.pm * 256 + wr * 64 + fr, col0 = u.pn * 128 + wc * 32 + 8 * fq;
#pragma unroll
        for (int ai = 0; ai < 2; ++ai)
#pragma unroll
            for (int m = 0; m < 4; ++m) {
                const int row = row0 + ai * 128 + m * 16;
                const float rstd = rsqrtf(rowsq[row] * (1.0f / D) + RMS_EPS);
                f32x4 o[2];
#pragma unroll
                for (int n = 0; n < 2; ++n)
#pragma unroll
                    for (int j = 0; j < 4; ++j) { const float gt = acc[ai][0][m][n][j] * rstd, up = acc[ai][1][m][n][j] * rstd; o[n][j] = gt * sigmoidf_(gt) * up; }
                u32x4 w; w.x = pk_bf16(o[0][0], o[0][1]); w.y = pk_bf16(o[0][2], o[0][3]); w.z = pk_bf16(o[1][0], o[1][1]); w.w = pk_bf16(o[1][2], o[1][3]);
                *(u32x4*)(U + (size_t)row * DFF + col0) = w;
            }
    }
};
struct EpiDown {
    static constexpr bool PERM = false, AFTER_DRAIN = false;
    float* out;
    __device__ __forceinline__ void operator()(const f32x4 (&acc)[2][2][4][2], const Unit& u, int wr, int wc, int fr, int fq) const {
        const int row0 = u.pm * 256 + wr * 64 + fr, col0 = u.pn * 256 + wc * 32 + 4 * fq;
#pragma unroll
        for (int ai = 0; ai < 2; ++ai)
#pragma unroll
            for (int m = 0; m < 4; ++m) {
                const int row = row0 + ai * 128 + m * 16;
#pragma unroll
                for (int bj = 0; bj < 2; ++bj)
#pragma unroll
                    for (int n = 0; n < 2; ++n) {
                        const int c = col0 + bj * 128 + n * 16; float* p = out + (size_t)row * D + c;
                        *(f32x4*)p = acc[ai][bj][m][n] + *(const f32x4*)p;
                    }
            }
    }
};
struct EpiDownNorm {
    static constexpr bool PERM = false, AFTER_DRAIN = true;
    float* out; float* rowsq; unsigned* cnt; const float* g;
    __device__ __forceinline__ void operator()(f32x4 (&acc)[2][2][4][2], const Unit& u, int wr, int wc, int fr, int fq) const {
        const int row0 = u.pm * 256 + wr * 64 + fr, col0 = u.pn * 256 + wc * 32 + 4 * fq;
        float chk = 0.f;
#pragma unroll
        for (int ai = 0; ai < 2; ++ai)
#pragma unroll
            for (int m = 0; m < 4; ++m) {
                const int row = row0 + ai * 128 + m * 16; float s = 0.f;
#pragma unroll
                for (int bj = 0; bj < 2; ++bj)
#pragma unroll
                    for (int n = 0; n < 2; ++n) {
                        const f32x4 x2 = acc[ai][bj][m][n] + *(const f32x4*)(out + (size_t)row * D + col0 + bj * 128 + n * 16); acc[ai][bj][m][n] = x2;
                        s += (x2[0] * x2[0] + x2[1] * x2[1]) + (x2[2] * x2[2] + x2[3] * x2[3]);
                    }
                s += __shfl_xor(s, 16); s += __shfl_xor(s, 32);
                if (fq == 0) chk += unsafeAtomicAdd(rowsq + row, s);
            }
        asm volatile("s_waitcnt vmcnt(0)" :: "v"(chk) : "memory");
        unsigned* pc = cnt + 64 * u.pm;
        if ((threadIdx.x & 63) == 0) __hip_atomic_fetch_add(pc, 1u, __ATOMIC_RELAXED, __HIP_MEMORY_SCOPE_AGENT);
        { unsigned spins = 0; while (__hip_atomic_load(pc, __ATOMIC_RELAXED, __HIP_MEMORY_SCOPE_AGENT) < 64u) { __builtin_amdgcn_s_sleep(2); if (++spins > (1u << 22)) break; } }
        __builtin_amdgcn_fence(__ATOMIC_ACQUIRE, "agent");
        asm volatile("s_waitcnt vmcnt(0)" ::: "memory");
#pragma unroll
        for (int ai = 0; ai < 2; ++ai)
#pragma unroll
            for (int m = 0; m < 4; ++m) {
                const int row = row0 + ai * 128 + m * 16;
                const float rstd = rsqrtf(__hip_atomic_load(rowsq + row, __ATOMIC_RELAXED, __HIP_MEMORY_SCOPE_AGENT) * (1.0f / D) + RMS_EPS);
#pragma unroll
                for (int bj = 0; bj < 2; ++bj)
#pragma unroll
                    for (int n = 0; n < 2; ++n) { const int c = col0 + bj * 128 + n * 16; *(f32x4*)(out + (size_t)row * D + c) = acc[ai][bj][m][n] * rstd * *(const f32x4*)(g + c); }
            }
    }
};
struct EpiPartial {
    static constexpr bool PERM = false, AFTER_DRAIN = false;
    float* buf;
    __device__ __forceinline__ void operator()(const f32x4 (&acc)[2][2][4][2], const Unit& u, int wr, int wc, int fr, int fq) const {
        const int col0 = u.pn * 256 + wc * 32 + 4 * fq;
#pragma unroll
        for (int m = 0; m < 4; ++m) {
            const int lrow = wr * 64 + m * 16 + fr;
            float* p = buf + ((size_t)u.ks * MSA + lrow) * D + col0;
#pragma unroll
            for (int bj = 0; bj < 2; ++bj)
#pragma unroll
                for (int n = 0; n < 2; ++n) *(f32x4*)(p + bj * 128 + n * 16) = acc[0][bj][m][n];
        }
    }
};

template <int RM> __device__ __forceinline__ int rowmap(int n) { return RM == 0 ? n : (RM == 1 ? ((n >> 7) * 256 + (n & 127)) : ((n >> 7) * 256 + 128 + (n & 127))); }
template <int RM>
__device__ __forceinline__ void transpose_bf16(const float* src, int Ksrc, int Nsrc, int ld, bf16_t* dst, int Kdst, int Ndst, int rot, int vgw, int gws) {
    const int lane = threadIdx.x & 63, gw = (vgw + rot) % gws;
    const int nn = Ndst / 64, ntile = nn * (Kdst / 64);
    for (int t = gw; t < ntile; t += gws) {
        const int k0 = (t / nn) * 64, n = (t % nn) * 64 + lane;
        const bool nok = n < Nsrc;
        const float* sp = src + (nok ? n : 0);
        float v[64];
        const float mskn = nok ? 1.f : 0.f;
#pragma unroll
        for (int j = 0; j < 64; ++j) { const int k = k0 + j; v[j] = sp[(size_t)(k < Ksrc ? k : Ksrc - 1) * ld]; }
#pragma unroll
        for (int j = 0; j < 64; ++j) v[j] *= ((k0 + j) < Ksrc ? mskn : 0.f);
        bf16_t* dp = dst + (size_t)rowmap<RM>(n) * Kdst + k0;
#pragma unroll
        for (int q8 = 0; q8 < 8; ++q8) { u32x4 w; w.x = pk_bf16(v[q8 * 8 + 0], v[q8 * 8 + 1]); w.y = pk_bf16(v[q8 * 8 + 2], v[q8 * 8 + 3]); w.z = pk_bf16(v[q8 * 8 + 4], v[q8 * 8 + 5]); w.w = pk_bf16(v[q8 * 8 + 6], v[q8 * 8 + 7]);
            *(u32x4*)(dp + q8 * 8) = w; }
    }
}
template <int CTRL> __device__ __forceinline__ float dpp_(float x) { return __int_as_float(__builtin_amdgcn_update_dpp(0, __float_as_int(x), CTRL, 0xF, 0xF, true)); }
__device__ __forceinline__ float red8(float x) { x += dpp_<0x141>(x); x += dpp_<0xB1>(x); x += dpp_<0x4E>(x); return x; }

template <int W>
__device__ __forceinline__ void pool_block_prompt(const bf16_t* proj, bf16_t* pooled, int b, int t0, int c) {
    float ux[15 + W], uy[15 + W]; unsigned raw[15 + W];
#pragma unroll
    for (int j = 0; j < 15 + W; ++j) {
        const int t = t0 - (W - 1) + j;
        raw[j] = *(const unsigned*)(proj + (size_t)(b * TT + (t < 0 ? 0 : t)) * PJP + c);
    }
#pragma unroll
    for (int j = 0; j < 15 + W; ++j) {
        const int t = t0 - (W - 1) + j; const float zm = t < 0 ? 0.f : 1.f;
        ux[j] = bf2f(raw[j] & 0xffffu) * zm; uy[j] = bf2f(raw[j] >> 16) * zm;
    }
#pragma unroll
    for (int i = 0; i < 16; ++i) {
        const int t = t0 + i; float sx = 0.f, sy = 0.f;
#pragma unroll
        for (int j = 0; j < W; ++j) { sx += ux[i + j]; sy += uy[i + j]; }
        const float inv = 1.0f / (float)(t + 1 < W ? t + 1 : W);
        const float px = sx * inv - ux[i + W - 1], py = sy * inv - uy[i + W - 1];
        *(unsigned*)(pooled + (size_t)(b * TT + t) * XLD + c) = pk_bf16(px, py);
    }
}

__global__ void __launch_bounds__(NTHR) hymba_fwd(Params P) {
    extern __shared__ __attribute__((aligned(16))) unsigned char lds_raw[];
    LAS unsigned char* lds = (LAS unsigned char*)lds_raw;
    const int G = gridDim.x, bid = blockIdx.x, gthreads = G * NTHR, gwaves = G * 8;
#define PHASE_IDS int tid = threadIdx.x; asm volatile("" : "+v"(tid)); const int lane = tid & 63, wave = tid >> 6, gtid = bid * NTHR + tid, gwave = bid * 8 + wave; (void)lane; (void)wave; (void)gtid; (void)gwave;
    unsigned char* ws = P.ws; float* out = P.out;
    const float* x_prompt = P.in[0]; const float* x_sample = P.in[1]; const float* state_pool = P.in[2]; const float* state_shift = P.in[3]; const float* state_wkv = P.in[4];
    const float* norm_mix = P.in[5]; const float* w_in = P.in[6]; const float* w_pool = P.in[7]; const float* pool_scale = P.in[8]; const float* mu_shift = P.in[9];
    const float* w0 = P.in[10]; const float* w2 = P.in[11]; const float* a0 = P.in[12]; const float* a2 = P.in[13]; const float* g2 = P.in[14];
    const float* k_k = P.in[15]; const float* k_a = P.in[16]; const float* r_k = P.in[17]; const float* gn_w = P.in[18]; const float* gn_b = P.in[19];
    const float* w_out = P.in[20]; const float* norm_ffn = P.in[21]; const float* w_gate = P.in[22]; const float* w_up = P.in[23]; const float* w_down = P.in[24]; const float* norm_final = P.in[25];
    bf16_t* WinT = (bf16_t*)(ws + WS_WIN); bf16_t* WoutT = (bf16_t*)(ws + WS_WOUT); bf16_t* WguT = (bf16_t*)(ws + WS_WGU); bf16_t* WdnT = (bf16_t*)(ws + WS_WDN);
    bf16_t* WpoolT = (bf16_t*)(ws + WS_WPOOL); bf16_t* WloraT = (bf16_t*)(ws + WS_WLORA);
    bf16_t* Hb = (bf16_t*)(ws + WS_R1); bf16_t* Xb = (bf16_t*)(ws + WS_R1); bf16_t* H2 = (bf16_t*)(ws + WS_R1);
    bf16_t* Proj = (bf16_t*)(ws + WS_PROJ); bf16_t* Ub = (bf16_t*)(ws + WS_PROJ); bf16_t* Ab = (bf16_t*)(ws + WS_A); bf16_t* Gb = (bf16_t*)(ws + WS_GATE);
    bf16_t* Mix = (bf16_t*)(ws + WS_MIX); float* rowsq1 = (float*)(ws + WS_ROWSQ); float* rowsq2 = rowsq1 + MPAD; unsigned* pcnt = (unsigned*)(ws + WS_PCNT); float* Bonus = (float*)(ws + WS_BONUS);
    unsigned* barctr = (unsigned*)(ws + WS_BAR);
    float* Yb = out + SCR_Y; float* Dec = out + SCR_DEC;
    float* Part6 = (float*)(ws + WS_A);
    float* Part8 = (float*)(ws + WS_R1);
    { LAS unsigned* st0 = (LAS unsigned*)(lds + LDS_ST_OFF); if (threadIdx.x < 2) st0[threadIdx.x] = 0u; }
    __syncthreads();
    const XcdBarrier xbar = xcd_barrier_post(barctr, (volatile LAS unsigned*)(lds + LDS_ST_OFF));
#ifndef P3SEL
#define P3SEL 15
#endif
#ifndef PHASE_MASK
#define PHASE_MASK 0x3ff
#endif
#define IN(k) (((PHASE_MASK >> (k)) & 1) && (!P.multi || P.phase == (k)))
#define SEAM() do { if (!P.multi) xcd_barrier(xbar); } while (0)

    if (IN(0)) {
        PHASE_IDS
        transpose_bf16<0>(w_in, D, PJ, PJ, WinT, D, PJP, 0, gwave, gwaves);
        for (int g = 0; g < 4; ++g) transpose_bf16<0>(w_pool + (size_t)g * 65536, 256, 256, 256, WpoolT + (size_t)g * 65536, 256, 256, 1280 + g * 16, gwave, gwaves);
        transpose_bf16<0>(w2, 64, CW, CW, WloraT, 256, CW, 1344, gwave, gwaves);
        transpose_bf16<0>(a2, 64, CW, CW, WloraT + (size_t)CW * 256, 256, CW, 1408, gwave, gwaves);
        transpose_bf16<0>(g2, 160, CW, CW, WloraT + (size_t)2 * CW * 256, 256, CW, 1472, gwave, gwaves);
        for (int i = gtid; i < 2 * MPAD; i += gthreads) rowsq1[i] = 0.f;
        for (int m = gwave; m < MPAD; m += gwaves) {
            bf16_t* hr = Hb + (size_t)m * D;
            if (m < MV) {
                const float* xr = m < MPR ? x_prompt + (size_t)m * D : x_sample + (size_t)(m - MPR) * D;
                f32x4 v[8]; float s = 0.f;
#pragma unroll
                for (int i = 0; i < 8; ++i) v[i] = *(const f32x4*)(xr + (i * 64 + lane) * 4);
#pragma unroll
                for (int i = 0; i < 8; ++i) s += (v[i][0] * v[i][0] + v[i][1] * v[i][1]) + (v[i][2] * v[i][2] + v[i][3] * v[i][3]);
                s = wsum(s); const float rstd = rsqrtf(s * (1.0f / D) + RMS_EPS);
#pragma unroll
                for (int i = 0; i < 8; ++i) { const int c = (i * 64 + lane) * 4; const f32x4 gg = *(const f32x4*)(norm_mix + c); const f32x4 o = v[i] * rstd * gg;
                    u32x2 w; w.x = pk_bf16(o[0], o[1]); w.y = pk_bf16(o[2], o[3]); *(u32x2*)(hr + c) = w; }
            } else {
#pragma unroll
                for (int i = 0; i < 8; ++i) *(u32x2*)(hr + (i * 64 + lane) * 4) = (u32x2){0u, 0u};
            }
        }
    }
    if (P.multi == 2) cg::this_grid().sync();
    SEAM();

    if (IN(1)) {
        PHASE_IDS
        pg8::Gemm g{Hb, WinT, D, D, D}; pg8::StaticOrder S; S.init(MPAD, PJP, G, bid);
        EpiBf16<0> E{Proj, PJP, 0, nullptr};
        pg8::gemm_phase(lds, g, S, E);
    }
    SEAM();

    if (IN(2)) {
        PHASE_IDS
        for (int rb = bid; rb < MPR / 16; rb += G) {
            const int b = rb >> 7, t0 = (rb & 127) * 16, c = tid * 2, gq = tid >> 7;
            if (gq == 0) pool_block_prompt<2>(Proj, Xb, b, t0, c);
            else if (gq == 1) pool_block_prompt<4>(Proj, Xb, b, t0, c);
            else if (gq == 2) pool_block_prompt<8>(Proj, Xb, b, t0, c);
            else pool_block_prompt<16>(Proj, Xb, b, t0, c);
        }
        for (int b = bid; b < MSA; b += G) {
            const int c = tid * 2, W = 2 << (tid >> 7);
            const unsigned v = *(const unsigned*)(Proj + (size_t)(MPR + b) * PJP + c); const float ux = bf2f(v & 0xffffu), uy = bf2f(v >> 16);
            f32x2 pr[15];
#pragma unroll
            for (int j = 0; j < 15; ++j) pr[j] = *(const f32x2*)(state_pool + ((size_t)b * 15 + j) * PW + c);
            float sx = ux, sy = uy;
#pragma unroll
            for (int j = 1; j < 16; ++j) { const float mk = j < W ? 1.f : 0.f; sx += pr[15 - j][0] * mk; sy += pr[15 - j][1] * mk; }
            const float inv = 1.0f / (float)W;
            *(unsigned*)(Xb + (size_t)(MPR + b) * XLD + c) = pk_bf16(sx * inv - ux, sy * inv - uy);
            float* np = out + OUT_POOLS + (size_t)b * 15 * PW;
#pragma unroll
            for (int j = 0; j < 14; ++j) *(f32x2*)(np + (size_t)j * PW + c) = pr[j + 1];
            *(f32x2*)(np + (size_t)14 * PW + c) = (f32x2){ux, uy};
        }
        {
            constexpr int NIT = MV * 144;
            for (int base = gtid; base < NIT; base += 5 * gthreads) {
                unsigned cv[5], pv[5]; f32x2 mu[5]; int mm[5], cpo[5], sg[5], pcs[5]; bool val[5];
#pragma unroll
                for (int u = 0; u < 5; ++u) {
                    const int idx = base + u * gthreads; val[u] = idx < NIT; const int id2 = val[u] ? idx : 0;
                    const int m = id2 / 144, jp = id2 - m * 144, seg = jp < 32 ? 0 : (jp < 64 ? 1 : 2);
                    const int j = (jp - (seg == 0 ? 0 : (seg == 1 ? 32 : 64))) * 2, pc = (seg == 0 ? 3072 : (seg == 1 ? 3136 : 3200)) + j;
                    mm[u] = m; sg[u] = seg; cpo[u] = seg * 256 + j; pcs[u] = pc;
                    const int mprev = (m >= MPR || (m & (TT - 1)) == 0) ? m : m - 1;
                    cv[u] = *(const unsigned*)(Proj + (size_t)m * PJP + PW + pc);
                    pv[u] = *(const unsigned*)(Proj + (size_t)mprev * PJP + PW + pc);
                    mu[u] = *(const f32x2*)(mu_shift + pc);
                }
#pragma unroll
                for (int u = 0; u < 5; ++u) {
                    const int m = mm[u]; const float cx = bf2f(cv[u] & 0xffffu), cy = bf2f(cv[u] >> 16);
                    const float fm = (m & (TT - 1)) == 0 ? 0.f : 1.f;
                    float px = bf2f(pv[u] & 0xffffu) * fm, py = bf2f(pv[u] >> 16) * fm;
                    if (m >= MPR) { const f32x2 p = *(const f32x2*)(state_shift + (size_t)(m - MPR) * SW + pcs[u]); px = p[0]; py = p[1]; }
                    float vx = cx + (px - cx) * mu[u][0], vy = cy + (py - cy) * mu[u][1];
                    if (sg[u] == 0) { vx = tanhf(vx); vy = tanhf(vy); } else if (sg[u] == 2) { vx = sigmoidf_(vx); vy = sigmoidf_(vy); }
                    if (val[u]) *(unsigned*)(Xb + (size_t)m * XLD + 1024 + cpo[u]) = pk_bf16(vx, vy);
                }
            }
        }
        for (int i = gtid; i < 4 * SW; i += gthreads) { const int b = i / SW, j = i - b * SW; out[OUT_SHIFTP + i] = bf2f(Proj[(size_t)(b * TT + TT - 1) * PJP + PW + j]); }
        for (int i = gtid; i < MSA * SW / 2; i += gthreads) { const int b = i / (SW / 2), j = (i - b * (SW / 2)) * 2; const unsigned v = *(const unsigned*)(Proj + (size_t)(MPR + b) * PJP + PW + j);
            *(f32x2*)(out + OUT_SHIFTS + (size_t)b * SW + j) = (f32x2){bf2f(v & 0xffffu), bf2f(v >> 16)}; }
        for (int i = gtid; i < 4 * 15 * PW; i += gthreads) { const int b = i / (15 * PW), r = i - b * 15 * PW, j = r / PW, c = r - j * PW; out[OUT_POOLP + i] = bf2f(Proj[(size_t)(b * TT + TT - 15 + j) * PJP + c]); }
    }
    SEAM();

    if (IN(3)) {
        PHASE_IDS
        { pg8::Gemm g{Xb, WpoolT, XLD, 256, 256}; pg8::P3Order S{G, bid};
          EpiP3 E{Mix, Dec, Ab, Gb, pool_scale, w0, a0}; pg8::gemm_phase(lds, g, S, E); }
    }
    SEAM();

    if (IN(4)) {
        PHASE_IDS
        LAS float* ldf = (LAS float*)lds;
        constexpr int REC = 392, TB = 32, NPS = TB / 4;
        for (int unit = bid; unit < 256; unit += G) {
            const int s = unit >> 2, b = s >> 4, h = s & 15, q = unit & 3;
            const int wv = __builtin_amdgcn_readfirstlane(tid >> 6);
            if (wv < 2) {
              const int crow = wv * 8 + (lane >> 3), kq = lane & 7; const bool first8 = kq == 0;
              f32x2 S2[4];
#pragma unroll
              for (int e = 0; e < 4; ++e) S2[e] = (f32x2){0.f, 0.f};
              const LAS float* recq0 = ldf + kq * 8; const LAS float* recv0 = ldf + 320 + q * 16 + crow;
              float* yp = Yb + (size_t)(b * TT + 7 - kq) * CW + h * 64 + q * 16 + crow;
              __builtin_amdgcn_s_setprio(3);
              WG_BAR();
              for (int blk = 0; blk < TT / TB; ++blk) {
                    const int bo = (blk & 1) * (TB * REC);
                    const LAS float* recq = recq0 + bo; const LAS float* recv = recv0 + bo; const LAS float* recs = ldf + bo + 384;
#define LDSTEP(o_, A0, A1, B0, B1, D0, D1, K0, K1, W0, W1, VV, SC) do { A0 = *(const LAS f32x4*)(recq + (o_)); A1 = *(const LAS f32x4*)(recq + (o_) + 4); B0 = *(const LAS f32x4*)(recq + (o_) + 64); B1 = *(const LAS f32x4*)(recq + (o_) + 68); \
                        D0 = *(const LAS f32x4*)(recq + (o_) + 128); D1 = *(const LAS f32x4*)(recq + (o_) + 132); K0 = *(const LAS f32x4*)(recq + (o_) + 192); K1 = *(const LAS f32x4*)(recq + (o_) + 196); \
                        W0 = *(const LAS f32x4*)(recq + (o_) + 256); W1 = *(const LAS f32x4*)(recq + (o_) + 260); VV = recv[(o_)]; SC = *(const LAS f32x2*)(recs + (o_)); } while (0)
                    f32x4 av0, av1, bv0, bv1, dw0, dw1, kt0, kt1, wr0, wr1; float vv; f32x2 sc;
                    f32x4 nav0, nav1, nbv0, nbv1, ndw0, ndw1, nkt0, nkt1, nwr0, nwr1; float nvv; f32x2 nsc;
                    f32x4 a0, a1, b0, b1, d0, d1, k0, k1, w0_, w1_; float vv_; f32x2 sc_;
                    LDSTEP(0, a0, a1, b0, b1, d0, d1, k0, k1, w0_, w1_, vv_, sc_);
                    LDSTEP(REC, av0, av1, bv0, bv1, dw0, dw1, kt0, kt1, wr0, wr1, vv, sc);
                    float yacc = 0.f;
#pragma unroll
                    for (int st = 0; st < TB; ++st) {
                        if (st + 2 < TB) LDSTEP((st + 2) * REC, nav0, nav1, nbv0, nbv1, ndw0, ndw1, nkt0, nkt1, nwr0, nwr1, nvv, nsc);
                        __builtin_amdgcn_sched_barrier(0);
                        const f32x2 pa = pkfma_(S2[3], hi2(a1), pkfma_(S2[2], lo2(a1), pkfma_(S2[1], hi2(a0), pkmul_(S2[0], lo2(a0)))));
                        const f32x2 py = pkfma_(S2[3], hi2(w1_), pkfma_(S2[2], lo2(w1_), pkfma_(S2[1], hi2(w0_), pkmul_(S2[0], lo2(w0_)))));
                        float da = pa[0] + pa[1], dy = py[0] + py[1];
                        da = red8(da); dy = red8(dy);
                        const float y = dy + da * sc_[0] + vv_ * sc_[1];
                        { f32x2 dab, vvb; dab[0] = da; dab[1] = da; vvb[0] = vv_; vvb[1] = vv_;
                          S2[0] = pkfma_b(lo2(k0), vvb, pkfma_b(lo2(b0), dab, pkmul_(S2[0], lo2(d0)))); S2[1] = pkfma_b(hi2(k0), vvb, pkfma_b(hi2(b0), dab, pkmul_(S2[1], hi2(d0))));
                          S2[2] = pkfma_b(lo2(k1), vvb, pkfma_b(lo2(b1), dab, pkmul_(S2[2], lo2(d1)))); S2[3] = pkfma_b(hi2(k1), vvb, pkfma_b(hi2(b1), dab, pkmul_(S2[3], hi2(d1)))); }
                        const float sh = __int_as_float(__builtin_amdgcn_update_dpp(__float_as_int(y), __float_as_int(yacc), 0x111, 0xF, 0xF, false));
                        yacc = first8 ? y : sh;
                        if ((st & 7) == 7) yp[(size_t)(blk * TB + (st - 7)) * CW] = yacc;
                        a0 = av0; a1 = av1; b0 = bv0; b1 = bv1; d0 = dw0; d1 = dw1; k0 = kt0; k1 = kt1; w0_ = wr0; w1_ = wr1; vv_ = vv; sc_ = sc;
                        av0 = nav0; av1 = nav1; bv0 = nbv0; bv1 = nbv1; dw0 = ndw0; dw1 = ndw1; kt0 = nkt0; kt1 = nkt1; wr0 = nwr0; wr1 = nwr1; vv = nvv; sc = nsc;
                        asm volatile("" ::: "memory");
                    }
#undef LDSTEP
                    WG_BAR();
              }
              __builtin_amdgcn_s_setprio(0);
              float* so = out + OUT_WKVP + ((size_t)(b * NH + h) * 64 + q * 16 + crow) * 64 + kq * 8;
              *(f32x4*)so = (f32x4){S2[0][0], S2[0][1], S2[1][0], S2[1][1]}; *(f32x4*)(so + 4) = (f32x4){S2[2][0], S2[2][1], S2[3][0], S2[3][1]};
            } else if (wv == 4 || wv == 5) {
              constexpr int CT_PER = 5632, CT_ALL = 3 * CT_PER + 2048;
              float cvv[32]; int ctile = unit * 2 + (wv - 4), cph = 0;
#define CONV_LOAD16(P0_) do { if (ctile < CT_ALL) { const int m_ = ctile / CT_PER, r_ = ctile - m_ * CT_PER; const float* sp_; unsigned ld_; \
                    if (m_ < 2) { sp_ = (m_ == 0 ? w_gate : w_up) + (size_t)((r_ / 88) * 32) * DFF + (r_ % 88) * 64; ld_ = DFF; } \
                    else { sp_ = (m_ == 2 ? w_down : w_out) + (size_t)((r_ >> 5) * 32) * D + (r_ & 31) * 64; ld_ = D; } \
                    _Pragma("unroll") for (int j_ = (P0_); j_ < (P0_) + 16; ++j_) cvv[j_] = sp_[(unsigned)j_ * ld_ + lane]; } } while (0)
#define CONV_STORE() do { if (ctile < CT_ALL) { const int m_ = ctile / CT_PER, r_ = ctile - m_ * CT_PER; bf16_t* dp_; \
                    if (m_ < 2) { const int k0_ = (r_ / 88) * 32, n_ = (r_ % 88) * 64 + lane; dp_ = WguT + (size_t)((n_ >> 7) * 256 + (m_ == 1 ? 128 : 0) + (n_ & 127)) * D + k0_; } \
                    else { const int k0_ = (r_ >> 5) * 32, n_ = (r_ & 31) * 64 + lane; dp_ = m_ == 2 ? WdnT + (size_t)n_ * DFF + k0_ : WoutT + (size_t)n_ * D + k0_; } \
                    _Pragma("unroll") for (int q8_ = 0; q8_ < 4; ++q8_) { u32x4 w_; w_.x = pk_bf16(cvv[q8_ * 8 + 0], cvv[q8_ * 8 + 1]); w_.y = pk_bf16(cvv[q8_ * 8 + 2], cvv[q8_ * 8 + 3]); \
                        w_.z = pk_bf16(cvv[q8_ * 8 + 4], cvv[q8_ * 8 + 5]); w_.w = pk_bf16(cvv[q8_ * 8 + 6], cvv[q8_ * 8 + 7]); *(u32x4*)(dp_ + q8_ * 8) = w_; } \
                    ctile += 512; } } while (0)
              WG_BAR();
              for (int blk = 0; blk < TT / TB; ++blk) {
#pragma unroll
                for (int tk = 0; tk < 2; ++tk) {
                  if (cph == 0) CONV_LOAD16(0); else if (cph == 1) CONV_LOAD16(16); else CONV_STORE();
                  cph = cph == 2 ? 0 : cph + 1;
                }
                WG_BAR();
              }
              while (ctile < CT_ALL) {
                if (cph <= 0) CONV_LOAD16(0);
                if (cph <= 1) CONV_LOAD16(16);
                CONV_STORE(); cph = 0;
              }
#undef CONV_LOAD16
#undef CONV_STORE
            } else {
              const int pw = (wv & 1) + ((wv >> 2) << 1), ch = h * 64 + lane;
              const float c_kk = k_k[ch], c_ka = k_a[ch], c_rk = r_k[ch], mu_r = mu_shift[ch], mu_k = mu_shift[CW + ch], mu_v = mu_shift[2 * CW + ch];
              const bf16_t* pbase = Proj + (size_t)(b * TT) * PJP + PW + h * 64; const float* dbase = Dec + (size_t)(b * TT) * CW + h * 64; const bf16_t* abase = Ab + (size_t)(b * TT) * CW + h * 64;
              constexpr int PD = 2;
              unsigned short rr[PD][NPS + 1], kr_[PD][NPS + 1], vr[PD][NPS + 1], aa[PD][NPS]; float dd[PD][NPS];
#define SCAN_LOAD(blk, SET) do { const int t0_ = (blk) * TB + pw * NPS; \
            _Pragma("unroll") for (int i_ = 0; i_ < NPS + 1; ++i_) { const unsigned t_ = (unsigned)((i_ == 0 && t0_ == 0) ? 0 : t0_ - 1 + i_); const bf16_t* pp_ = pbase + t_ * (unsigned)PJP; \
                rr[SET][i_] = pp_[lane]; kr_[SET][i_] = pp_[CW + lane]; vr[SET][i_] = pp_[2 * CW + lane]; } \
            _Pragma("unroll") for (int i_ = 0; i_ < NPS; ++i_) { const unsigned mi_ = (unsigned)(t0_ + i_) * (unsigned)CW; dd[SET][i_] = dbase[mi_ + lane]; aa[SET][i_] = abase[mi_ + lane]; } } while (0)
#define SCAN_PRODUCE(blk, SET) do { LAS float* bufp_ = ldf + ((blk) & 1) * (TB * REC); const int t0_ = (blk) * TB + pw * NPS; \
            _Pragma("unroll") for (int i_ = 0; i_ < NPS; ++i_) { \
                const float zz_ = (i_ == 0 && t0_ == 0) ? 0.f : 1.f; \
                const float rc_ = bf2f(rr[SET][i_ + 1]), kc_ = bf2f(kr_[SET][i_ + 1]), vc_ = bf2f(vr[SET][i_ + 1]), rp_ = bf2f(rr[SET][i_]) * zz_, kp_ = bf2f(kr_[SET][i_]) * zz_, vp_ = bf2f(vr[SET][i_]) * zz_; \
                const float r_ = rc_ + (rp_ - rc_) * mu_r, k_ = kc_ + (kp_ - kc_) * mu_k, v_ = vc_ + (vp_ - vc_) * mu_v; \
                const float a_ = bf2f(aa[SET][i_]), d_ = dd[SET][i_]; \
                const float kkr_ = k_ * c_kk; const float n2_ = wsum(kkr_ * kkr_); const float kk_ = kkr_ * rsqrtf(fmaxf(n2_, 1e-24f)); \
                const float kt_ = k_ * (1.0f + (a_ - 1.0f) * c_ka); const float bv_ = kk_ * a_; \
                const float br_ = wsum(bv_ * r_), krs_ = wsum(kt_ * r_), bon_ = wsum(r_ * kt_ * c_rk); \
                LAS float* rec_ = bufp_ + (pw * NPS + i_) * REC; \
                rec_[lane] = -kk_; rec_[64 + lane] = bv_; rec_[128 + lane] = d_; rec_[192 + lane] = kt_; rec_[256 + lane] = d_ * r_; rec_[320 + lane] = v_; \
                if (lane == 0) { rec_[384] = br_; rec_[385] = krs_; if (q == 0) Bonus[(size_t)(b * TT + t0_ + i_) * NH + h] = bon_; } } } while (0)
              SCAN_LOAD(0, 0); SCAN_LOAD(1, 1);
              SCAN_PRODUCE(0, 0); SCAN_LOAD(2, 0);
              WG_BAR();
              static_assert((TT / TB) % PD == 0 && PD == 2, "block loop is unrolled by PD = 2");
              for (int blk0 = 0; blk0 < TT / TB; blk0 += PD) {
#define SCAN_ITER(D_, SET) do { const int blk = blk0 + (D_); if (blk + 1 < TT / TB) { SCAN_PRODUCE(blk + 1, SET); if (blk + 1 + PD < TT / TB) SCAN_LOAD(blk + 1 + PD, SET); } WG_BAR(); } while (0)
                SCAN_ITER(0, 1); SCAN_ITER(1, 0);
#undef SCAN_ITER
              }
            }
#undef SCAN_LOAD
#undef SCAN_PRODUCE
        }
        __syncthreads();
        LAS float* wl = ldf + wave * 512;
        for (int p = gwave; p < MSA * NH; p += gwaves) {
            const int b = p >> 4, h = p & 15, m = MPR + b, ch = h * 64 + lane;
            const bf16_t* pp = Proj + (size_t)m * PJP + PW + ch; const float* sp = state_shift + (size_t)b * SW + ch;
            const float rc = bf2f(pp[0]), kc = bf2f(pp[CW]), vc = bf2f(pp[2 * CW]);
            const float r = rc + (sp[0] - rc) * mu_shift[ch], k = kc + (sp[CW] - kc) * mu_shift[CW + ch], v = vc + (sp[2 * CW] - vc) * mu_shift[2 * CW + ch];
            const float d = Dec[(size_t)m * CW + ch], a = bf2f(Ab[(size_t)m * CW + ch]);
            const float kkr = k * k_k[ch]; const float n2 = wsum(kkr * kkr); const float kk = kkr * rsqrtf(fmaxf(n2, 1e-24f));
            const float kt = k * (1.0f + (a - 1.0f) * k_a[ch]);
            const float bon = wsum(r * kt * r_k[ch]);
            wl[lane] = -kk; wl[64 + lane] = kk * a; wl[128 + lane] = d; wl[192 + lane] = kt; wl[256 + lane] = r; wl[320 + lane] = v;
            asm volatile("s_waitcnt lgkmcnt(0)" ::: "memory");
            const int kq = lane & 15, r4 = lane >> 4;
            const f32x4 av = *(const LAS f32x4*)(wl + kq * 4), bv = *(const LAS f32x4*)(wl + 64 + kq * 4), dw = *(const LAS f32x4*)(wl + 128 + kq * 4);
            const f32x4 ktv = *(const LAS f32x4*)(wl + 192 + kq * 4), rv = *(const LAS f32x4*)(wl + 256 + kq * 4);
            const float* sin_ = state_wkv + (size_t)(b * NH + h) * 4096; float* sout = out + OUT_WKVS + (size_t)(b * NH + h) * 4096;
#pragma unroll 4
            for (int j = 0; j < 16; ++j) {
                const int row = r4 + 4 * j; f32x4 Sv = *(const f32x4*)(sin_ + row * 64 + kq * 4);
                float da = (Sv[0] * av[0] + Sv[1] * av[1]) + (Sv[2] * av[2] + Sv[3] * av[3]); da = red16(da);
                const float vv = wl[320 + row];
                Sv = Sv * dw + da * bv + vv * ktv;
                *(f32x4*)(sout + row * 64 + kq * 4) = Sv;
                float dy = (Sv[0] * rv[0] + Sv[1] * rv[1]) + (Sv[2] * rv[2] + Sv[3] * rv[3]); dy = red16(dy);
                if (kq == 0) wl[384 + row] = dy;
            }
            asm volatile("s_waitcnt lgkmcnt(0)" ::: "memory");
            const float y = wl[384 + lane];
            const float mean = wsum(y) * (1.0f / 64.0f); const float dl = y - mean; const float var = wsum(dl * dl) * (1.0f / 64.0f);
            const float yn = dl * rsqrtf(var + GN_EPS) * gn_w[ch] + gn_b[ch];
            const float o = (yn + bon * v) * bf2f(Gb[(size_t)m * CW + ch]);
            Mix[(size_t)m * D + PW + ch] = (bf16_t)f2bf(o);
            asm volatile("s_waitcnt lgkmcnt(0)" ::: "memory");
        }
    }
    SEAM();

    if (IN(5)) {
        PHASE_IDS
        { pg8::Gemm g{Mix, WoutT, D, D, 256}; pg8::SplitKOrder S{8, KS6, 32, 256, G, (bid + G - 192 % G) % G};
          EpiPartial E{Part6}; pg8::gemm_phase(lds, g, S, E); }
        {
            const int half = gwave & 1, ch0 = half * 512 + lane * 8, h = ch0 >> 6;
            const f32x4 mu0 = *(const f32x4*)(mu_shift + 2 * CW + ch0), mu1 = *(const f32x4*)(mu_shift + 2 * CW + ch0 + 4);
            const f32x4 gw0 = *(const f32x4*)(gn_w + ch0), gw1 = *(const f32x4*)(gn_w + ch0 + 4), gb0 = *(const f32x4*)(gn_b + ch0), gb1 = *(const f32x4*)(gn_b + ch0 + 4);
            for (int it0 = gwave; it0 < MPR * 2; it0 += 2 * gwaves) {
                f32x4 y0[2], y1[2]; u32x4 vc[2], vp[2], gt[2]; float bon[2]; int mm[2]; bool val[2];
#pragma unroll
                for (int u = 0; u < 2; ++u) {
                    const int it = it0 + u * gwaves; val[u] = it < MPR * 2; const int m = val[u] ? (it >> 1) : 0; mm[u] = m;
                    const int mprev = (m & (TT - 1)) ? m - 1 : m;
                    y0[u] = *(const f32x4*)(Yb + (size_t)m * CW + ch0); y1[u] = *(const f32x4*)(Yb + (size_t)m * CW + ch0 + 4);
                    vc[u] = *(const u32x4*)(Proj + (size_t)m * PJP + PW + 2 * CW + ch0); vp[u] = *(const u32x4*)(Proj + (size_t)mprev * PJP + PW + 2 * CW + ch0);
                    gt[u] = *(const u32x4*)(Gb + (size_t)m * CW + ch0); bon[u] = Bonus[(size_t)m * NH + h];
                }
#pragma unroll
                for (int u = 0; u < 2; ++u) {
                    const int m = mm[u]; const float fm = (m & (TT - 1)) == 0 ? 0.f : 1.f;
                    float y[8] = {y0[u][0], y0[u][1], y0[u][2], y0[u][3], y1[u][0], y1[u][1], y1[u][2], y1[u][3]};
                    float s = ((y[0] + y[1]) + (y[2] + y[3])) + ((y[4] + y[5]) + (y[6] + y[7])); s = red8(s);
                    const float mean = s * (1.0f / 64.0f); float q2 = 0.f;
#pragma unroll
                    for (int j = 0; j < 8; ++j) { y[j] -= mean; q2 += y[j] * y[j]; }
                    q2 = red8(q2); const float rstd = rsqrtf(q2 * (1.0f / 64.0f) + GN_EPS);
                    unsigned ow[4];
#pragma unroll
                    for (int j2 = 0; j2 < 4; ++j2) {
                        float o2[2];
#pragma unroll
                        for (int e = 0; e < 2; ++e) {
                            const int j = j2 * 2 + e; const unsigned cw = vc[u][j2], pw_ = vp[u][j2], gw_ = gt[u][j2];
                            const float c_ = e ? bf2f(cw >> 16) : bf2f(cw & 0xffffu), p_ = fm * (e ? bf2f(pw_ >> 16) : bf2f(pw_ & 0xffffu)), g_ = e ? bf2f(gw_ >> 16) : bf2f(gw_ & 0xffffu);
                            const float mu_ = j < 4 ? mu0[j & 3] : mu1[j & 3], gnw = j < 4 ? gw0[j & 3] : gw1[j & 3], gnb = j < 4 ? gb0[j & 3] : gb1[j & 3];
                            const float v = c_ + (p_ - c_) * mu_;
                            o2[e] = (y[j] * rstd * gnw + gnb + bon[u] * v) * g_;
                        }
                        ow[j2] = pk_bf16(o2[0], o2[1]);
                    }
                    if (val[u]) *(u32x4*)(Mix + (size_t)m * D + PW + ch0) = (u32x4){ow[0], ow[1], ow[2], ow[3]};
                }
            }
        }
    }
    SEAM();

    if (IN(6)) {
        PHASE_IDS
        pg8::Gemm g{Mix, WoutT, D, D, D}; pg8::StaticOrder S; S.init(MPR, D, G, bid);
        EpiOut E{x_prompt, x_sample, out, H2, norm_ffn, rowsq1};
        pg8::gemm_phase(lds, g, S, E);
        for (int r = gwave; r < MSA; r += gwaves) {
            const int row = MPR + r; float s = 0.f;
#pragma unroll
            for (int i = 0; i < 8; ++i) {
                const int c = (i * 64 + lane) * 4; f32x4 x1 = *(const f32x4*)(x_sample + (size_t)r * D + c);
#pragma unroll
                for (int ks = 0; ks < KS6; ++ks) x1 = x1 + *(const f32x4*)(Part6 + ((size_t)ks * MSA + r) * D + c);
                *(f32x4*)(out + (size_t)row * D + c) = x1;
                s += (x1[0] * x1[0] + x1[1] * x1[1]) + (x1[2] * x1[2] + x1[3] * x1[3]);
                const f32x4 hv = x1 * *(const f32x4*)(norm_ffn + c);
                u32x2 w; w.x = pk_bf16(hv[0], hv[1]); w.y = pk_bf16(hv[2], hv[3]); *(u32x2*)(H2 + (size_t)row * D + c) = w;
            }
            s = wsum(s); if (lane == 0) rowsq1[row] = s;
        }
    }
    SEAM();

    if (IN(7)) {
        PHASE_IDS
        pg8::Gemm g{H2, WguT, D, D, D}; pg8::StaticOrder S; S.init(MPAD, 2 * DFF, G, bid);
        EpiGU E{Ub, rowsq1};
        pg8::gemm_phase(lds, g, S, E);
    }
    SEAM();

    if (IN(8)) {
        PHASE_IDS
        if (G == 256) { pg8::Gemm g{Ub, WdnT, DFF, DFF, DFF}; pg8::StaticOrder S; S.init(MPR, D, G, bid);
          EpiDownNorm E{out, rowsq2, pcnt, norm_final}; pg8::gemm_phase(lds, g, S, E); }
        else { pg8::Gemm g{Ub, WdnT, DFF, DFF, DFF}; pg8::StaticOrder S; S.init(MPR, D, G, bid);
          EpiDown E{out}; pg8::gemm_phase(lds, g, S, E); }
        { pg8::Gemm g{Ub, WdnT, DFF, DFF, 512}; pg8::SplitKOrder S{8, KS8, 32, 512, G, bid};
          EpiPartial E{Part8}; pg8::gemm_phase(lds, g, S, E); }
    }
    SEAM();

    if (IN(9)) {
        PHASE_IDS
        for (int row = (G == 256 ? MPR : 0) + gwave; row < MV; row += gwaves) {
            float* p = out + (size_t)row * D; f32x4 v[8]; float s = 0.f;
#pragma unroll
            for (int i = 0; i < 8; ++i) v[i] = *(const f32x4*)(p + (i * 64 + lane) * 4);
            if (row >= MPR) {
#pragma unroll
                for (int i = 0; i < 8; ++i)
#pragma unroll
                    for (int ks = 0; ks < KS8; ++ks) v[i] = v[i] + *(const f32x4*)(Part8 + ((size_t)ks * MSA + (row - MPR)) * D + (i * 64 + lane) * 4);
            }
#pragma unroll
            for (int i = 0; i < 8; ++i) s += (v[i][0] * v[i][0] + v[i][1] * v[i][1]) + (v[i][2] * v[i][2] + v[i][3] * v[i][3]);
            s = wsum(s); const float rstd = rsqrtf(s * (1.0f / D) + RMS_EPS);
#pragma unroll
            for (int i = 0; i < 8; ++i) { const int c = (i * 64 + lane) * 4; *(f32x4*)(p + c) = v[i] * rstd * *(const f32x4*)(norm_final + c); }
        }
    }
#undef IN
#undef SEAM
}

#ifndef HY_MULTI
#define HY_MULTI 0
#endif
#ifndef HY_REP
#define HY_REP 0
#endif
extern "C" void kernel_launch(void* const* d_in, const int* in_sizes, int n_in, void* d_out, int out_size, void* d_ws, size_t ws_size, hipStream_t stream) {
    static int grid = 0;
    if (grid == 0) {
        if (n_in != 26 || ws_size < WS_END) { fprintf(stderr, "kernel_launch: need 26 inputs and >= %zu bytes of workspace (got %d, %zu)\n", (size_t)WS_END, n_in, ws_size); grid = -1; return; }
        int dev = 0, cus = 0, per_cu = 0;
        hipGetDevice(&dev); hipDeviceGetAttribute(&cus, hipDeviceAttributeMultiprocessorCount, dev);
        if (hipFuncSetAttribute((const void*)hymba_fwd, hipFuncAttributeMaxDynamicSharedMemorySize, LDS_BYTES) != hipSuccess) { fprintf(stderr, "kernel_launch: hipFuncSetAttribute failed\n"); grid = -1; return; }
        if (hipOccupancyMaxActiveBlocksPerMultiprocessor(&per_cu, (const void*)hymba_fwd, NTHR, LDS_BYTES) != hipSuccess || per_cu < 1) { fprintf(stderr, "kernel_launch: occupancy query says %d\n", per_cu); per_cu = 1; }
        (void)hipGetLastError();
        grid = cus;
        if (grid > 256) grid = 256;
    }
    if (grid < 0) return;
    Params p{};
    for (int i = 0; i < 26; ++i) p.in[i] = (const float*)d_in[i];
    p.out = (float*)d_out; p.ws = (unsigned char*)d_ws;
#if HY_MULTI
    p.multi = 1;
    for (int ph = 0; ph < 10; ++ph) { p.phase = ph; for (int r = 0; r < ((HY_REP >> ph) & 1) + 1; ++r) hipLaunchKernelGGL(hymba_fwd, dim3(grid), dim3(NTHR), LDS_BYTES, stream, p); }
#else
    p.multi = 0; p.phase = 0;
    hipMemsetAsync((char*)d_ws + WS_BAR, 0, 16384 + 8192, stream);
    void* args[] = {&p};
    hipError_t e = hipLaunchCooperativeKernel((const void*)hymba_fwd, dim3(grid), dim3(NTHR), args, LDS_BYTES, stream);
    if (e != hipSuccess) fprintf(stderr, "cooperative launch failed: %s (grid %d)\n", hipGetErrorString(e), grid);
#endif
}
```

```cpp
#include <hip/hip_runtime.h>
#include <hip/hip_cooperative_groups.h>
#include <cstdio>
namespace cg = cooperative_groups;

#define LAS __attribute__((address_space(3)))
typedef unsigned short bf16_t;
typedef short bf16x8 __attribute__((ext_vector_type(8)));
typedef float f32x4 __attribute__((ext_vector_type(4)));
typedef float f32x2 __attribute__((ext_vector_type(2)));
typedef unsigned u32x4 __attribute__((ext_vector_type(4)));
typedef unsigned u32x2 __attribute__((ext_vector_type(2)));

constexpr int D = 2048, TT = 2048, MPR = 8192, MSA = 128, MV = 8320, MPAD = 8448;
constexpr int PW = 1024, SW = 3360, PJ = 4384, PJP = 4608, DFF = 5632, CW = 1024, NH = 16;
constexpr int NTHR = 512, LDS_BYTES = 131072 + 16, LDS_ST_OFF = 131072;
constexpr float RMS_EPS = 1e-6f, GN_EPS = 64e-5f;

constexpr size_t WS_WIN = 0;
constexpr size_t WS_WOUT = WS_WIN + (size_t)PJP * D * 2;
constexpr size_t WS_WGU = WS_WOUT + (size_t)D * D * 2;
constexpr size_t WS_WDN = WS_WGU + (size_t)2 * DFF * D * 2;
constexpr size_t WS_WPOOL = WS_WDN + (size_t)D * DFF * 2;
constexpr size_t WS_WLORA = WS_WPOOL + (size_t)4 * 256 * 256 * 2;
constexpr size_t WS_R1 = WS_WLORA + (size_t)3 * 1024 * 256 * 2;
constexpr size_t WS_PROJ = WS_R1 + (size_t)MPAD * D * 2;
constexpr size_t WS_A = WS_PROJ + (size_t)MPAD * PJP * 2;
constexpr size_t WS_GATE = WS_A + (size_t)MPAD * CW * 2;
constexpr size_t WS_MIX = WS_GATE + (size_t)MPAD * CW * 2;
constexpr size_t WS_ROWSQ = WS_MIX + (size_t)MPAD * D * 2;
constexpr size_t WS_BONUS = WS_ROWSQ + (size_t)2 * MPAD * 4;
constexpr size_t WS_BAR = WS_BONUS + (size_t)MV * NH * 4;
constexpr size_t WS_PCNT = WS_BAR + 16384;
constexpr size_t WS_END = WS_PCNT + 8192;
static_assert((size_t)MPAD * DFF * 2 <= (WS_MIX - WS_PROJ), "U must fit in proj+a+gate");
constexpr int XLD = 1792;
static_assert((size_t)MPAD * XLD * 2 <= (size_t)MPAD * D * 2, "X fits in WS_R1");
constexpr int KS6 = 8, KS8 = 11;
static_assert((size_t)KS6 * MSA * D * 4 <= (size_t)MPAD * CW * 2 && (size_t)KS8 * MSA * D * 4 <= (size_t)MPAD * D * 2, "partial buffers alias WS_A / WS_R1");

constexpr size_t OUT_Y = 0;
constexpr size_t OUT_POOLP = (size_t)MV * D;
constexpr size_t OUT_SHIFTP = OUT_POOLP + (size_t)4 * 15 * PW;
constexpr size_t OUT_WKVP = OUT_SHIFTP + (size_t)4 * SW;
constexpr size_t OUT_POOLS = OUT_WKVP + (size_t)4 * NH * 64 * 64;
constexpr size_t OUT_SHIFTS = OUT_POOLS + (size_t)MSA * 15 * PW;
constexpr size_t OUT_WKVS = OUT_SHIFTS + (size_t)MSA * SW;
constexpr size_t SCR_Y = 0;
constexpr size_t SCR_DEC = (size_t)MPR * CW;
static_assert(SCR_DEC + (size_t)MV * CW <= OUT_POOLP, "scratch must fit in the y region");

struct Params { const float* in[26]; float* out; unsigned char* ws; int multi; int phase; };

__device__ __forceinline__ float bf2f(unsigned b) { return __uint_as_float(b << 16); }
__device__ __forceinline__ unsigned f2bf(float f) { unsigned u = __float_as_uint(f); u += 0x7FFFu + ((u >> 16) & 1u); return u >> 16; }
__device__ __forceinline__ unsigned pk_bf16(float lo, float hi) { unsigned r; asm volatile("v_cvt_pk_bf16_f32 %0, %1, %2" : "=v"(r) : "v"(lo), "v"(hi)); return r; }
template <int CTRL> __device__ __forceinline__ float dpp(float x) { return __int_as_float(__builtin_amdgcn_update_dpp(0, __float_as_int(x), CTRL, 0xF, 0xF, true)); }
__device__ __forceinline__ float red16(float x) {
    x += dpp<0x128>(x); x += dpp<0x124>(x); x += dpp<0x4E>(x); x += dpp<0xB1>(x); return x;
}
__device__ __forceinline__ float wsum(float x) {
    x = red16(x);
    x += __int_as_float(__builtin_amdgcn_update_dpp(0, __float_as_int(x), 0x142, 0xA, 0xF, false));
    x += __int_as_float(__builtin_amdgcn_update_dpp(0, __float_as_int(x), 0x143, 0xC, 0xF, false));
    return __int_as_float(__builtin_amdgcn_readlane(__float_as_int(x), 63));
}
__device__ __forceinline__ float fma_(float a, float b, float c) { float d; asm("v_fma_f32 %0, %1, %2, %3" : "=v"(d) : "v"(a), "v"(b), "v"(c)); return d; }
__device__ __forceinline__ f32x2 pkmul_(f32x2 a, f32x2 b) { f32x2 d; asm("v_pk_mul_f32 %0, %1, %2" : "=v"(d) : "v"(a), "v"(b)); return d; }
__device__ __forceinline__ f32x2 pkfma_(f32x2 a, f32x2 b, f32x2 c) { f32x2 d; asm("v_pk_fma_f32 %0, %1, %2, %3" : "=v"(d) : "v"(a), "v"(b), "v"(c)); return d; }
__device__ __forceinline__ f32x2 pkfma_b(f32x2 a, f32x2 s, f32x2 c) { f32x2 d; asm("v_pk_fma_f32 %0, %1, %2, %3 op_sel_hi:[1,0,1]" : "=v"(d) : "v"(a), "v"(s), "v"(c)); return d; }
__device__ __forceinline__ f32x2 lo2(f32x4 v) { return __builtin_shufflevector(v, v, 0, 1); }
__device__ __forceinline__ f32x2 hi2(f32x4 v) { return __builtin_shufflevector(v, v, 2, 3); }
__device__ __forceinline__ float mul_(float a, float b) { float d; asm("v_mul_f32 %0, %1, %2" : "=v"(d) : "v"(a), "v"(b)); return d; }
__device__ __forceinline__ float sigmoidf_(float x) { return __builtin_amdgcn_rcpf(1.0f + __expf(-x)); }

#define WG_BAR() do { asm volatile("s_waitcnt lgkmcnt(0)" ::: "memory"); __builtin_amdgcn_s_barrier(); asm volatile("" ::: "memory"); } while (0)

#define XB_TMO      128
#define XB_XCNT(j)  (256  + 64 * (j))
#define XB_XSUB(j)  (1280 + 64 * (j))
#define XB_XGEN(j)  (2304 + 64 * (j))
#define XB_TOP      3328
#define XB_TOPGEN   3392
#define XCD_BAR_WORDS 3456
#define XB_SPIN_CAP (1u << 18)

__device__ __forceinline__ unsigned xb_ld(unsigned* p)              { return __hip_atomic_load(p, __ATOMIC_RELAXED, __HIP_MEMORY_SCOPE_AGENT); }
__device__ __forceinline__ unsigned xb_add(unsigned* p, unsigned v) { return __hip_atomic_fetch_add(p, v, __ATOMIC_RELAXED, __HIP_MEMORY_SCOPE_AGENT); }
__device__ __forceinline__ unsigned xb_xcc_id() { return (unsigned)__builtin_amdgcn_s_getreg((3 << 11) | 20) & 0xFu; }
#define XB_SPIN(cond, bar) do { unsigned _sp = 0; while (cond) { __builtin_amdgcn_s_sleep(1); \
    if ((++_sp & 255u) == 0u) { if (xb_ld(&(bar)[XB_TMO])) break; if (_sp > XB_SPIN_CAP) { atomicAdd(&(bar)[XB_TMO], 1u); break; } } } } while (0)

struct XcdBarrier {
    unsigned* bar; unsigned x;
    volatile LAS unsigned* st;
};

__device__ __forceinline__ XcdBarrier xcd_barrier_post(unsigned* bar, volatile LAS unsigned* st) {
    XcdBarrier b; b.bar = bar; b.x = xb_xcc_id(); b.st = st;
    if (threadIdx.x == 0) (void)xb_add(&bar[XB_XCNT(b.x)], 1u);
    return b;
}
__device__ __forceinline__ void xcd_barrier_complete(unsigned* bar, unsigned x, unsigned& nloc, unsigned& nx) {
    const unsigned G = gridDim.x * gridDim.y * gridDim.z;
    unsigned sum, cnt, mine, sp = 0u;
    for (;;) {
        sum = 0u; cnt = 0u; mine = 0u;
#pragma unroll
        for (unsigned j = 0; j < 16; ++j) { const unsigned c = xb_ld(&bar[XB_XCNT(j)]); sum += c; cnt += (c > 0u) ? 1u : 0u; mine = (j == x) ? c : mine; }
        if (sum == G) break;
        __builtin_amdgcn_s_sleep(1);
        if ((++sp & 255u) == 0u) { if (xb_ld(&bar[XB_TMO])) break; if (sp > XB_SPIN_CAP) { atomicAdd(&bar[XB_TMO], 1u); break; } }
    }
    nloc = mine > 0u ? mine : 1u; nx = cnt > 0u ? cnt : 1u;
}

__device__ __forceinline__ void xcd_barrier(const XcdBarrier& b) {
    asm volatile("s_waitcnt vmcnt(0)" ::: "memory");
    __syncthreads();
    if (threadIdx.x == 0) {
        unsigned* bar = b.bar;
        __builtin_amdgcn_s_waitcnt(0);
        unsigned nloc = b.st[0], nx = b.st[1];
        if (nloc == 0u) { xcd_barrier_complete(bar, b.x, nloc, nx); b.st[0] = nloc; b.st[1] = nx; }
        const unsigned old = xb_add(&bar[XB_XSUB(b.x)], 1u);
        const unsigned gen = old / nloc;
        if (old + 1u == (gen + 1u) * nloc) {
            __builtin_amdgcn_fence(__ATOMIC_RELEASE, "agent");
            asm volatile("s_waitcnt vmcnt(0)" ::: "memory");
            const unsigned og = xb_add(&bar[XB_TOP], 1u);
            const unsigned tg = og / nx;
            if (og + 1u == (tg + 1u) * nx) xb_add(&bar[XB_TOPGEN], 1u);
            else XB_SPIN(xb_ld(&bar[XB_TOPGEN]) == tg, bar);
            __builtin_amdgcn_fence(__ATOMIC_ACQUIRE, "agent");
            xb_add(&bar[XB_XGEN(b.x)], 1u);
            asm volatile("s_waitcnt vmcnt(0)" ::: "memory");
        } else {
            XB_SPIN(xb_ld(&bar[XB_XGEN(b.x)]) == gen, bar);
            __builtin_amdgcn_fence(__ATOMIC_ACQUIRE, "agent");
            asm volatile("s_waitcnt vmcnt(0)" ::: "memory");
        }
    }
    __syncthreads();
}

__device__ __forceinline__ void grid_bar(unsigned* ctr, unsigned target) {
    asm volatile("s_waitcnt vmcnt(0) lgkmcnt(0)" ::: "memory");
    __syncthreads();
    if (threadIdx.x == 0) {
        __builtin_amdgcn_fence(__ATOMIC_RELEASE, "agent");
        asm volatile("s_waitcnt vmcnt(0)" ::: "memory");
        __hip_atomic_fetch_add(ctr, 1u, __ATOMIC_RELAXED, __HIP_MEMORY_SCOPE_AGENT);
        while (__hip_atomic_load(ctr, __ATOMIC_RELAXED, __HIP_MEMORY_SCOPE_AGENT) < target) __builtin_amdgcn_s_sleep(4);
        __builtin_amdgcn_fence(__ATOMIC_ACQUIRE, "agent");
        asm volatile("s_waitcnt vmcnt(0)" ::: "memory");
    }
    __syncthreads();
}

namespace pg8 {
constexpr int BM = 256, BK = 64, HALF = 128, HTB = HALF * BK * 2, NXCD = 8, WGM = 8;
__device__ __forceinline__ int lds_byte(int r, int c) { const int st = (r >> 4) * 2 + (c >> 5), rr = r & 15, cc = c & 31, ob = rr * 64 + cc * 2; return st * 1024 + (ob ^ (((ob >> 9) & 1) << 5)); }
__device__ __forceinline__ void stage_rc(int b, int& R, int& C) { const int st = b / 1024, sb = b % 1024, swz = sb ^ (((sb >> 9) & 1) << 5); R = (st >> 1) * 16 + swz / 64; C = (st & 1) * 32 + (swz % 64) / 2; }
__device__ __forceinline__ int perm32(int rho) { const int n = rho >> 4, i = rho & 15; return 8 * (i >> 2) + 4 * n + (i & 3); }
struct Unit { int pm, pn, ks, koffA, koffB; };
struct Gemm { const bf16_t* A; const bf16_t* Bt; int lda, ldb, K; };
struct StaticOrder {
    int nM, nN, nwg, G, c;
    __device__ void init(int M, int N, int G_, int c_) { nM = M / BM; nN = N / BM; nwg = nM * nN; G = G_; c = c_; }
    __device__ bool next(int i, Unit& u) const {
        const long L = (long)i * G + c; if (L >= nwg) return false;
        int wgid = (int)L; { const int q = nwg / NXCD, r = nwg % NXCD, xcd = wgid % NXCD, off = wgid / NXCD; wgid = (xcd < r ? xcd * (q + 1) : r * (q + 1) + (xcd - r) * q) + off; }
        const int nig = WGM * nN, gid = wgid / nig, fm = gid * WGM, gsz = (nM - fm) < WGM ? (nM - fm) : WGM;
        u.pm = fm + ((wgid % nig) % gsz); u.pn = (wgid % nig) / gsz; u.ks = 0; u.koffA = 0; u.koffB = 0; return true;
    }
};
struct SplitKOrder {
    int nN, nks, pm, kchunk, G, c;
    __device__ bool next(int i, Unit& u) const { const long L = (long)i * G + c; if (L >= (long)nN * nks) return false;
        u.pm = pm; u.pn = (int)(L % nN); u.ks = (int)(L / nN); u.koffA = u.ks * kchunk; u.koffB = u.koffA; return true; }
};

struct P3Order {
    int G, c;
    __device__ bool next(int i, Unit& u) const { const int L = i * G + c; if (L >= 16 * 33) return false;
        u.pn = L / 33; u.pm = L - u.pn * 33; u.ks = 0; u.koffB = 0; u.koffA = u.pn < 4 ? u.pn * 256 : 1024 + ((u.pn - 4) >> 2) * 256; return true; }
};
template <class Epi, class Sched>
__device__ __forceinline__ void gemm_phase(LAS unsigned char* lds, const Gemm g, const Sched& S, const Epi& E) {
    const int tid = threadIdx.x, wid = __builtin_amdgcn_readfirstlane(tid >> 6), lane = tid & 63, wr = wid >> 2, wc = wid & 3, fr = lane & 15, fq = lane >> 4;
    const int K = g.K, nt = K / BK;
    unsigned voffA[2], voffB[2];
#pragma unroll
    for (int i = 0; i < 2; ++i) { int R, C; stage_rc(tid * 16 + i * 8192, R, C); const int Rb = Epi::PERM ? ((R & ~31) + perm32(R & 31)) : R;
        voffA[i] = (unsigned)(R * g.lda + C) * 2u; voffB[i] = (unsigned)(Rb * g.ldb + C) * 2u; }
    const size_t kstep = (size_t)(BK * 2);
    const size_t hstepA = (size_t)HALF * g.lda * 2, hstepB = (size_t)HALF * g.ldb * 2;
    const size_t tstepA = 2 * hstepA, tstepB = 2 * hstepB;
    const unsigned ldsw = (unsigned)wid * 1024u;
    const int aoff = lds_byte(wr * 64 + fr, fq * 8), boff = lds_byte(wc * 32 + fr, fq * 8);
#define PG8_SA(b, h) (((b) * 2 + (h)) * HTB)
#define PG8_SB(b, h) ((4 + (b) * 2 + (h)) * HTB)
#define PG8_STAGE(bufoff, gbase, voff) do { _Pragma("unroll") for (int _i = 0; _i < 2; ++_i) \
        __builtin_amdgcn_global_load_lds((const unsigned*)((const char*)(gbase) + (voff)[_i]), (LAS unsigned*)(lds + (bufoff) + ldsw + _i * 8192), 16, 0, 0); } while (0)
#define PG8_LDA(dst, b, h) do { _Pragma("unroll") for (int m = 0; m < 4; ++m) _Pragma("unroll") for (int k = 0; k < 2; ++k) dst[m][k] = *(const LAS bf16x8*)(lds + PG8_SA(b, h) + aoff + m * 2048 + k * 1024); } while (0)
#define PG8_LDB(dst, b, h) do { _Pragma("unroll") for (int n = 0; n < 2; ++n) _Pragma("unroll") for (int k = 0; k < 2; ++k) dst[n][k] = *(const LAS bf16x8*)(lds + PG8_SB(b, h) + boff + n * 2048 + k * 1024); } while (0)
#define PG8_MMA(ai, bj, At, Bt) do { __builtin_amdgcn_s_setprio(1); _Pragma("unroll") for (int m = 0; m < 4; ++m) _Pragma("unroll") for (int n = 0; n < 2; ++n) _Pragma("unroll") for (int k = 0; k < 2; ++k) \
        acc[ai][bj][m][n] = __builtin_amdgcn_mfma_f32_16x16x32_bf16(Bt[n][k], At[m][k], acc[ai][bj][m][n], 0, 0, 0); __builtin_amdgcn_s_setprio(0); } while (0)
#define PG8_WAIT_V(n) asm volatile("s_waitcnt vmcnt(" #n ")" ::: "memory")
#define PG8_WAIT_L(n) asm volatile("s_waitcnt lgkmcnt(" #n ")" ::: "memory")
#define PG8_BAR __builtin_amdgcn_s_barrier()
#define PG8_SCHED __builtin_amdgcn_sched_barrier(0)
    Unit cur, nxt; int ui = 0;
    if (!S.next(0, cur)) return;
    f32x4 acc[2][2][4][2];
#pragma unroll
    for (int a = 0; a < 2; ++a)
#pragma unroll
        for (int b = 0; b < 2; ++b)
#pragma unroll
            for (int m = 0; m < 4; ++m)
#pragma unroll
                for (int n = 0; n < 2; ++n) acc[a][b][m][n] = (f32x4){0.f, 0.f, 0.f, 0.f};
    bf16x8 At[4][2], B0[2][2], B1[2][2];
    const char* cA = (const char*)g.A + (size_t)cur.pm * tstepA + (size_t)cur.koffA * 2; const char* cB = (const char*)g.Bt + (size_t)cur.pn * tstepB + (size_t)cur.koffB * 2;
    PG8_STAGE(PG8_SB(0, 0), cB, voffB); PG8_STAGE(PG8_SA(0, 0), cA, voffA); PG8_STAGE(PG8_SB(0, 1), cB + hstepB, voffB); PG8_STAGE(PG8_SA(0, 1), cA + hstepA, voffA);
    if (wr == 1) PG8_BAR;
    PG8_WAIT_V(4); PG8_BAR;
    PG8_STAGE(PG8_SB(1, 0), cB + kstep, voffB); PG8_STAGE(PG8_SA(1, 0), cA + kstep, voffA); PG8_STAGE(PG8_SB(1, 1), cB + hstepB + kstep, voffB);
    PG8_WAIT_V(6); PG8_BAR;
    for (;;) {
        const bool has_next = S.next(ui + 1, nxt);
        const char* nA = has_next ? (const char*)g.A + (size_t)nxt.pm * tstepA + (size_t)nxt.koffA * 2 : cA; const char* nB = has_next ? (const char*)g.Bt + (size_t)nxt.pn * tstepB + (size_t)nxt.koffB * 2 : cB;
#pragma clang loop unroll(disable)
        for (int t = 0; t < nt; t += 2) {
            const bool last = (t == nt - 2);
            const char* a1 = cA + (size_t)(t + 1) * kstep;
            const char* a2 = last ? nA : cA + (size_t)(t + 2) * kstep; const char* b2 = last ? nB : cB + (size_t)(t + 2) * kstep;
            const char* a3 = a2 + kstep; const char* b3 = b2 + kstep;
            PG8_LDB(B0, 0, 0); PG8_SCHED; PG8_LDA(At, 0, 0); PG8_STAGE(PG8_SA(1, 1), a1 + hstepA, voffA);
            PG8_WAIT_L(8); PG8_BAR; PG8_WAIT_L(0); PG8_MMA(0, 0, At, B0); PG8_BAR; PG8_SCHED;
            PG8_LDB(B1, 0, 1); PG8_STAGE(PG8_SB(0, 0), b2, voffB);
            PG8_BAR; PG8_WAIT_L(0); PG8_MMA(0, 1, At, B1); PG8_BAR;
            PG8_LDA(At, 0, 1); PG8_STAGE(PG8_SA(0, 0), a2, voffA);
            PG8_BAR; PG8_WAIT_L(0); PG8_MMA(1, 0, At, B0); PG8_BAR; PG8_SCHED;
            PG8_STAGE(PG8_SB(0, 1), b2 + hstepB, voffB);
            PG8_WAIT_V(6); PG8_BAR; PG8_MMA(1, 1, At, B1); PG8_BAR;
            PG8_LDB(B0, 1, 0); PG8_SCHED; PG8_LDA(At, 1, 0); PG8_STAGE(PG8_SA(0, 1), a2 + hstepA, voffA);
            PG8_WAIT_L(8); PG8_BAR; PG8_WAIT_L(0); PG8_MMA(0, 0, At, B0); PG8_BAR; PG8_SCHED;
            PG8_LDB(B1, 1, 1); PG8_STAGE(PG8_SB(1, 0), b3, voffB);
            PG8_BAR; PG8_WAIT_L(0); PG8_MMA(0, 1, At, B1); PG8_BAR;
            PG8_LDA(At, 1, 1); PG8_STAGE(PG8_SA(1, 0), a3, voffA);
            PG8_BAR; PG8_WAIT_L(0); PG8_MMA(1, 0, At, B0); PG8_BAR; PG8_SCHED;
            PG8_STAGE(PG8_SB(1, 1), b3 + hstepB, voffB);
            PG8_WAIT_V(6); PG8_BAR; PG8_MMA(1, 1, At, B1); PG8_BAR;
        }
        if constexpr (!Epi::AFTER_DRAIN) E(acc, cur, wr, wc, fr, fq);
        if (!has_next) break;
#pragma unroll
        for (int a = 0; a < 2; ++a)
#pragma unroll
            for (int b = 0; b < 2; ++b)
#pragma unroll
                for (int m = 0; m < 4; ++m)
#pragma unroll
                    for (int n = 0; n < 2; ++n) acc[a][b][m][n] = (f32x4){0.f, 0.f, 0.f, 0.f};
        cur = nxt; cA = nA; cB = nB; ++ui;
    }
    PG8_WAIT_V(0);
    if (wr == 0) PG8_BAR;
    PG8_BAR;
    if constexpr (Epi::AFTER_DRAIN) E(acc, cur, wr, wc, fr, fq);
#undef PG8_SA
#undef PG8_SB
#undef PG8_STAGE
#undef PG8_LDA
#undef PG8_LDB
#undef PG8_MMA
#undef PG8_WAIT_V
#undef PG8_WAIT_L
#undef PG8_BAR
#undef PG8_SCHED
}
}
using pg8::Unit;

template <int MODE> struct EpiBf16 {
    static constexpr bool PERM = true, AFTER_DRAIN = false;
    bf16_t* O; int ldc; int coff; const float* vec;
    __device__ __forceinline__ void operator()(const f32x4 (&acc)[2][2][4][2], const Unit& u, int wr, int wc, int fr, int fq) const {
        const int row0 = u.pm * 256 + wr * 64 + fr, col0 = coff + u.pn * 256 + wc * 32 + 8 * fq;
#pragma unroll
        for (int bj = 0; bj < 2; ++bj) {
            const int c = col0 + bj * 128;
            f32x4 s0, s1;
            if (MODE == 0) { s0 = vec ? *(const f32x4*)(vec + c) : (f32x4){1.f, 1.f, 1.f, 1.f}; s1 = vec ? *(const f32x4*)(vec + c + 4) : (f32x4){1.f, 1.f, 1.f, 1.f}; }
            else { s0 = *(const f32x4*)(vec + c); s1 = *(const f32x4*)(vec + c + 4); }
#pragma unroll
            for (int ai = 0; ai < 2; ++ai)
#pragma unroll
                for (int m = 0; m < 4; ++m) {
                    f32x4 v0 = acc[ai][bj][m][0], v1 = acc[ai][bj][m][1];
                    if (MODE == 0) { v0 = v0 * s0; v1 = v1 * s1; }
                    else {
#pragma unroll
                        for (int j = 0; j < 4; ++j) { v0[j] = sigmoidf_(v0[j] + s0[j]); v1[j] = sigmoidf_(v1[j] + s1[j]); } }
                    u32x4 w; w.x = pk_bf16(v0[0], v0[1]); w.y = pk_bf16(v0[2], v0[3]); w.z = pk_bf16(v1[0], v1[1]); w.w = pk_bf16(v1[2], v1[3]);
                    *(u32x4*)(O + (size_t)(row0 + ai * 128 + m * 16) * ldc + c) = w;
                }
        }
    }
};
struct EpiP3 {
    static constexpr bool PERM = true, AFTER_DRAIN = false;
    bf16_t* MixO; float* DecO; bf16_t* AO; bf16_t* GO; const float* pscale; const float* w0v; const float* a0v;
    __device__ __forceinline__ void operator()(const f32x4 (&acc)[2][2][4][2], const Unit& u, int wr, int wc, int fr, int fq) const {
        const bool pool = u.pn < 4; const int sgm = (u.pn - 4) >> 2;
        const int mode = pool ? 0 : (sgm == 0 ? 2 : (sgm == 1 ? 1 : 0)), ldc = pool ? D : CW;
        bf16_t* o0 = MixO; bf16_t* o1 = AO; bf16_t* o2 = GO; const float* v0 = pscale; const float* v1 = w0v; const float* v2 = a0v;
        asm volatile("" : "+s"(o0), "+s"(o1), "+s"(o2), "+s"(v0), "+s"(v1), "+s"(v2));
        bf16_t* Ob = pool ? o0 : (sgm == 1 ? o1 : o2); float* Of = DecO;
        const float* vec = pool ? v0 : (sgm == 0 ? v1 : (sgm == 1 ? v2 : (const float*)nullptr));
        const int row0 = u.pm * 256 + wr * 64 + fr, col0 = (pool ? u.pn * 256 : ((u.pn - 4) & 3) * 256) + wc * 32 + 8 * fq;
#pragma unroll
        for (int bj = 0; bj < 2; ++bj) {
            const int c = col0 + bj * 128;
            const f32x4 one = (f32x4){1.f, 1.f, 1.f, 1.f};
            const f32x4 s0 = vec ? *(const f32x4*)(vec + c) : one, s1 = vec ? *(const f32x4*)(vec + c + 4) : one;
#pragma unroll
            for (int ai = 0; ai < 2; ++ai)
#pragma unroll
                for (int m = 0; m < 4; ++m) {
                    const int row = row0 + ai * 128 + m * 16;
                    f32x4 v0 = acc[ai][bj][m][0], v1 = acc[ai][bj][m][1];
                    if (mode == 0) { v0 = v0 * s0; v1 = v1 * s1; }
                    else if (mode == 1) {
#pragma unroll
                        for (int j = 0; j < 4; ++j) { v0[j] = sigmoidf_(v0[j] + s0[j]); v1[j] = sigmoidf_(v1[j] + s1[j]); } }
                    else {
                        v0 = v0 + s0; v1 = v1 + s1;
#pragma unroll
                        for (int j = 0; j < 4; ++j) {
                            v0[j] = __expf(-0.60653066f * sigmoidf_(v0[j])); v1[j] = __expf(-0.60653066f * sigmoidf_(v1[j])); }
                    }
                    if (mode == 2) { if (row < MV) { float* p = Of + (size_t)row * ldc + c; *(f32x4*)p = v0; *(f32x4*)(p + 4) = v1; } }
                    else { u32x4 w; w.x = pk_bf16(v0[0], v0[1]); w.y = pk_bf16(v0[2], v0[3]); w.z = pk_bf16(v1[0], v1[1]); w.w = pk_bf16(v1[2], v1[3]);
                        *(u32x4*)(Ob + (size_t)row * ldc + c) = w; }
                }
        }
    }
};
struct EpiDecay {
    static constexpr bool PERM = false, AFTER_DRAIN = false;
    float* O; const float* w0;
    __device__ __forceinline__ void operator()(const f32x4 (&acc)[2][2][4][2], const Unit& u, int wr, int wc, int fr, int fq) const {
        const int row0 = u.pm * 256 + wr * 64 + fr, col0 = u.pn * 256 + wc * 32 + 4 * fq;
#pragma unroll
        for (int bj = 0; bj < 2; ++bj)
#pragma unroll
            for (int n = 0; n < 2; ++n) {
                const int c = col0 + bj * 128 + n * 16; const f32x4 b = *(const f32x4*)(w0 + c);
#pragma unroll
                for (int ai = 0; ai < 2; ++ai)
#pragma unroll
                    for (int m = 0; m < 4; ++m) {
                        const int row = row0 + ai * 128 + m * 16; f32x4 v = acc[ai][bj][m][n] + b, o;
#pragma unroll
                        for (int j = 0; j < 4; ++j) { const float z = -v[j]; const float sp = fmaxf(z, 0.f) + __logf(1.0f + __expf(-fabsf(z))); o[j] = __expf(-__expf(-sp - 0.5f)); }
                        if (row < MV) *(f32x4*)(O + (size_t)row * CW + c) = o;
                    }
            }
    }
};
struct EpiOut {
    static constexpr bool PERM = false, AFTER_DRAIN = false;
    const float* xp; const float* xs; float* out; bf16_t* h2; const float* g; float* rowsq;
    __device__ __forceinline__ void operator()(const f32x4 (&acc)[2][2][4][2], const Unit& u, int wr, int wc, int fr, int fq) const {
        const int row0 = u.pm * 256 + wr * 64 + fr, col0 = u.pn * 256 + wc * 32 + 4 * fq;
#pragma unroll
        for (int ai = 0; ai < 2; ++ai)
#pragma unroll
            for (int m = 0; m < 4; ++m) {
                const int row = row0 + ai * 128 + m * 16; const bool ok = row < MV;
                const float* xr = row < MPR ? xp + (size_t)row * D : xs + (size_t)(ok ? row - MPR : 0) * D;
                float s = 0.f;
#pragma unroll
                for (int bj = 0; bj < 2; ++bj)
#pragma unroll
                    for (int n = 0; n < 2; ++n) {
                        const int c = col0 + bj * 128 + n * 16;
                        f32x4 x1 = acc[ai][bj][m][n];
                        if (ok) { x1 = x1 + *(const f32x4*)(xr + c); *(f32x4*)(out + (size_t)row * D + c) = x1; }
                        s += (x1[0] * x1[0] + x1[1] * x1[1]) + (x1[2] * x1[2] + x1[3] * x1[3]);
                        const f32x4 gg = *(const f32x4*)(g + c); const f32x4 hv = x1 * gg;
                        u32x2 w; w.x = pk_bf16(hv[0], hv[1]); w.y = pk_bf16(hv[2], hv[3]);
                        *(u32x2*)(h2 + (size_t)row * D + c) = w;
                    }
                s += __shfl_xor(s, 16); s += __shfl_xor(s, 32);
                if (ok && fq == 0) unsafeAtomicAdd(rowsq + row, s);
            }
    }
};
struct EpiGU {
    static constexpr bool PERM = true, AFTER_DRAIN = false;
    bf16_t* U; const float* rowsq;
    __device__ __forceinline__ void operator()(const f32x4 (&acc)[2][2][4][2], const Unit& u, int wr, int wc, int fr, int fq) const {
        const int row0 = u.pm * 256 + wr * 64 + fr, col0 = u.pn * 128 + wc * 32 + 8 * fq;
#pragma unroll
        for (int ai = 0; ai < 2; ++ai)
#pragma unroll
            for (int m = 0; m < 4; ++m) {
                const int row = row0 + ai * 128 + m * 16;
                const float rstd = rsqrtf(rowsq[row] * (1.0f / D) + RMS_EPS);
                f32x4 o[2];
#pragma unroll
                for (int n = 0; n < 2; ++n)
#pragma unroll
                    for (int j = 0; j < 4; ++j) { const float gt = acc[ai][0][m][n][j] * rstd, up = acc[ai][1][m][n][j] * rstd; o[n][j] = gt * sigmoidf_(gt) * up; }
                u32x4 w; w.x = pk_bf16(o[0][0], o[0][1]); w.y = pk_bf16(o[0][2], o[0][3]); w.z = pk_bf16(o[1][0], o[1][1]); w.w = pk_bf16(o[1][2], o[1][3]);
                *(u32x4*)(U + (size_t)row * DFF + col0) = w;
            }
    }
};
struct EpiDown {
    static constexpr bool PERM = false, AFTER_DRAIN = false;
    float* out;
    __device__ __forceinline__ void operator()(const f32x4 (&acc)[2][2][4][2], const Unit& u, int wr, int wc, int fr, int fq) const {
        const int row0 = u.pm * 256 + wr * 64 + fr, col0 = u.pn * 256 + wc * 32 + 4 * fq;
#pragma unroll
        for (int ai = 0; ai < 2; ++ai)
#pragma unroll
            for (int m = 0; m < 4; ++m) {
                const int row = row0 + ai * 128 + m * 16;
#pragma unroll
                for (int bj = 0; bj < 2; ++bj)
#pragma unroll
                    for (int n = 0; n < 2; ++n) {
                        const int c = col0 + bj * 128 + n * 16; float* p = out + (size_t)row * D + c;
                        *(f32x4*)p = acc[ai][bj][m][n] + *(const f32x4*)p;
                    }
            }
    }
};
struct EpiDownNorm {
    static constexpr bool PERM = false, AFTER_DRAIN = true;
    float* out; float* rowsq; unsigned* cnt; const float* g;
    __device__ __forceinline__ void operator()(f32x4 (&acc)[2][2][4][2], const Unit& u, int wr, int wc, int fr, int fq) const {
        const int row0 = u.pm * 256 + wr * 64 + fr, col0 = u.pn * 256 + wc * 32 + 4 * fq;
        float chk = 0.f;
#pragma unroll
        for (int ai = 0; ai < 2; ++ai)
#pragma unroll
            for (int m = 0; m < 4; ++m) {
                const int row = row0 + ai * 128 + m * 16; float s = 0.f;
#pragma unroll
                for (int bj = 0; bj < 2; ++bj)
#pragma unroll
                    for (int n = 0; n < 2; ++n) {
                        const f32x4 x2 = acc[ai][bj][m][n] + *(const f32x4*)(out + (size_t)row * D + col0 + bj * 128 + n * 16); acc[ai][bj][m][n] = x2;
                        s += (x2[0] * x2[0] + x2[1] * x2[1]) + (x2[2] * x2[2] + x2[3] * x2[3]);
                    }
                s += __shfl_xor(s, 16); s += __shfl_xor(s, 32);
                if (fq == 0) chk += unsafeAtomicAdd(rowsq + row, s);
            }
        asm volatile("s_waitcnt vmcnt(0)" :: "v"(chk) : "memory");
        unsigned* pc = cnt + 64 * u.pm;
        if ((threadIdx.x & 63) == 0) __hip_atomic_fetch_add(pc, 1u, __ATOMIC_RELAXED, __HIP_MEMORY_SCOPE_AGENT);
        { unsigned spins = 0; while (__hip_atomic_load(pc, __ATOMIC_RELAXED, __HIP_MEMORY_SCOPE_AGENT) < 64u) { __builtin_amdgcn_s_sleep(2); if (++spins > (1u << 22)) break; } }
        __builtin_amdgcn_fence(__ATOMIC_ACQUIRE, "agent");
        asm volatile("s_waitcnt vmcnt(0)" ::: "memory");
#pragma unroll
        for (int ai = 0; ai < 2; ++ai)
#pragma unroll
            for (int m = 0; m < 4; ++m) {
                const int row = row0 + ai * 128 + m * 16;
                const float rstd = rsqrtf(__hip_atomic_load(rowsq + row, __ATOMIC_RELAXED, __HIP_MEMORY_SCOPE_AGENT) * (1.0f / D) + RMS_EPS);
#pragma unroll
                for (int bj = 0; bj < 2; ++bj)
#pragma unroll
                    for (int n = 0; n < 2; ++n) { const int c = col0 + bj * 128 + n * 16; *(f32x4*)(out + (size_t)row * D + c) = acc[ai][bj][m][n] * rstd * *(const f32x4*)(g + c); }
            }
    }
};
struct EpiPartial {
    static constexpr bool PERM = false, AFTER_DRAIN = false;
    float* buf;
    __device__ __forceinline__ void operator()(const f32x4 (&acc)[2][2][4][2], const Unit& u, int wr, int wc, int fr, int fq) const {
        const int col0 = u.pn * 256 + wc * 32 + 4 * fq;
#pragma unroll
        for (int m = 0; m < 4; ++m) {
            const int lrow = wr * 64 + m * 16 + fr;
            float* p = buf + ((size_t)u.ks * MSA + lrow) * D + col0;
#pragma unroll
            for (int bj = 0; bj < 2; ++bj)
#pragma unroll
                for (int n = 0; n < 2; ++n) *(f32x4*)(p + bj * 128 + n * 16) = acc[0][bj][m][n];
        }
    }
};

template <int RM> __device__ __forceinline__ int rowmap(int n) { return RM == 0 ? n : (RM == 1 ? ((n >> 7) * 256 + (n & 127)) : ((n >> 7) * 256 + 128 + (n & 127))); }
template <int RM>
__device__ __forceinline__ void transpose_bf16(const float* src, int Ksrc, int Nsrc, int ld, bf16_t* dst, int Kdst, int Ndst, int rot, int vgw, int gws) {
    const int lane = threadIdx.x & 63, gw = (vgw + rot) % gws;
    const int nn = Ndst / 64, ntile = nn * (Kdst / 64);
    for (int t = gw; t < ntile; t += gws) {
        const int k0 = (t / nn) * 64, n = (t % nn) * 64 + lane;
        const bool nok = n < Nsrc;
        const float* sp = src + (nok ? n : 0);
        float v[64];
        const float mskn = nok ? 1.f : 0.f;
#pragma unroll
        for (int j = 0; j < 64; ++j) { const int k = k0 + j; v[j] = sp[(size_t)(k < Ksrc ? k : Ksrc - 1) * ld]; }
#pragma unroll
        for (int j = 0; j < 64; ++j) v[j] *= ((k0 + j) < Ksrc ? mskn : 0.f);
        bf16_t* dp = dst + (size_t)rowmap<RM>(n) * Kdst + k0;
#pragma unroll
        for (int q8 = 0; q8 < 8; ++q8) { u32x4 w; w.x = pk_bf16(v[q8 * 8 + 0], v[q8 * 8 + 1]); w.y = pk_bf16(v[q8 * 8 + 2], v[q8 * 8 + 3]); w.z = pk_bf16(v[q8 * 8 + 4], v[q8 * 8 + 5]); w.w = pk_bf16(v[q8 * 8 + 6], v[q8 * 8 + 7]);
            *(u32x4*)(dp + q8 * 8) = w; }
    }
}
template <int CTRL> __device__ __forceinline__ float dpp_(float x) { return __int_as_float(__builtin_amdgcn_update_dpp(0, __float_as_int(x), CTRL, 0xF, 0xF, true)); }
__device__ __forceinline__ float red8(float x) { x += dpp_<0x141>(x); x += dpp_<0xB1>(x); x += dpp_<0x4E>(x); return x; }

template <int W>
__device__ __forceinline__ void pool_block_prompt(const bf16_t* proj, bf16_t* pooled, int b, int t0, int c) {
    float ux[15 + W], uy[15 + W]; unsigned raw[15 + W];
#pragma unroll
    for (int j = 0; j < 15 + W; ++j) {
        const int t = t0 - (W - 1) + j;
        raw[j] = *(const unsigned*)(proj + (size_t)(b * TT + (t < 0 ? 0 : t)) * PJP + c);
    }
#pragma unroll
    for (int j = 0; j < 15 + W; ++j) {
        const int t = t0 - (W - 1) + j; const float zm = t < 0 ? 0.f : 1.f;
        ux[j] = bf2f(raw[j] & 0xffffu) * zm; uy[j] = bf2f(raw[j] >> 16) * zm;
    }
#pragma unroll
    for (int i = 0; i < 16; ++i) {
        const int t = t0 + i; float sx = 0.f, sy = 0.f;
#pragma unroll
        for (int j = 0; j < W; ++j) { sx += ux[i + j]; sy += uy[i + j]; }
        const float inv = 1.0f / (float)(t + 1 < W ? t + 1 : W);
        const float px = sx * inv - ux[i + W - 1], py = sy * inv - uy[i + W - 1];
        *(unsigned*)(pooled + (size_t)(b * TT + t) * XLD + c) = pk_bf16(px, py);
    }
}

__global__ void __launch_bounds__(NTHR) hymba_fwd(Params P) {
    extern __shared__ __attribute__((aligned(16))) unsigned char lds_raw[];
    LAS unsigned char* lds = (LAS unsigned char*)lds_raw;
    const int G = gridDim.x, bid = blockIdx.x, gthreads = G * NTHR, gwaves = G * 8;
#define PHASE_IDS int tid = threadIdx.x; asm volatile("" : "+v"(tid)); const int lane = tid & 63, wave = tid >> 6, gtid = bid * NTHR + tid, gwave = bid * 8 + wave; (void)lane; (void)wave; (void)gtid; (void)gwave;
    unsigned char* ws = P.ws; float* out = P.out;
    const float* x_prompt = P.in[0]; const float* x_sample = P.in[1]; const float* state_pool = P.in[2]; const float* state_shift = P.in[3]; const float* state_wkv = P.in[4];
    const float* norm_mix = P.in[5]; const float* w_in = P.in[6]; const float* w_pool = P.in[7]; const float* pool_scale = P.in[8]; const float* mu_shift = P.in[9];
    const float* w0 = P.in[10]; const float* w2 = P.in[11]; const float* a0 = P.in[12]; const float* a2 = P.in[13]; const float* g2 = P.in[14];
    const float* k_k = P.in[15]; const float* k_a = P.in[16]; const float* r_k = P.in[17]; const float* gn_w = P.in[18]; const float* gn_b = P.in[19];
    const float* w_out = P.in[20]; const float* norm_ffn = P.in[21]; const float* w_gate = P.in[22]; const float* w_up = P.in[23]; const float* w_down = P.in[24]; const float* norm_final = P.in[25];
    bf16_t* WinT = (bf16_t*)(ws + WS_WIN); bf16_t* WoutT = (bf16_t*)(ws + WS_WOUT); bf16_t* WguT = (bf16_t*)(ws + WS_WGU); bf16_t* WdnT = (bf16_t*)(ws + WS_WDN);
    bf16_t* WpoolT = (bf16_t*)(ws + WS_WPOOL); bf16_t* WloraT = (bf16_t*)(ws + WS_WLORA);
    bf16_t* Hb = (bf16_t*)(ws + WS_R1); bf16_t* Xb = (bf16_t*)(ws + WS_R1); bf16_t* H2 = (bf16_t*)(ws + WS_R1);
    bf16_t* Proj = (bf16_t*)(ws + WS_PROJ); bf16_t* Ub = (bf16_t*)(ws + WS_PROJ); bf16_t* Ab = (bf16_t*)(ws + WS_A); bf16_t* Gb = (bf16_t*)(ws + WS_GATE);
    bf16_t* Mix = (bf16_t*)(ws + WS_MIX); float* rowsq1 = (float*)(ws + WS_ROWSQ); float* rowsq2 = rowsq1 + MPAD; unsigned* pcnt = (unsigned*)(ws + WS_PCNT); float* Bonus = (float*)(ws + WS_BONUS);
    unsigned* barctr = (unsigned*)(ws + WS_BAR);
    float* Yb = out + SCR_Y; float* Dec = out + SCR_DEC;
    float* Part6 = (float*)(ws + WS_A);
    float* Part8 = (float*)(ws + WS_R1);
    { LAS unsigned* st0 = (LAS unsigned*)(lds + LDS_ST_OFF); if (threadIdx.x < 2) st0[threadIdx.x] = 0u; }
    __syncthreads();
    const XcdBarrier xbar = xcd_barrier_post(barctr, (volatile LAS unsigned*)(lds + LDS_ST_OFF));
#ifndef P3SEL
#define P3SEL 15
#endif
#ifndef PHASE_MASK
#define PHASE_MASK 0x3ff
#endif
#define IN(k) (((PHASE_MASK >> (k)) & 1) && (!P.multi || P.phase == (k)))
#define SEAM() do { if (!P.multi) xcd_barrier(xbar); } while (0)

    if (IN(0)) {
        PHASE_IDS
        transpose_bf16<0>(w_in, D, PJ, PJ, WinT, D, PJP, 0, gwave, gwaves);
        for (int g = 0; g < 4; ++g) transpose_bf16<0>(w_pool + (size_t)g * 65536, 256, 256, 256, WpoolT + (size_t)g * 65536, 256, 256, 1280 + g * 16, gwave, gwaves);
        transpose_bf16<0>(w2, 64, CW, CW, WloraT, 256, CW, 1344, gwave, gwaves);
        transpose_bf16<0>(a2, 64, CW, CW, WloraT + (size_t)CW * 256, 256, CW, 1408, gwave, gwaves);
        transpose_bf16<0>(g2, 160, CW, CW, WloraT + (size_t)2 * CW * 256, 256, CW, 1472, gwave, gwaves);
        for (int i = gtid; i < 2 * MPAD; i += gthreads) rowsq1[i] = 0.f;
        for (int m = gwave; m < MPAD; m += gwaves) {
            bf16_t* hr = Hb + (size_t)m * D;
            if (m < MV) {
                const float* xr = m < MPR ? x_prompt + (size_t)m * D : x_sample + (size_t)(m - MPR) * D;
                f32x4 v[8]; float s = 0.f;
#pragma unroll
                for (int i = 0; i < 8; ++i) v[i] = *(const f32x4*)(xr + (i * 64 + lane) * 4);
#pragma unroll
                for (int i = 0; i < 8; ++i) s += (v[i][0] * v[i][0] + v[i][1] * v[i][1]) + (v[i][2] * v[i][2] + v[i][3] * v[i][3]);
                s = wsum(s); const float rstd = rsqrtf(s * (1.0f / D) + RMS_EPS);
#pragma unroll
                for (int i = 0; i < 8; ++i) { const int c = (i * 64 + lane) * 4; const f32x4 gg = *(const f32x4*)(norm_mix + c); const f32x4 o = v[i] * rstd * gg;
                    u32x2 w; w.x = pk_bf16(o[0], o[1]); w.y = pk_bf16(o[2], o[3]); *(u32x2*)(hr + c) = w; }
            } else {
#pragma unroll
                for (int i = 0; i < 8; ++i) *(u32x2*)(hr + (i * 64 + lane) * 4) = (u32x2){0u, 0u};
            }
        }
    }
    if (P.multi == 2) cg::this_grid().sync();
    SEAM();

    if (IN(1)) {
        PHASE_IDS
        pg8::Gemm g{Hb, WinT, D, D, D}; pg8::StaticOrder S; S.init(MPAD, PJP, G, bid);
        EpiBf16<0> E{Proj, PJP, 0, nullptr};
        pg8::gemm_phase(lds, g, S, E);
    }
    SEAM();

    if (IN(2)) {
        PHASE_IDS
        for (int rb = bid; rb < MPR / 16; rb += G) {
            const int b = rb >> 7, t0 = (rb & 127) * 16, c = tid * 2, gq = tid >> 7;
            if (gq == 0) pool_block_prompt<2>(Proj, Xb, b, t0, c);
            else if (gq == 1) pool_block_prompt<4>(Proj, Xb, b, t0, c);
            else if (gq == 2) pool_block_prompt<8>(Proj, Xb, b, t0, c);
            else pool_block_prompt<16>(Proj, Xb, b, t0, c);
        }
        for (int b = bid; b < MSA; b += G) {
            const int c = tid * 2, W = 2 << (tid >> 7);
            const unsigned v = *(const unsigned*)(Proj + (size_t)(MPR + b) * PJP + c); const float ux = bf2f(v & 0xffffu), uy = bf2f(v >> 16);
            f32x2 pr[15];
#pragma unroll
            for (int j = 0; j < 15; ++j) pr[j] = *(const f32x2*)(state_pool + ((size_t)b * 15 + j) * PW + c);
            float sx = ux, sy = uy;
#pragma unroll
            for (int j = 1; j < 16; ++j) { const float mk = j < W ? 1.f : 0.f; sx += pr[15 - j][0] * mk; sy += pr[15 - j][1] * mk; }
            const float inv = 1.0f / (float)W;
            *(unsigned*)(Xb + (size_t)(MPR + b) * XLD + c) = pk_bf16(sx * inv - ux, sy * inv - uy);
            float* np = out + OUT_POOLS + (size_t)b * 15 * PW;
#pragma unroll
            for (int j = 0; j < 14; ++j) *(f32x2*)(np + (size_t)j * PW + c) = pr[j + 1];
            *(f32x2*)(np + (size_t)14 * PW + c) = (f32x2){ux, uy};
        }
        {
            constexpr int NIT = MV * 144;
            for (int base = gtid; base < NIT; base += 5 * gthreads) {
                unsigned cv[5], pv[5]; f32x2 mu[5]; int mm[5], cpo[5], sg[5], pcs[5]; bool val[5];
#pragma unroll
                for (int u = 0; u < 5; ++u) {
                    const int idx = base + u * gthreads; val[u] = idx < NIT; const int id2 = val[u] ? idx : 0;
                    const int m = id2 / 144, jp = id2 - m * 144, seg = jp < 32 ? 0 : (jp < 64 ? 1 : 2);
                    const int j = (jp - (seg == 0 ? 0 : (seg == 1 ? 32 : 64))) * 2, pc = (seg == 0 ? 3072 : (seg == 1 ? 3136 : 3200)) + j;
                    mm[u] = m; sg[u] = seg; cpo[u] = seg * 256 + j; pcs[u] = pc;
                    const int mprev = (m >= MPR || (m & (TT - 1)) == 0) ? m : m - 1;
                    cv[u] = *(const unsigned*)(Proj + (size_t)m * PJP + PW + pc);
                    pv[u] = *(const unsigned*)(Proj + (size_t)mprev * PJP + PW + pc);
                    mu[u] = *(const f32x2*)(mu_shift + pc);
                }
#pragma unroll
                for (int u = 0; u < 5; ++u) {
                    const int m = mm[u]; const float cx = bf2f(cv[u] & 0xffffu), cy = bf2f(cv[u] >> 16);
                    const float fm = (m & (TT - 1)) == 0 ? 0.f : 1.f;
                    float px = bf2f(pv[u] & 0xffffu) * fm, py = bf2f(pv[u] >> 16) * fm;
                    if (m >= MPR) { const f32x2 p = *(const f32x2*)(state_shift + (size_t)(m - MPR) * SW + pcs[u]); px = p[0]; py = p[1]; }
                    float vx = cx + (px - cx) * mu[u][0], vy = cy + (py - cy) * mu[u][1];
                    if (sg[u] == 0) { vx = tanhf(vx); vy = tanhf(vy); } else if (sg[u] == 2) { vx = sigmoidf_(vx); vy = sigmoidf_(vy); }
                    if (val[u]) *(unsigned*)(Xb + (size_t)m * XLD + 1024 + cpo[u]) = pk_bf16(vx, vy);
                }
            }
        }
        for (int i = gtid; i < 4 * SW; i += gthreads) { const int b = i / SW, j = i - b * SW; out[OUT_SHIFTP + i] = bf2f(Proj[(size_t)(b * TT + TT - 1) * PJP + PW + j]); }
        for (int i = gtid; i < MSA * SW / 2; i += gthreads) { const int b = i / (SW / 2), j = (i - b * (SW / 2)) * 2; const unsigned v = *(const unsigned*)(Proj + (size_t)(MPR + b) * PJP + PW + j);
            *(f32x2*)(out + OUT_SHIFTS + (size_t)b * SW + j) = (f32x2){bf2f(v & 0xffffu), bf2f(v >> 16)}; }
        for (int i = gtid; i < 4 * 15 * PW; i += gthreads) { const int b = i / (15 * PW), r = i - b * 15 * PW, j = r / PW, c = r - j * PW; out[OUT_POOLP + i] = bf2f(Proj[(size_t)(b * TT + TT - 15 + j) * PJP + c]); }
    }
    SEAM();

    if (IN(3)) {
        PHASE_IDS
        { pg8::Gemm g{Xb, WpoolT, XLD, 256, 256}; pg8::P3Order S{G, bid};
          EpiP3 E{Mix, Dec, Ab, Gb, pool_scale, w0, a0}; pg8::gemm_phase(lds, g, S, E); }
    }
    SEAM();

    if (IN(4)) {
        PHASE_IDS
        LAS float* ldf = (LAS float*)lds;
        constexpr int REC = 392, TB = 32, NPS = TB / 4;
        for (int unit = bid; unit < 256; unit += G) {
            const int s = unit >> 2, b = s >> 4, h = s & 15, q = unit & 3;
            const int wv = __builtin_amdgcn_readfirstlane(tid >> 6);
            if (wv < 2) {
              const int crow = wv * 8 + (lane >> 3), kq = lane & 7; const bool first8 = kq == 0;
              f32x2 S2[4];
#pragma unroll
              for (int e = 0; e < 4; ++e) S2[e] = (f32x2){0.f, 0.f};
              const LAS float* recq0 = ldf + kq * 8; const LAS float* recv0 = ldf + 320 + q * 16 + crow;
              float* yp = Yb + (size_t)(b * TT + 7 - kq) * CW + h * 64 + q * 16 + crow;
              __builtin_amdgcn_s_setprio(3);
              WG_BAR();
              for (int blk = 0; blk < TT / TB; ++blk) {
                    const int bo = (blk & 1) * (TB * REC);
                    const LAS float* recq = recq0 + bo; const LAS float* recv = recv0 + bo; const LAS float* recs = ldf + bo + 384;
#define LDSTEP(o_, A0, A1, B0, B1, D0, D1, K0, K1, W0, W1, VV, SC) do { A0 = *(const LAS f32x4*)(recq + (o_)); A1 = *(const LAS f32x4*)(recq + (o_) + 4); B0 = *(const LAS f32x4*)(recq + (o_) + 64); B1 = *(const LAS f32x4*)(recq + (o_) + 68); \
                        D0 = *(const LAS f32x4*)(recq + (o_) + 128); D1 = *(const LAS f32x4*)(recq + (o_) + 132); K0 = *(const LAS f32x4*)(recq + (o_) + 192); K1 = *(const LAS f32x4*)(recq + (o_) + 196); \
                        W0 = *(const LAS f32x4*)(recq + (o_) + 256); W1 = *(const LAS f32x4*)(recq + (o_) + 260); VV = recv[(o_)]; SC = *(const LAS f32x2*)(recs + (o_)); } while (0)
                    f32x4 av0, av1, bv0, bv1, dw0, dw1, kt0, kt1, wr0, wr1; float vv; f32x2 sc;
                    f32x4 nav0, nav1, nbv0, nbv1, ndw0, ndw1, nkt0, nkt1, nwr0, nwr1; float nvv; f32x2 nsc;
                    f32x4 a0, a1, b0, b1, d0, d1, k0, k1, w0_, w1_; float vv_; f32x2 sc_;
                    LDSTEP(0, a0, a1, b0, b1, d0, d1, k0, k1, w0_, w1_, vv_, sc_);
                    LDSTEP(REC, av0, av1, bv0, bv1, dw0, dw1, kt0, kt1, wr0, wr1, vv, sc);
                    float yacc = 0.f;
#pragma unroll
                    for (int st = 0; st < TB; ++st) {
                        if (st + 2 < TB) LDSTEP((st + 2) * REC, nav0, nav1, nbv0, nbv1, ndw0, ndw1, nkt0, nkt1, nwr0, nwr1, nvv, nsc);
                        __builtin_amdgcn_sched_barrier(0);
                        const f32x2 pa = pkfma_(S2[3], hi2(a1), pkfma_(S2[2], lo2(a1), pkfma_(S2[1], hi2(a0), pkmul_(S2[0], lo2(a0)))));
                        const f32x2 py = pkfma_(S2[3], hi2(w1_), pkfma_(S2[2], lo2(w1_), pkfma_(S2[1], hi2(w0_), pkmul_(S2[0], lo2(w0_)))));
                        float da = pa[0] + pa[1], dy = py[0] + py[1];
                        da = red8(da); dy = red8(dy);
                        const float y = dy + da * sc_[0] + vv_ * sc_[1];
                        { f32x2 dab, vvb; dab[0] = da; dab[1] = da; vvb[0] = vv_; vvb[1] = vv_;
                          S2[0] = pkfma_b(lo2(k0), vvb, pkfma_b(lo2(b0), dab, pkmul_(S2[0], lo2(d0)))); S2[1] = pkfma_b(hi2(k0), vvb, pkfma_b(hi2(b0), dab, pkmul_(S2[1], hi2(d0))));
                          S2[2] = pkfma_b(lo2(k1), vvb, pkfma_b(lo2(b1), dab, pkmul_(S2[2], lo2(d1)))); S2[3] = pkfma_b(hi2(k1), vvb, pkfma_b(hi2(b1), dab, pkmul_(S2[3], hi2(d1)))); }
                        const float sh = __int_as_float(__builtin_amdgcn_update_dpp(__float_as_int(y), __float_as_int(yacc), 0x111, 0xF, 0xF, false));
                        yacc = first8 ? y : sh;
                        if ((st & 7) == 7) yp[(size_t)(blk * TB + (st - 7)) * CW] = yacc;
                        a0 = av0; a1 = av1; b0 = bv0; b1 = bv1; d0 = dw0; d1 = dw1; k0 = kt0; k1 = kt1; w0_ = wr0; w1_ = wr1; vv_ = vv; sc_ = sc;
                        av0 = nav0; av1 = nav1; bv0 = nbv0; bv1 = nbv1; dw0 = ndw0; dw1 = ndw1; kt0 = nkt0; kt1 = nkt1; wr0 = nwr0; wr1 = nwr1; vv = nvv; sc = nsc;
                        asm volatile("" ::: "memory");
                    }
#undef LDSTEP
                    WG_BAR();
              }
              __builtin_amdgcn_s_setprio(0);
              float* so = out + OUT_WKVP + ((size_t)(b * NH + h) * 64 + q * 16 + crow) * 64 + kq * 8;
              *(f32x4*)so = (f32x4){S2[0][0], S2[0][1], S2[1][0], S2[1][1]}; *(f32x4*)(so + 4) = (f32x4){S2[2][0], S2[2][1], S2[3][0], S2[3][1]};
            } else if (wv == 4 || wv == 5) {
              constexpr int CT_PER = 5632, CT_ALL = 3 * CT_PER + 2048;
              float cvv[32]; int ctile = unit * 2 + (wv - 4), cph = 0;
#define CONV_LOAD16(P0_) do { if (ctile < CT_ALL) { const int m_ = ctile / CT_PER, r_ = ctile - m_ * CT_PER; const float* sp_; unsigned ld_; \
                    if (m_ < 2) { sp_ = (m_ == 0 ? w_gate : w_up) + (size_t)((r_ / 88) * 32) * DFF + (r_ % 88) * 64; ld_ = DFF; } \
                    else { sp_ = (m_ == 2 ? w_down : w_out) + (size_t)((r_ >> 5) * 32) * D + (r_ & 31) * 64; ld_ = D; } \
                    _Pragma("unroll") for (int j_ = (P0_); j_ < (P0_) + 16; ++j_) cvv[j_] = sp_[(unsigned)j_ * ld_ + lane]; } } while (0)
#define CONV_STORE() do { if (ctile < CT_ALL) { const int m_ = ctile / CT_PER, r_ = ctile - m_ * CT_PER; bf16_t* dp_; \
                    if (m_ < 2) { const int k0_ = (r_ / 88) * 32, n_ = (r_ % 88) * 64 + lane; dp_ = WguT + (size_t)((n_ >> 7) * 256 + (m_ == 1 ? 128 : 0) + (n_ & 127)) * D + k0_; } \
                    else { const int k0_ = (r_ >> 5) * 32, n_ = (r_ & 31) * 64 + lane; dp_ = m_ == 2 ? WdnT + (size_t)n_ * DFF + k0_ : WoutT + (size_t)n_ * D + k0_; } \
                    _Pragma("unroll") for (int q8_ = 0; q8_ < 4; ++q8_) { u32x4 w_; w_.x = pk_bf16(cvv[q8_ * 8 + 0], cvv[q8_ * 8 + 1]); w_.y = pk_bf16(cvv[q8_ * 8 + 2], cvv[q8_ * 8 + 3]); \
                        w_.z = pk_bf16(cvv[q8_ * 8 + 4], cvv[q8_ * 8 + 5]); w_.w = pk_bf16(cvv[q8_ * 8 + 6], cvv[q8_ * 8 + 7]); *(u32x4*)(dp_ + q8_ * 8) = w_; } \
                    ctile += 512; } } while (0)
              WG_BAR();
              for (int blk = 0; blk < TT / TB; ++blk) {
#pragma unroll
                for (int tk = 0; tk < 2; ++tk) {
                  if (cph == 0) CONV_LOAD16(0); else if (cph == 1) CONV_LOAD16(16); else CONV_STORE();
                  cph = cph == 2 ? 0 : cph + 1;
                }
                WG_BAR();
              }
              while (ctile < CT_ALL) {
                if (cph <= 0) CONV_LOAD16(0);
                if (cph <= 1) CONV_LOAD16(16);
                CONV_STORE(); cph = 0;
              }
#undef CONV_LOAD16
#undef CONV_STORE
            } else {
              const int pw = (wv & 1) + ((wv >> 2) << 1), ch = h * 64 + lane;
              const float c_kk = k_k[ch], c_ka = k_a[ch], c_rk = r_k[ch], mu_r = mu_shift[ch], mu_k = mu_shift[CW + ch], mu_v = mu_shift[2 * CW + ch];
              const bf16_t* pbase = Proj + (size_t)(b * TT) * PJP + PW + h * 64; const float* dbase = Dec + (size_t)(b * TT) * CW + h * 64; const bf16_t* abase = Ab + (size_t)(b * TT) * CW + h * 64;
              constexpr int PD = 2;
              unsigned short rr[PD][NPS + 1], kr_[PD][NPS + 1], vr[PD][NPS + 1], aa[PD][NPS]; float dd[PD][NPS];
#define SCAN_LOAD(blk, SET) do { const int t0_ = (blk) * TB + pw * NPS; \
            _Pragma("unroll") for (int i_ = 0; i_ < NPS + 1; ++i_) { const unsigned t_ = (unsigned)((i_ == 0 && t0_ == 0) ? 0 : t0_ - 1 + i_); const bf16_t* pp_ = pbase + t_ * (unsigned)PJP; \
                rr[SET][i_] = pp_[lane]; kr_[SET][i_] = pp_[CW + lane]; vr[SET][i_] = pp_[2 * CW + lane]; } \
            _Pragma("unroll") for (int i_ = 0; i_ < NPS; ++i_) { const unsigned mi_ = (unsigned)(t0_ + i_) * (unsigned)CW; dd[SET][i_] = dbase[mi_ + lane]; aa[SET][i_] = abase[mi_ + lane]; } } while (0)
#define SCAN_PRODUCE(blk, SET) do { LAS float* bufp_ = ldf + ((blk) & 1) * (TB * REC); const int t0_ = (blk) * TB + pw * NPS; \
            _Pragma("unroll") for (int i_ = 0; i_ < NPS; ++i_) { \
                const float zz_ = (i_ == 0 && t0_ == 0) ? 0.f : 1.f; \
                const float rc_ = bf2f(rr[SET][i_ + 1]), kc_ = bf2f(kr_[SET][i_ + 1]), vc_ = bf2f(vr[SET][i_ + 1]), rp_ = bf2f(rr[SET][i_]) * zz_, kp_ = bf2f(kr_[SET][i_]) * zz_, vp_ = bf2f(vr[SET][i_]) * zz_; \
                const float r_ = rc_ + (rp_ - rc_) * mu_r, k_ = kc_ + (kp_ - kc_) * mu_k, v_ = vc_ + (vp_ - vc_) * mu_v; \
                const float a_ = bf2f(aa[SET][i_]), d_ = dd[SET][i_]; \
                const float kkr_ = k_ * c_kk; const float n2_ = wsum(kkr_ * kkr_); const float kk_ = kkr_ * rsqrtf(fmaxf(n2_, 1e-24f)); \
                const float kt_ = k_ * (1.0f + (a_ - 1.0f) * c_ka); const float bv_ = kk_ * a_; \
                const float br_ = wsum(bv_ * r_), krs_ = wsum(kt_ * r_), bon_ = wsum(r_ * kt_ * c_rk); \
                LAS float* rec_ = bufp_ + (pw * NPS + i_) * REC; \
                rec_[lane] = -kk_; rec_[64 + lane] = bv_; rec_[128 + lane] = d_; rec_[192 + lane] = kt_; rec_[256 + lane] = d_ * r_; rec_[320 + lane] = v_; \
                if (lane == 0) { rec_[384] = br_; rec_[385] = krs_; if (q == 0) Bonus[(size_t)(b * TT + t0_ + i_) * NH + h] = bon_; } } } while (0)
              SCAN_LOAD(0, 0); SCAN_LOAD(1, 1);
              SCAN_PRODUCE(0, 0); SCAN_LOAD(2, 0);
              WG_BAR();
              static_assert((TT / TB) % PD == 0 && PD == 2, "block loop is unrolled by PD = 2");
              for (int blk0 = 0; blk0 < TT / TB; blk0 += PD) {
#define SCAN_ITER(D_, SET) do { const int blk = blk0 + (D_); if (blk + 1 < TT / TB) { SCAN_PRODUCE(blk + 1, SET); if (blk + 1 + PD < TT / TB) SCAN_LOAD(blk + 1 + PD, SET); } WG_BAR(); } while (0)
                SCAN_ITER(0, 1); SCAN_ITER(1, 0);
#undef SCAN_ITER
              }
            }
#undef SCAN_LOAD
#undef SCAN_PRODUCE
        }
        __syncthreads();
        LAS float* wl = ldf + wave * 512;
        for (int p = gwave; p < MSA * NH; p += gwaves) {
            const int b = p >> 4, h = p & 15, m = MPR + b, ch = h * 64 + lane;
            const bf16_t* pp = Proj + (size_t)m * PJP + PW + ch; const float* sp = state_shift + (size_t)b * SW + ch;
            const float rc = bf2f(pp[0]), kc = bf2f(pp[CW]), vc = bf2f(pp[2 * CW]);
            const float r = rc + (sp[0] - rc) * mu_shift[ch], k = kc + (sp[CW] - kc) * mu_shift[CW + ch], v = vc + (sp[2 * CW] - vc) * mu_shift[2 * CW + ch];
            const float d = Dec[(size_t)m * CW + ch], a = bf2f(Ab[(size_t)m * CW + ch]);
            const float kkr = k * k_k[ch]; const float n2 = wsum(kkr * kkr); const float kk = kkr * rsqrtf(fmaxf(n2, 1e-24f));
            const float kt = k * (1.0f + (a - 1.0f) * k_a[ch]);
            const float bon = wsum(r * kt * r_k[ch]);
            wl[lane] = -kk; wl[64 + lane] = kk * a; wl[128 + lane] = d; wl[192 + lane] = kt; wl[256 + lane] = r; wl[320 + lane] = v;
            asm volatile("s_waitcnt lgkmcnt(0)" ::: "memory");
            const int kq = lane & 15, r4 = lane >> 4;
            const f32x4 av = *(const LAS f32x4*)(wl + kq * 4), bv = *(const LAS f32x4*)(wl + 64 + kq * 4), dw = *(const LAS f32x4*)(wl + 128 + kq * 4);
            const f32x4 ktv = *(const LAS f32x4*)(wl + 192 + kq * 4), rv = *(const LAS f32x4*)(wl + 256 + kq * 4);
            const float* sin_ = state_wkv + (size_t)(b * NH + h) * 4096; float* sout = out + OUT_WKVS + (size_t)(b * NH + h) * 4096;
#pragma unroll 4
            for (int j = 0; j < 16; ++j) {
                const int row = r4 + 4 * j; f32x4 Sv = *(const f32x4*)(sin_ + row * 64 + kq * 4);
                float da = (Sv[0] * av[0] + Sv[1] * av[1]) + (Sv[2] * av[2] + Sv[3] * av[3]); da = red16(da);
                const float vv = wl[320 + row];
                Sv = Sv * dw + da * bv + vv * ktv;
                *(f32x4*)(sout + row * 64 + kq * 4) = Sv;
                float dy = (Sv[0] * rv[0] + Sv[1] * rv[1]) + (Sv[2] * rv[2] + Sv[3] * rv[3]); dy = red16(dy);
                if (kq == 0) wl[384 + row] = dy;
            }
            asm volatile("s_waitcnt lgkmcnt(0)" ::: "memory");
            const float y = wl[384 + lane];
            const float mean = wsum(y) * (1.0f / 64.0f); const float dl = y - mean; const float var = wsum(dl * dl) * (1.0f / 64.0f);
            const float yn = dl * rsqrtf(var + GN_EPS) * gn_w[ch] + gn_b[ch];
            const float o = (yn + bon * v) * bf2f(Gb[(size_t)m * CW + ch]);
            Mix[(size_t)m * D + PW + ch] = (bf16_t)f2bf(o);
            asm volatile("s_waitcnt lgkmcnt(0)" ::: "memory");
        }
    }
    SEAM();

    if (IN(5)) {
        PHASE_IDS
        { pg8::Gemm g{Mix, WoutT, D, D, 256}; pg8::SplitKOrder S{8, KS6, 32, 256, G, (bid + G - 192 % G) % G};
          EpiPartial E{Part6}; pg8::gemm_phase(lds, g, S, E); }
        {
            const int half = gwave & 1, ch0 = half * 512 + lane * 8, h = ch0 >> 6;
            const f32x4 mu0 = *(const f32x4*)(mu_shift + 2 * CW + ch0), mu1 = *(const f32x4*)(mu_shift + 2 * CW + ch0 + 4);
            const f32x4 gw0 = *(const f32x4*)(gn_w + ch0), gw1 = *(const f32x4*)(gn_w + ch0 + 4), gb0 = *(const f32x4*)(gn_b + ch0), gb1 = *(const f32x4*)(gn_b + ch0 + 4);
            for (int it0 = gwave; it0 < MPR * 2; it0 += 2 * gwaves) {
                f32x4 y0[2], y1[2]; u32x4 vc[2], vp[2], gt[2]; float bon[2]; int mm[2]; bool val[2];
#pragma unroll
                for (int u = 0; u < 2; ++u) {
                    const int it = it0 + u * gwaves; val[u] = it < MPR * 2; const int m = val[u] ? (it >> 1) : 0; mm[u] = m;
                    const int mprev = (m & (TT - 1)) ? m - 1 : m;
                    y0[u] = *(const f32x4*)(Yb + (size_t)m * CW + ch0); y1[u] = *(const f32x4*)(Yb + (size_t)m * CW + ch0 + 4);
                    vc[u] = *(const u32x4*)(Proj + (size_t)m * PJP + PW + 2 * CW + ch0); vp[u] = *(const u32x4*)(Proj + (size_t)mprev * PJP + PW + 2 * CW + ch0);
                    gt[u] = *(const u32x4*)(Gb + (size_t)m * CW + ch0); bon[u] = Bonus[(size_t)m * NH + h];
                }
#pragma unroll
                for (int u = 0; u < 2; ++u) {
                    const int m = mm[u]; const float fm = (m & (TT - 1)) == 0 ? 0.f : 1.f;
                    float y[8] = {y0[u][0], y0[u][1], y0[u][2], y0[u][3], y1[u][0], y1[u][1], y1[u][2], y1[u][3]};
                    float s = ((y[0] + y[1]) + (y[2] + y[3])) + ((y[4] + y[5]) + (y[6] + y[7])); s = red8(s);
                    const float mean = s * (1.0f / 64.0f); float q2 = 0.f;
#pragma unroll
                    for (int j = 0; j < 8; ++j) { y[j] -= mean; q2 += y[j] * y[j]; }
                    q2 = red8(q2); const float rstd = rsqrtf(q2 * (1.0f / 64.0f) + GN_EPS);
                    unsigned ow[4];
#pragma unroll
                    for (int j2 = 0; j2 < 4; ++j2) {
                        float o2[2];
#pragma unroll
                        for (int e = 0; e < 2; ++e) {
                            const int j = j2 * 2 + e; const unsigned cw = vc[u][j2], pw_ = vp[u][j2], gw_ = gt[u][j2];
                            const float c_ = e ? bf2f(cw >> 16) : bf2f(cw & 0xffffu), p_ = fm * (e ? bf2f(pw_ >> 16) : bf2f(pw_ & 0xffffu)), g_ = e ? bf2f(gw_ >> 16) : bf2f(gw_ & 0xffffu);
                            const float mu_ = j < 4 ? mu0[j & 3] : mu1[j & 3], gnw = j < 4 ? gw0[j & 3] : gw1[j & 3], gnb = j < 4 ? gb0[j & 3] : gb1[j & 3];
                            const float v = c_ + (p_ - c_) * mu_;
                            o2[e] = (y[j] * rstd * gnw + gnb + bon[u] * v) * g_;
                        }
                        ow[j2] = pk_bf16(o2[0], o2[1]);
                    }
                    if (val[u]) *(u32x4*)(Mix + (size_t)m * D + PW + ch0) = (u32x4){ow[0], ow[1], ow[2], ow[3]};
                }
            }
        }
    }
    SEAM();

    if (IN(6)) {
        PHASE_IDS
        pg8::Gemm g{Mix, WoutT, D, D, D}; pg8::StaticOrder S; S.init(MPR, D, G, bid);
        EpiOut E{x_prompt, x_sample, out, H2, norm_ffn, rowsq1};
        pg8::gemm_phase(lds, g, S, E);
        for (int r = gwave; r < MSA; r += gwaves) {
            const int row = MPR + r; float s = 0.f;
#pragma unroll
            for (int i = 0; i < 8; ++i) {
                const int c = (i * 64 + lane) * 4; f32x4 x1 = *(const f32x4*)(x_sample + (size_t)r * D + c);
#pragma unroll
                for (int ks = 0; ks < KS6; ++ks) x1 = x1 + *(const f32x4*)(Part6 + ((size_t)ks * MSA + r) * D + c);
                *(f32x4*)(out + (size_t)row * D + c) = x1;
                s += (x1[0] * x1[0] + x1[1] * x1[1]) + (x1[2] * x1[2] + x1[3] * x1[3]);
                const f32x4 hv = x1 * *(const f32x4*)(norm_ffn + c);
                u32x2 w; w.x = pk_bf16(hv[0], hv[1]); w.y = pk_bf16(hv[2], hv[3]); *(u32x2*)(H2 + (size_t)row * D + c) = w;
            }
            s = wsum(s); if (lane == 0) rowsq1[row] = s;
        }
    }
    SEAM();

    if (IN(7)) {
        PHASE_IDS
        pg8::Gemm g{H2, WguT, D, D, D}; pg8::StaticOrder S; S.init(MPAD, 2 * DFF, G, bid);
        EpiGU E{Ub, rowsq1};
        pg8::gemm_phase(lds, g, S, E);
    }
    SEAM();

    if (IN(8)) {
        PHASE_IDS
        if (G == 256) { pg8::Gemm g{Ub, WdnT, DFF, DFF, DFF}; pg8::StaticOrder S; S.init(MPR, D, G, bid);
          EpiDownNorm E{out, rowsq2, pcnt, norm_final}; pg8::gemm_phase(lds, g, S, E); }
        else { pg8::Gemm g{Ub, WdnT, DFF, DFF, DFF}; pg8::StaticOrder S; S.init(MPR, D, G, bid);
          EpiDown E{out}; pg8::gemm_phase(lds, g, S, E); }
        { pg8::Gemm g{Ub, WdnT, DFF, DFF, 512}; pg8::SplitKOrder S{8, KS8, 32, 512, G, bid};
          EpiPartial E{Part8}; pg8::gemm_phase(lds, g, S, E); }
    }
    SEAM();

    if (IN(9)) {
        PHASE_IDS
        for (int row = (G == 256 ? MPR : 0) + gwave; row < MV; row += gwaves) {
            float* p = out + (size_t)row * D; f32x4 v[8]; float s = 0.f;
#pragma unroll
            for (int i = 0; i < 8; ++i) v[i] = *(const f32x4*)(p + (i * 64 + lane) * 4);
            if (row >= MPR) {
#pragma unroll
                for (int i = 0; i < 8; ++i)
#pragma unroll
                    for (int ks = 0; ks < KS8; ++ks) v[i] = v[i] + *(const f32x4*)(Part8 + ((size_t)ks * MSA + (row - MPR)) * D + (i * 64 + lane) * 4);
            }
#pragma unroll
            for (int i = 0; i < 8; ++i) s += (v[i][0] * v[i][0] + v[i][1] * v[i][1]) + (v[i][2] * v[i][2] + v[i][3] * v[i][3]);
            s = wsum(s); const float rstd = rsqrtf(s * (1.0f / D) + RMS_EPS);
#pragma unroll
            for (int i = 0; i < 8; ++i) { const int c = (i * 64 + lane) * 4; *(f32x4*)(p + c) = v[i] * rstd * *(const f32x4*)(norm_final + c); }
        }
    }
#undef IN
#undef SEAM
}

#ifndef HY_MULTI
#define HY_MULTI 0
#endif
#ifndef HY_REP
#define HY_REP 0
#endif
extern "C" void kernel_launch(void* const* d_in, const int* in_sizes, int n_in, void* d_out, int out_size, void* d_ws, size_t ws_size, hipStream_t stream) {
    static int grid = 0;
    if (grid == 0) {
        if (n_in != 26 || ws_size < WS_END) { fprintf(stderr, "kernel_launch: need 26 inputs and >= %zu bytes of workspace (got %d, %zu)\n", (size_t)WS_END, n_in, ws_size); grid = -1; return; }
        int dev = 0, cus = 0, per_cu = 0;
        hipGetDevice(&dev); hipDeviceGetAttribute(&cus, hipDeviceAttributeMultiprocessorCount, dev);
        if (hipFuncSetAttribute((const void*)hymba_fwd, hipFuncAttributeMaxDynamicSharedMemorySize, LDS_BYTES) != hipSuccess) { fprintf(stderr, "kernel_launch: hipFuncSetAttribute failed\n"); grid = -1; return; }
        if (hipOccupancyMaxActiveBlocksPerMultiprocessor(&per_cu, (const void*)hymba_fwd, NTHR, LDS_BYTES) != hipSuccess || per_cu < 1) { fprintf(stderr, "kernel_launch: occupancy query says %d\n", per_cu); per_cu = 1; }
        (void)hipGetLastError();
        grid = cus;
        if (grid > 256) grid = 256;
    }
    if (grid < 0) return;
    Params p{};
    for (int i = 0; i < 26; ++i) p.in[i] = (const float*)d_in[i];
    p.out = (float*)d_out; p.ws = (unsigned char*)d_ws;
#if HY_MULTI
    p.multi = 1;
    for (int ph = 0; ph < 10; ++ph) { p.phase = ph; for (int r = 0; r < ((HY_REP >> ph) & 1) + 1; ++r) hipLaunchKernelGGL(hymba_fwd, dim3(grid), dim3(NTHR), LDS_BYTES, stream, p); }
#else
    p.multi = 0; p.phase = 0;
    hipMemsetAsync((char*)d_ws + WS_BAR, 0, 16384 + 8192, stream);
    void* args[] = {&p};
    hipError_t e = hipLaunchCooperativeKernel((const void*)hymba_fwd, dim3(grid), dim3(NTHR), args, LDS_BYTES, stream);
    if (e != hipSuccess) fprintf(stderr, "cooperative launch failed: %s (grid %d)\n", hipGetErrorString(e), grid);
#endif
}
```

```cpp
#include <hip/hip_runtime.h>
#include <hip/hip_cooperative_groups.h>
#include <cstdio>
namespace cg = cooperative_groups;

#define LAS __attribute__((address_space(3)))
typedef unsigned short bf16_t;
typedef short bf16x8 __attribute__((ext_vector_type(8)));
typedef float f32x4 __attribute__((ext_vector_type(4)));
typedef float f32x2 __attribute__((ext_vector_type(2)));
typedef unsigned u32x4 __attribute__((ext_vector_type(4)));
typedef unsigned u32x2 __attribute__((ext_vector_type(2)));

constexpr int D = 2048, TT = 2048, MPR = 8192, MSA = 128, MV = 8320, MPAD = 8448;
constexpr int PW = 1024, SW = 3360, PJ = 4384, PJP = 4608, DFF = 5632, CW = 1024, NH = 16;
constexpr int NTHR = 512, LDS_BYTES = 131072 + 16, LDS_ST_OFF = 131072;
constexpr float RMS_EPS = 1e-6f, GN_EPS = 64e-5f;

constexpr size_t WS_WIN = 0;
constexpr size_t WS_WOUT = WS_WIN + (size_t)PJP * D * 2;
constexpr size_t WS_WGU = WS_WOUT + (size_t)D * D * 2;
constexpr size_t WS_WDN = WS_WGU + (size_t)2 * DFF * D * 2;
constexpr size_t WS_WPOOL = WS_WDN + (size_t)D * DFF * 2;
constexpr size_t WS_WLORA = WS_WPOOL + (size_t)4 * 256 * 256 * 2;
constexpr size_t WS_R1 = WS_WLORA + (size_t)3 * 1024 * 256 * 2;
constexpr size_t WS_PROJ = WS_R1 + (size_t)MPAD * D * 2;
constexpr size_t WS_A = WS_PROJ + (size_t)MPAD * PJP * 2;
constexpr size_t WS_GATE = WS_A + (size_t)MPAD * CW * 2;
constexpr size_t WS_MIX = WS_GATE + (size_t)MPAD * CW * 2;
constexpr size_t WS_ROWSQ = WS_MIX + (size_t)MPAD * D * 2;
constexpr size_t WS_BONUS = WS_ROWSQ + (size_t)2 * MPAD * 4;
constexpr size_t WS_BAR = WS_BONUS + (size_t)MV * NH * 4;
constexpr size_t WS_PCNT = WS_BAR + 16384;
constexpr size_t WS_END = WS_PCNT + 8192;
static_assert((size_t)MPAD * DFF * 2 <= (WS_MIX - WS_PROJ), "U must fit in proj+a+gate");
constexpr int XLD = 1792;
static_assert((size_t)MPAD * XLD * 2 <= (size_t)MPAD * D * 2, "X fits in WS_R1");
constexpr int KS6 = 8, KS8 = 11;
static_assert((size_t)KS6 * MSA * D * 4 <= (size_t)MPAD * CW * 2 && (size_t)KS8 * MSA * D * 4 <= (size_t)MPAD * D * 2, "partial buffers alias WS_A / WS_R1");

constexpr size_t OUT_Y = 0;
constexpr size_t OUT_POOLP = (size_t)MV * D;
constexpr size_t OUT_SHIFTP = OUT_POOLP + (size_t)4 * 15 * PW;
constexpr size_t OUT_WKVP = OUT_SHIFTP + (size_t)4 * SW;
constexpr size_t OUT_POOLS = OUT_WKVP + (size_t)4 * NH * 64 * 64;
constexpr size_t OUT_SHIFTS = OUT_POOLS + (size_t)MSA * 15 * PW;
constexpr size_t OUT_WKVS = OUT_SHIFTS + (size_t)MSA * SW;
constexpr size_t SCR_Y = 0;
constexpr size_t SCR_DEC = (size_t)MPR * CW;
static_assert(SCR_DEC + (size_t)MV * CW <= OUT_POOLP, "scratch must fit in the y region");

struct Params { const float* in[26]; float* out; unsigned char* ws; int multi; int phase; };

__device__ __forceinline__ float bf2f(unsigned b) { return __uint_as_float(b << 16); }
__device__ __forceinline__ unsigned f2bf(float f) { unsigned u = __float_as_uint(f); u += 0x7FFFu + ((u >> 16) & 1u); return u >> 16; }
__device__ __forceinline__ unsigned pk_bf16(float lo, float hi) { unsigned r; asm volatile("v_cvt_pk_bf16_f32 %0, %1, %2" : "=v"(r) : "v"(lo), "v"(hi)); return r; }
template <int CTRL> __device__ __forceinline__ float dpp(float x) { return __int_as_float(__builtin_amdgcn_update_dpp(0, __float_as_int(x), CTRL, 0xF, 0xF, true)); }
__device__ __forceinline__ float red16(float x) {
    x += dpp<0x128>(x); x += dpp<0x124>(x); x += dpp<0x4E>(x); x += dpp<0xB1>(x); return x;
}
__device__ __forceinline__ float wsum(float x) {
    x = red16(x);
    x += __int_as_float(__builtin_amdgcn_update_dpp(0, __float_as_int(x), 0x142, 0xA, 0xF, false));
    x += __int_as_float(__builtin_amdgcn_update_dpp(0, __float_as_int(x), 0x143, 0xC, 0xF, false));
    return __int_as_float(__builtin_amdgcn_readlane(__float_as_int(x), 63));
}
__device__ __forceinline__ float fma_(float a, float b, float c) { float d; asm("v_fma_f32 %0, %1, %2, %3" : "=v"(d) : "v"(a), "v"(b), "v"(c)); return d; }
__device__ __forceinline__ f32x2 pkmul_(f32x2 a, f32x2 b) { f32x2 d; asm("v_pk_mul_f32 %0, %1, %2" : "=v"(d) : "v"(a), "v"(b)); return d; }
__device__ __forceinline__ f32x2 pkfma_(f32x2 a, f32x2 b, f32x2 c) { f32x2 d; asm("v_pk_fma_f32 %0, %1, %2, %3" : "=v"(d) : "v"(a), "v"(b), "v"(c)); return d; }
__device__ __forceinline__ f32x2 pkfma_b(f32x2 a, f32x2 s, f32x2 c) { f32x2 d; asm("v_pk_fma_f32 %0, %1, %2, %3 op_sel_hi:[1,0,1]" : "=v"(d) : "v"(a), "v"(s), "v"(c)); return d; }
__device__ __forceinline__ f32x2 lo2(f32x4 v) { return __builtin_shufflevector(v, v, 0, 1); }
__device__ __forceinline__ f32x2 hi2(f32x4 v) { return __builtin_shufflevector(v, v, 2, 3); }
__device__ __forceinline__ float mul_(float a, float b) { float d; asm("v_mul_f32 %0, %1, %2" : "=v"(d) : "v"(a), "v"(b)); return d; }
__device__ __forceinline__ float sigmoidf_(float x) { return __builtin_amdgcn_rcpf(1.0f + __expf(-x)); }

#define WG_BAR() do { asm volatile("s_waitcnt lgkmcnt(0)" ::: "memory"); __builtin_amdgcn_s_barrier(); asm volatile("" ::: "memory"); } while (0)

#define XB_TMO      128
#define XB_XCNT(j)  (256  + 64 * (j))
#define XB_XSUB(j)  (1280 + 64 * (j))
#define XB_XGEN(j)  (2304 + 64 * (j))
#define XB_TOP      3328
#define XB_TOPGEN   3392
#define XCD_BAR_WORDS 3456
#define XB_SPIN_CAP (1u << 18)

__device__ __forceinline__ unsigned xb_ld(unsigned* p)              { return __hip_atomic_load(p, __ATOMIC_RELAXED, __HIP_MEMORY_SCOPE_AGENT); }
__device__ __forceinline__ unsigned xb_add(unsigned* p, unsigned v) { return __hip_atomic_fetch_add(p, v, __ATOMIC_RELAXED, __HIP_MEMORY_SCOPE_AGENT); }
__device__ __forceinline__ unsigned xb_xcc_id() { return (unsigned)__builtin_amdgcn_s_getreg((3 << 11) | 20) & 0xFu; }
#define XB_SPIN(cond, bar) do { unsigned _sp = 0; while (cond) { __builtin_amdgcn_s_sleep(1); \
    if ((++_sp & 255u) == 0u) { if (xb_ld(&(bar)[XB_TMO])) break; if (_sp > XB_SPIN_CAP) { atomicAdd(&(bar)[XB_TMO], 1u); break; } } } } while (0)

struct XcdBarrier {
    unsigned* bar; unsigned x;
    volatile LAS unsigned* st;
};

__device__ __forceinline__ XcdBarrier xcd_barrier_post(unsigned* bar, volatile LAS unsigned* st) {
    XcdBarrier b; b.bar = bar; b.x = xb_xcc_id(); b.st = st;
    if (threadIdx.x == 0) (void)xb_add(&bar[XB_XCNT(b.x)], 1u);
    return b;
}
__device__ __forceinline__ void xcd_barrier_complete(unsigned* bar, unsigned x, unsigned& nloc, unsigned& nx) {
    const unsigned G = gridDim.x * gridDim.y * gridDim.z;
    unsigned sum, cnt, mine, sp = 0u;
    for (;;) {
        sum = 0u; cnt = 0u; mine = 0u;
#pragma unroll
        for (unsigned j = 0; j < 16; ++j) { const unsigned c = xb_ld(&bar[XB_XCNT(j)]); sum += c; cnt += (c > 0u) ? 1u : 0u; mine = (j == x) ? c : mine; }
        if (sum == G) break;
        __builtin_amdgcn_s_sleep(1);
        if ((++sp & 255u) == 0u) { if (xb_ld(&bar[XB_TMO])) break; if (sp > XB_SPIN_CAP) { atomicAdd(&bar[XB_TMO], 1u); break; } }
    }
    nloc = mine > 0u ? mine : 1u; nx = cnt > 0u ? cnt : 1u;
}

__device__ __forceinline__ void xcd_barrier(const XcdBarrier& b) {
    asm volatile("s_waitcnt vmcnt(0)" ::: "memory");
    __syncthreads();
    if (threadIdx.x == 0) {
        unsigned* bar = b.bar;
        __builtin_amdgcn_s_waitcnt(0);
        unsigned nloc = b.st[0], nx = b.st[1];
        if (nloc == 0u) { xcd_barrier_complete(bar, b.x, nloc, nx); b.st[0] = nloc; b.st[1] = nx; }
        const unsigned old = xb_add(&bar[XB_XSUB(b.x)], 1u);
        const unsigned gen = old / nloc;
        if (old + 1u == (gen + 1u) * nloc) {
            __builtin_amdgcn_fence(__ATOMIC_RELEASE, "agent");
            asm volatile("s_waitcnt vmcnt(0)" ::: "memory");
            const unsigned og = xb_add(&bar[XB_TOP], 1u);
            const unsigned tg = og / nx;
            if (og + 1u == (tg + 1u) * nx) xb_add(&bar[XB_TOPGEN], 1u);
            else XB_SPIN(xb_ld(&bar[XB_TOPGEN]) == tg, bar);
            __builtin_amdgcn_fence(__ATOMIC_ACQUIRE, "agent");
            xb_add(&bar[XB_XGEN(b.x)], 1u);
            asm volatile("s_waitcnt vmcnt(0)" ::: "memory");
        } else {
            XB_SPIN(xb_ld(&bar[XB_XGEN(b.x)]) == gen, bar);
            __builtin_amdgcn_fence(__ATOMIC_ACQUIRE, "agent");
            asm volatile("s_waitcnt vmcnt(0)" ::: "memory");
        }
    }
    __syncthreads();
}

__device__ __forceinline__ void grid_bar(unsigned* ctr, unsigned target) {
    asm volatile("s_waitcnt vmcnt(0) lgkmcnt(0)" ::: "memory");
    __syncthreads();
    if (threadIdx.x == 0) {
        __builtin_amdgcn_fence(__ATOMIC_RELEASE, "agent");
        asm volatile("s_waitcnt vmcnt(0)" ::: "memory");
        __hip_atomic_fetch_add(ctr, 1u, __ATOMIC_RELAXED, __HIP_MEMORY_SCOPE_AGENT);
        while (__hip_atomic_load(ctr, __ATOMIC_RELAXED, __HIP_MEMORY_SCOPE_AGENT) < target) __builtin_amdgcn_s_sleep(4);
        __builtin_amdgcn_fence(__ATOMIC_ACQUIRE, "agent");
        asm volatile("s_waitcnt vmcnt(0)" ::: "memory");
    }
    __syncthreads();
}

namespace pg8 {
constexpr int BM = 256, BK = 64, HALF = 128, HTB = HALF * BK * 2, NXCD = 8, WGM = 8;
__device__ __forceinline__ int lds_byte(int r, int c) { const int st = (r >> 4) * 2 + (c >> 5), rr = r & 15, cc = c & 31, ob = rr * 64 + cc * 2; return st * 1024 + (ob ^ (((ob >> 9) & 1) << 5)); }
__device__ __forceinline__ void stage_rc(int b, int& R, int& C) { const int st = b / 1024, sb = b % 1024, swz = sb ^ (((sb >> 9) & 1) << 5); R = (st >> 1) * 16 + swz / 64; C = (st & 1) * 32 + (swz % 64) / 2; }
__device__ __forceinline__ int perm32(int rho) { const int n = rho >> 4, i = rho & 15; return 8 * (i >> 2) + 4 * n + (i & 3); }
struct Unit { int pm, pn, ks, koffA, koffB; };
struct Gemm { const bf16_t* A; const bf16_t* Bt; int lda, ldb, K; };
struct StaticOrder {
    int nM, nN, nwg, G, c;
    __device__ void init(int M, int N, int G_, int c_) { nM = M / BM; nN = N / BM; nwg = nM * nN; G = G_; c = c_; }
    __device__ bool next(int i, Unit& u) const {
        const long L = (long)i * G + c; if (L >= nwg) return false;
        int wgid = (int)L; { const int q = nwg / NXCD, r = nwg % NXCD, xcd = wgid % NXCD, off = wgid / NXCD; wgid = (xcd < r ? xcd * (q + 1) : r * (q + 1) + (xcd - r) * q) + off; }
        const int nig = WGM * nN, gid = wgid / nig, fm = gid * WGM, gsz = (nM - fm) < WGM ? (nM - fm) : WGM;
        u.pm = fm + ((wgid % nig) % gsz); u.pn = (wgid % nig) / gsz; u.ks = 0; u.koffA = 0; u.koffB = 0; return true;
    }
};
struct SplitKOrder {
    int nN, nks, pm, kchunk, G, c;
    __device__ bool next(int i, Unit& u) const { const long L = (long)i * G + c; if (L >= (long)nN * nks) return false;
        u.pm = pm; u.pn = (int)(L % nN); u.ks = (int)(L / nN); u.koffA = u.ks * kchunk; u.koffB = u.koffA; return true; }
};

struct P3Order {
    int G, c;
    __device__ bool next(int i, Unit& u) const { const int L = i * G + c; if (L >= 16 * 33) return false;
        u.pn = L / 33; u.pm = L - u.pn * 33; u.ks = 0; u.koffB = 0; u.koffA = u.pn < 4 ? u.pn * 256 : 1024 + ((u.pn - 4) >> 2) * 256; return true; }
};
template <class Epi, class Sched>
__device__ __forceinline__ void gemm_phase(LAS unsigned char* lds, const Gemm g, const Sched& S, const Epi& E) {
    const int tid = threadIdx.x, wid = __builtin_amdgcn_readfirstlane(tid >> 6), lane = tid & 63, wr = wid >> 2, wc = wid & 3, fr = lane & 15, fq = lane >> 4;
    const int K = g.K, nt = K / BK;
    unsigned voffA[2], voffB[2];
#pragma unroll
    for (int i = 0; i < 2; ++i) { int R, C; stage_rc(tid * 16 + i * 8192, R, C); const int Rb = Epi::PERM ? ((R & ~31) + perm32(R & 31)) : R;
        voffA[i] = (unsigned)(R * g.lda + C) * 2u; voffB[i] = (unsigned)(Rb * g.ldb + C) * 2u; }
    const size_t kstep = (size_t)(BK * 2);
    const size_t hstepA = (size_t)HALF * g.lda * 2, hstepB = (size_t)HALF * g.ldb * 2;
    const size_t tstepA = 2 * hstepA, tstepB = 2 * hstepB;
    const unsigned ldsw = (unsigned)wid * 1024u;
    const int aoff = lds_byte(wr * 64 + fr, fq * 8), boff = lds_byte(wc * 32 + fr, fq * 8);
#define PG8_SA(b, h) (((b) * 2 + (h)) * HTB)
#define PG8_SB(b, h) ((4 + (b) * 2 + (h)) * HTB)
#define PG8_STAGE(bufoff, gbase, voff) do { _Pragma("unroll") for (int _i = 0; _i < 2; ++_i) \
        __builtin_amdgcn_global_load_lds((const unsigned*)((const char*)(gbase) + (voff)[_i]), (LAS unsigned*)(lds + (bufoff) + ldsw + _i * 8192), 16, 0, 0); } while (0)
#define PG8_LDA(dst, b, h) do { _Pragma("unroll") for (int m = 0; m < 4; ++m) _Pragma("unroll") for (int k = 0; k < 2; ++k) dst[m][k] = *(const LAS bf16x8*)(lds + PG8_SA(b, h) + aoff + m * 2048 + k * 1024); } while (0)
#define PG8_LDB(dst, b, h) do { _Pragma("unroll") for (int n = 0; n < 2; ++n) _Pragma("unroll") for (int k = 0; k < 2; ++k) dst[n][k] = *(const LAS bf16x8*)(lds + PG8_SB(b, h) + boff + n * 2048 + k * 1024); } while (0)
#define PG8_MMA(ai, bj, At, Bt) do { __builtin_amdgcn_s_setprio(1); _Pragma("unroll") for (int m = 0; m < 4; ++m) _Pragma("unroll") for (int n = 0; n < 2; ++n) _Pragma("unroll") for (int k = 0; k < 2; ++k) \
        acc[ai][bj][m][n] = __builtin_amdgcn_mfma_f32_16x16x32_bf16(Bt[n][k], At[m][k], acc[ai][bj][m][n], 0, 0, 0); __builtin_amdgcn_s_setprio(0); } while (0)
#define PG8_WAIT_V(n) asm volatile("s_waitcnt vmcnt(" #n ")" ::: "memory")
#define PG8_WAIT_L(n) asm volatile("s_waitcnt lgkmcnt(" #n ")" ::: "memory")
#define PG8_BAR __builtin_amdgcn_s_barrier()
#define PG8_SCHED __builtin_amdgcn_sched_barrier(0)
    Unit cur, nxt; int ui = 0;
    if (!S.next(0, cur)) return;
    f32x4 acc[2][2][4][2];
#pragma unroll
    for (int a = 0; a < 2; ++a)
#pragma unroll
        for (int b = 0; b < 2; ++b)
#pragma unroll
            for (int m = 0; m < 4; ++m)
#pragma unroll
                for (int n = 0; n < 2; ++n) acc[a][b][m][n] = (f32x4){0.f, 0.f, 0.f, 0.f};
    bf16x8 At[4][2], B0[2][2], B1[2][2];
    const char* cA = (const char*)g.A + (size_t)cur.pm * tstepA + (size_t)cur.koffA * 2; const char* cB = (const char*)g.Bt + (size_t)cur.pn * tstepB + (size_t)cur.koffB * 2;
    PG8_STAGE(PG8_SB(0, 0), cB, voffB); PG8_STAGE(PG8_SA(0, 0), cA, voffA); PG8_STAGE(PG8_SB(0, 1), cB + hstepB, voffB); PG8_STAGE(PG8_SA(0, 1), cA + hstepA, voffA);
    if (wr == 1) PG8_BAR;
    PG8_WAIT_V(4); PG8_BAR;
    PG8_STAGE(PG8_SB(1, 0), cB + kstep, voffB); PG8_STAGE(PG8_SA(1, 0), cA + kstep, voffA); PG8_STAGE(PG8_SB(1, 1), cB + hstepB + kstep, voffB);
    PG8_WAIT_V(6); PG8_BAR;
    for (;;) {
        const bool has_next = S.next(ui + 1, nxt);
        const char* nA = has_next ? (const char*)g.A + (size_t)nxt.pm * tstepA + (size_t)nxt.koffA * 2 : cA; const char* nB = has_next ? (const char*)g.Bt + (size_t)nxt.pn * tstepB + (size_t)nxt.koffB * 2 : cB;
#pragma clang loop unroll(disable)
        for (int t = 0; t < nt; t += 2) {
            const bool last = (t == nt - 2);
            const char* a1 = cA + (size_t)(t + 1) * kstep;
            const char* a2 = last ? nA : cA + (size_t)(t + 2) * kstep; const char* b2 = last ? nB : cB + (size_t)(t + 2) * kstep;
            const char* a3 = a2 + kstep; const char* b3 = b2 + kstep;
            PG8_LDB(B0, 0, 0); PG8_SCHED; PG8_LDA(At, 0, 0); PG8_STAGE(PG8_SA(1, 1), a1 + hstepA, voffA);
            PG8_WAIT_L(8); PG8_BAR; PG8_WAIT_L(0); PG8_MMA(0, 0, At, B0); PG8_BAR; PG8_SCHED;
            PG8_LDB(B1, 0, 1); PG8_STAGE(PG8_SB(0, 0), b2, voffB);
            PG8_BAR; PG8_WAIT_L(0); PG8_MMA(0, 1, At, B1); PG8_BAR;
            PG8_LDA(At, 0, 1); PG8_STAGE(PG8_SA(0, 0), a2, voffA);
            PG8_BAR; PG8_WAIT_L(0); PG8_MMA(1, 0, At, B0); PG8_BAR; PG8_SCHED;
            PG8_STAGE(PG8_SB(0, 1), b2 + hstepB, voffB);
            PG8_WAIT_V(6); PG8_BAR; PG8_MMA(1, 1, At, B1); PG8_BAR;
            PG8_LDB(B0, 1, 0); PG8_SCHED; PG8_LDA(At, 1, 0); PG8_STAGE(PG8_SA(0, 1), a2 + hstepA, voffA);
            PG8_WAIT_L(8); PG8_BAR; PG8_WAIT_L(0); PG8_MMA(0, 0, At, B0); PG8_BAR; PG8_SCHED;
            PG8_LDB(B1, 1, 1); PG8_STAGE(PG8_SB(1, 0), b3, voffB);
            PG8_BAR; PG8_WAIT_L(0); PG8_MMA(0, 1, At, B1); PG8_BAR;
            PG8_LDA(At, 1, 1); PG8_STAGE(PG8_SA(1, 0), a3, voffA);
            PG8_BAR; PG8_WAIT_L(0); PG8_MMA(1, 0, At, B0); PG8_BAR; PG8_SCHED;
            PG8_STAGE(PG8_SB(1, 1), b3 + hstepB, voffB);
            PG8_WAIT_V(6); PG8_BAR; PG8_MMA(1, 1, At, B1); PG8_BAR;
        }
        if constexpr (!Epi::AFTER_DRAIN) E(acc, cur, wr, wc, fr, fq);
        if (!has_next) break;
#pragma unroll
        for (int a = 0; a < 2; ++a)
#pragma unroll
            for (int b = 0; b < 2; ++b)
#pragma unroll
                for (int m = 0; m < 4; ++m)
#pragma unroll
                    for (int n = 0; n < 2; ++n) acc[a][b][m][n] = (f32x4){0.f, 0.f, 0.f, 0.f};
        cur = nxt; cA = nA; cB = nB; ++ui;
    }
    PG8_WAIT_V(0);
    if (wr == 0) PG8_BAR;
    PG8_BAR;
    if constexpr (Epi::AFTER_DRAIN) E(acc, cur, wr, wc, fr, fq);
#undef PG8_SA
#undef PG8_SB
#undef PG8_STAGE
#undef PG8_LDA
#undef PG8_LDB
#undef PG8_MMA
#undef PG8_WAIT_V
#undef PG8_WAIT_L
#undef PG8_BAR
#undef PG8_SCHED
}
}
using pg8::Unit;

template <int MODE> struct EpiBf16 {
    static constexpr bool PERM = true, AFTER_DRAIN = false;
    bf16_t* O; int ldc; int coff; const float* vec;
    __device__ __forceinline__ void operator()(const f32x4 (&acc)[2][2][4][2], const Unit& u, int wr, int wc, int fr, int fq) const {
        const int row0 = u.pm * 256 + wr * 64 + fr, col0 = coff + u.pn * 256 + wc * 32 + 8 * fq;
#pragma unroll
        for (int bj = 0; bj < 2; ++bj) {
            const int c = col0 + bj * 128;
            f32x4 s0, s1;
            if (MODE == 0) { s0 = vec ? *(const f32x4*)(vec + c) : (f32x4){1.f, 1.f, 1.f, 1.f}; s1 = vec ? *(const f32x4*)(vec + c + 4) : (f32x4){1.f, 1.f, 1.f, 1.f}; }
            else { s0 = *(const f32x4*)(vec + c); s1 = *(const f32x4*)(vec + c + 4); }
#pragma unroll
            for (int ai = 0; ai < 2; ++ai)
#pragma unroll
                for (int m = 0; m < 4; ++m) {
                    f32x4 v0 = acc[ai][bj][m][0], v1 = acc[ai][bj][m][1];
                    if (MODE == 0) { v0 = v0 * s0; v1 = v1 * s1; }
                    else {
#pragma unroll
                        for (int j = 0; j < 4; ++j) { v0[j] = sigmoidf_(v0[j] + s0[j]); v1[j] = sigmoidf_(v1[j] + s1[j]); } }
                    u32x4 w; w.x = pk_bf16(v0[0], v0[1]); w.y = pk_bf16(v0[2], v0[3]); w.z = pk_bf16(v1[0], v1[1]); w.w = pk_bf16(v1[2], v1[3]);
                    *(u32x4*)(O + (size_t)(row0 + ai * 128 + m * 16) * ldc + c) = w;
                }
        }
    }
};
struct EpiP3 {
    static constexpr bool PERM = true, AFTER_DRAIN = false;
    bf16_t* MixO; float* DecO; bf16_t* AO; bf16_t* GO; const float* pscale; const float* w0v; const float* a0v;
    __device__ __forceinline__ void operator()(const f32x4 (&acc)[2][2][4][2], const Unit& u, int wr, int wc, int fr, int fq) const {
        const bool pool = u.pn < 4; const int sgm = (u.pn - 4) >> 2;
        const int mode = pool ? 0 : (sgm == 0 ? 2 : (sgm == 1 ? 1 : 0)), ldc = pool ? D : CW;
        bf16_t* o0 = MixO; bf16_t* o1 = AO; bf16_t* o2 = GO; const float* v0 = pscale; const float* v1 = w0v; const float* v2 = a0v;
        asm volatile("" : "+s"(o0), "+s"(o1), "+s"(o2), "+s"(v0), "+s"(v1), "+s"(v2));
        bf16_t* Ob = pool ? o0 : (sgm == 1 ? o1 : o2); float* Of = DecO;
        const float* vec = pool ? v0 : (sgm == 0 ? v1 : (sgm == 1 ? v2 : (const float*)nullptr));
        const int row0 = u.pm * 256 + wr * 64 + fr, col0 = (pool ? u.pn * 256 : ((u.pn - 4) & 3) * 256) + wc * 32 + 8 * fq;
        const f32x4 one = (f32x4){1.f, 1.f, 1.f, 1.f};
        f32x4 sv[2][2];
#pragma unroll
        for (int bj = 0; bj < 2; ++bj) { sv[bj][0] = vec ? *(const f32x4*)(vec + col0 + bj * 128) : one; sv[bj][1] = vec ? *(const f32x4*)(vec + col0 + bj * 128 + 4) : one; }
#pragma unroll
        for (int bj = 0; bj < 2; ++bj) {
            const int c = col0 + bj * 128;
            const f32x4 s0 = sv[bj][0], s1 = sv[bj][1];
#pragma unroll
            for (int ai = 0; ai < 2; ++ai)
#pragma unroll
                for (int m = 0; m < 4; ++m) {
                    const int row = row0 + ai * 128 + m * 16;
                    f32x4 v0 = acc[ai][bj][m][0], v1 = acc[ai][bj][m][1];
                    if (mode == 0) { v0 = v0 * s0; v1 = v1 * s1; }
                    else if (mode == 1) {
#pragma unroll
                        for (int j = 0; j < 4; ++j) { v0[j] = sigmoidf_(v0[j] + s0[j]); v1[j] = sigmoidf_(v1[j] + s1[j]); } }
                    else {
                        v0 = v0 + s0; v1 = v1 + s1;
#pragma unroll
                        for (int j = 0; j < 4; ++j) {
                            v0[j] = __expf(-0.60653066f * sigmoidf_(v0[j])); v1[j] = __expf(-0.60653066f * sigmoidf_(v1[j])); }
                    }
                    if (mode == 2) { if (row < MV) { float* p = Of + (size_t)row * ldc + c; *(f32x4*)p = v0; *(f32x4*)(p + 4) = v1; } }
                    else { u32x4 w; w.x = pk_bf16(v0[0], v0[1]); w.y = pk_bf16(v0[2], v0[3]); w.z = pk_bf16(v1[0], v1[1]); w.w = pk_bf16(v1[2], v1[3]);
                        *(u32x4*)(Ob + (size_t)row * ldc + c) = w; }
                }
        }
    }
};
struct EpiDecay {
    static constexpr bool PERM = false, AFTER_DRAIN = false;
    float* O; const float* w0;
    __device__ __forceinline__ void operator()(const f32x4 (&acc)[2][2][4][2], const Unit& u, int wr, int wc, int fr, int fq) const {
        const int row0 = u.pm * 256 + wr * 64 + fr, col0 = u.pn * 256 + wc * 32 + 4 * fq;
#pragma unroll
        for (int bj = 0; bj < 2; ++bj)
#pragma unroll
            for (int n = 0; n < 2; ++n) {
                const int c = col0 + bj * 128 + n * 16; const f32x4 b = *(const f32x4*)(w0 + c);
#pragma unroll
                for (int ai = 0; ai < 2; ++ai)
#pragma unroll
                    for (int m = 0; m < 4; ++m) {
                        const int row = row0 + ai * 128 + m * 16; f32x4 v = acc[ai][bj][m][n] + b, o;
#pragma unroll
                        for (int j = 0; j < 4; ++j) { const float z = -v[j]; const float sp = fmaxf(z, 0.f) + __logf(1.0f + __expf(-fabsf(z))); o[j] = __expf(-__expf(-sp - 0.5f)); }
                        if (row < MV) *(f32x4*)(O + (size_t)row * CW + c) = o;
                    }
            }
    }
};
struct EpiOut {
    static constexpr bool PERM = false, AFTER_DRAIN = false;
    const float* xp; const float* xs; float* out; bf16_t* h2; const float* g; float* rowsq;
    __device__ __forceinline__ void operator()(const f32x4 (&acc)[2][2][4][2], const Unit& u, int wr, int wc, int fr, int fq) const {
        const int row0 = u.pm * 256 + wr * 64 + fr, col0 = u.pn * 256 + wc * 32 + 4 * fq;
        f32x4 gg[2][2];
#pragma unroll
        for (int bj = 0; bj < 2; ++bj)
#pragma unroll
            for (int n = 0; n < 2; ++n) gg[bj][n] = *(const f32x4*)(g + col0 + bj * 128 + n * 16);
        f32x4 xv[2][2], xn[2][2];
#define EPIOUT_LOAD(DST, IDX) do { const int row_ = row0 + ((IDX) >> 2) * 128 + ((IDX) & 3) * 16; const bool ok_ = row_ < MV; \
            const float* xr_ = row_ < MPR ? xp + (size_t)row_ * D : xs + (size_t)(ok_ ? row_ - MPR : 0) * D; \
            _Pragma("unroll") for (int bj = 0; bj < 2; ++bj) _Pragma("unroll") for (int n = 0; n < 2; ++n) DST[bj][n] = *(const f32x4*)(xr_ + col0 + bj * 128 + n * 16); } while (0)
        EPIOUT_LOAD(xv, 0);
#pragma unroll
        for (int idx = 0; idx < 8; ++idx) {
            const int ai = idx >> 2, m = idx & 3;
            if (idx + 1 < 8) EPIOUT_LOAD(xn, idx + 1);
            const int row = row0 + ai * 128 + m * 16; const bool ok = row < MV;
            float s = 0.f;
#pragma unroll
            for (int bj = 0; bj < 2; ++bj)
#pragma unroll
                for (int n = 0; n < 2; ++n) {
                    const int c = col0 + bj * 128 + n * 16;
                    f32x4 x1 = acc[ai][bj][m][n];
                    if (ok) { x1 = x1 + xv[bj][n]; *(f32x4*)(out + (size_t)row * D + c) = x1; }
                    s += (x1[0] * x1[0] + x1[1] * x1[1]) + (x1[2] * x1[2] + x1[3] * x1[3]);
                    const f32x4 hv = x1 * gg[bj][n];
                    u32x2 w; w.x = pk_bf16(hv[0], hv[1]); w.y = pk_bf16(hv[2], hv[3]);
                    *(u32x2*)(h2 + (size_t)row * D + c) = w;
                }
            s += __shfl_xor(s, 16); s += __shfl_xor(s, 32);
            if (ok && fq == 0) unsafeAtomicAdd(rowsq + row, s);
#pragma unroll
            for (int bj = 0; bj < 2; ++bj)
#pragma unroll
                for (int n = 0; n < 2; ++n) xv[bj][n] = xn[bj][n];
        }
#undef EPIOUT_LOAD
    }
};
struct EpiGU {
    static constexpr bool PERM = true, AFTER_DRAIN = false;
    bf16_t* U; const float* rowsq;
    __device__ __forceinline__ void operator()(const f32x4 (&acc)[2][2][4][2], const Unit& u, int wr, int wc, int fr, int fq) const {
        const int row0 = u.pm * 256 + wr * 64 + fr, col0 = u.pn * 128 + wc * 32 + 8 * fq;
        float rs[2][4];
#pragma unroll
        for (int ai = 0; ai < 2; ++ai)
#pragma unroll
            for (int m = 0; m < 4; ++m) rs[ai][m] = rowsq[row0 + ai * 128 + m * 16];
#pragma unroll
        for (int ai = 0; ai < 2; ++ai)
#pragma unroll
            for (int m = 0; m < 4; ++m) {
                const int row = row0 + ai * 128 + m * 16;
                const float rstd = rsqrtf(rs[ai][m] * (1.0f / D) + RMS_EPS);
                f32x4 o[2];
#pragma unroll
                for (int n = 0; n < 2; ++n)
#pragma unroll
                    for (int j = 0; j < 4; ++j) { const float gt = acc[ai][0][m][n][j] * rstd, up = acc[ai][1][m][n][j] * rstd; o[n][j] = gt * sigmoidf_(gt) * up; }
                u32x4 w; w.x = pk_bf16(o[0][0], o[0][1]); w.y = pk_bf16(o[0][2], o[0][3]); w.z = pk_bf16(o[1][0], o[1][1]); w.w = pk_bf16(o[1][2], o[1][3]);
                *(u32x4*)(U + (size_t)row * DFF + col0) = w;
            }
    }
};
struct EpiDown {
    static constexpr bool PERM = false, AFTER_DRAIN = false;
    float* out;
    __device__ __forceinline__ void operator()(const f32x4 (&acc)[2][2][4][2], const Unit& u, int wr, int wc, int fr, int fq) const {
        const int row0 = u.pm * 256 + wr * 64 + fr, col0 = u.pn * 256 + wc * 32 + 4 * fq;
#pragma unroll
        for (int ai = 0; ai < 2; ++ai)
#pragma unroll
            for (int m = 0; m < 4; ++m) {
                const int row = row0 + ai * 128 + m * 16;
#pragma unroll
                for (int bj = 0; bj < 2; ++bj)
#pragma unroll
                    for (int n = 0; n < 2; ++n) {
                        const int c = col0 + bj * 128 + n * 16; float* p = out + (size_t)row * D + c;
                        *(f32x4*)p = acc[ai][bj][m][n] + *(const f32x4*)p;
                    }
            }
    }
};
struct EpiDownNorm {
    static constexpr bool PERM = false, AFTER_DRAIN = true;
    float* out; float* rowsq; unsigned* cnt; const float* g;
    __device__ __forceinline__ void operator()(f32x4 (&acc)[2][2][4][2], const Unit& u, int wr, int wc, int fr, int fq) const {
        const int row0 = u.pm * 256 + wr * 64 + fr, col0 = u.pn * 256 + wc * 32 + 4 * fq;
        float chk = 0.f;
        f32x4 xv[2][2], xn[2][2];
#define EPIDN_LOAD(DST, IDX) do { const float* xr_ = out + (size_t)(row0 + ((IDX) >> 2) * 128 + ((IDX) & 3) * 16) * D + col0; \
            _Pragma("unroll") for (int bj = 0; bj < 2; ++bj) _Pragma("unroll") for (int n = 0; n < 2; ++n) DST[bj][n] = *(const f32x4*)(xr_ + bj * 128 + n * 16); } while (0)
        EPIDN_LOAD(xv, 0);
#pragma unroll
        for (int idx = 0; idx < 8; ++idx) {
            const int ai = idx >> 2, m = idx & 3;
            if (idx + 1 < 8) EPIDN_LOAD(xn, idx + 1);
            const int row = row0 + ai * 128 + m * 16; float s = 0.f;
#pragma unroll
            for (int bj = 0; bj < 2; ++bj)
#pragma unroll
                for (int n = 0; n < 2; ++n) {
                    const f32x4 x2 = acc[ai][bj][m][n] + xv[bj][n]; acc[ai][bj][m][n] = x2;
                    s += (x2[0] * x2[0] + x2[1] * x2[1]) + (x2[2] * x2[2] + x2[3] * x2[3]);
                }
            s += __shfl_xor(s, 16); s += __shfl_xor(s, 32);
            if (fq == 0) chk += unsafeAtomicAdd(rowsq + row, s);
#pragma unroll
            for (int bj = 0; bj < 2; ++bj)
#pragma unroll
                for (int n = 0; n < 2; ++n) xv[bj][n] = xn[bj][n];
        }
#undef EPIDN_LOAD
        asm volatile("s_waitcnt vmcnt(0)" :: "v"(chk) : "memory");
        unsigned* pc = cnt + 64 * u.pm;
        if ((threadIdx.x & 63) == 0) __hip_atomic_fetch_add(pc, 1u, __ATOMIC_RELAXED, __HIP_MEMORY_SCOPE_AGENT);
        f32x4 gg[2][2];
#pragma unroll
        for (int bj = 0; bj < 2; ++bj)
#pragma unroll
            for (int n = 0; n < 2; ++n) gg[bj][n] = *(const f32x4*)(g + col0 + bj * 128 + n * 16);
        { unsigned spins = 0; while (__hip_atomic_load(pc, __ATOMIC_RELAXED, __HIP_MEMORY_SCOPE_AGENT) < 64u) { __builtin_amdgcn_s_sleep(2); if (++spins > (1u << 22)) break; } }
        __builtin_amdgcn_fence(__ATOMIC_ACQUIRE, "agent");
        asm volatile("s_waitcnt vmcnt(0)" ::: "memory");
        float rs[2][4];
#pragma unroll
        for (int ai = 0; ai < 2; ++ai)
#pragma unroll
            for (int m = 0; m < 4; ++m) rs[ai][m] = __hip_atomic_load(rowsq + row0 + ai * 128 + m * 16, __ATOMIC_RELAXED, __HIP_MEMORY_SCOPE_AGENT);
#pragma unroll
        for (int ai = 0; ai < 2; ++ai)
#pragma unroll
            for (int m = 0; m < 4; ++m) {
                const int row = row0 + ai * 128 + m * 16;
                const float rstd = rsqrtf(rs[ai][m] * (1.0f / D) + RMS_EPS);
#pragma unroll
                for (int bj = 0; bj < 2; ++bj)
#pragma unroll
                    for (int n = 0; n < 2; ++n) { const int c = col0 + bj * 128 + n * 16; *(f32x4*)(out + (size_t)row * D + c) = acc[ai][bj][m][n] * rstd * gg[bj][n]; }
            }
    }
};
struct EpiPartial {
    static constexpr bool PERM = false, AFTER_DRAIN = false;
    float* buf;
    __device__ __forceinline__ void operator()(const f32x4 (&acc)[2][2][4][2], const Unit& u, int wr, int wc, int fr, int fq) const {
        const int col0 = u.pn * 256 + wc * 32 + 4 * fq;
#pragma unroll
        for (int m = 0; m < 4; ++m) {
            const int lrow = wr * 64 + m * 16 + fr;
            float* p = buf + ((size_t)u.ks * MSA + lrow) * D + col0;
#pragma unroll
            for (int bj = 0; bj < 2; ++bj)
#pragma unroll
                for (int n = 0; n < 2; ++n) *(f32x4*)(p + bj * 128 + n * 16) = acc[0][bj][m][n];
        }
    }
};

template <int RM> __device__ __forceinline__ int rowmap(int n) { return RM == 0 ? n : (RM == 1 ? ((n >> 7) * 256 + (n & 127)) : ((n >> 7) * 256 + 128 + (n & 127))); }
template <int RM>
__device__ __forceinline__ void transpose_bf16(const float* src, int Ksrc, int Nsrc, int ld, bf16_t* dst, int Kdst, int Ndst, int rot, int vgw, int gws) {
    const int lane = threadIdx.x & 63, gw = (vgw + rot) % gws;
    const int nn = Ndst / 64, ntile = nn * (Kdst / 64);
    for (int t = gw; t < ntile; t += gws) {
        const int k0 = (t / nn) * 64, n = (t % nn) * 64 + lane;
        const bool nok = n < Nsrc;
        const float* sp = src + (nok ? n : 0);
        float v[64];
        const float mskn = nok ? 1.f : 0.f;
#pragma unroll
        for (int j = 0; j < 64; ++j) { const int k = k0 + j; v[j] = sp[(size_t)(k < Ksrc ? k : Ksrc - 1) * ld]; }
#pragma unroll
        for (int j = 0; j < 64; ++j) v[j] *= ((k0 + j) < Ksrc ? mskn : 0.f);
        bf16_t* dp = dst + (size_t)rowmap<RM>(n) * Kdst + k0;
#pragma unroll
        for (int q8 = 0; q8 < 8; ++q8) { u32x4 w; w.x = pk_bf16(v[q8 * 8 + 0], v[q8 * 8 + 1]); w.y = pk_bf16(v[q8 * 8 + 2], v[q8 * 8 + 3]); w.z = pk_bf16(v[q8 * 8 + 4], v[q8 * 8 + 5]); w.w = pk_bf16(v[q8 * 8 + 6], v[q8 * 8 + 7]);
            *(u32x4*)(dp + q8 * 8) = w; }
    }
}
template <int CTRL> __device__ __forceinline__ float dpp_(float x) { return __int_as_float(__builtin_amdgcn_update_dpp(0, __float_as_int(x), CTRL, 0xF, 0xF, true)); }
__device__ __forceinline__ float red8(float x) { x += dpp_<0x141>(x); x += dpp_<0xB1>(x); x += dpp_<0x4E>(x); return x; }

template <int W>
__device__ __forceinline__ void pool_block_prompt(const bf16_t* proj, bf16_t* pooled, int b, int t0, int c) {
    float ux[15 + W], uy[15 + W]; unsigned raw[15 + W];
#pragma unroll
    for (int j = 0; j < 15 + W; ++j) {
        const int t = t0 - (W - 1) + j;
        raw[j] = *(const unsigned*)(proj + (size_t)(b * TT + (t < 0 ? 0 : t)) * PJP + c);
    }
#pragma unroll
    for (int j = 0; j < 15 + W; ++j) {
        const int t = t0 - (W - 1) + j; const float zm = t < 0 ? 0.f : 1.f;
        ux[j] = bf2f(raw[j] & 0xffffu) * zm; uy[j] = bf2f(raw[j] >> 16) * zm;
    }
#pragma unroll
    for (int i = 0; i < 16; ++i) {
        const int t = t0 + i; float sx = 0.f, sy = 0.f;
#pragma unroll
        for (int j = 0; j < W; ++j) { sx += ux[i + j]; sy += uy[i + j]; }
        const float inv = 1.0f / (float)(t + 1 < W ? t + 1 : W);
        const float px = sx * inv - ux[i + W - 1], py = sy * inv - uy[i + W - 1];
        *(unsigned*)(pooled + (size_t)(b * TT + t) * XLD + c) = pk_bf16(px, py);
    }
}

__global__ void __launch_bounds__(NTHR) hymba_fwd(Params P) {
    extern __shared__ __attribute__((aligned(16))) unsigned char lds_raw[];
    LAS unsigned char* lds = (LAS unsigned char*)lds_raw;
    const int G = gridDim.x, bid = blockIdx.x, gthreads = G * NTHR, gwaves = G * 8;
#define PHASE_IDS int tid = threadIdx.x; asm volatile("" : "+v"(tid)); const int lane = tid & 63, wave = tid >> 6, gtid = bid * NTHR + tid, gwave = bid * 8 + wave; (void)lane; (void)wave; (void)gtid; (void)gwave;
    unsigned char* ws = P.ws; float* out = P.out;
    const float* x_prompt = P.in[0]; const float* x_sample = P.in[1]; const float* state_pool = P.in[2]; const float* state_shift = P.in[3]; const float* state_wkv = P.in[4];
    const float* norm_mix = P.in[5]; const float* w_in = P.in[6]; const float* w_pool = P.in[7]; const float* pool_scale = P.in[8]; const float* mu_shift = P.in[9];
    const float* w0 = P.in[10]; const float* w2 = P.in[11]; const float* a0 = P.in[12]; const float* a2 = P.in[13]; const float* g2 = P.in[14];
    const float* k_k = P.in[15]; const float* k_a = P.in[16]; const float* r_k = P.in[17]; const float* gn_w = P.in[18]; const float* gn_b = P.in[19];
    const float* w_out = P.in[20]; const float* norm_ffn = P.in[21]; const float* w_gate = P.in[22]; const float* w_up = P.in[23]; const float* w_down = P.in[24]; const float* norm_final = P.in[25];
    bf16_t* WinT = (bf16_t*)(ws + WS_WIN); bf16_t* WoutT = (bf16_t*)(ws + WS_WOUT); bf16_t* WguT = (bf16_t*)(ws + WS_WGU); bf16_t* WdnT = (bf16_t*)(ws + WS_WDN);
    bf16_t* WpoolT = (bf16_t*)(ws + WS_WPOOL); bf16_t* WloraT = (bf16_t*)(ws + WS_WLORA);
    bf16_t* Hb = (bf16_t*)(ws + WS_R1); bf16_t* Xb = (bf16_t*)(ws + WS_R1); bf16_t* H2 = (bf16_t*)(ws + WS_R1);
    bf16_t* Proj = (bf16_t*)(ws + WS_PROJ); bf16_t* Ub = (bf16_t*)(ws + WS_PROJ); bf16_t* Ab = (bf16_t*)(ws + WS_A); bf16_t* Gb = (bf16_t*)(ws + WS_GATE);
    bf16_t* Mix = (bf16_t*)(ws + WS_MIX); float* rowsq1 = (float*)(ws + WS_ROWSQ); float* rowsq2 = rowsq1 + MPAD; unsigned* pcnt = (unsigned*)(ws + WS_PCNT); float* Bonus = (float*)(ws + WS_BONUS);
    unsigned* barctr = (unsigned*)(ws + WS_BAR);
    float* Yb = out + SCR_Y; float* Dec = out + SCR_DEC;
    float* Part6 = (float*)(ws + WS_A);
    float* Part8 = (float*)(ws + WS_R1);
    { LAS unsigned* st0 = (LAS unsigned*)(lds + LDS_ST_OFF); if (threadIdx.x < 2) st0[threadIdx.x] = 0u; }
    __syncthreads();
    const XcdBarrier xbar = xcd_barrier_post(barctr, (volatile LAS unsigned*)(lds + LDS_ST_OFF));
#ifndef P3SEL
#define P3SEL 15
#endif
#ifndef PHASE_MASK
#define PHASE_MASK 0x3ff
#endif
#define IN(k) (((PHASE_MASK >> (k)) & 1) && (!P.multi || P.phase == (k)))
#define SEAM() do { if (!P.multi) xcd_barrier(xbar); } while (0)

    if (IN(0)) {
        PHASE_IDS
        transpose_bf16<0>(w_in, D, PJ, PJ, WinT, D, PJP, 0, gwave, gwaves);
        for (int g = 0; g < 4; ++g) transpose_bf16<0>(w_pool + (size_t)g * 65536, 256, 256, 256, WpoolT + (size_t)g * 65536, 256, 256, 1280 + g * 16, gwave, gwaves);
        transpose_bf16<0>(w2, 64, CW, CW, WloraT, 256, CW, 1344, gwave, gwaves);
        transpose_bf16<0>(a2, 64, CW, CW, WloraT + (size_t)CW * 256, 256, CW, 1408, gwave, gwaves);
        transpose_bf16<0>(g2, 160, CW, CW, WloraT + (size_t)2 * CW * 256, 256, CW, 1472, gwave, gwaves);
        for (int i = gtid; i < 2 * MPAD; i += gthreads) rowsq1[i] = 0.f;
        f32x4 gmix[8];
#pragma unroll
        for (int i = 0; i < 8; ++i) gmix[i] = *(const f32x4*)(norm_mix + (i * 64 + lane) * 4);
        for (int m = gwave; m < MPAD; m += gwaves) {
            bf16_t* hr = Hb + (size_t)m * D;
            if (m < MV) {
                const float* xr = m < MPR ? x_prompt + (size_t)m * D : x_sample + (size_t)(m - MPR) * D;
                f32x4 v[8]; float s = 0.f;
#pragma unroll
                for (int i = 0; i < 8; ++i) v[i] = *(const f32x4*)(xr + (i * 64 + lane) * 4);
#pragma unroll
                for (int i = 0; i < 8; ++i) s += (v[i][0] * v[i][0] + v[i][1] * v[i][1]) + (v[i][2] * v[i][2] + v[i][3] * v[i][3]);
                s = wsum(s); const float rstd = rsqrtf(s * (1.0f / D) + RMS_EPS);
#pragma unroll
                for (int i = 0; i < 8; ++i) { const int c = (i * 64 + lane) * 4; const f32x4 o = v[i] * rstd * gmix[i];
                    u32x2 w; w.x = pk_bf16(o[0], o[1]); w.y = pk_bf16(o[2], o[3]); *(u32x2*)(hr + c) = w; }
            } else {
#pragma unroll
                for (int i = 0; i < 8; ++i) *(u32x2*)(hr + (i * 64 + lane) * 4) = (u32x2){0u, 0u};
            }
        }
    }
    if (P.multi == 2) cg::this_grid().sync();
    SEAM();

    if (IN(1)) {
        PHASE_IDS
        pg8::Gemm g{Hb, WinT, D, D, D}; pg8::StaticOrder S; S.init(MPAD, PJP, G, bid);
        EpiBf16<0> E{Proj, PJP, 0, nullptr};
        pg8::gemm_phase(lds, g, S, E);
    }
    SEAM();

    if (IN(2)) {
        PHASE_IDS
        for (int rb = bid; rb < MPR / 16; rb += G) {
            const int b = rb >> 7, t0 = (rb & 127) * 16, c = tid * 2, gq = tid >> 7;
            if (gq == 0) pool_block_prompt<2>(Proj, Xb, b, t0, c);
            else if (gq == 1) pool_block_prompt<4>(Proj, Xb, b, t0, c);
            else if (gq == 2) pool_block_prompt<8>(Proj, Xb, b, t0, c);
            else pool_block_prompt<16>(Proj, Xb, b, t0, c);
        }
        for (int b = bid; b < MSA; b += G) {
            const int c = tid * 2, W = 2 << (tid >> 7);
            const unsigned v = *(const unsigned*)(Proj + (size_t)(MPR + b) * PJP + c); const float ux = bf2f(v & 0xffffu), uy = bf2f(v >> 16);
            f32x2 pr[15];
#pragma unroll
            for (int j = 0; j < 15; ++j) pr[j] = *(const f32x2*)(state_pool + ((size_t)b * 15 + j) * PW + c);
            float sx = ux, sy = uy;
#pragma unroll
            for (int j = 1; j < 16; ++j) { const float mk = j < W ? 1.f : 0.f; sx += pr[15 - j][0] * mk; sy += pr[15 - j][1] * mk; }
            const float inv = 1.0f / (float)W;
            *(unsigned*)(Xb + (size_t)(MPR + b) * XLD + c) = pk_bf16(sx * inv - ux, sy * inv - uy);
            float* np = out + OUT_POOLS + (size_t)b * 15 * PW;
#pragma unroll
            for (int j = 0; j < 14; ++j) *(f32x2*)(np + (size_t)j * PW + c) = pr[j + 1];
            *(f32x2*)(np + (size_t)14 * PW + c) = (f32x2){ux, uy};
        }
        {
            constexpr int NIT = MV * 144;
            for (int base = gtid; base < NIT; base += 5 * gthreads) {
                unsigned cv[5], pv[5]; f32x2 mu[5]; int mm[5], cpo[5], sg[5], pcs[5]; bool val[5];
#pragma unroll
                for (int u = 0; u < 5; ++u) {
                    const int idx = base + u * gthreads; val[u] = idx < NIT; const int id2 = val[u] ? idx : 0;
                    const int m = id2 / 144, jp = id2 - m * 144, seg = jp < 32 ? 0 : (jp < 64 ? 1 : 2);
                    const int j = (jp - (seg == 0 ? 0 : (seg == 1 ? 32 : 64))) * 2, pc = (seg == 0 ? 3072 : (seg == 1 ? 3136 : 3200)) + j;
                    mm[u] = m; sg[u] = seg; cpo[u] = seg * 256 + j; pcs[u] = pc;
                    const int mprev = (m >= MPR || (m & (TT - 1)) == 0) ? m : m - 1;
                    cv[u] = *(const unsigned*)(Proj + (size_t)m * PJP + PW + pc);
                    pv[u] = *(const unsigned*)(Proj + (size_t)mprev * PJP + PW + pc);
                    mu[u] = *(const f32x2*)(mu_shift + pc);
                }
#pragma unroll
                for (int u = 0; u < 5; ++u) {
                    const int m = mm[u]; const float cx = bf2f(cv[u] & 0xffffu), cy = bf2f(cv[u] >> 16);
                    const float fm = (m & (TT - 1)) == 0 ? 0.f : 1.f;
                    float px = bf2f(pv[u] & 0xffffu) * fm, py = bf2f(pv[u] >> 16) * fm;
                    if (m >= MPR) { const f32x2 p = *(const f32x2*)(state_shift + (size_t)(m - MPR) * SW + pcs[u]); px = p[0]; py = p[1]; }
                    float vx = cx + (px - cx) * mu[u][0], vy = cy + (py - cy) * mu[u][1];
                    if (sg[u] == 0) { vx = tanhf(vx); vy = tanhf(vy); } else if (sg[u] == 2) { vx = sigmoidf_(vx); vy = sigmoidf_(vy); }
                    if (val[u]) *(unsigned*)(Xb + (size_t)m * XLD + 1024 + cpo[u]) = pk_bf16(vx, vy);
                }
            }
        }
        for (int i = gtid; i < 4 * SW; i += gthreads) { const int b = i / SW, j = i - b * SW; out[OUT_SHIFTP + i] = bf2f(Proj[(size_t)(b * TT + TT - 1) * PJP + PW + j]); }
        for (int i = gtid; i < MSA * SW / 2; i += gthreads) { const int b = i / (SW / 2), j = (i - b * (SW / 2)) * 2; const unsigned v = *(const unsigned*)(Proj + (size_t)(MPR + b) * PJP + PW + j);
            *(f32x2*)(out + OUT_SHIFTS + (size_t)b * SW + j) = (f32x2){bf2f(v & 0xffffu), bf2f(v >> 16)}; }
        for (int i = gtid; i < 4 * 15 * PW; i += gthreads) { const int b = i / (15 * PW), r = i - b * 15 * PW, j = r / PW, c = r - j * PW; out[OUT_POOLP + i] = bf2f(Proj[(size_t)(b * TT + TT - 15 + j) * PJP + c]); }
    }
    SEAM();

    if (IN(3)) {
        PHASE_IDS
        { pg8::Gemm g{Xb, WpoolT, XLD, 256, 256}; pg8::P3Order S{G, bid};
          EpiP3 E{Mix, Dec, Ab, Gb, pool_scale, w0, a0}; pg8::gemm_phase(lds, g, S, E); }
    }
    SEAM();

    if (IN(4)) {
        PHASE_IDS
        LAS float* ldf = (LAS float*)lds;
        constexpr int REC = 392, TB = 32, NPS = TB / 4;
        for (int unit = bid; unit < 256; unit += G) {
            const int s = unit >> 2, b = s >> 4, h = s & 15, q = unit & 3;
            const int wv = __builtin_amdgcn_readfirstlane(tid >> 6);
            if (wv < 2) {
              const int crow = wv * 8 + (lane >> 3), kq = lane & 7; const bool first8 = kq == 0;
              f32x2 S2[4];
#pragma unroll
              for (int e = 0; e < 4; ++e) S2[e] = (f32x2){0.f, 0.f};
              const LAS float* recq0 = ldf + kq * 8; const LAS float* recv0 = ldf + 320 + q * 16 + crow;
              float* yp = Yb + (size_t)(b * TT + 7 - kq) * CW + h * 64 + q * 16 + crow;
              __builtin_amdgcn_s_setprio(3);
              WG_BAR();
              for (int blk = 0; blk < TT / TB; ++blk) {
                    const int bo = (blk & 1) * (TB * REC);
                    const LAS float* recq = recq0 + bo; const LAS float* recv = recv0 + bo; const LAS float* recs = ldf + bo + 384;
#define LDSTEP(o_, A0, A1, B0, B1, D0, D1, K0, K1, W0, W1, VV, SC) do { A0 = *(const LAS f32x4*)(recq + (o_)); A1 = *(const LAS f32x4*)(recq + (o_) + 4); B0 = *(const LAS f32x4*)(recq + (o_) + 64); B1 = *(const LAS f32x4*)(recq + (o_) + 68); \
                        D0 = *(const LAS f32x4*)(recq + (o_) + 128); D1 = *(const LAS f32x4*)(recq + (o_) + 132); K0 = *(const LAS f32x4*)(recq + (o_) + 192); K1 = *(const LAS f32x4*)(recq + (o_) + 196); \
                        W0 = *(const LAS f32x4*)(recq + (o_) + 256); W1 = *(const LAS f32x4*)(recq + (o_) + 260); VV = recv[(o_)]; SC = *(const LAS f32x2*)(recs + (o_)); } while (0)
                    f32x4 av0, av1, bv0, bv1, dw0, dw1, kt0, kt1, wr0, wr1; float vv; f32x2 sc;
                    f32x4 nav0, nav1, nbv0, nbv1, ndw0, ndw1, nkt0, nkt1, nwr0, nwr1; float nvv; f32x2 nsc;
                    f32x4 a0, a1, b0, b1, d0, d1, k0, k1, w0_, w1_; float vv_; f32x2 sc_;
                    LDSTEP(0, a0, a1, b0, b1, d0, d1, k0, k1, w0_, w1_, vv_, sc_);
                    LDSTEP(REC, av0, av1, bv0, bv1, dw0, dw1, kt0, kt1, wr0, wr1, vv, sc);
                    float yacc = 0.f;
#pragma unroll
                    for (int st = 0; st < TB; ++st) {
                        if (st + 2 < TB) LDSTEP((st + 2) * REC, nav0, nav1, nbv0, nbv1, ndw0, ndw1, nkt0, nkt1, nwr0, nwr1, nvv, nsc);
                        __builtin_amdgcn_sched_barrier(0);
                        const f32x2 pa = pkfma_(S2[3], hi2(a1), pkfma_(S2[2], lo2(a1), pkfma_(S2[1], hi2(a0), pkmul_(S2[0], lo2(a0)))));
                        const f32x2 py = pkfma_(S2[3], hi2(w1_), pkfma_(S2[2], lo2(w1_), pkfma_(S2[1], hi2(w0_), pkmul_(S2[0], lo2(w0_)))));
                        float da = pa[0] + pa[1], dy = py[0] + py[1];
                        da = red8(da); dy = red8(dy);
                        const float y = dy + da * sc_[0] + vv_ * sc_[1];
                        { f32x2 dab, vvb; dab[0] = da; dab[1] = da; vvb[0] = vv_; vvb[1] = vv_;
                          S2[0] = pkfma_b(lo2(k0), vvb, pkfma_b(lo2(b0), dab, pkmul_(S2[0], lo2(d0)))); S2[1] = pkfma_b(hi2(k0), vvb, pkfma_b(hi2(b0), dab, pkmul_(S2[1], hi2(d0))));
                          S2[2] = pkfma_b(lo2(k1), vvb, pkfma_b(lo2(b1), dab, pkmul_(S2[2], lo2(d1)))); S2[3] = pkfma_b(hi2(k1), vvb, pkfma_b(hi2(b1), dab, pkmul_(S2[3], hi2(d1)))); }
                        const float sh = __int_as_float(__builtin_amdgcn_update_dpp(__float_as_int(y), __float_as_int(yacc), 0x111, 0xF, 0xF, false));
                        yacc = first8 ? y : sh;
                        if ((st & 7) == 7) yp[(size_t)(blk * TB + (st - 7)) * CW] = yacc;
                        a0 = av0; a1 = av1; b0 = bv0; b1 = bv1; d0 = dw0; d1 = dw1; k0 = kt0; k1 = kt1; w0_ = wr0; w1_ = wr1; vv_ = vv; sc_ = sc;
                        av0 = nav0; av1 = nav1; bv0 = nbv0; bv1 = nbv1; dw0 = ndw0; dw1 = ndw1; kt0 = nkt0; kt1 = nkt1; wr0 = nwr0; wr1 = nwr1; vv = nvv; sc = nsc;
                        asm volatile("" ::: "memory");
                    }
#undef LDSTEP
                    WG_BAR();
              }
              __builtin_amdgcn_s_setprio(0);
              float* so = out + OUT_WKVP + ((size_t)(b * NH + h) * 64 + q * 16 + crow) * 64 + kq * 8;
              *(f32x4*)so = (f32x4){S2[0][0], S2[0][1], S2[1][0], S2[1][1]}; *(f32x4*)(so + 4) = (f32x4){S2[2][0], S2[2][1], S2[3][0], S2[3][1]};
            } else if (wv == 4 || wv == 5) {
              constexpr int CT_PER = 5632, CT_ALL = 3 * CT_PER + 2048;
              float cvv[32]; int ctile = unit * 2 + (wv - 4), cph = 0;
#define CONV_LOAD16(P0_) do { if (ctile < CT_ALL) { const int m_ = ctile / CT_PER, r_ = ctile - m_ * CT_PER; const float* sp_; unsigned ld_; \
                    if (m_ < 2) { sp_ = (m_ == 0 ? w_gate : w_up) + (size_t)((r_ / 88) * 32) * DFF + (r_ % 88) * 64; ld_ = DFF; } \
                    else { sp_ = (m_ == 2 ? w_down : w_out) + (size_t)((r_ >> 5) * 32) * D + (r_ & 31) * 64; ld_ = D; } \
                    _Pragma("unroll") for (int j_ = (P0_); j_ < (P0_) + 16; ++j_) cvv[j_] = sp_[(unsigned)j_ * ld_ + lane]; } } while (0)
#define CONV_STORE() do { if (ctile < CT_ALL) { const int m_ = ctile / CT_PER, r_ = ctile - m_ * CT_PER; bf16_t* dp_; \
                    if (m_ < 2) { const int k0_ = (r_ / 88) * 32, n_ = (r_ % 88) * 64 + lane; dp_ = WguT + (size_t)((n_ >> 7) * 256 + (m_ == 1 ? 128 : 0) + (n_ & 127)) * D + k0_; } \
                    else { const int k0_ = (r_ >> 5) * 32, n_ = (r_ & 31) * 64 + lane; dp_ = m_ == 2 ? WdnT + (size_t)n_ * DFF + k0_ : WoutT + (size_t)n_ * D + k0_; } \
                    _Pragma("unroll") for (int q8_ = 0; q8_ < 4; ++q8_) { u32x4 w_; w_.x = pk_bf16(cvv[q8_ * 8 + 0], cvv[q8_ * 8 + 1]); w_.y = pk_bf16(cvv[q8_ * 8 + 2], cvv[q8_ * 8 + 3]); \
                        w_.z = pk_bf16(cvv[q8_ * 8 + 4], cvv[q8_ * 8 + 5]); w_.w = pk_bf16(cvv[q8_ * 8 + 6], cvv[q8_ * 8 + 7]); *(u32x4*)(dp_ + q8_ * 8) = w_; } \
                    ctile += 512; } } while (0)
              WG_BAR();
              for (int blk = 0; blk < TT / TB; ++blk) {
#pragma unroll
                for (int tk = 0; tk < 2; ++tk) {
                  if (cph == 0) CONV_LOAD16(0); else if (cph == 1) CONV_LOAD16(16); else CONV_STORE();
                  cph = cph == 2 ? 0 : cph + 1;
                }
                WG_BAR();
              }
              while (ctile < CT_ALL) {
                if (cph <= 0) CONV_LOAD16(0);
                if (cph <= 1) CONV_LOAD16(16);
                CONV_STORE(); cph = 0;
              }
#undef CONV_LOAD16
#undef CONV_STORE
            } else {
              const int pw = (wv & 1) + ((wv >> 2) << 1), ch = h * 64 + lane;
              const float c_kk = k_k[ch], c_ka = k_a[ch], c_rk = r_k[ch], mu_r = mu_shift[ch], mu_k = mu_shift[CW + ch], mu_v = mu_shift[2 * CW + ch];
              const bf16_t* pbase = Proj + (size_t)(b * TT) * PJP + PW + h * 64; const float* dbase = Dec + (size_t)(b * TT) * CW + h * 64; const bf16_t* abase = Ab + (size_t)(b * TT) * CW + h * 64;
              constexpr int PD = 2;
              unsigned short rr[PD][NPS + 1], kr_[PD][NPS + 1], vr[PD][NPS + 1], aa[PD][NPS]; float dd[PD][NPS];
#define SCAN_LOAD(blk, SET) do { const int t0_ = (blk) * TB + pw * NPS; \
            _Pragma("unroll") for (int i_ = 0; i_ < NPS + 1; ++i_) { const unsigned t_ = (unsigned)((i_ == 0 && t0_ == 0) ? 0 : t0_ - 1 + i_); const bf16_t* pp_ = pbase + t_ * (unsigned)PJP; \
                rr[SET][i_] = pp_[lane]; kr_[SET][i_] = pp_[CW + lane]; vr[SET][i_] = pp_[2 * CW + lane]; } \
            _Pragma("unroll") for (int i_ = 0; i_ < NPS; ++i_) { const unsigned mi_ = (unsigned)(t0_ + i_) * (unsigned)CW; dd[SET][i_] = dbase[mi_ + lane]; aa[SET][i_] = abase[mi_ + lane]; } } while (0)
#define SCAN_PRODUCE(blk, SET) do { LAS float* bufp_ = ldf + ((blk) & 1) * (TB * REC); const int t0_ = (blk) * TB + pw * NPS; \
            _Pragma("unroll") for (int i_ = 0; i_ < NPS; ++i_) { \
                const float zz_ = (i_ == 0 && t0_ == 0) ? 0.f : 1.f; \
                const float rc_ = bf2f(rr[SET][i_ + 1]), kc_ = bf2f(kr_[SET][i_ + 1]), vc_ = bf2f(vr[SET][i_ + 1]), rp_ = bf2f(rr[SET][i_]) * zz_, kp_ = bf2f(kr_[SET][i_]) * zz_, vp_ = bf2f(vr[SET][i_]) * zz_; \
                const float r_ = rc_ + (rp_ - rc_) * mu_r, k_ = kc_ + (kp_ - kc_) * mu_k, v_ = vc_ + (vp_ - vc_) * mu_v; \
                const float a_ = bf2f(aa[SET][i_]), d_ = dd[SET][i_]; \
                const float kkr_ = k_ * c_kk; const float n2_ = wsum(kkr_ * kkr_); const float kk_ = kkr_ * rsqrtf(fmaxf(n2_, 1e-24f)); \
                const float kt_ = k_ * (1.0f + (a_ - 1.0f) * c_ka); const float bv_ = kk_ * a_; \
                const float br_ = wsum(bv_ * r_), krs_ = wsum(kt_ * r_), bon_ = wsum(r_ * kt_ * c_rk); \
                LAS float* rec_ = bufp_ + (pw * NPS + i_) * REC; \
                rec_[lane] = -kk_; rec_[64 + lane] = bv_; rec_[128 + lane] = d_; rec_[192 + lane] = kt_; rec_[256 + lane] = d_ * r_; rec_[320 + lane] = v_; \
                if (lane == 0) { rec_[384] = br_; rec_[385] = krs_; if (q == 0) Bonus[(size_t)(b * TT + t0_ + i_) * NH + h] = bon_; } } } while (0)
              SCAN_LOAD(0, 0); SCAN_LOAD(1, 1);
              SCAN_PRODUCE(0, 0); SCAN_LOAD(2, 0);
              WG_BAR();
              static_assert((TT / TB) % PD == 0 && PD == 2, "block loop is unrolled by PD = 2");
              for (int blk0 = 0; blk0 < TT / TB; blk0 += PD) {
#define SCAN_ITER(D_, SET) do { const int blk = blk0 + (D_); if (blk + 1 < TT / TB) { SCAN_PRODUCE(blk + 1, SET); if (blk + 1 + PD < TT / TB) SCAN_LOAD(blk + 1 + PD, SET); } WG_BAR(); } while (0)
                SCAN_ITER(0, 1); SCAN_ITER(1, 0);
#undef SCAN_ITER
              }
            }
#undef SCAN_LOAD
#undef SCAN_PRODUCE
        }
        __syncthreads();
        LAS float* wl = ldf + wave * 512;
        for (int p = gwave; p < MSA * NH; p += gwaves) {
            const int b = p >> 4, h = p & 15, m = MPR + b, ch = h * 64 + lane;
            const bf16_t* pp = Proj + (size_t)m * PJP + PW + ch; const float* sp = state_shift + (size_t)b * SW + ch;
            const float rc = bf2f(pp[0]), kc = bf2f(pp[CW]), vc = bf2f(pp[2 * CW]);
            const float r = rc + (sp[0] - rc) * mu_shift[ch], k = kc + (sp[CW] - kc) * mu_shift[CW + ch], v = vc + (sp[2 * CW] - vc) * mu_shift[2 * CW + ch];
            const float d = Dec[(size_t)m * CW + ch], a = bf2f(Ab[(size_t)m * CW + ch]);
            const float kkr = k * k_k[ch]; const float n2 = wsum(kkr * kkr); const float kk = kkr * rsqrtf(fmaxf(n2, 1e-24f));
            const float kt = k * (1.0f + (a - 1.0f) * k_a[ch]);
            const float bon = wsum(r * kt * r_k[ch]);
            wl[lane] = -kk; wl[64 + lane] = kk * a; wl[128 + lane] = d; wl[192 + lane] = kt; wl[256 + lane] = r; wl[320 + lane] = v;
            asm volatile("s_waitcnt lgkmcnt(0)" ::: "memory");
            const int kq = lane & 15, r4 = lane >> 4;
            const f32x4 av = *(const LAS f32x4*)(wl + kq * 4), bv = *(const LAS f32x4*)(wl + 64 + kq * 4), dw = *(const LAS f32x4*)(wl + 128 + kq * 4);
            const f32x4 ktv = *(const LAS f32x4*)(wl + 192 + kq * 4), rv = *(const LAS f32x4*)(wl + 256 + kq * 4);
            const float* sin_ = state_wkv + (size_t)(b * NH + h) * 4096; float* sout = out + OUT_WKVS + (size_t)(b * NH + h) * 4096;
            f32x4 Sall[16];
#pragma unroll
            for (int j = 0; j < 16; ++j) Sall[j] = *(const f32x4*)(sin_ + (r4 + 4 * j) * 64 + kq * 4);
            const float gnw_ = gn_w[ch], gnb_ = gn_b[ch], gate_ = bf2f(Gb[(size_t)m * CW + ch]);
#pragma unroll
            for (int j = 0; j < 16; ++j) {
                const int row = r4 + 4 * j; f32x4 Sv = Sall[j];
                float da = (Sv[0] * av[0] + Sv[1] * av[1]) + (Sv[2] * av[2] + Sv[3] * av[3]); da = red16(da);
                const float vv = wl[320 + row];
                Sv = Sv * dw + da * bv + vv * ktv;
                *(f32x4*)(sout + row * 64 + kq * 4) = Sv;
                float dy = (Sv[0] * rv[0] + Sv[1] * rv[1]) + (Sv[2] * rv[2] + Sv[3] * rv[3]); dy = red16(dy);
                if (kq == 0) wl[384 + row] = dy;
            }
            asm volatile("s_waitcnt lgkmcnt(0)" ::: "memory");
            const float y = wl[384 + lane];
            const float mean = wsum(y) * (1.0f / 64.0f); const float dl = y - mean; const float var = wsum(dl * dl) * (1.0f / 64.0f);
            const float yn = dl * rsqrtf(var + GN_EPS) * gnw_ + gnb_;
            const float o = (yn + bon * v) * gate_;
            Mix[(size_t)m * D + PW + ch] = (bf16_t)f2bf(o);
            asm volatile("s_waitcnt lgkmcnt(0)" ::: "memory");
        }
    }
    SEAM();

    if (IN(5)) {
        PHASE_IDS
        { pg8::Gemm g{Mix, WoutT, D, D, 256}; pg8::SplitKOrder S{8, KS6, 32, 256, G, (bid + G - 192 % G) % G};
          EpiPartial E{Part6}; pg8::gemm_phase(lds, g, S, E); }
        {
            const int half = gwave & 1, ch0 = half * 512 + lane * 8, h = ch0 >> 6;
            const f32x4 mu0 = *(const f32x4*)(mu_shift + 2 * CW + ch0), mu1 = *(const f32x4*)(mu_shift + 2 * CW + ch0 + 4);
            const f32x4 gw0 = *(const f32x4*)(gn_w + ch0), gw1 = *(const f32x4*)(gn_w + ch0 + 4), gb0 = *(const f32x4*)(gn_b + ch0), gb1 = *(const f32x4*)(gn_b + ch0 + 4);
            for (int it0 = gwave; it0 < MPR * 2; it0 += 4 * gwaves) {
                f32x4 y0[4], y1[4]; u32x4 vc[4], vp[4], gt[4]; float bon[4]; int mm[4]; bool val[4];
#pragma unroll
                for (int u = 0; u < 4; ++u) {
                    const int it = it0 + u * gwaves; val[u] = it < MPR * 2; const int m = val[u] ? (it >> 1) : 0; mm[u] = m;
                    const int mprev = (m & (TT - 1)) ? m - 1 : m;
                    y0[u] = *(const f32x4*)(Yb + (size_t)m * CW + ch0); y1[u] = *(const f32x4*)(Yb + (size_t)m * CW + ch0 + 4);
                    vc[u] = *(const u32x4*)(Proj + (size_t)m * PJP + PW + 2 * CW + ch0); vp[u] = *(const u32x4*)(Proj + (size_t)mprev * PJP + PW + 2 * CW + ch0);
                    gt[u] = *(const u32x4*)(Gb + (size_t)m * CW + ch0); bon[u] = Bonus[(size_t)m * NH + h];
                }
#pragma unroll
                for (int u = 0; u < 4; ++u) {
                    const int m = mm[u]; const float fm = (m & (TT - 1)) == 0 ? 0.f : 1.f;
                    float y[8] = {y0[u][0], y0[u][1], y0[u][2], y0[u][3], y1[u][0], y1[u][1], y1[u][2], y1[u][3]};
                    float s = ((y[0] + y[1]) + (y[2] + y[3])) + ((y[4] + y[5]) + (y[6] + y[7])); s = red8(s);
                    const float mean = s * (1.0f / 64.0f); float q2 = 0.f;
#pragma unroll
                    for (int j = 0; j < 8; ++j) { y[j] -= mean; q2 += y[j] * y[j]; }
                    q2 = red8(q2); const float rstd = rsqrtf(q2 * (1.0f / 64.0f) + GN_EPS);
                    unsigned ow[4];
#pragma unroll
                    for (int j2 = 0; j2 < 4; ++j2) {
                        float o2[2];
#pragma unroll
                        for (int e = 0; e < 2; ++e) {
                            const int j = j2 * 2 + e; const unsigned cw = vc[u][j2], pw_ = vp[u][j2], gw_ = gt[u][j2];
                            const float c_ = e ? bf2f(cw >> 16) : bf2f(cw & 0xffffu), p_ = fm * (e ? bf2f(pw_ >> 16) : bf2f(pw_ & 0xffffu)), g_ = e ? bf2f(gw_ >> 16) : bf2f(gw_ & 0xffffu);
                            const float mu_ = j < 4 ? mu0[j & 3] : mu1[j & 3], gnw = j < 4 ? gw0[j & 3] : gw1[j & 3], gnb = j < 4 ? gb0[j & 3] : gb1[j & 3];
                            const float v = c_ + (p_ - c_) * mu_;
                            o2[e] = (y[j] * rstd * gnw + gnb + bon[u] * v) * g_;
                        }
                        ow[j2] = pk_bf16(o2[0], o2[1]);
                    }
                    if (val[u]) *(u32x4*)(Mix + (size_t)m * D + PW + ch0) = (u32x4){ow[0], ow[1], ow[2], ow[3]};
                }
            }
        }
    }
    SEAM();

    if (IN(6)) {
        PHASE_IDS
        pg8::Gemm g{Mix, WoutT, D, D, D}; pg8::StaticOrder S; S.init(MPR, D, G, bid);
        EpiOut E{x_prompt, x_sample, out, H2, norm_ffn, rowsq1};
        pg8::gemm_phase(lds, g, S, E);
        for (int it = gwave; it < MSA * 8; it += gwaves) {
            const int r = it >> 3, c = ((it & 7) * 64 + lane) * 4, row = MPR + r;
            f32x4 x1 = *(const f32x4*)(x_sample + (size_t)r * D + c); f32x4 pp[KS6];
#pragma unroll
            for (int ks = 0; ks < KS6; ++ks) pp[ks] = *(const f32x4*)(Part6 + ((size_t)ks * MSA + r) * D + c);
            const f32x4 gv = *(const f32x4*)(norm_ffn + c);
#pragma unroll
            for (int ks = 0; ks < KS6; ++ks) x1 = x1 + pp[ks];
            *(f32x4*)(out + (size_t)row * D + c) = x1;
            const f32x4 hv = x1 * gv; u32x2 w; w.x = pk_bf16(hv[0], hv[1]); w.y = pk_bf16(hv[2], hv[3]); *(u32x2*)(H2 + (size_t)row * D + c) = w;
            const float sq = wsum((x1[0] * x1[0] + x1[1] * x1[1]) + (x1[2] * x1[2] + x1[3] * x1[3]));
            if (lane == 0) unsafeAtomicAdd(rowsq1 + row, sq);
        }
    }
    SEAM();

    if (IN(7)) {
        PHASE_IDS
        pg8::Gemm g{H2, WguT, D, D, D}; pg8::StaticOrder S; S.init(MPAD, 2 * DFF, G, bid);
        EpiGU E{Ub, rowsq1};
        pg8::gemm_phase(lds, g, S, E);
    }
    SEAM();

    if (IN(8)) {
        PHASE_IDS
        if (G == 256) { pg8::Gemm g{Ub, WdnT, DFF, DFF, DFF}; pg8::StaticOrder S; S.init(MPR, D, G, bid);
          EpiDownNorm E{out, rowsq2, pcnt, norm_final}; pg8::gemm_phase(lds, g, S, E); }
        else { pg8::Gemm g{Ub, WdnT, DFF, DFF, DFF}; pg8::StaticOrder S; S.init(MPR, D, G, bid);
          EpiDown E{out}; pg8::gemm_phase(lds, g, S, E); }
        { pg8::Gemm g{Ub, WdnT, DFF, DFF, 512}; pg8::SplitKOrder S{8, KS8, 32, 512, G, bid};
          EpiPartial E{Part8}; pg8::gemm_phase(lds, g, S, E); }
    }
    SEAM();

    if (IN(9)) {
        PHASE_IDS
        for (int row = (G == 256 ? MPR : 0) + gwave; row < MV; row += gwaves) {
            float* p = out + (size_t)row * D; f32x4 v[8]; float s = 0.f;
#pragma unroll
            for (int i = 0; i < 8; ++i) v[i] = *(const f32x4*)(p + (i * 64 + lane) * 4);
            if (row >= MPR) {
#pragma unroll
                for (int i = 0; i < 8; ++i)
#pragma unroll
                    for (int ks = 0; ks < KS8; ++ks) v[i] = v[i] + *(const f32x4*)(Part8 + ((size_t)ks * MSA + (row - MPR)) * D + (i * 64 + lane) * 4);
            }
#pragma unroll
            for (int i = 0; i < 8; ++i) s += (v[i][0] * v[i][0] + v[i][1] * v[i][1]) + (v[i][2] * v[i][2] + v[i][3] * v[i][3]);
            s = wsum(s); const float rstd = rsqrtf(s * (1.0f / D) + RMS_EPS);
#pragma unroll
            for (int i = 0; i < 8; ++i) { const int c = (i * 64 + lane) * 4; *(f32x4*)(p + c) = v[i] * rstd * *(const f32x4*)(norm_final + c); }
        }
    }
#undef IN
#undef SEAM
}

#ifndef HY_MULTI
#define HY_MULTI 0
#endif
#ifndef HY_REP
#define HY_REP 0
#endif
extern "C" void kernel_launch(void* const* d_in, const int* in_sizes, int n_in, void* d_out, int out_size, void* d_ws, size_t ws_size, hipStream_t stream) {
    static int grid = 0;
    if (grid == 0) {
        if (n_in != 26 || ws_size < WS_END) { fprintf(stderr, "kernel_launch: need 26 inputs and >= %zu bytes of workspace (got %d, %zu)\n", (size_t)WS_END, n_in, ws_size); grid = -1; return; }
        int dev = 0, cus = 0, per_cu = 0;
        hipGetDevice(&dev); hipDeviceGetAttribute(&cus, hipDeviceAttributeMultiprocessorCount, dev);
        if (hipFuncSetAttribute((const void*)hymba_fwd, hipFuncAttributeMaxDynamicSharedMemorySize, LDS_BYTES) != hipSuccess) { fprintf(stderr, "kernel_launch: hipFuncSetAttribute failed\n"); grid = -1; return; }
        if (hipOccupancyMaxActiveBlocksPerMultiprocessor(&per_cu, (const void*)hymba_fwd, NTHR, LDS_BYTES) != hipSuccess || per_cu < 1) { fprintf(stderr, "kernel_launch: occupancy query says %d\n", per_cu); per_cu = 1; }
        (void)hipGetLastError();
        grid = cus;
        if (grid > 256) grid = 256;
    }
    if (grid < 0) return;
    Params p{};
    for (int i = 0; i < 26; ++i) p.in[i] = (const float*)d_in[i];
    p.out = (float*)d_out; p.ws = (unsigned char*)d_ws;
#if HY_MULTI
    p.multi = 1;
    for (int ph = 0; ph < 10; ++ph) { p.phase = ph; for (int r = 0; r < ((HY_REP >> ph) & 1) + 1; ++r) hipLaunchKernelGGL(hymba_fwd, dim3(grid), dim3(NTHR), LDS_BYTES, stream, p); }
#else
    p.multi = 0; p.phase = 0;
    hipMemsetAsync((char*)d_ws + WS_BAR, 0, 16384 + 8192, stream);
    void* args[] = {&p};
    hipError_t e = hipLaunchCooperativeKernel((const void*)hymba_fwd, dim3(grid), dim3(NTHR), args, LDS_BYTES, stream);
    if (e != hipSuccess) fprintf(stderr, "cooperative launch failed: %s (grid %d)\n", hipGetErrorString(e), grid);
#endif
}
```

```cpp
#include <hip/hip_runtime.h>
#include <hip/hip_cooperative_groups.h>
#include <cstdio>
namespace cg = cooperative_groups;

#define LAS __attribute__((address_space(3)))
typedef unsigned short bf16_t;
typedef short bf16x8 __attribute__((ext_vector_type(8)));
typedef float f32x4 __attribute__((ext_vector_type(4)));
typedef float f32x2 __attribute__((ext_vector_type(2)));
typedef unsigned u32x4 __attribute__((ext_vector_type(4)));
typedef unsigned u32x2 __attribute__((ext_vector_type(2)));

constexpr int D = 2048, TT = 2048, MPR = 8192, MSA = 128, MV = 8320, MPAD = 8448;
constexpr int PW = 1024, SW = 3360, PJ = 4384, PJP = 4608, DFF = 5632, CW = 1024, NH = 16;
constexpr int NTHR = 512, LDS_BYTES = 131072 + 16, LDS_ST_OFF = 131072;
constexpr float RMS_EPS = 1e-6f, GN_EPS = 64e-5f;

constexpr size_t WS_WIN = 0;
constexpr size_t WS_WOUT = WS_WIN + (size_t)PJP * D * 2;
constexpr size_t WS_WGU = WS_WOUT + (size_t)D * D * 2;
constexpr size_t WS_WDN = WS_WGU + (size_t)2 * DFF * D * 2;
constexpr size_t WS_WPOOL = WS_WDN + (size_t)D * DFF * 2;
constexpr size_t WS_WLORA = WS_WPOOL + (size_t)4 * 256 * 256 * 2;
constexpr size_t WS_R1 = WS_WLORA + (size_t)3 * 1024 * 256 * 2;
constexpr size_t WS_PROJ = WS_R1 + (size_t)MPAD * D * 2;
constexpr size_t WS_A = WS_PROJ + (size_t)MPAD * PJP * 2;
constexpr size_t WS_GATE = WS_A + (size_t)MPAD * CW * 2;
constexpr size_t WS_MIX = WS_GATE + (size_t)MPAD * CW * 2;
constexpr size_t WS_ROWSQ = WS_MIX + (size_t)MPAD * D * 2;
constexpr size_t WS_BONUS = WS_ROWSQ + (size_t)2 * MPAD * 4;
constexpr size_t WS_BAR = WS_BONUS + (size_t)MV * NH * 4;
constexpr size_t WS_PCNT = WS_BAR + 16384;
constexpr size_t WS_RANK = WS_PCNT + 8192;
constexpr size_t WS_END = WS_RANK + 4096;
static_assert((size_t)MPAD * DFF * 2 <= (WS_MIX - WS_PROJ), "U must fit in proj+a+gate");
constexpr int XLD = 1792;
static_assert((size_t)MPAD * XLD * 2 <= (size_t)MPAD * D * 2, "X fits in WS_R1");
constexpr int KS6 = 8, KS8 = 11;
static_assert((size_t)KS6 * MSA * D * 4 <= (size_t)MPAD * CW * 2 && (size_t)KS8 * MSA * D * 4 <= (size_t)MPAD * D * 2, "partial buffers alias WS_A / WS_R1");

constexpr size_t OUT_Y = 0;
constexpr size_t OUT_POOLP = (size_t)MV * D;
constexpr size_t OUT_SHIFTP = OUT_POOLP + (size_t)4 * 15 * PW;
constexpr size_t OUT_WKVP = OUT_SHIFTP + (size_t)4 * SW;
constexpr size_t OUT_POOLS = OUT_WKVP + (size_t)4 * NH * 64 * 64;
constexpr size_t OUT_SHIFTS = OUT_POOLS + (size_t)MSA * 15 * PW;
constexpr size_t OUT_WKVS = OUT_SHIFTS + (size_t)MSA * SW;
constexpr size_t SCR_Y = 0;
constexpr size_t SCR_DEC = (size_t)MPR * CW;
static_assert(SCR_DEC + (size_t)MV * CW <= OUT_POOLP, "scratch must fit in the y region");

struct Params { const float* in[26]; float* out; unsigned char* ws; int multi; int phase; };

__device__ __forceinline__ float bf2f(unsigned b) { return __uint_as_float(b << 16); }
__device__ __forceinline__ unsigned f2bf(float f) { unsigned u = __float_as_uint(f); u += 0x7FFFu + ((u >> 16) & 1u); return u >> 16; }
__device__ __forceinline__ unsigned pk_bf16(float lo, float hi) { unsigned r; asm volatile("v_cvt_pk_bf16_f32 %0, %1, %2" : "=v"(r) : "v"(lo), "v"(hi)); return r; }
template <int CTRL> __device__ __forceinline__ float dpp(float x) { return __int_as_float(__builtin_amdgcn_update_dpp(0, __float_as_int(x), CTRL, 0xF, 0xF, true)); }
__device__ __forceinline__ float red16(float x) {
    x += dpp<0x128>(x); x += dpp<0x124>(x); x += dpp<0x4E>(x); x += dpp<0xB1>(x); return x;
}
__device__ __forceinline__ float wsum(float x) {
    x = red16(x);
    x += __int_as_float(__builtin_amdgcn_update_dpp(0, __float_as_int(x), 0x142, 0xA, 0xF, false));
    x += __int_as_float(__builtin_amdgcn_update_dpp(0, __float_as_int(x), 0x143, 0xC, 0xF, false));
    return __int_as_float(__builtin_amdgcn_readlane(__float_as_int(x), 63));
}
__device__ __forceinline__ float fma_(float a, float b, float c) { float d; asm("v_fma_f32 %0, %1, %2, %3" : "=v"(d) : "v"(a), "v"(b), "v"(c)); return d; }
__device__ __forceinline__ f32x2 pkmul_(f32x2 a, f32x2 b) { f32x2 d; asm("v_pk_mul_f32 %0, %1, %2" : "=v"(d) : "v"(a), "v"(b)); return d; }
__device__ __forceinline__ f32x2 pkfma_(f32x2 a, f32x2 b, f32x2 c) { f32x2 d; asm("v_pk_fma_f32 %0, %1, %2, %3" : "=v"(d) : "v"(a), "v"(b), "v"(c)); return d; }
__device__ __forceinline__ f32x2 pkfma_b(f32x2 a, f32x2 s, f32x2 c) { f32x2 d; asm("v_pk_fma_f32 %0, %1, %2, %3 op_sel_hi:[1,0,1]" : "=v"(d) : "v"(a), "v"(s), "v"(c)); return d; }
__device__ __forceinline__ f32x2 lo2(f32x4 v) { return __builtin_shufflevector(v, v, 0, 1); }
__device__ __forceinline__ f32x2 hi2(f32x4 v) { return __builtin_shufflevector(v, v, 2, 3); }
__device__ __forceinline__ float mul_(float a, float b) { float d; asm("v_mul_f32 %0, %1, %2" : "=v"(d) : "v"(a), "v"(b)); return d; }
__device__ __forceinline__ float sigmoidf_(float x) { return __builtin_amdgcn_rcpf(1.0f + __expf(-x)); }

#define WG_BAR() do { asm volatile("s_waitcnt lgkmcnt(0)" ::: "memory"); __builtin_amdgcn_s_barrier(); asm volatile("" ::: "memory"); } while (0)

#define XB_TMO      128
#define XB_XCNT(j)  (256  + 64 * (j))
#define XB_XSUB(j)  (1280 + 64 * (j))
#define XB_XGEN(j)  (2304 + 64 * (j))
#define XB_TOP      3328
#define XB_TOPGEN   3392
#define XCD_BAR_WORDS 3456
#define XB_SPIN_CAP (1u << 18)

__device__ __forceinline__ unsigned xb_ld(unsigned* p)              { return __hip_atomic_load(p, __ATOMIC_RELAXED, __HIP_MEMORY_SCOPE_AGENT); }
__device__ __forceinline__ unsigned xb_add(unsigned* p, unsigned v) { return __hip_atomic_fetch_add(p, v, __ATOMIC_RELAXED, __HIP_MEMORY_SCOPE_AGENT); }
__device__ __forceinline__ unsigned xb_xcc_id() { return (unsigned)__builtin_amdgcn_s_getreg((3 << 11) | 20) & 0xFu; }
#define XB_SPIN(cond, bar) do { unsigned _sp = 0; while (cond) { __builtin_amdgcn_s_sleep(1); \
    if ((++_sp & 255u) == 0u) { if (xb_ld(&(bar)[XB_TMO])) break; if (_sp > XB_SPIN_CAP) { atomicAdd(&(bar)[XB_TMO], 1u); break; } } } } while (0)

struct XcdBarrier {
    unsigned* bar; unsigned x;
    volatile LAS unsigned* st;
};

__device__ __forceinline__ XcdBarrier xcd_barrier_post(unsigned* bar, volatile LAS unsigned* st) {
    XcdBarrier b; b.bar = bar; b.x = xb_xcc_id(); b.st = st;
    if (threadIdx.x == 0) (void)xb_add(&bar[XB_XCNT(b.x)], 1u);
    return b;
}
__device__ __forceinline__ void xcd_barrier_complete(unsigned* bar, unsigned x, unsigned& nloc, unsigned& nx) {
    const unsigned G = gridDim.x * gridDim.y * gridDim.z;
    unsigned sum, cnt, mine, sp = 0u;
    for (;;) {
        sum = 0u; cnt = 0u; mine = 0u;
#pragma unroll
        for (unsigned j = 0; j < 16; ++j) { const unsigned c = xb_ld(&bar[XB_XCNT(j)]); sum += c; cnt += (c > 0u) ? 1u : 0u; mine = (j == x) ? c : mine; }
        if (sum == G) break;
        __builtin_amdgcn_s_sleep(1);
        if ((++sp & 255u) == 0u) { if (xb_ld(&bar[XB_TMO])) break; if (sp > XB_SPIN_CAP) { atomicAdd(&bar[XB_TMO], 1u); break; } }
    }
    nloc = mine > 0u ? mine : 1u; nx = cnt > 0u ? cnt : 1u;
}

__device__ __forceinline__ void xcd_barrier(const XcdBarrier& b) {
    asm volatile("s_waitcnt vmcnt(0)" ::: "memory");
    __syncthreads();
    if (threadIdx.x == 0) {
        unsigned* bar = b.bar;
        __builtin_amdgcn_s_waitcnt(0);
        unsigned nloc = b.st[0], nx = b.st[1];
        if (nloc == 0u) { xcd_barrier_complete(bar, b.x, nloc, nx); b.st[0] = nloc; b.st[1] = nx; }
        const unsigned old = xb_add(&bar[XB_XSUB(b.x)], 1u);
        const unsigned gen = old / nloc;
        if (old + 1u == (gen + 1u) * nloc) {
            __builtin_amdgcn_fence(__ATOMIC_RELEASE, "agent");
            asm volatile("s_waitcnt vmcnt(0)" ::: "memory");
            const unsigned og = xb_add(&bar[XB_TOP], 1u);
            const unsigned tg = og / nx;
            if (og + 1u == (tg + 1u) * nx) xb_add(&bar[XB_TOPGEN], 1u);
            else XB_SPIN(xb_ld(&bar[XB_TOPGEN]) == tg, bar);
            __builtin_amdgcn_fence(__ATOMIC_ACQUIRE, "agent");
            xb_add(&bar[XB_XGEN(b.x)], 1u);
            asm volatile("s_waitcnt vmcnt(0)" ::: "memory");
        } else {
            XB_SPIN(xb_ld(&bar[XB_XGEN(b.x)]) == gen, bar);
            __builtin_amdgcn_fence(__ATOMIC_ACQUIRE, "agent");
            asm volatile("s_waitcnt vmcnt(0)" ::: "memory");
        }
    }
    __syncthreads();
}

__device__ __forceinline__ void grid_bar(unsigned* ctr, unsigned target) {
    asm volatile("s_waitcnt vmcnt(0) lgkmcnt(0)" ::: "memory");
    __syncthreads();
    if (threadIdx.x == 0) {
        __builtin_amdgcn_fence(__ATOMIC_RELEASE, "agent");
        asm volatile("s_waitcnt vmcnt(0)" ::: "memory");
        __hip_atomic_fetch_add(ctr, 1u, __ATOMIC_RELAXED, __HIP_MEMORY_SCOPE_AGENT);
        while (__hip_atomic_load(ctr, __ATOMIC_RELAXED, __HIP_MEMORY_SCOPE_AGENT) < target) __builtin_amdgcn_s_sleep(4);
        __builtin_amdgcn_fence(__ATOMIC_ACQUIRE, "agent");
        asm volatile("s_waitcnt vmcnt(0)" ::: "memory");
    }
    __syncthreads();
}

namespace pg8 {
constexpr int BM = 256, BK = 64, HALF = 128, HTB = HALF * BK * 2, NXCD = 8, WGM = 8;
__device__ __forceinline__ int lds_byte(int r, int c) { const int st = (r >> 4) * 2 + (c >> 5), rr = r & 15, cc = c & 31, ob = rr * 64 + cc * 2; return st * 1024 + (ob ^ (((ob >> 9) & 1) << 5)); }
__device__ __forceinline__ void stage_rc(int b, int& R, int& C) { const int st = b / 1024, sb = b % 1024, swz = sb ^ (((sb >> 9) & 1) << 5); R = (st >> 1) * 16 + swz / 64; C = (st & 1) * 32 + (swz % 64) / 2; }
__device__ __forceinline__ int perm32(int rho) { const int n = rho >> 4, i = rho & 15; return 8 * (i >> 2) + 4 * n + (i & 3); }
struct Unit { int pm, pn, ks, koffA, koffB; };
struct Gemm { const bf16_t* A; const bf16_t* Bt; int lda, ldb, K; };
struct StaticOrder {
    int nM, nN, nwg, G, c;
    __device__ void init(int M, int N, int G_, int c_) { nM = M / BM; nN = N / BM; nwg = nM * nN; G = G_; c = c_; }
    __device__ bool next(int i, Unit& u) const {
        const long L = (long)i * G + c; if (L >= nwg) return false;
        int wgid = (int)L; { const int q = nwg / NXCD, r = nwg % NXCD, xcd = wgid % NXCD, off = wgid / NXCD; wgid = (xcd < r ? xcd * (q + 1) : r * (q + 1) + (xcd - r) * q) + off; }
        const int nig = WGM * nN, gid = wgid / nig, fm = gid * WGM, gsz = (nM - fm) < WGM ? (nM - fm) : WGM;
        u.pm = fm + ((wgid % nig) % gsz); u.pn = (wgid % nig) / gsz; u.ks = 0; u.koffA = 0; u.koffB = 0; return true;
    }
};
struct SplitKOrder {
    int nN, nks, pm, kchunk, G, c;
    __device__ bool next(int i, Unit& u) const { const long L = (long)i * G + c; if (L >= (long)nN * nks) return false;
        u.pm = pm; u.pn = (int)(L % nN); u.ks = (int)(L / nN); u.koffA = u.ks * kchunk; u.koffB = u.koffA; return true; }
};

struct P3Order {
    int G, c;
    __device__ bool next(int i, Unit& u) const { const int L = i * G + c; if (L >= 16 * 33) return false;
        u.pn = L / 33; u.pm = L - u.pn * 33; u.ks = 0; u.koffB = 0; u.koffA = u.pn < 4 ? u.pn * 256 : 1024 + ((u.pn - 4) >> 2) * 256; return true; }
};
template <class Epi, class Sched>
__device__ __forceinline__ void gemm_phase(LAS unsigned char* lds, const Gemm g, const Sched& S, const Epi& E) {
    const int tid = threadIdx.x, wid = __builtin_amdgcn_readfirstlane(tid >> 6), lane = tid & 63, wr = wid >> 2, wc = wid & 3, fr = lane & 15, fq = lane >> 4;
    const int K = g.K, nt = K / BK;
    unsigned voffA[2], voffB[2];
#pragma unroll
    for (int i = 0; i < 2; ++i) { int R, C; stage_rc(tid * 16 + i * 8192, R, C); const int Rb = Epi::PERM ? ((R & ~31) + perm32(R & 31)) : R;
        voffA[i] = (unsigned)(R * g.lda + C) * 2u; voffB[i] = (unsigned)(Rb * g.ldb + C) * 2u; }
    const size_t kstep = (size_t)(BK * 2);
    const size_t hstepA = (size_t)HALF * g.lda * 2, hstepB = (size_t)HALF * g.ldb * 2;
    const size_t tstepA = 2 * hstepA, tstepB = 2 * hstepB;
    const unsigned ldsw = (unsigned)wid * 1024u;
    const int aoff = lds_byte(wr * 64 + fr, fq * 8), boff = lds_byte(wc * 32 + fr, fq * 8);
#define PG8_SA(b, h) (((b) * 2 + (h)) * HTB)
#define PG8_SB(b, h) ((4 + (b) * 2 + (h)) * HTB)
#define PG8_STAGE(bufoff, gbase, voff) do { _Pragma("unroll") for (int _i = 0; _i < 2; ++_i) \
        __builtin_amdgcn_global_load_lds((const unsigned*)((const char*)(gbase) + (voff)[_i]), (LAS unsigned*)(lds + (bufoff) + ldsw + _i * 8192), 16, 0, 0); } while (0)
#define PG8_LDA(dst, b, h) do { _Pragma("unroll") for (int m = 0; m < 4; ++m) _Pragma("unroll") for (int k = 0; k < 2; ++k) dst[m][k] = *(const LAS bf16x8*)(lds + PG8_SA(b, h) + aoff + m * 2048 + k * 1024); } while (0)
#define PG8_LDB(dst, b, h) do { _Pragma("unroll") for (int n = 0; n < 2; ++n) _Pragma("unroll") for (int k = 0; k < 2; ++k) dst[n][k] = *(const LAS bf16x8*)(lds + PG8_SB(b, h) + boff + n * 2048 + k * 1024); } while (0)
#define PG8_MMA(ai, bj, At, Bt) do { __builtin_amdgcn_s_setprio(1); _Pragma("unroll") for (int m = 0; m < 4; ++m) _Pragma("unroll") for (int n = 0; n < 2; ++n) _Pragma("unroll") for (int k = 0; k < 2; ++k) \
        acc[ai][bj][m][n] = __builtin_amdgcn_mfma_f32_16x16x32_bf16(Bt[n][k], At[m][k], acc[ai][bj][m][n], 0, 0, 0); __builtin_amdgcn_s_setprio(0); } while (0)
#define PG8_WAIT_V(n) asm volatile("s_waitcnt vmcnt(" #n ")" ::: "memory")
#define PG8_WAIT_L(n) asm volatile("s_waitcnt lgkmcnt(" #n ")" ::: "memory")
#define PG8_BAR __builtin_amdgcn_s_barrier()
#define PG8_SCHED __builtin_amdgcn_sched_barrier(0)
    Unit cur, nxt; int ui = 0;
    if (!S.next(0, cur)) return;
    f32x4 acc[2][2][4][2];
#pragma unroll
    for (int a = 0; a < 2; ++a)
#pragma unroll
        for (int b = 0; b < 2; ++b)
#pragma unroll
            for (int m = 0; m < 4; ++m)
#pragma unroll
                for (int n = 0; n < 2; ++n) acc[a][b][m][n] = (f32x4){0.f, 0.f, 0.f, 0.f};
    bf16x8 At[4][2], B0[2][2], B1[2][2];
    const char* cA = (const char*)g.A + (size_t)cur.pm * tstepA + (size_t)cur.koffA * 2; const char* cB = (const char*)g.Bt + (size_t)cur.pn * tstepB + (size_t)cur.koffB * 2;
    PG8_STAGE(PG8_SB(0, 0), cB, voffB); PG8_STAGE(PG8_SA(0, 0), cA, voffA); PG8_STAGE(PG8_SB(0, 1), cB + hstepB, voffB); PG8_STAGE(PG8_SA(0, 1), cA + hstepA, voffA);
    if (wr == 1) PG8_BAR;
    PG8_WAIT_V(4); PG8_BAR;
    PG8_STAGE(PG8_SB(1, 0), cB + kstep, voffB); PG8_STAGE(PG8_SA(1, 0), cA + kstep, voffA); PG8_STAGE(PG8_SB(1, 1), cB + hstepB + kstep, voffB);
    PG8_WAIT_V(6); PG8_BAR;
    for (;;) {
        const bool has_next = S.next(ui + 1, nxt);
        const char* nA = has_next ? (const char*)g.A + (size_t)nxt.pm * tstepA + (size_t)nxt.koffA * 2 : cA; const char* nB = has_next ? (const char*)g.Bt + (size_t)nxt.pn * tstepB + (size_t)nxt.koffB * 2 : cB;
#pragma clang loop unroll(disable)
        for (int t = 0; t < nt; t += 2) {
            const bool last = (t == nt - 2);
            const char* a1 = cA + (size_t)(t + 1) * kstep;
            const char* a2 = last ? nA : cA + (size_t)(t + 2) * kstep; const char* b2 = last ? nB : cB + (size_t)(t + 2) * kstep;
            const char* a3 = a2 + kstep; const char* b3 = b2 + kstep;
            PG8_LDB(B0, 0, 0); PG8_SCHED; PG8_LDA(At, 0, 0); PG8_STAGE(PG8_SA(1, 1), a1 + hstepA, voffA);
            PG8_WAIT_L(8); PG8_BAR; PG8_WAIT_L(0); PG8_MMA(0, 0, At, B0); PG8_BAR; PG8_SCHED;
            PG8_LDB(B1, 0, 1); PG8_STAGE(PG8_SB(0, 0), b2, voffB);
            PG8_BAR; PG8_WAIT_L(0); PG8_MMA(0, 1, At, B1); PG8_BAR;
            PG8_LDA(At, 0, 1); PG8_STAGE(PG8_SA(0, 0), a2, voffA);
            PG8_BAR; PG8_WAIT_L(0); PG8_MMA(1, 0, At, B0); PG8_BAR; PG8_SCHED;
            PG8_STAGE(PG8_SB(0, 1), b2 + hstepB, voffB);
            PG8_WAIT_V(6); PG8_BAR; PG8_MMA(1, 1, At, B1); PG8_BAR;
            PG8_LDB(B0, 1, 0); PG8_SCHED; PG8_LDA(At, 1, 0); PG8_STAGE(PG8_SA(0, 1), a2 + hstepA, voffA);
            PG8_WAIT_L(8); PG8_BAR; PG8_WAIT_L(0); PG8_MMA(0, 0, At, B0); PG8_BAR; PG8_SCHED;
            PG8_LDB(B1, 1, 1); PG8_STAGE(PG8_SB(1, 0), b3, voffB);
            PG8_BAR; PG8_WAIT_L(0); PG8_MMA(0, 1, At, B1); PG8_BAR;
            PG8_LDA(At, 1, 1); PG8_STAGE(PG8_SA(1, 0), a3, voffA);
            PG8_BAR; PG8_WAIT_L(0); PG8_MMA(1, 0, At, B0); PG8_BAR; PG8_SCHED;
            PG8_STAGE(PG8_SB(1, 1), b3 + hstepB, voffB);
            PG8_WAIT_V(6); PG8_BAR; PG8_MMA(1, 1, At, B1); PG8_BAR;
        }
        if constexpr (!Epi::AFTER_DRAIN) E(acc, cur, wr, wc, fr, fq);
        if (!has_next) break;
#pragma unroll
        for (int a = 0; a < 2; ++a)
#pragma unroll
            for (int b = 0; b < 2; ++b)
#pragma unroll
                for (int m = 0; m < 4; ++m)
#pragma unroll
                    for (int n = 0; n < 2; ++n) acc[a][b][m][n] = (f32x4){0.f, 0.f, 0.f, 0.f};
        cur = nxt; cA = nA; cB = nB; ++ui;
    }
    PG8_WAIT_V(0);
    if (wr == 0) PG8_BAR;
    PG8_BAR;
    if constexpr (Epi::AFTER_DRAIN) E(acc, cur, wr, wc, fr, fq);
#undef PG8_SA
#undef PG8_SB
#undef PG8_STAGE
#undef PG8_LDA
#undef PG8_LDB
#undef PG8_MMA
#undef PG8_WAIT_V
#undef PG8_WAIT_L
#undef PG8_BAR
#undef PG8_SCHED
}
}
using pg8::Unit;

template <int MODE> struct EpiBf16 {
    static constexpr bool PERM = true, AFTER_DRAIN = false;
    bf16_t* O; int ldc; int coff; const float* vec;
    __device__ __forceinline__ void operator()(const f32x4 (&acc)[2][2][4][2], const Unit& u, int wr, int wc, int fr, int fq) const {
        const int row0 = u.pm * 256 + wr * 64 + fr, col0 = coff + u.pn * 256 + wc * 32 + 8 * fq;
#pragma unroll
        for (int bj = 0; bj < 2; ++bj) {
            const int c = col0 + bj * 128;
            f32x4 s0, s1;
            if (MODE == 0) { s0 = vec ? *(const f32x4*)(vec + c) : (f32x4){1.f, 1.f, 1.f, 1.f}; s1 = vec ? *(const f32x4*)(vec + c + 4) : (f32x4){1.f, 1.f, 1.f, 1.f}; }
            else { s0 = *(const f32x4*)(vec + c); s1 = *(const f32x4*)(vec + c + 4); }
#pragma unroll
            for (int ai = 0; ai < 2; ++ai)
#pragma unroll
                for (int m = 0; m < 4; ++m) {
                    f32x4 v0 = acc[ai][bj][m][0], v1 = acc[ai][bj][m][1];
                    if (MODE == 0) { v0 = v0 * s0; v1 = v1 * s1; }
                    else {
#pragma unroll
                        for (int j = 0; j < 4; ++j) { v0[j] = sigmoidf_(v0[j] + s0[j]); v1[j] = sigmoidf_(v1[j] + s1[j]); } }
                    u32x4 w; w.x = pk_bf16(v0[0], v0[1]); w.y = pk_bf16(v0[2], v0[3]); w.z = pk_bf16(v1[0], v1[1]); w.w = pk_bf16(v1[2], v1[3]);
                    *(u32x4*)(O + (size_t)(row0 + ai * 128 + m * 16) * ldc + c) = w;
                }
        }
    }
};
struct EpiP3 {
    static constexpr bool PERM = true, AFTER_DRAIN = false;
    bf16_t* MixO; float* DecO; bf16_t* AO; bf16_t* GO; const float* pscale; const float* w0v; const float* a0v;
    __device__ __forceinline__ void operator()(const f32x4 (&acc)[2][2][4][2], const Unit& u, int wr, int wc, int fr, int fq) const {
        const bool pool = u.pn < 4; const int sgm = (u.pn - 4) >> 2;
        const int mode = pool ? 0 : (sgm == 0 ? 2 : (sgm == 1 ? 1 : 0)), ldc = pool ? D : CW;
        bf16_t* o0 = MixO; bf16_t* o1 = AO; bf16_t* o2 = GO; const float* v0 = pscale; const float* v1 = w0v; const float* v2 = a0v;
        asm volatile("" : "+s"(o0), "+s"(o1), "+s"(o2), "+s"(v0), "+s"(v1), "+s"(v2));
        bf16_t* Ob = pool ? o0 : (sgm == 1 ? o1 : o2); float* Of = DecO;
        const float* vec = pool ? v0 : (sgm == 0 ? v1 : (sgm == 1 ? v2 : (const float*)nullptr));
        const int row0 = u.pm * 256 + wr * 64 + fr, col0 = (pool ? u.pn * 256 : ((u.pn - 4) & 3) * 256) + wc * 32 + 8 * fq;
        const f32x4 one = (f32x4){1.f, 1.f, 1.f, 1.f};
        f32x4 sv[2][2];
#pragma unroll
        for (int bj = 0; bj < 2; ++bj) { sv[bj][0] = vec ? *(const f32x4*)(vec + col0 + bj * 128) : one; sv[bj][1] = vec ? *(const f32x4*)(vec + col0 + bj * 128 + 4) : one; }
#pragma unroll
        for (int bj = 0; bj < 2; ++bj) {
            const int c = col0 + bj * 128;
            const f32x4 s0 = sv[bj][0], s1 = sv[bj][1];
#pragma unroll
            for (int ai = 0; ai < 2; ++ai)
#pragma unroll
                for (int m = 0; m < 4; ++m) {
                    const int row = row0 + ai * 128 + m * 16;
                    f32x4 v0 = acc[ai][bj][m][0], v1 = acc[ai][bj][m][1];
                    if (mode == 0) { v0 = v0 * s0; v1 = v1 * s1; }
                    else if (mode == 1) {
#pragma unroll
                        for (int j = 0; j < 4; ++j) { v0[j] = sigmoidf_(v0[j] + s0[j]); v1[j] = sigmoidf_(v1[j] + s1[j]); } }
                    else {
                        v0 = v0 + s0; v1 = v1 + s1;
#pragma unroll
                        for (int j = 0; j < 4; ++j) {
                            v0[j] = __expf(-0.60653066f * sigmoidf_(v0[j])); v1[j] = __expf(-0.60653066f * sigmoidf_(v1[j])); }
                    }
                    if (mode == 2) { if (row < MV) { float* p = Of + (size_t)row * ldc + c; *(f32x4*)p = v0; *(f32x4*)(p + 4) = v1; } }
                    else { u32x4 w; w.x = pk_bf16(v0[0], v0[1]); w.y = pk_bf16(v0[2], v0[3]); w.z = pk_bf16(v1[0], v1[1]); w.w = pk_bf16(v1[2], v1[3]);
                        *(u32x4*)(Ob + (size_t)row * ldc + c) = w; }
                }
        }
    }
};
struct EpiDecay {
    static constexpr bool PERM = false, AFTER_DRAIN = false;
    float* O; const float* w0;
    __device__ __forceinline__ void operator()(const f32x4 (&acc)[2][2][4][2], const Unit& u, int wr, int wc, int fr, int fq) const {
        const int row0 = u.pm * 256 + wr * 64 + fr, col0 = u.pn * 256 + wc * 32 + 4 * fq;
#pragma unroll
        for (int bj = 0; bj < 2; ++bj)
#pragma unroll
            for (int n = 0; n < 2; ++n) {
                const int c = col0 + bj * 128 + n * 16; const f32x4 b = *(const f32x4*)(w0 + c);
#pragma unroll
                for (int ai = 0; ai < 2; ++ai)
#pragma unroll
                    for (int m = 0; m < 4; ++m) {
                        const int row = row0 + ai * 128 + m * 16; f32x4 v = acc[ai][bj][m][n] + b, o;
#pragma unroll
                        for (int j = 0; j < 4; ++j) { const float z = -v[j]; const float sp = fmaxf(z, 0.f) + __logf(1.0f + __expf(-fabsf(z))); o[j] = __expf(-__expf(-sp - 0.5f)); }
                        if (row < MV) *(f32x4*)(O + (size_t)row * CW + c) = o;
                    }
            }
    }
};
struct EpiOut {
    static constexpr bool PERM = false, AFTER_DRAIN = false;
    const float* xp; const float* xs; float* out; bf16_t* h2; const float* g; float* rowsq;
    __device__ __forceinline__ void operator()(const f32x4 (&acc)[2][2][4][2], const Unit& u, int wr, int wc, int fr, int fq) const {
        const int row0 = u.pm * 256 + wr * 64 + fr, col0 = u.pn * 256 + wc * 32 + 4 * fq;
        f32x4 gg[2][2];
#pragma unroll
        for (int bj = 0; bj < 2; ++bj)
#pragma unroll
            for (int n = 0; n < 2; ++n) gg[bj][n] = *(const f32x4*)(g + col0 + bj * 128 + n * 16);
        f32x4 xv[2][2], xn[2][2];
#define EPIOUT_LOAD(DST, IDX) do { const int row_ = row0 + ((IDX) >> 2) * 128 + ((IDX) & 3) * 16; const bool ok_ = row_ < MV; \
            const float* xr_ = row_ < MPR ? xp + (size_t)row_ * D : xs + (size_t)(ok_ ? row_ - MPR : 0) * D; \
            _Pragma("unroll") for (int bj = 0; bj < 2; ++bj) _Pragma("unroll") for (int n = 0; n < 2; ++n) DST[bj][n] = *(const f32x4*)(xr_ + col0 + bj * 128 + n * 16); } while (0)
        EPIOUT_LOAD(xv, 0);
#pragma unroll
        for (int idx = 0; idx < 8; ++idx) {
            const int ai = idx >> 2, m = idx & 3;
            if (idx + 1 < 8) EPIOUT_LOAD(xn, idx + 1);
            const int row = row0 + ai * 128 + m * 16; const bool ok = row < MV;
            float s = 0.f;
#pragma unroll
            for (int bj = 0; bj < 2; ++bj)
#pragma unroll
                for (int n = 0; n < 2; ++n) {
                    const int c = col0 + bj * 128 + n * 16;
                    f32x4 x1 = acc[ai][bj][m][n];
                    if (ok) { x1 = x1 + xv[bj][n]; *(f32x4*)(out + (size_t)row * D + c) = x1; }
                    s += (x1[0] * x1[0] + x1[1] * x1[1]) + (x1[2] * x1[2] + x1[3] * x1[3]);
                    const f32x4 hv = x1 * gg[bj][n];
                    u32x2 w; w.x = pk_bf16(hv[0], hv[1]); w.y = pk_bf16(hv[2], hv[3]);
                    *(u32x2*)(h2 + (size_t)row * D + c) = w;
                }
            s += __shfl_xor(s, 16); s += __shfl_xor(s, 32);
            if (ok && fq == 0) unsafeAtomicAdd(rowsq + row, s);
#pragma unroll
            for (int bj = 0; bj < 2; ++bj)
#pragma unroll
                for (int n = 0; n < 2; ++n) xv[bj][n] = xn[bj][n];
        }
#undef EPIOUT_LOAD
    }
};
struct EpiGU {
    static constexpr bool PERM = true, AFTER_DRAIN = false;
    bf16_t* U; const float* rowsq;
    __device__ __forceinline__ void operator()(const f32x4 (&acc)[2][2][4][2], const Unit& u, int wr, int wc, int fr, int fq) const {
        const int row0 = u.pm * 256 + wr * 64 + fr, col0 = u.pn * 128 + wc * 32 + 8 * fq;
        float rs[2][4];
#pragma unroll
        for (int ai = 0; ai < 2; ++ai)
#pragma unroll
            for (int m = 0; m < 4; ++m) rs[ai][m] = rowsq[row0 + ai * 128 + m * 16];
#pragma unroll
        for (int ai = 0; ai < 2; ++ai)
#pragma unroll
            for (int m = 0; m < 4; ++m) {
                const int row = row0 + ai * 128 + m * 16;
                const float rstd = rsqrtf(rs[ai][m] * (1.0f / D) + RMS_EPS);
                f32x4 o[2];
#pragma unroll
                for (int n = 0; n < 2; ++n)
#pragma unroll
                    for (int j = 0; j < 4; ++j) { const float gt = acc[ai][0][m][n][j] * rstd, up = acc[ai][1][m][n][j] * rstd; o[n][j] = gt * sigmoidf_(gt) * up; }
                u32x4 w; w.x = pk_bf16(o[0][0], o[0][1]); w.y = pk_bf16(o[0][2], o[0][3]); w.z = pk_bf16(o[1][0], o[1][1]); w.w = pk_bf16(o[1][2], o[1][3]);
                *(u32x4*)(U + (size_t)row * DFF + col0) = w;
            }
    }
};
struct EpiDown {
    static constexpr bool PERM = false, AFTER_DRAIN = false;
    float* out;
    __device__ __forceinline__ void operator()(const f32x4 (&acc)[2][2][4][2], const Unit& u, int wr, int wc, int fr, int fq) const {
        const int row0 = u.pm * 256 + wr * 64 + fr, col0 = u.pn * 256 + wc * 32 + 4 * fq;
#pragma unroll
        for (int ai = 0; ai < 2; ++ai)
#pragma unroll
            for (int m = 0; m < 4; ++m) {
                const int row = row0 + ai * 128 + m * 16;
#pragma unroll
                for (int bj = 0; bj < 2; ++bj)
#pragma unroll
                    for (int n = 0; n < 2; ++n) {
                        const int c = col0 + bj * 128 + n * 16; float* p = out + (size_t)row * D + c;
                        *(f32x4*)p = acc[ai][bj][m][n] + *(const f32x4*)p;
                    }
            }
    }
};
struct EpiDownNorm {
    static constexpr bool PERM = false, AFTER_DRAIN = true;
    float* out; float* rowsq; unsigned* cnt; const float* g;
    __device__ __forceinline__ void operator()(f32x4 (&acc)[2][2][4][2], const Unit& u, int wr, int wc, int fr, int fq) const {
        const int row0 = u.pm * 256 + wr * 64 + fr, col0 = u.pn * 256 + wc * 32 + 4 * fq;
        float chk = 0.f;
        f32x4 xv[2][2], xn[2][2];
#define EPIDN_LOAD(DST, IDX) do { const float* xr_ = out + (size_t)(row0 + ((IDX) >> 2) * 128 + ((IDX) & 3) * 16) * D + col0; \
            _Pragma("unroll") for (int bj = 0; bj < 2; ++bj) _Pragma("unroll") for (int n = 0; n < 2; ++n) DST[bj][n] = *(const f32x4*)(xr_ + bj * 128 + n * 16); } while (0)
        EPIDN_LOAD(xv, 0);
#pragma unroll
        for (int idx = 0; idx < 8; ++idx) {
            const int ai = idx >> 2, m = idx & 3;
            if (idx + 1 < 8) EPIDN_LOAD(xn, idx + 1);
            const int row = row0 + ai * 128 + m * 16; float s = 0.f;
#pragma unroll
            for (int bj = 0; bj < 2; ++bj)
#pragma unroll
                for (int n = 0; n < 2; ++n) {
                    const f32x4 x2 = acc[ai][bj][m][n] + xv[bj][n]; acc[ai][bj][m][n] = x2;
                    s += (x2[0] * x2[0] + x2[1] * x2[1]) + (x2[2] * x2[2] + x2[3] * x2[3]);
                }
            s += __shfl_xor(s, 16); s += __shfl_xor(s, 32);
            if (fq == 0) chk += unsafeAtomicAdd(rowsq + row, s);
#pragma unroll
            for (int bj = 0; bj < 2; ++bj)
#pragma unroll
                for (int n = 0; n < 2; ++n) xv[bj][n] = xn[bj][n];
        }
#undef EPIDN_LOAD
        asm volatile("s_waitcnt vmcnt(0)" :: "v"(chk) : "memory");
        unsigned* pc = cnt + 64 * u.pm;
        if ((threadIdx.x & 63) == 0) __hip_atomic_fetch_add(pc, 1u, __ATOMIC_RELAXED, __HIP_MEMORY_SCOPE_AGENT);
        f32x4 gg[2][2];
#pragma unroll
        for (int bj = 0; bj < 2; ++bj)
#pragma unroll
            for (int n = 0; n < 2; ++n) gg[bj][n] = *(const f32x4*)(g + col0 + bj * 128 + n * 16);
        { unsigned spins = 0; while (__hip_atomic_load(pc, __ATOMIC_RELAXED, __HIP_MEMORY_SCOPE_AGENT) < 64u) { __builtin_amdgcn_s_sleep(2); if (++spins > (1u << 22)) break; } }
        __builtin_amdgcn_fence(__ATOMIC_ACQUIRE, "agent");
        asm volatile("s_waitcnt vmcnt(0)" ::: "memory");
        float rs[2][4];
#pragma unroll
        for (int ai = 0; ai < 2; ++ai)
#pragma unroll
            for (int m = 0; m < 4; ++m) rs[ai][m] = __hip_atomic_load(rowsq + row0 + ai * 128 + m * 16, __ATOMIC_RELAXED, __HIP_MEMORY_SCOPE_AGENT);
#pragma unroll
        for (int ai = 0; ai < 2; ++ai)
#pragma unroll
            for (int m = 0; m < 4; ++m) {
                const int row = row0 + ai * 128 + m * 16;
                const float rstd = rsqrtf(rs[ai][m] * (1.0f / D) + RMS_EPS);
#pragma unroll
                for (int bj = 0; bj < 2; ++bj)
#pragma unroll
                    for (int n = 0; n < 2; ++n) { const int c = col0 + bj * 128 + n * 16; *(f32x4*)(out + (size_t)row * D + c) = acc[ai][bj][m][n] * rstd * gg[bj][n]; }
            }
    }
};
struct EpiPartial {
    static constexpr bool PERM = false, AFTER_DRAIN = false;
    float* buf;
    __device__ __forceinline__ void operator()(const f32x4 (&acc)[2][2][4][2], const Unit& u, int wr, int wc, int fr, int fq) const {
        const int col0 = u.pn * 256 + wc * 32 + 4 * fq;
#pragma unroll
        for (int m = 0; m < 4; ++m) {
            const int lrow = wr * 64 + m * 16 + fr;
            float* p = buf + ((size_t)u.ks * MSA + lrow) * D + col0;
#pragma unroll
            for (int bj = 0; bj < 2; ++bj)
#pragma unroll
                for (int n = 0; n < 2; ++n) *(f32x4*)(p + bj * 128 + n * 16) = acc[0][bj][m][n];
        }
    }
};

template <int RM> __device__ __forceinline__ int rowmap(int n) { return RM == 0 ? n : (RM == 1 ? ((n >> 7) * 256 + (n & 127)) : ((n >> 7) * 256 + 128 + (n & 127))); }
template <int RM>
__device__ __forceinline__ void transpose_bf16(const float* src, int Ksrc, int Nsrc, int ld, bf16_t* dst, int Kdst, int Ndst, int rot, int vgw, int gws) {
    const int lane = threadIdx.x & 63, gw = (vgw + rot) % gws;
    const int nn = Ndst / 64, ntile = nn * (Kdst / 64);
    for (int t = gw; t < ntile; t += gws) {
        const int k0 = (t / nn) * 64, n = (t % nn) * 64 + lane;
        const bool nok = n < Nsrc;
        const float* sp = src + (nok ? n : 0);
        float v[64];
        const float mskn = nok ? 1.f : 0.f;
#pragma unroll
        for (int j = 0; j < 64; ++j) { const int k = k0 + j; v[j] = sp[(size_t)(k < Ksrc ? k : Ksrc - 1) * ld]; }
#pragma unroll
        for (int j = 0; j < 64; ++j) v[j] *= ((k0 + j) < Ksrc ? mskn : 0.f);
        bf16_t* dp = dst + (size_t)rowmap<RM>(n) * Kdst + k0;
#pragma unroll
        for (int q8 = 0; q8 < 8; ++q8) { u32x4 w; w.x = pk_bf16(v[q8 * 8 + 0], v[q8 * 8 + 1]); w.y = pk_bf16(v[q8 * 8 + 2], v[q8 * 8 + 3]); w.z = pk_bf16(v[q8 * 8 + 4], v[q8 * 8 + 5]); w.w = pk_bf16(v[q8 * 8 + 6], v[q8 * 8 + 7]);
            *(u32x4*)(dp + q8 * 8) = w; }
    }
}
template <int CTRL> __device__ __forceinline__ float dpp_(float x) { return __int_as_float(__builtin_amdgcn_update_dpp(0, __float_as_int(x), CTRL, 0xF, 0xF, true)); }
__device__ __forceinline__ float red8(float x) { x += dpp_<0x141>(x); x += dpp_<0xB1>(x); x += dpp_<0x4E>(x); return x; }

template <int W>
__device__ __forceinline__ void pool_block_prompt(const bf16_t* proj, bf16_t* pooled, int b, int t0, int c) {
    float ux[15 + W], uy[15 + W]; unsigned raw[15 + W];
#pragma unroll
    for (int j = 0; j < 15 + W; ++j) {
        const int t = t0 - (W - 1) + j;
        raw[j] = *(const unsigned*)(proj + (size_t)(b * TT + (t < 0 ? 0 : t)) * PJP + c);
    }
#pragma unroll
    for (int j = 0; j < 15 + W; ++j) {
        const int t = t0 - (W - 1) + j; const float zm = t < 0 ? 0.f : 1.f;
        ux[j] = bf2f(raw[j] & 0xffffu) * zm; uy[j] = bf2f(raw[j] >> 16) * zm;
    }
#pragma unroll
    for (int i = 0; i < 16; ++i) {
        const int t = t0 + i; float sx = 0.f, sy = 0.f;
#pragma unroll
        for (int j = 0; j < W; ++j) { sx += ux[i + j]; sy += uy[i + j]; }
        const float inv = 1.0f / (float)(t + 1 < W ? t + 1 : W);
        const float px = sx * inv - ux[i + W - 1], py = sy * inv - uy[i + W - 1];
        *(unsigned*)(pooled + (size_t)(b * TT + t) * XLD + c) = pk_bf16(px, py);
    }
}

__global__ void __launch_bounds__(NTHR) hymba_fwd(Params P) {
    extern __shared__ __attribute__((aligned(16))) unsigned char lds_raw[];
    LAS unsigned char* lds = (LAS unsigned char*)lds_raw;
    const int G = gridDim.x, bid = blockIdx.x, gthreads = G * NTHR, gwaves = G * 8;
#define PHASE_IDS int tid = threadIdx.x; asm volatile("" : "+v"(tid)); const int lane = tid & 63, wave = tid >> 6, gtid = bid * NTHR + tid, gwave = bid * 8 + wave; (void)lane; (void)wave; (void)gtid; (void)gwave;
    unsigned char* ws = P.ws; float* out = P.out;
    const float* x_prompt = P.in[0]; const float* x_sample = P.in[1]; const float* state_pool = P.in[2]; const float* state_shift = P.in[3]; const float* state_wkv = P.in[4];
    const float* norm_mix = P.in[5]; const float* w_in = P.in[6]; const float* w_pool = P.in[7]; const float* pool_scale = P.in[8]; const float* mu_shift = P.in[9];
    const float* w0 = P.in[10]; const float* w2 = P.in[11]; const float* a0 = P.in[12]; const float* a2 = P.in[13]; const float* g2 = P.in[14];
    const float* k_k = P.in[15]; const float* k_a = P.in[16]; const float* r_k = P.in[17]; const float* gn_w = P.in[18]; const float* gn_b = P.in[19];
    const float* w_out = P.in[20]; const float* norm_ffn = P.in[21]; const float* w_gate = P.in[22]; const float* w_up = P.in[23]; const float* w_down = P.in[24]; const float* norm_final = P.in[25];
    bf16_t* WinT = (bf16_t*)(ws + WS_WIN); bf16_t* WoutT = (bf16_t*)(ws + WS_WOUT); bf16_t* WguT = (bf16_t*)(ws + WS_WGU); bf16_t* WdnT = (bf16_t*)(ws + WS_WDN);
    bf16_t* WpoolT = (bf16_t*)(ws + WS_WPOOL); bf16_t* WloraT = (bf16_t*)(ws + WS_WLORA);
    bf16_t* Hb = (bf16_t*)(ws + WS_R1); bf16_t* Xb = (bf16_t*)(ws + WS_R1); bf16_t* H2 = (bf16_t*)(ws + WS_R1);
    bf16_t* Proj = (bf16_t*)(ws + WS_PROJ); bf16_t* Ub = (bf16_t*)(ws + WS_PROJ); bf16_t* Ab = (bf16_t*)(ws + WS_A); bf16_t* Gb = (bf16_t*)(ws + WS_GATE);
    bf16_t* Mix = (bf16_t*)(ws + WS_MIX); float* rowsq1 = (float*)(ws + WS_ROWSQ); float* rowsq2 = rowsq1 + MPAD; unsigned* pcnt = (unsigned*)(ws + WS_PCNT); float* Bonus = (float*)(ws + WS_BONUS);
    unsigned* barctr = (unsigned*)(ws + WS_BAR);
    float* Yb = out + SCR_Y; float* Dec = out + SCR_DEC;
    float* Part6 = (float*)(ws + WS_A);
    float* Part8 = (float*)(ws + WS_R1);
    { LAS unsigned* st0 = (LAS unsigned*)(lds + LDS_ST_OFF); if (threadIdx.x < 2) st0[threadIdx.x] = 0u; }
    __syncthreads();
    const XcdBarrier xbar = xcd_barrier_post(barctr, (volatile LAS unsigned*)(lds + LDS_ST_OFF));
    { LAS unsigned* st0 = (LAS unsigned*)(lds + LDS_ST_OFF);
      if (threadIdx.x == 0) st0[2] = __hip_atomic_fetch_add((unsigned*)(ws + WS_RANK) + 64 * xbar.x, 1u, __ATOMIC_RELAXED, __HIP_MEMORY_SCOPE_AGENT);
      __syncthreads(); }
    const int xrank = (int)((LAS unsigned*)(lds + LDS_ST_OFF))[2];
    int vc = bid;
#ifndef P3SEL
#define P3SEL 15
#endif
#ifndef PHASE_MASK
#define PHASE_MASK 0x3ff
#endif
#define IN(k) (((PHASE_MASK >> (k)) & 1) && (!P.multi || P.phase == (k)))
#define SEAM() do { if (!P.multi) xcd_barrier(xbar); } while (0)

    if (IN(0)) {
        PHASE_IDS
        transpose_bf16<0>(w_in, D, PJ, PJ, WinT, D, PJP, 0, gwave, gwaves);
        for (int g = 0; g < 4; ++g) transpose_bf16<0>(w_pool + (size_t)g * 65536, 256, 256, 256, WpoolT + (size_t)g * 65536, 256, 256, 1280 + g * 16, gwave, gwaves);
        transpose_bf16<0>(w2, 64, CW, CW, WloraT, 256, CW, 1344, gwave, gwaves);
        transpose_bf16<0>(a2, 64, CW, CW, WloraT + (size_t)CW * 256, 256, CW, 1408, gwave, gwaves);
        transpose_bf16<0>(g2, 160, CW, CW, WloraT + (size_t)2 * CW * 256, 256, CW, 1472, gwave, gwaves);
        for (int i = gtid; i < 2 * MPAD; i += gthreads) rowsq1[i] = 0.f;
        f32x4 gmix[8];
#pragma unroll
        for (int i = 0; i < 8; ++i) gmix[i] = *(const f32x4*)(norm_mix + (i * 64 + lane) * 4);
        for (int m = gwave; m < MPAD; m += gwaves) {
            bf16_t* hr = Hb + (size_t)m * D;
            if (m < MV) {
                const float* xr = m < MPR ? x_prompt + (size_t)m * D : x_sample + (size_t)(m - MPR) * D;
                f32x4 v[8]; float s = 0.f;
#pragma unroll
                for (int i = 0; i < 8; ++i) v[i] = *(const f32x4*)(xr + (i * 64 + lane) * 4);
#pragma unroll
                for (int i = 0; i < 8; ++i) s += (v[i][0] * v[i][0] + v[i][1] * v[i][1]) + (v[i][2] * v[i][2] + v[i][3] * v[i][3]);
                s = wsum(s); const float rstd = rsqrtf(s * (1.0f / D) + RMS_EPS);
#pragma unroll
                for (int i = 0; i < 8; ++i) { const int c = (i * 64 + lane) * 4; const f32x4 o = v[i] * rstd * gmix[i];
                    u32x2 w; w.x = pk_bf16(o[0], o[1]); w.y = pk_bf16(o[2], o[3]); *(u32x2*)(hr + c) = w; }
            } else {
#pragma unroll
                for (int i = 0; i < 8; ++i) *(u32x2*)(hr + (i * 64 + lane) * 4) = (u32x2){0u, 0u};
            }
        }
    }
    if (P.multi == 2) cg::this_grid().sync();
    SEAM();
    if (!P.multi && (G & 7) == 0 && xbar.x < 8u) {
        bool even = true;
#pragma unroll
        for (int j = 0; j < 8; ++j) even = even && (xb_ld(&barctr[XB_XCNT(j)]) == (unsigned)(G >> 3));
        if (even && xrank < (G >> 3)) vc = xrank * 8 + (int)xbar.x;
    }

    if (IN(1)) {
        PHASE_IDS
        pg8::Gemm g{Hb, WinT, D, D, D}; pg8::StaticOrder S; S.init(MPAD, PJP, G, vc);
        EpiBf16<0> E{Proj, PJP, 0, nullptr};
        pg8::gemm_phase(lds, g, S, E);
    }
    SEAM();

    if (IN(2)) {
        PHASE_IDS
        for (int rb = bid; rb < MPR / 16; rb += G) {
            const int b = rb >> 7, t0 = (rb & 127) * 16, c = tid * 2, gq = tid >> 7;
            if (gq == 0) pool_block_prompt<2>(Proj, Xb, b, t0, c);
            else if (gq == 1) pool_block_prompt<4>(Proj, Xb, b, t0, c);
            else if (gq == 2) pool_block_prompt<8>(Proj, Xb, b, t0, c);
            else pool_block_prompt<16>(Proj, Xb, b, t0, c);
        }
        for (int b = bid; b < MSA; b += G) {
            const int c = tid * 2, W = 2 << (tid >> 7);
            const unsigned v = *(const unsigned*)(Proj + (size_t)(MPR + b) * PJP + c); const float ux = bf2f(v & 0xffffu), uy = bf2f(v >> 16);
            f32x2 pr[15];
#pragma unroll
            for (int j = 0; j < 15; ++j) pr[j] = *(const f32x2*)(state_pool + ((size_t)b * 15 + j) * PW + c);
            float sx = ux, sy = uy;
#pragma unroll
            for (int j = 1; j < 16; ++j) { const float mk = j < W ? 1.f : 0.f; sx += pr[15 - j][0] * mk; sy += pr[15 - j][1] * mk; }
            const float inv = 1.0f / (float)W;
            *(unsigned*)(Xb + (size_t)(MPR + b) * XLD + c) = pk_bf16(sx * inv - ux, sy * inv - uy);
            float* np = out + OUT_POOLS + (size_t)b * 15 * PW;
#pragma unroll
            for (int j = 0; j < 14; ++j) *(f32x2*)(np + (size_t)j * PW + c) = pr[j + 1];
            *(f32x2*)(np + (size_t)14 * PW + c) = (f32x2){ux, uy};
        }
        {
            constexpr int NIT = MV * 144;
            for (int base = gtid; base < NIT; base += 5 * gthreads) {
                unsigned cv[5], pv[5]; f32x2 mu[5]; int mm[5], cpo[5], sg[5], pcs[5]; bool val[5];
#pragma unroll
                for (int u = 0; u < 5; ++u) {
                    const int idx = base + u * gthreads; val[u] = idx < NIT; const int id2 = val[u] ? idx : 0;
                    const int m = id2 / 144, jp = id2 - m * 144, seg = jp < 32 ? 0 : (jp < 64 ? 1 : 2);
                    const int j = (jp - (seg == 0 ? 0 : (seg == 1 ? 32 : 64))) * 2, pc = (seg == 0 ? 3072 : (seg == 1 ? 3136 : 3200)) + j;
                    mm[u] = m; sg[u] = seg; cpo[u] = seg * 256 + j; pcs[u] = pc;
                    const int mprev = (m >= MPR || (m & (TT - 1)) == 0) ? m : m - 1;
                    cv[u] = *(const unsigned*)(Proj + (size_t)m * PJP + PW + pc);
                    pv[u] = *(const unsigned*)(Proj + (size_t)mprev * PJP + PW + pc);
                    mu[u] = *(const f32x2*)(mu_shift + pc);
                }
#pragma unroll
                for (int u = 0; u < 5; ++u) {
                    const int m = mm[u]; const float cx = bf2f(cv[u] & 0xffffu), cy = bf2f(cv[u] >> 16);
                    const float fm = (m & (TT - 1)) == 0 ? 0.f : 1.f;
                    float px = bf2f(pv[u] & 0xffffu) * fm, py = bf2f(pv[u] >> 16) * fm;
                    if (m >= MPR) { const f32x2 p = *(const f32x2*)(state_shift + (size_t)(m - MPR) * SW + pcs[u]); px = p[0]; py = p[1]; }
                    float vx = cx + (px - cx) * mu[u][0], vy = cy + (py - cy) * mu[u][1];
                    if (sg[u] == 0) { vx = tanhf(vx); vy = tanhf(vy); } else if (sg[u] == 2) { vx = sigmoidf_(vx); vy = sigmoidf_(vy); }
                    if (val[u]) *(unsigned*)(Xb + (size_t)m * XLD + 1024 + cpo[u]) = pk_bf16(vx, vy);
                }
            }
        }
        for (int i = gtid; i < 4 * SW; i += gthreads) { const int b = i / SW, j = i - b * SW; out[OUT_SHIFTP + i] = bf2f(Proj[(size_t)(b * TT + TT - 1) * PJP + PW + j]); }
        for (int i = gtid; i < MSA * SW / 2; i += gthreads) { const int b = i / (SW / 2), j = (i - b * (SW / 2)) * 2; const unsigned v = *(const unsigned*)(Proj + (size_t)(MPR + b) * PJP + PW + j);
            *(f32x2*)(out + OUT_SHIFTS + (size_t)b * SW + j) = (f32x2){bf2f(v & 0xffffu), bf2f(v >> 16)}; }
        for (int i = gtid; i < 4 * 15 * PW; i += gthreads) { const int b = i / (15 * PW), r = i - b * 15 * PW, j = r / PW, c = r - j * PW; out[OUT_POOLP + i] = bf2f(Proj[(size_t)(b * TT + TT - 15 + j) * PJP + c]); }
    }
    SEAM();

    if (IN(3)) {
        PHASE_IDS
        { pg8::Gemm g{Xb, WpoolT, XLD, 256, 256}; pg8::P3Order S{G, vc};
          EpiP3 E{Mix, Dec, Ab, Gb, pool_scale, w0, a0}; pg8::gemm_phase(lds, g, S, E); }
    }
    SEAM();

    if (IN(4)) {
        PHASE_IDS
        LAS float* ldf = (LAS float*)lds;
        constexpr int REC = 392, TB = 32, NPS = TB / 4;
        for (int unit = bid; unit < 256; unit += G) {
            const int s = unit >> 2, b = s >> 4, h = s & 15, q = unit & 3;
            const int wv = __builtin_amdgcn_readfirstlane(tid >> 6);
            if (wv < 2) {
              const int crow = wv * 8 + (lane >> 3), kq = lane & 7; const bool first8 = kq == 0;
              f32x2 S2[4];
#pragma unroll
              for (int e = 0; e < 4; ++e) S2[e] = (f32x2){0.f, 0.f};
              const LAS float* recq0 = ldf + kq * 8; const LAS float* recv0 = ldf + 320 + q * 16 + crow;
              float* yp = Yb + (size_t)(b * TT + 7 - kq) * CW + h * 64 + q * 16 + crow;
              __builtin_amdgcn_s_setprio(3);
              WG_BAR();
              for (int blk = 0; blk < TT / TB; ++blk) {
                    const int bo = (blk & 1) * (TB * REC);
                    const LAS float* recq = recq0 + bo; const LAS float* recv = recv0 + bo; const LAS float* recs = ldf + bo + 384;
#define LDSTEP(o_, A0, A1, B0, B1, D0, D1, K0, K1, W0, W1, VV, SC) do { A0 = *(const LAS f32x4*)(recq + (o_)); A1 = *(const LAS f32x4*)(recq + (o_) + 4); B0 = *(const LAS f32x4*)(recq + (o_) + 64); B1 = *(const LAS f32x4*)(recq + (o_) + 68); \
                        D0 = *(const LAS f32x4*)(recq + (o_) + 128); D1 = *(const LAS f32x4*)(recq + (o_) + 132); K0 = *(const LAS f32x4*)(recq + (o_) + 192); K1 = *(const LAS f32x4*)(recq + (o_) + 196); \
                        W0 = *(const LAS f32x4*)(recq + (o_) + 256); W1 = *(const LAS f32x4*)(recq + (o_) + 260); VV = recv[(o_)]; SC = *(const LAS f32x2*)(recs + (o_)); } while (0)
                    f32x4 av0, av1, bv0, bv1, dw0, dw1, kt0, kt1, wr0, wr1; float vv; f32x2 sc;
                    f32x4 nav0, nav1, nbv0, nbv1, ndw0, ndw1, nkt0, nkt1, nwr0, nwr1; float nvv; f32x2 nsc;
                    f32x4 a0, a1, b0, b1, d0, d1, k0, k1, w0_, w1_; float vv_; f32x2 sc_;
                    LDSTEP(0, a0, a1, b0, b1, d0, d1, k0, k1, w0_, w1_, vv_, sc_);
                    LDSTEP(REC, av0, av1, bv0, bv1, dw0, dw1, kt0, kt1, wr0, wr1, vv, sc);
                    float yacc = 0.f;
#pragma unroll
                    for (int st = 0; st < TB; ++st) {
                        if (st + 2 < TB) LDSTEP((st + 2) * REC, nav0, nav1, nbv0, nbv1, ndw0, ndw1, nkt0, nkt1, nwr0, nwr1, nvv, nsc);
                        __builtin_amdgcn_sched_barrier(0);
                        const f32x2 pa = pkfma_(S2[3], hi2(a1), pkfma_(S2[2], lo2(a1), pkfma_(S2[1], hi2(a0), pkmul_(S2[0], lo2(a0)))));
                        const f32x2 py = pkfma_(S2[3], hi2(w1_), pkfma_(S2[2], lo2(w1_), pkfma_(S2[1], hi2(w0_), pkmul_(S2[0], lo2(w0_)))));
                        float da = pa[0] + pa[1], dy = py[0] + py[1];
                        da = red8(da); dy = red8(dy);
                        const float y = dy + da * sc_[0] + vv_ * sc_[1];
                        { f32x2 dab, vvb; dab[0] = da; dab[1] = da; vvb[0] = vv_; vvb[1] = vv_;
                          S2[0] = pkfma_b(lo2(k0), vvb, pkfma_b(lo2(b0), dab, pkmul_(S2[0], lo2(d0)))); S2[1] = pkfma_b(hi2(k0), vvb, pkfma_b(hi2(b0), dab, pkmul_(S2[1], hi2(d0))));
                          S2[2] = pkfma_b(lo2(k1), vvb, pkfma_b(lo2(b1), dab, pkmul_(S2[2], lo2(d1)))); S2[3] = pkfma_b(hi2(k1), vvb, pkfma_b(hi2(b1), dab, pkmul_(S2[3], hi2(d1)))); }
                        const float sh = __int_as_float(__builtin_amdgcn_update_dpp(__float_as_int(y), __float_as_int(yacc), 0x111, 0xF, 0xF, false));
                        yacc = first8 ? y : sh;
                        if ((st & 7) == 7) yp[(size_t)(blk * TB + (st - 7)) * CW] = yacc;
                        a0 = av0; a1 = av1; b0 = bv0; b1 = bv1; d0 = dw0; d1 = dw1; k0 = kt0; k1 = kt1; w0_ = wr0; w1_ = wr1; vv_ = vv; sc_ = sc;
                        av0 = nav0; av1 = nav1; bv0 = nbv0; bv1 = nbv1; dw0 = ndw0; dw1 = ndw1; kt0 = nkt0; kt1 = nkt1; wr0 = nwr0; wr1 = nwr1; vv = nvv; sc = nsc;
                        asm volatile("" ::: "memory");
                    }
#undef LDSTEP
                    WG_BAR();
              }
              __builtin_amdgcn_s_setprio(0);
              float* so = out + OUT_WKVP + ((size_t)(b * NH + h) * 64 + q * 16 + crow) * 64 + kq * 8;
              *(f32x4*)so = (f32x4){S2[0][0], S2[0][1], S2[1][0], S2[1][1]}; *(f32x4*)(so + 4) = (f32x4){S2[2][0], S2[2][1], S2[3][0], S2[3][1]};
            } else if (wv == 4 || wv == 5) {
              constexpr int CT_PER = 5632, CT_ALL = 3 * CT_PER + 2048;
              float cvv[32]; int ctile = unit * 2 + (wv - 4), cph = 0;
#define CONV_LOAD16(P0_) do { if (ctile < CT_ALL) { const int m_ = ctile / CT_PER, r_ = ctile - m_ * CT_PER; const float* sp_; unsigned ld_; \
                    if (m_ < 2) { sp_ = (m_ == 0 ? w_gate : w_up) + (size_t)((r_ / 88) * 32) * DFF + (r_ % 88) * 64; ld_ = DFF; } \
                    else { sp_ = (m_ == 2 ? w_down : w_out) + (size_t)((r_ >> 5) * 32) * D + (r_ & 31) * 64; ld_ = D; } \
                    _Pragma("unroll") for (int j_ = (P0_); j_ < (P0_) + 16; ++j_) cvv[j_] = sp_[(unsigned)j_ * ld_ + lane]; } } while (0)
#define CONV_STORE() do { if (ctile < CT_ALL) { const int m_ = ctile / CT_PER, r_ = ctile - m_ * CT_PER; bf16_t* dp_; \
                    if (m_ < 2) { const int k0_ = (r_ / 88) * 32, n_ = (r_ % 88) * 64 + lane; dp_ = WguT + (size_t)((n_ >> 7) * 256 + (m_ == 1 ? 128 : 0) + (n_ & 127)) * D + k0_; } \
                    else { const int k0_ = (r_ >> 5) * 32, n_ = (r_ & 31) * 64 + lane; dp_ = m_ == 2 ? WdnT + (size_t)n_ * DFF + k0_ : WoutT + (size_t)n_ * D + k0_; } \
                    _Pragma("unroll") for (int q8_ = 0; q8_ < 4; ++q8_) { u32x4 w_; w_.x = pk_bf16(cvv[q8_ * 8 + 0], cvv[q8_ * 8 + 1]); w_.y = pk_bf16(cvv[q8_ * 8 + 2], cvv[q8_ * 8 + 3]); \
                        w_.z = pk_bf16(cvv[q8_ * 8 + 4], cvv[q8_ * 8 + 5]); w_.w = pk_bf16(cvv[q8_ * 8 + 6], cvv[q8_ * 8 + 7]); *(u32x4*)(dp_ + q8_ * 8) = w_; } \
                    ctile += 512; } } while (0)
              WG_BAR();
              for (int blk = 0; blk < TT / TB; ++blk) {
#pragma unroll
                for (int tk = 0; tk < 2; ++tk) {
                  if (cph == 0) CONV_LOAD16(0); else if (cph == 1) CONV_LOAD16(16); else CONV_STORE();
                  cph = cph == 2 ? 0 : cph + 1;
                }
                WG_BAR();
              }
              while (ctile < CT_ALL) {
                if (cph <= 0) CONV_LOAD16(0);
                if (cph <= 1) CONV_LOAD16(16);
                CONV_STORE(); cph = 0;
              }
#undef CONV_LOAD16
#undef CONV_STORE
            } else {
              const int pw = (wv & 1) + ((wv >> 2) << 1), ch = h * 64 + lane;
              const float c_kk = k_k[ch], c_ka = k_a[ch], c_rk = r_k[ch], mu_r = mu_shift[ch], mu_k = mu_shift[CW + ch], mu_v = mu_shift[2 * CW + ch];
              const bf16_t* pbase = Proj + (size_t)(b * TT) * PJP + PW + h * 64; const float* dbase = Dec + (size_t)(b * TT) * CW + h * 64; const bf16_t* abase = Ab + (size_t)(b * TT) * CW + h * 64;
              constexpr int PD = 2;
              unsigned short rr[PD][NPS + 1], kr_[PD][NPS + 1], vr[PD][NPS + 1], aa[PD][NPS]; float dd[PD][NPS];
#define SCAN_LOAD(blk, SET) do { const int t0_ = (blk) * TB + pw * NPS; \
            _Pragma("unroll") for (int i_ = 0; i_ < NPS + 1; ++i_) { const unsigned t_ = (unsigned)((i_ == 0 && t0_ == 0) ? 0 : t0_ - 1 + i_); const bf16_t* pp_ = pbase + t_ * (unsigned)PJP; \
                rr[SET][i_] = pp_[lane]; kr_[SET][i_] = pp_[CW + lane]; vr[SET][i_] = pp_[2 * CW + lane]; } \
            _Pragma("unroll") for (int i_ = 0; i_ < NPS; ++i_) { const unsigned mi_ = (unsigned)(t0_ + i_) * (unsigned)CW; dd[SET][i_] = dbase[mi_ + lane]; aa[SET][i_] = abase[mi_ + lane]; } } while (0)
#define SCAN_PRODUCE(blk, SET) do { LAS float* bufp_ = ldf + ((blk) & 1) * (TB * REC); const int t0_ = (blk) * TB + pw * NPS; \
            _Pragma("unroll") for (int i_ = 0; i_ < NPS; ++i_) { \
                const float zz_ = (i_ == 0 && t0_ == 0) ? 0.f : 1.f; \
                const float rc_ = bf2f(rr[SET][i_ + 1]), kc_ = bf2f(kr_[SET][i_ + 1]), vc_ = bf2f(vr[SET][i_ + 1]), rp_ = bf2f(rr[SET][i_]) * zz_, kp_ = bf2f(kr_[SET][i_]) * zz_, vp_ = bf2f(vr[SET][i_]) * zz_; \
                const float r_ = rc_ + (rp_ - rc_) * mu_r, k_ = kc_ + (kp_ - kc_) * mu_k, v_ = vc_ + (vp_ - vc_) * mu_v; \
                const float a_ = bf2f(aa[SET][i_]), d_ = dd[SET][i_]; \
                const float kkr_ = k_ * c_kk; const float n2_ = wsum(kkr_ * kkr_); const float kk_ = kkr_ * rsqrtf(fmaxf(n2_, 1e-24f)); \
                const float kt_ = k_ * (1.0f + (a_ - 1.0f) * c_ka); const float bv_ = kk_ * a_; \
                const float br_ = wsum(bv_ * r_), krs_ = wsum(kt_ * r_), bon_ = wsum(r_ * kt_ * c_rk); \
                LAS float* rec_ = bufp_ + (pw * NPS + i_) * REC; \
                rec_[lane] = -kk_; rec_[64 + lane] = bv_; rec_[128 + lane] = d_; rec_[192 + lane] = kt_; rec_[256 + lane] = d_ * r_; rec_[320 + lane] = v_; \
                if (lane == 0) { rec_[384] = br_; rec_[385] = krs_; if (q == 0) Bonus[(size_t)(b * TT + t0_ + i_) * NH + h] = bon_; } } } while (0)
              SCAN_LOAD(0, 0); SCAN_LOAD(1, 1);
              SCAN_PRODUCE(0, 0); SCAN_LOAD(2, 0);
              WG_BAR();
              static_assert((TT / TB) % PD == 0 && PD == 2, "block loop is unrolled by PD = 2");
              for (int blk0 = 0; blk0 < TT / TB; blk0 += PD) {
#define SCAN_ITER(D_, SET) do { const int blk = blk0 + (D_); if (blk + 1 < TT / TB) { SCAN_PRODUCE(blk + 1, SET); if (blk + 1 + PD < TT / TB) SCAN_LOAD(blk + 1 + PD, SET); } WG_BAR(); } while (0)
                SCAN_ITER(0, 1); SCAN_ITER(1, 0);
#undef SCAN_ITER
              }
            }
#undef SCAN_LOAD
#undef SCAN_PRODUCE
        }
        __syncthreads();
        LAS float* wl = ldf + wave * 512;
        for (int p = gwave; p < MSA * NH; p += gwaves) {
            const int b = p >> 4, h = p & 15, m = MPR + b, ch = h * 64 + lane;
            const bf16_t* pp = Proj + (size_t)m * PJP + PW + ch; const float* sp = state_shift + (size_t)b * SW + ch;
            const float rc = bf2f(pp[0]), kc = bf2f(pp[CW]), vc = bf2f(pp[2 * CW]);
            const float r = rc + (sp[0] - rc) * mu_shift[ch], k = kc + (sp[CW] - kc) * mu_shift[CW + ch], v = vc + (sp[2 * CW] - vc) * mu_shift[2 * CW + ch];
            const float d = Dec[(size_t)m * CW + ch], a = bf2f(Ab[(size_t)m * CW + ch]);
            const float kkr = k * k_k[ch]; const float n2 = wsum(kkr * kkr); const float kk = kkr * rsqrtf(fmaxf(n2, 1e-24f));
            const float kt = k * (1.0f + (a - 1.0f) * k_a[ch]);
            const float bon = wsum(r * kt * r_k[ch]);
            wl[lane] = -kk; wl[64 + lane] = kk * a; wl[128 + lane] = d; wl[192 + lane] = kt; wl[256 + lane] = r; wl[320 + lane] = v;
            asm volatile("s_waitcnt lgkmcnt(0)" ::: "memory");
            const int kq = lane & 15, r4 = lane >> 4;
            const f32x4 av = *(const LAS f32x4*)(wl + kq * 4), bv = *(const LAS f32x4*)(wl + 64 + kq * 4), dw = *(const LAS f32x4*)(wl + 128 + kq * 4);
            const f32x4 ktv = *(const LAS f32x4*)(wl + 192 + kq * 4), rv = *(const LAS f32x4*)(wl + 256 + kq * 4);
            const float* sin_ = state_wkv + (size_t)(b * NH + h) * 4096; float* sout = out + OUT_WKVS + (size_t)(b * NH + h) * 4096;
            f32x4 Sall[16];
#pragma unroll
            for (int j = 0; j < 16; ++j) Sall[j] = *(const f32x4*)(sin_ + (r4 + 4 * j) * 64 + kq * 4);
            const float gnw_ = gn_w[ch], gnb_ = gn_b[ch], gate_ = bf2f(Gb[(size_t)m * CW + ch]);
#pragma unroll
            for (int j = 0; j < 16; ++j) {
                const int row = r4 + 4 * j; f32x4 Sv = Sall[j];
                float da = (Sv[0] * av[0] + Sv[1] * av[1]) + (Sv[2] * av[2] + Sv[3] * av[3]); da = red16(da);
                const float vv = wl[320 + row];
                Sv = Sv * dw + da * bv + vv * ktv;
                *(f32x4*)(sout + row * 64 + kq * 4) = Sv;
                float dy = (Sv[0] * rv[0] + Sv[1] * rv[1]) + (Sv[2] * rv[2] + Sv[3] * rv[3]); dy = red16(dy);
                if (kq == 0) wl[384 + row] = dy;
            }
            asm volatile("s_waitcnt lgkmcnt(0)" ::: "memory");
            const float y = wl[384 + lane];
            const float mean = wsum(y) * (1.0f / 64.0f); const float dl = y - mean; const float var = wsum(dl * dl) * (1.0f / 64.0f);
            const float yn = dl * rsqrtf(var + GN_EPS) * gnw_ + gnb_;
            const float o = (yn + bon * v) * gate_;
            Mix[(size_t)m * D + PW + ch] = (bf16_t)f2bf(o);
            asm volatile("s_waitcnt lgkmcnt(0)" ::: "memory");
        }
    }
    SEAM();

    if (IN(5)) {
        PHASE_IDS
        { pg8::Gemm g{Mix, WoutT, D, D, 256}; pg8::SplitKOrder S{8, KS6, 32, 256, G, (vc + G - 192 % G) % G};
          EpiPartial E{Part6}; pg8::gemm_phase(lds, g, S, E); }
        {
            const int half = gwave & 1, ch0 = half * 512 + lane * 8, h = ch0 >> 6;
            const f32x4 mu0 = *(const f32x4*)(mu_shift + 2 * CW + ch0), mu1 = *(const f32x4*)(mu_shift + 2 * CW + ch0 + 4);
            const f32x4 gw0 = *(const f32x4*)(gn_w + ch0), gw1 = *(const f32x4*)(gn_w + ch0 + 4), gb0 = *(const f32x4*)(gn_b + ch0), gb1 = *(const f32x4*)(gn_b + ch0 + 4);
            for (int it0 = gwave; it0 < MPR * 2; it0 += 4 * gwaves) {
                f32x4 y0[4], y1[4]; u32x4 vc[4], vp[4], gt[4]; float bon[4]; int mm[4]; bool val[4];
#pragma unroll
                for (int u = 0; u < 4; ++u) {
                    const int it = it0 + u * gwaves; val[u] = it < MPR * 2; const int m = val[u] ? (it >> 1) : 0; mm[u] = m;
                    const int mprev = (m & (TT - 1)) ? m - 1 : m;
                    y0[u] = *(const f32x4*)(Yb + (size_t)m * CW + ch0); y1[u] = *(const f32x4*)(Yb + (size_t)m * CW + ch0 + 4);
                    vc[u] = *(const u32x4*)(Proj + (size_t)m * PJP + PW + 2 * CW + ch0); vp[u] = *(const u32x4*)(Proj + (size_t)mprev * PJP + PW + 2 * CW + ch0);
                    gt[u] = *(const u32x4*)(Gb + (size_t)m * CW + ch0); bon[u] = Bonus[(size_t)m * NH + h];
                }
#pragma unroll
                for (int u = 0; u < 4; ++u) {
                    const int m = mm[u]; const float fm = (m & (TT - 1)) == 0 ? 0.f : 1.f;
                    float y[8] = {y0[u][0], y0[u][1], y0[u][2], y0[u][3], y1[u][0], y1[u][1], y1[u][2], y1[u][3]};
                    float s = ((y[0] + y[1]) + (y[2] + y[3])) + ((y[4] + y[5]) + (y[6] + y[7])); s = red8(s);
                    const float mean = s * (1.0f / 64.0f); float q2 = 0.f;
#pragma unroll
                    for (int j = 0; j < 8; ++j) { y[j] -= mean; q2 += y[j] * y[j]; }
                    q2 = red8(q2); const float rstd = rsqrtf(q2 * (1.0f / 64.0f) + GN_EPS);
                    unsigned ow[4];
#pragma unroll
                    for (int j2 = 0; j2 < 4; ++j2) {
                        float o2[2];
#pragma unroll
                        for (int e = 0; e < 2; ++e) {
                            const int j = j2 * 2 + e; const unsigned cw = vc[u][j2], pw_ = vp[u][j2], gw_ = gt[u][j2];
                            const float c_ = e ? bf2f(cw >> 16) : bf2f(cw & 0xffffu), p_ = fm * (e ? bf2f(pw_ >> 16) : bf2f(pw_ & 0xffffu)), g_ = e ? bf2f(gw_ >> 16) : bf2f(gw_ & 0xffffu);
                            const float mu_ = j < 4 ? mu0[j & 3] : mu1[j & 3], gnw = j < 4 ? gw0[j & 3] : gw1[j & 3], gnb = j < 4 ? gb0[j & 3] : gb1[j & 3];
                            const float v = c_ + (p_ - c_) * mu_;
                            o2[e] = (y[j] * rstd * gnw + gnb + bon[u] * v) * g_;
                        }
                        ow[j2] = pk_bf16(o2[0], o2[1]);
                    }
                    if (val[u]) *(u32x4*)(Mix + (size_t)m * D + PW + ch0) = (u32x4){ow[0], ow[1], ow[2], ow[3]};
                }
            }
        }
    }
    SEAM();

    if (IN(6)) {
        PHASE_IDS
        pg8::Gemm g{Mix, WoutT, D, D, D}; pg8::StaticOrder S; S.init(MPR, D, G, vc);
        EpiOut E{x_prompt, x_sample, out, H2, norm_ffn, rowsq1};
        pg8::gemm_phase(lds, g, S, E);
        for (int it = gwave; it < MSA * 8; it += gwaves) {
            const int r = it >> 3, c = ((it & 7) * 64 + lane) * 4, row = MPR + r;
            f32x4 x1 = *(const f32x4*)(x_sample + (size_t)r * D + c); f32x4 pp[KS6];
#pragma unroll
            for (int ks = 0; ks < KS6; ++ks) pp[ks] = *(const f32x4*)(Part6 + ((size_t)ks * MSA + r) * D + c);
            const f32x4 gv = *(const f32x4*)(norm_ffn + c);
#pragma unroll
            for (int ks = 0; ks < KS6; ++ks) x1 = x1 + pp[ks];
            *(f32x4*)(out + (size_t)row * D + c) = x1;
            const f32x4 hv = x1 * gv; u32x2 w; w.x = pk_bf16(hv[0], hv[1]); w.y = pk_bf16(hv[2], hv[3]); *(u32x2*)(H2 + (size_t)row * D + c) = w;
            const float sq = wsum((x1[0] * x1[0] + x1[1] * x1[1]) + (x1[2] * x1[2] + x1[3] * x1[3]));
            if (lane == 0) unsafeAtomicAdd(rowsq1 + row, sq);
        }
    }
    SEAM();

    if (IN(7)) {
        PHASE_IDS
        pg8::Gemm g{H2, WguT, D, D, D}; pg8::StaticOrder S; S.init(MPAD, 2 * DFF, G, vc);
        EpiGU E{Ub, rowsq1};
        pg8::gemm_phase(lds, g, S, E);
    }
    SEAM();

    if (IN(8)) {
        PHASE_IDS
        if (G == 256) { pg8::Gemm g{Ub, WdnT, DFF, DFF, DFF}; pg8::StaticOrder S; S.init(MPR, D, G, vc);
          EpiDownNorm E{out, rowsq2, pcnt, norm_final}; pg8::gemm_phase(lds, g, S, E); }
        else { pg8::Gemm g{Ub, WdnT, DFF, DFF, DFF}; pg8::StaticOrder S; S.init(MPR, D, G, vc);
          EpiDown E{out}; pg8::gemm_phase(lds, g, S, E); }
        { pg8::Gemm g{Ub, WdnT, DFF, DFF, 512}; pg8::SplitKOrder S{8, KS8, 32, 512, G, vc};
          EpiPartial E{Part8}; pg8::gemm_phase(lds, g, S, E); }
    }
    SEAM();

    if (IN(9)) {
        PHASE_IDS
        for (int row = (G == 256 ? MPR : 0) + gwave; row < MV; row += gwaves) {
            float* p = out + (size_t)row * D; f32x4 v[8]; float s = 0.f;
#pragma unroll
            for (int i = 0; i < 8; ++i) v[i] = *(const f32x4*)(p + (i * 64 + lane) * 4);
            if (row >= MPR) {
#pragma unroll
                for (int i = 0; i < 8; ++i)
#pragma unroll
                    for (int ks = 0; ks < KS8; ++ks) v[i] = v[i] + *(const f32x4*)(Part8 + ((size_t)ks * MSA + (row - MPR)) * D + (i * 64 + lane) * 4);
            }
#pragma unroll
            for (int i = 0; i < 8; ++i) s += (v[i][0] * v[i][0] + v[i][1] * v[i][1]) + (v[i][2] * v[i][2] + v[i][3] * v[i][3]);
            s = wsum(s); const float rstd = rsqrtf(s * (1.0f / D) + RMS_EPS);
#pragma unroll
            for (int i = 0; i < 8; ++i) { const int c = (i * 64 + lane) * 4; *(f32x4*)(p + c) = v[i] * rstd * *(const f32x4*)(norm_final + c); }
        }
    }
#undef IN
#undef SEAM
}

#ifndef HY_MULTI
#define HY_MULTI 0
#endif
#ifndef HY_REP
#define HY_REP 0
#endif
extern "C" void kernel_launch(void* const* d_in, const int* in_sizes, int n_in, void* d_out, int out_size, void* d_ws, size_t ws_size, hipStream_t stream) {
    static int grid = 0;
    if (grid == 0) {
        if (n_in != 26 || ws_size < WS_END) { fprintf(stderr, "kernel_launch: need 26 inputs and >= %zu bytes of workspace (got %d, %zu)\n", (size_t)WS_END, n_in, ws_size); grid = -1; return; }
        int dev = 0, cus = 0, per_cu = 0;
        hipGetDevice(&dev); hipDeviceGetAttribute(&cus, hipDeviceAttributeMultiprocessorCount, dev);
        if (hipFuncSetAttribute((const void*)hymba_fwd, hipFuncAttributeMaxDynamicSharedMemorySize, LDS_BYTES) != hipSuccess) { fprintf(stderr, "kernel_launch: hipFuncSetAttribute failed\n"); grid = -1; return; }
        if (hipOccupancyMaxActiveBlocksPerMultiprocessor(&per_cu, (const void*)hymba_fwd, NTHR, LDS_BYTES) != hipSuccess || per_cu < 1) { fprintf(stderr, "kernel_launch: occupancy query says %d\n", per_cu); per_cu = 1; }
        (void)hipGetLastError();
        grid = cus;
        if (grid > 256) grid = 256;
    }
    if (grid < 0) return;
    Params p{};
    for (int i = 0; i < 26; ++i) p.in[i] = (const float*)d_in[i];
    p.out = (float*)d_out; p.ws = (unsigned char*)d_ws;
#if HY_MULTI
    p.multi = 1;
    for (int ph = 0; ph < 10; ++ph) { p.phase = ph; for (int r = 0; r < ((HY_REP >> ph) & 1) + 1; ++r) hipLaunchKernelGGL(hymba_fwd, dim3(grid), dim3(NTHR), LDS_BYTES, stream, p); }
#else
    p.multi = 0; p.phase = 0;
    hipMemsetAsync((char*)d_ws + WS_BAR, 0, 16384 + 8192 + 4096, stream);
    void* args[] = {&p};
    hipError_t e = hipLaunchCooperativeKernel((const void*)hymba_fwd, dim3(grid), dim3(NTHR), args, LDS_BYTES, stream);
    if (e != hipSuccess) fprintf(stderr, "cooperative launch failed: %s (grid %d)\n", hipGetErrorString(e), grid);
#endif
}
```
